# Optimizing an MI355X kernel written in HIP

```python
import jax, jax.numpy as jnp
from jax import lax
import numpy as np

D_MODEL = 1024
BATCH = 8
SEQ = 4096
DEPTH = 2

HEAD_DIM = 64
FOX_HEADS = 8
FOX_W = FOX_HEADS * HEAD_DIM
RWKV_HEADS = 4
RWKV_W = RWKV_HEADS * HEAD_DIM
POOL_GROUPS = 4
POOL_GROUP_DIM = 64
POOL_W = POOL_GROUPS * POOL_GROUP_DIM
POOL_WINDOWS = (2, 4, 8, 16)
D_MIX = FOX_W + RWKV_W + POOL_W
RWKV_DECAY_RANK = 64
RWKV_ICL_RANK = 64
RWKV_SHIFT_W = 3 * RWKV_W + RWKV_DECAY_RANK + RWKV_ICL_RANK
Q_BLOCK = 128
NORM_EPS = 1e-6
RWKV_GN_EPS = 64e-5
DECAY_SCALE = float(np.exp(-0.5))
IN_SPLITS = (FOX_W, FOX_W, FOX_W, FOX_HEADS, RWKV_SHIFT_W, POOL_W, D_MIX)
D_IN = int(sum(IN_SPLITS))
IN_IDX = [int(i) for i in np.cumsum(IN_SPLITS)[:-1]]
RWKV_IDX = [int(i) for i in np.cumsum((RWKV_W, RWKV_W, RWKV_W, RWKV_DECAY_RANK))]

kernel_name = "hymba_fox_rwkv7_pool_adaln"


def rms_norm(z, g):
    zf = z.astype(jnp.float32)
    y = zf * lax.rsqrt(jnp.mean(zf * zf, axis=-1, keepdims=True) + NORM_EPS)
    return (y * g.astype(jnp.float32)).astype(z.dtype)


def token_shift(z):
    return jnp.pad(z, ((0, 0), (1, 0), (0, 0)))[:, :-1]


def fox_attention(q, k, v, f_logit, q_gain, k_gain, f_bias):
    B, S, _ = q.shape

    def heads(z):
        return z.reshape(B, S, FOX_HEADS, HEAD_DIM).transpose(0, 2, 1, 3)

    qh = rms_norm(heads(q), q_gain).astype(jnp.float32) * (HEAD_DIM ** -0.5)
    kh = rms_norm(heads(k), k_gain).astype(jnp.float32)
    vh = heads(v).astype(jnp.float32)
    log_f = jax.nn.log_sigmoid((f_logit + f_bias).astype(jnp.float32))
    cum = jnp.cumsum(log_f, axis=1).transpose(0, 2, 1)
    outs = []
    for i in range(S // Q_BLOCK):
        q0 = i * Q_BLOCK
        L = q0 + Q_BLOCK
        s = jnp.einsum('bhqd,bhkd->bhqk', qh[:, :, q0:L], kh[:, :, :L])
        s = s + cum[:, :, q0:L, None] - cum[:, :, None, :L]
        causal = jnp.arange(L)[None, :] <= (q0 + jnp.arange(Q_BLOCK))[:, None]
        p = jax.nn.softmax(jnp.where(causal, s, -jnp.inf), axis=-1)
        outs.append(jnp.einsum('bhqk,bhkd->bhqd', p, vh[:, :, :L]))
    o = jnp.concatenate(outs, axis=2)
    return o.transpose(0, 2, 1, 3).reshape(B, S, FOX_W).astype(q.dtype)


def rwkv7_time_mix(z, mu, w0, w2, a0, a2, k_k, k_a, r_k, ln_g, ln_b):
    B, S, _ = z.shape
    zf = z.astype(jnp.float32)
    zf = zf + (token_shift(zf) - zf) * mu.astype(jnp.float32)
    r, k, v, wd, ad = jnp.split(zf, RWKV_IDX, axis=-1)
    log_w = -DECAY_SCALE * jax.nn.sigmoid(w0 + jnp.tanh(wd) @ w2)
    a = jax.nn.sigmoid(a0 + ad @ a2)
    kk = (k * k_k).reshape(B, S, RWKV_HEADS, HEAD_DIM)
    kk = kk / jnp.maximum(jnp.linalg.norm(kk, axis=-1, keepdims=True), 1e-12)
    k = k * (1.0 + (a - 1.0) * k_a)

    def hd(t):
        return t.reshape(B, S, RWKV_HEADS, HEAD_DIM)

    rh, kh, vh, ah = hd(r), hd(k), hd(v), hd(a)
    wh = jnp.exp(hd(log_w))
    xs = tuple(t.transpose(1, 0, 2, 3) for t in (rh, wh, kh, vh, kk, ah))

    def step(state, inp):
        r_t, w_t, k_t, v_t, kk_t, a_t = inp
        sa = jnp.einsum('bhij,bhj->bhi', state, -kk_t)
        state = (state * w_t[:, :, None, :]
                 + sa[..., :, None] * (kk_t * a_t)[:, :, None, :]
                 + v_t[..., :, None] * k_t[:, :, None, :])
        return state, jnp.einsum('bhij,bhj->bhi', state, r_t)

    state0 = jnp.zeros((B, RWKV_HEADS, HEAD_DIM, HEAD_DIM), jnp.float32)
    _, o = lax.scan(step, state0, xs)
    o = o.transpose(1, 0, 2, 3)
    mean = jnp.mean(o, axis=-1, keepdims=True)
    var = jnp.mean(jnp.square(o - mean), axis=-1, keepdims=True)
    o = ((o - mean) * lax.rsqrt(var + RWKV_GN_EPS)).reshape(B, S, RWKV_W) * ln_g + ln_b
    bonus = jnp.sum(rh * kh * r_k, axis=-1, keepdims=True) * vh
    return (o + bonus.reshape(B, S, RWKV_W)).astype(z.dtype)


def trailing_mean(z, w):
    S = z.shape[1]
    cs = jnp.pad(jnp.cumsum(z, axis=1), ((0, 0), (1, 0), (0, 0)))
    upper = cs[:, 1:]
    lower = jnp.pad(cs, ((0, 0), (w - 1, 0), (0, 0)))[:, :S]
    count = jnp.minimum(jnp.arange(S) + 1, w).astype(jnp.float32)
    return (upper - lower) / count[None, :, None]


def multiscale_pool(p, pool_w, pool_scale):
    B, S, _ = p.shape
    pf = p.astype(jnp.float32).reshape(B, S, POOL_GROUPS, POOL_GROUP_DIM)
    pooled = jnp.stack([trailing_mean(pf[:, :, g], w) - pf[:, :, g]
                        for g, w in enumerate(POOL_WINDOWS)], axis=2)
    y = jnp.einsum('bsgc,gcd->bsgd', pooled, pool_w.astype(jnp.float32))
    return (y.reshape(B, S, POOL_W) * pool_scale).astype(p.dtype)


def setup_inputs(seed: int = 0) -> dict:
    key = jax.random.key(seed)
    ks = jax.random.split(key, 24)
    nrm = lambda k, shape: jax.random.normal(k, shape, jnp.float32)
    L, D = DEPTH, D_MODEL
    return {
        "x": nrm(ks[0], (BATCH, SEQ, D)),
        "c": nrm(ks[1], (BATCH, D)),
        "ada_w": nrm(ks[2], (L, D, 3 * D)) * D ** -0.5,
        "ada_b": nrm(ks[3], (L, 3 * D)) * 0.02,
        "norm_pre": 1.0 + 0.05 * nrm(ks[4], (L, D)),
        "norm_post": 1.0 + 0.05 * nrm(ks[5], (L, D)),
        "w_in": nrm(ks[6], (L, D, D_IN)) * D ** -0.5,
        "fox_q_gain": 1.0 + 0.05 * nrm(ks[7], (L, HEAD_DIM)),
        "fox_k_gain": 1.0 + 0.05 * nrm(ks[8], (L, HEAD_DIM)),
        "fox_f_bias": 2.0 + 0.5 * nrm(ks[9], (L, FOX_HEADS)),
        "rwkv_mu": jax.random.uniform(ks[10], (L, RWKV_SHIFT_W), jnp.float32),
        "rwkv_w0": 0.5 * nrm(ks[11], (L, RWKV_W)),
        "rwkv_w2": nrm(ks[12], (L, RWKV_DECAY_RANK, RWKV_W)) * 0.1,
        "rwkv_a0": 0.1 * nrm(ks[13], (L, RWKV_W)),
        "rwkv_a2": nrm(ks[14], (L, RWKV_ICL_RANK, RWKV_W)) * 0.1,
        "rwkv_k_k": 0.85 + 0.05 * nrm(ks[15], (L, RWKV_W)),
        "rwkv_k_a": 1.0 + 0.05 * nrm(ks[16], (L, RWKV_W)),
        "rwkv_r_k": 0.1 * nrm(ks[17], (L, RWKV_HEADS, HEAD_DIM)),
        "rwkv_ln_g": 1.0 + 0.05 * nrm(ks[18], (L, RWKV_W)),
        "rwkv_ln_b": 0.02 * nrm(ks[19], (L, RWKV_W)),
        "pool_w": nrm(ks[20], (L, POOL_GROUPS, POOL_GROUP_DIM, POOL_GROUP_DIM)) * POOL_GROUP_DIM ** -0.5,
        "pool_scale": 1.0 + 0.1 * nrm(ks[21], (L, POOL_W)),
        "w_out": nrm(ks[22], (L, D_MIX, D)) * D_MIX ** -0.5,
    }


def reference(x, c, ada_w, ada_b, norm_pre, norm_post, w_in, fox_q_gain, fox_k_gain, fox_f_bias,
              rwkv_mu, rwkv_w0, rwkv_w2, rwkv_a0, rwkv_a2, rwkv_k_k, rwkv_k_a, rwkv_r_k,
              rwkv_ln_g, rwkv_ln_b, pool_w, pool_scale, w_out):
    for l in range(DEPTH):
        mod = jax.nn.silu(c) @ ada_w[l] + ada_b[l]
        shift, scale, gate = jnp.split(mod[:, None, :], 3, axis=-1)
        h = rms_norm(x, norm_pre[l]) * (1.0 + scale) + shift
        u = h @ w_in[l]
        q, k, v, f_logit, z_rwkv, p_pool, g = jnp.split(u, IN_IDX, axis=-1)
        y_fox = fox_attention(q, k, v, f_logit, fox_q_gain[l], fox_k_gain[l], fox_f_bias[l])
        y_rwkv = rwkv7_time_mix(z_rwkv, rwkv_mu[l], rwkv_w0[l], rwkv_w2[l], rwkv_a0[l], rwkv_a2[l],
                                rwkv_k_k[l], rwkv_k_a[l], rwkv_r_k[l], rwkv_ln_g[l], rwkv_ln_b[l])
        y_pool = multiscale_pool(p_pool, pool_w[l], pool_scale[l])
        y = jnp.concatenate([y_fox, y_rwkv, y_pool], axis=-1) * jax.nn.silu(g)
        x = x + gate * rms_norm(y @ w_out[l], norm_post[l])
    return x
```

```cpp
#include <hip/hip_runtime.h>
#include <hip/hip_bf16.h>
#include <cstdio>
#include <cstdint>

constexpr int NB = 8, SEQ = 4096, DM = 1024, MTOK = NB * SEQ, NL = 2;
constexpr int D_IN = 3720, NU = 3840;
constexpr int UQ = 0, UK = 512, UV = 1024, UR = 1536  , UP = 2432  , UG = 2688  , UF = 3712  ;
constexpr int SQ = 0, SF = 1536, SR = 1544, SP = 2440, SG = 2696;
constexpr float C2 = 0.125f * 1.4426950408889634f;
constexpr float LOG2E = 1.4426950408889634f;
constexpr float DECAY_SCALE = 0.6065306597126334f;

typedef unsigned short bf16_t;
typedef short bf16x8 __attribute__((ext_vector_type(8)));
typedef float f32x4 __attribute__((ext_vector_type(4)));
typedef unsigned u32x4 __attribute__((ext_vector_type(4)));
typedef unsigned u32x2 __attribute__((ext_vector_type(2)));

__device__ __forceinline__ unsigned f2bf(float f) { unsigned u = __builtin_bit_cast(unsigned, f); return (u + 0x7fffu + ((u >> 16) & 1u)) >> 16; }
__device__ __forceinline__ unsigned pk2(float lo, float hi) { return f2bf(lo) | (f2bf(hi) << 16); }
__device__ __forceinline__ float bf2f(unsigned short b) { return __builtin_bit_cast(float, (unsigned)b << 16); }
__device__ __forceinline__ float bflo(unsigned w) { return __builtin_bit_cast(float, w << 16); }
__device__ __forceinline__ float bfhi(unsigned w) { return __builtin_bit_cast(float, w & 0xffff0000u); }
__device__ __forceinline__ float sigmoidf_(float x) { return 1.f / (1.f + __expf(-x)); }
__device__ __forceinline__ float siluf_(float x) { return x / (1.f + __expf(-x)); }
__device__ __forceinline__ float wave_sum(float v) {
#pragma unroll
    for (int o = 1; o < 64; o <<= 1) v += __shfl_xor(v, o);
    return v;
}

constexpr size_t MiB = 1u << 20;
constexpr size_t WS_CTL = 0;
constexpr size_t WS_MOD = 1 * MiB;
constexpr size_t WS_WT = 2 * MiB;
constexpr size_t WS_WOT = 18 * MiB;
constexpr size_t WS_CB = 22 * MiB;
constexpr size_t WS_XN = 24 * MiB;
constexpr size_t WS_Y = 88 * MiB;
constexpr size_t WS_U = 152 * MiB;
constexpr size_t WS_Z = 152 * MiB;
constexpr size_t WS_PW = 392 * MiB;
constexpr size_t WS_PKK = 424 * MiB;
constexpr size_t WS_PA = 456 * MiB;
constexpr size_t WS_END = 488 * MiB;

struct Params {
    const float *x, *c, *ada_w, *ada_b, *norm_pre, *norm_post, *w_in, *q_gain, *k_gain, *f_bias, *mu, *w0, *w2, *a0, *a2, *k_k, *k_a, *r_k, *ln_g, *ln_b,
        *pool_w, *pool_scale, *w_out;
    float* out;
    unsigned char* ws;
};

__device__ __forceinline__ int src_col(int n) {
    if (n < 1536) return n;
    if (n < UP) return n - UR + SR;
    if (n < UG) return -1;
    if (n < UF) return n - UG + SG;
    if (n < UF + 8) return n - UF + SF;
    return -2;
}
__global__ void __launch_bounds__(256) k_weights(Params p) {
    __shared__ float tile[64][65];
    const int tid = threadIdx.x;
    constexpr int T_IN = (NU / 64) * (DM / 64), T_OUT = (DM / 64) * (DM / 64), PER_L = T_IN + T_OUT;
    for (int it = blockIdx.x; it < NL * PER_L; it += gridDim.x) {
        const int l = it / PER_L; int r = it % PER_L;
        if (r < T_IN) {
            const int nt = r / (DM / 64), kt = r % (DM / 64), n0 = nt * 64, k0 = kt * 64;
            const float* W = p.w_in + (size_t)l * DM * D_IN;
            for (int e = tid; e < 64 * 64; e += 256) {
                const int kk = e >> 6, nn = e & 63, n = n0 + nn, sc = src_col(n);
                float v = 0.f;
                if (sc >= 0) v = W[(size_t)(k0 + kk) * D_IN + sc];
                else if (sc == -1) {
                    const int g = (n - UP) >> 6, d = (n - UP) & 63;
                    const float* pw = p.pool_w + ((size_t)l * 4 + g) * 64 * 64;
                    const float* wr = W + (size_t)(k0 + kk) * D_IN + SP + g * 64;
                    float s = 0.f;
                    for (int cc = 0; cc < 64; ++cc) s += wr[cc] * pw[cc * 64 + d];
                    v = s;
                }
                tile[kk][nn] = v;
            }
            __syncthreads();
            bf16_t* WT = (bf16_t*)(p.ws + WS_WT) + (size_t)l * NU * DM;
            for (int e = tid; e < 64 * 32; e += 256) {
                const int nn = e >> 5, kp = (e & 31) * 2;
                *(unsigned*)(WT + (size_t)(n0 + nn) * DM + k0 + kp) = pk2(tile[kp][nn], tile[kp + 1][nn]);
            }
            __syncthreads();
        } else {
            r -= T_IN;
            const int nt = r / (DM / 64), kt = r % (DM / 64), n0 = nt * 64, k0 = kt * 64;
            const float* W = p.w_out + (size_t)l * DM * DM;
            for (int e = tid; e < 64 * 64; e += 256) { const int kk = e >> 6, nn = e & 63; tile[kk][nn] = W[(size_t)(k0 + kk) * DM + n0 + nn]; }
            __syncthreads();
            bf16_t* WOT = (bf16_t*)(p.ws + WS_WOT) + (size_t)l * DM * DM;
            for (int e = tid; e < 64 * 32; e += 256) {
                const int nn = e >> 5, kp = (e & 31) * 2;
                *(unsigned*)(WOT + (size_t)(n0 + nn) * DM + k0 + kp) = pk2(tile[kp][nn], tile[kp + 1][nn]);
            }
            __syncthreads();
        }
    }
}

__global__ void __launch_bounds__(512) k_mod(Params p) {
    __shared__ float sc[NB][DM];
    __shared__ float red[8][NB][64];
    const int tid = threadIdx.x;
    for (int e = tid; e < NB * DM; e += 512) sc[e / DM][e % DM] = siluf_(p.c[e]);
    __syncthreads();
    float* mod = (float*)(p.ws + WS_MOD);
    const int kg = tid >> 6, cl = tid & 63;
    for (int it = blockIdx.x; it < NL * 48; it += gridDim.x) {
        const int l = it / 48, n = (it % 48) * 64 + cl;
        const float* W = p.ada_w + (size_t)l * DM * 3072 + n;
        float acc[NB];
#pragma unroll
        for (int b = 0; b < NB; ++b) acc[b] = 0.f;
#pragma unroll 8
        for (int k = kg * 128; k < kg * 128 + 128; ++k) {
            const float w = W[(size_t)k * 3072];
#pragma unroll
            for (int b = 0; b < NB; ++b) acc[b] += sc[b][k] * w;
        }
#pragma unroll
        for (int b = 0; b < NB; ++b) red[kg][b][cl] = acc[b];
        __syncthreads();
        {
            const int b = tid >> 6;
            float s = p.ada_b[l * 3072 + n];
#pragma unroll
            for (int g = 0; g < 8; ++g) s += red[g][b][cl];
            mod[((size_t)l * NB + b) * 3072 + n] = s;
        }
        __syncthreads();
    }
}

__device__ __forceinline__ void row_h_store(const f32x4 (&v)[4], float rinv, const float* npre, const float* mod_lb, bf16_t* xnrow, int lane) {
#pragma unroll
    for (int j = 0; j < 4; ++j) {
        const int c = j * 256 + lane * 4;
        const f32x4 g = *(const f32x4*)(npre + c), sh = *(const f32x4*)(mod_lb + c), scl = *(const f32x4*)(mod_lb + 1024 + c);
        f32x4 h;
#pragma unroll
        for (int i = 0; i < 4; ++i) h[i] = v[j][i] * rinv * g[i] * (1.f + scl[i]) + sh[i];
        u32x2 w; w.x = pk2(h[0], h[1]); w.y = pk2(h[2], h[3]);
        *(u32x2*)(xnrow + c) = w;
    }
}
__global__ void __launch_bounds__(512) k_rows(Params p, int mode, int l) {
    const int lane = threadIdx.x & 63, wv = threadIdx.x >> 6;
    const int gw = blockIdx.x * 8 + wv, ngw = gridDim.x * 8;
    const float* mod = (const float*)(p.ws + WS_MOD);
    bf16_t* XN = (bf16_t*)(p.ws + WS_XN);
    const float* Z = (const float*)(p.ws + WS_Z);
    for (int m = gw; m < MTOK; m += ngw) {
        const int b = m / SEQ;
        f32x4 v[4];
        if (mode == 0) {
#pragma unroll
            for (int j = 0; j < 4; ++j) v[j] = *(const f32x4*)(p.x + (size_t)m * DM + j * 256 + lane * 4);
            float s = 0.f;
#pragma unroll
            for (int j = 0; j < 4; ++j) s += v[j][0] * v[j][0] + v[j][1] * v[j][1] + v[j][2] * v[j][2] + v[j][3] * v[j][3];
            const float rinv = rsqrtf(wave_sum(s) * (1.f / DM) + 1e-6f);
            row_h_store(v, rinv, p.norm_pre, mod + ((size_t)0 * NB + b) * 3072, XN + (size_t)m * DM, lane);
        } else {
            f32x4 z[4];
#pragma unroll
            for (int j = 0; j < 4; ++j) z[j] = *(const f32x4*)(Z + (size_t)m * DM + j * 256 + lane * 4);
            float s = 0.f;
#pragma unroll
            for (int j = 0; j < 4; ++j) s += z[j][0] * z[j][0] + z[j][1] * z[j][1] + z[j][2] * z[j][2] + z[j][3] * z[j][3];
            const float rz = rsqrtf(wave_sum(s) * (1.f / DM) + 1e-6f);
            const float* xold = (l == 0) ? p.x : p.out;
            const float* mod_lb = mod + ((size_t)l * NB + b) * 3072;
            float s2 = 0.f;
#pragma unroll
            for (int j = 0; j < 4; ++j) {
                const int c = j * 256 + lane * 4;
                const f32x4 xo = *(const f32x4*)(xold + (size_t)m * DM + c), gp = *(const f32x4*)(p.norm_post + l * DM + c), gt = *(const f32x4*)(mod_lb + 2048 + c);
#pragma unroll
                for (int i = 0; i < 4; ++i) { v[j][i] = xo[i] + gt[i] * (z[j][i] * rz * gp[i]); s2 += v[j][i] * v[j][i]; }
                *(f32x4*)(p.out + (size_t)m * DM + c) = v[j];
            }
            if (l + 1 < NL) {
                const float rinv = rsqrtf(wave_sum(s2) * (1.f / DM) + 1e-6f);
                row_h_store(v, rinv, p.norm_pre + (l + 1) * DM, mod + ((size_t)(l + 1) * NB + b) * 3072, XN + (size_t)m * DM, lane);
            }
        }
    }
}

template <int MODE>
__global__ void __launch_bounds__(512) k_gemm(const bf16_t* A, const bf16_t* Bt, void* Cout, int M, int N, int K, const float* qg, const float* kg) {
    __shared__ __attribute__((aligned(16))) bf16_t As[128][40];
    __shared__ __attribute__((aligned(16))) bf16_t Bs[64][40];
    const int tid = threadIdx.x, lane = tid & 63, wv = tid >> 6;
    const int ntn = N / 64, ntm = M / 128;
    for (int it = blockIdx.x; it < ntm * ntn; it += gridDim.x) {
        const int tm = it / ntn, tn = it % ntn, m0 = tm * 128, n0 = tn * 64;
        f32x4 acc[4];
#pragma unroll
        for (int n = 0; n < 4; ++n) acc[n] = (f32x4){0.f, 0.f, 0.f, 0.f};
        for (int k0 = 0; k0 < K; k0 += 32) {
            {
                const int r = tid >> 2, ch = tid & 3;
                *(u32x4*)(&As[r][ch * 8]) = *(const u32x4*)(A + (size_t)(m0 + r) * K + k0 + ch * 8);
                if (tid < 256) *(u32x4*)(&Bs[r][ch * 8]) = *(const u32x4*)(Bt + (size_t)(n0 + r) * K + k0 + ch * 8);
            }
            __syncthreads();
            const bf16x8 a = *(const bf16x8*)(&As[wv * 16 + (lane & 15)][(lane >> 4) * 8]);
#pragma unroll
            for (int n = 0; n < 4; ++n) {
                const bf16x8 b = *(const bf16x8*)(&Bs[n * 16 + (lane & 15)][(lane >> 4) * 8]);
                acc[n] = __builtin_amdgcn_mfma_f32_16x16x32_bf16(a, b, acc[n], 0, 0, 0);
            }
            __syncthreads();
        }
        if (MODE == 0) {
            bf16_t* C = (bf16_t*)Cout;
            float scale[4] = {1.f, 1.f, 1.f, 1.f};
            float gain[4] = {1.f, 1.f, 1.f, 1.f};
            if (n0 < 1024) {
#pragma unroll
                for (int r = 0; r < 4; ++r) {
                    float s = acc[0][r] * acc[0][r] + acc[1][r] * acc[1][r] + acc[2][r] * acc[2][r] + acc[3][r] * acc[3][r];
                    s += __shfl_xor(s, 1); s += __shfl_xor(s, 2); s += __shfl_xor(s, 4); s += __shfl_xor(s, 8);
                    scale[r] = rsqrtf(s * (1.f / 64.f) + 1e-6f) * (n0 < 512 ? C2 : 1.f);
                }
#pragma unroll
                for (int n = 0; n < 4; ++n) gain[n] = (n0 < 512 ? qg : kg)[n * 16 + (lane & 15)];
            }
#pragma unroll
            for (int n = 0; n < 4; ++n)
#pragma unroll
                for (int r = 0; r < 4; ++r)
                    C[(size_t)(m0 + wv * 16 + (lane >> 4) * 4 + r) * N + n0 + n * 16 + (lane & 15)] = (bf16_t)f2bf(acc[n][r] * scale[r] * gain[n]);
        } else {
            float* C = (float*)Cout;
#pragma unroll
            for (int n = 0; n < 4; ++n)
#pragma unroll
                for (int r = 0; r < 4; ++r) C[(size_t)(m0 + wv * 16 + (lane >> 4) * 4 + r) * N + n0 + n * 16 + (lane & 15)] = acc[n][r];
        }
    }
}

__global__ void __launch_bounds__(512) k_cum(Params p, int l) {
    __shared__ float wtot[8][8];
    const int tid = threadIdx.x, lane = tid & 63, wv = tid >> 6;
    const bf16_t* U = (const bf16_t*)(p.ws + WS_U);
    float* CB = (float*)(p.ws + WS_CB);
    for (int b = blockIdx.x; b < NB; b += gridDim.x) {
        float pre[8][8];
        float run[8];
#pragma unroll
        for (int h = 0; h < 8; ++h) run[h] = 0.f;
#pragma unroll
        for (int i = 0; i < 8; ++i) {
            const u32x4 w = *(const u32x4*)(U + (size_t)(b * SEQ + tid * 8 + i) * NU + UF);
            float f[8] = {bflo(w.x), bfhi(w.x), bflo(w.y), bfhi(w.y), bflo(w.z), bfhi(w.z), bflo(w.w), bfhi(w.w)};
#pragma unroll
            for (int h = 0; h < 8; ++h) {
                const float xx = f[h] + p.f_bias[l * 8 + h];
                const float ls = fminf(xx, 0.f) - log1pf(__expf(-fabsf(xx)));
                run[h] += -ls * LOG2E;
                pre[i][h] = run[h];
            }
        }
        float exc[8];
#pragma unroll
        for (int h = 0; h < 8; ++h) {
            float v = run[h];
#pragma unroll
            for (int o = 1; o < 64; o <<= 1) { const float t = __shfl_up(v, o); if (lane >= o) v += t; }
            if (lane == 63) wtot[wv][h] = v;
            exc[h] = v - run[h];
        }
        __syncthreads();
#pragma unroll
        for (int h = 0; h < 8; ++h) { float base = 0.f; for (int w2 = 0; w2 < wv; ++w2) base += wtot[w2][h]; exc[h] += base; }
#pragma unroll
        for (int h = 0; h < 8; ++h)
#pragma unroll
            for (int i = 0; i < 8; ++i) CB[((size_t)b * 8 + h) * SEQ + tid * 8 + i] = exc[h] + pre[i][h];
        __syncthreads();
    }
}

__global__ void __launch_bounds__(256) k_rwkv_prep(Params p, int l) {
    __shared__ __attribute__((aligned(16))) float xw[32][64];
    __shared__ __attribute__((aligned(16))) float xa[32][64];
    const int tid = threadIdx.x;
    const int c = tid;
    const bf16_t* U = (const bf16_t*)(p.ws + WS_U);
    float* PW = (float*)(p.ws + WS_PW); float* PKK = (float*)(p.ws + WS_PKK); float* PA = (float*)(p.ws + WS_PA);
    float w2c[64], a2c[64];
#pragma unroll
    for (int j = 0; j < 64; ++j) { w2c[j] = p.w2[((size_t)l * 64 + j) * 256 + c]; a2c[j] = p.a2[((size_t)l * 64 + j) * 256 + c]; }
    const float w0c = p.w0[l * 256 + c], a0c = p.a0[l * 256 + c], kkc = p.k_k[l * 256 + c], muk = p.mu[l * 896 + 256 + c];
    for (int tile = blockIdx.x; tile < MTOK / 32; tile += gridDim.x) {
        const int m0 = tile * 32;
        for (int e = tid; e < 32 * 128; e += 256) {
            const int t = e >> 7, j = e & 127, m = m0 + t;
            const float cur = bf2f(U[(size_t)m * NU + UR + 768 + j]);
            const float prev = (m % SEQ) ? bf2f(U[(size_t)(m - 1) * NU + UR + 768 + j]) : 0.f;
            const float v = cur + (prev - cur) * p.mu[l * 896 + 768 + j];
            if (j < 64) xw[t][j] = tanhf(v); else xa[t][j - 64] = v;
        }
        __syncthreads();
#pragma unroll 1
        for (int t = 0; t < 32; ++t) {
            const int m = m0 + t;
            float sw = w0c, sa = a0c;
#pragma unroll
            for (int j = 0; j < 64; j += 4) {
                const f32x4 xv = *(const f32x4*)(&xw[t][j]), av = *(const f32x4*)(&xa[t][j]);
                sw += xv[0] * w2c[j] + xv[1] * w2c[j + 1] + xv[2] * w2c[j + 2] + xv[3] * w2c[j + 3];
                sa += av[0] * a2c[j] + av[1] * a2c[j + 1] + av[2] * a2c[j + 2] + av[3] * a2c[j + 3];
            }
            const float w = __expf(-DECAY_SCALE * sigmoidf_(sw));
            const float a = sigmoidf_(sa);
            const float kc = bf2f(U[(size_t)m * NU + UR + 256 + c]);
            const float kp = (m % SEQ) ? bf2f(U[(size_t)(m - 1) * NU + UR + 256 + c]) : 0.f;
            const float kl = kc + (kp - kc) * muk;
            const float kkv = kl * kkc;
            const float nrm = sqrtf(wave_sum(kkv * kkv));
            PW[(size_t)m * 256 + c] = w; PA[(size_t)m * 256 + c] = a; PKK[(size_t)m * 256 + c] = kkv / fmaxf(nrm, 1e-12f);
        }
        __syncthreads();
    }
}

__global__ void __launch_bounds__(256) k_attn(Params p) {
    __shared__ __attribute__((aligned(16))) float Ks[64][64];
    __shared__ __attribute__((aligned(16))) float Vs[64][64];
    __shared__ float cbs[64];
    const int tid = threadIdx.x;
    const bf16_t* U = (const bf16_t*)(p.ws + WS_U);
    const float* CB = (const float*)(p.ws + WS_CB);
    bf16_t* Y = (bf16_t*)(p.ws + WS_Y);
    for (int it = blockIdx.x; it < NB * 8 * (SEQ / 256); it += gridDim.x) {
        const int qb = (SEQ / 256 - 1) - it / (NB * 8), bh = it % (NB * 8), b = bh >> 3, h = bh & 7;
        const int qpos = qb * 256 + tid;
        const size_t mrow = (size_t)b * SEQ + qpos;
        float q[64], o[64];
        {
            const bf16_t* qp = U + mrow * NU + UQ + h * 64;
#pragma unroll
            for (int d = 0; d < 64; d += 8) { const u32x4 w = *(const u32x4*)(qp + d);
                q[d] = bflo(w.x); q[d + 1] = bfhi(w.x); q[d + 2] = bflo(w.y); q[d + 3] = bfhi(w.y); q[d + 4] = bflo(w.z); q[d + 5] = bfhi(w.z); q[d + 6] = bflo(w.w); q[d + 7] = bfhi(w.w); }
        }
#pragma unroll
        for (int d = 0; d < 64; ++d) o[d] = 0.f;
        float mrun = -1e30f, lrun = 0.f;
        const int ntile = (qb * 256 + 256) / 64;
        for (int kt = 0; kt < ntile; ++kt) {
            __syncthreads();
            {
                const int key = tid >> 2, ch = (tid & 3) * 16;
                const bf16_t* kp = U + ((size_t)b * SEQ + kt * 64 + key) * NU + UK + h * 64 + ch;
                const bf16_t* vp = U + ((size_t)b * SEQ + kt * 64 + key) * NU + UV + h * 64 + ch;
#pragma unroll
                for (int hh = 0; hh < 2; ++hh) {
                    const u32x4 kw = *(const u32x4*)(kp + hh * 8), vw = *(const u32x4*)(vp + hh * 8);
                    float* kd = &Ks[key][ch + hh * 8]; float* vd = &Vs[key][ch + hh * 8];
                    kd[0] = bflo(kw.x); kd[1] = bfhi(kw.x); kd[2] = bflo(kw.y); kd[3] = bfhi(kw.y); kd[4] = bflo(kw.z); kd[5] = bfhi(kw.z); kd[6] = bflo(kw.w); kd[7] = bfhi(kw.w);
                    vd[0] = bflo(vw.x); vd[1] = bfhi(vw.x); vd[2] = bflo(vw.y); vd[3] = bfhi(vw.y); vd[4] = bflo(vw.z); vd[5] = bfhi(vw.z); vd[6] = bflo(vw.w); vd[7] = bfhi(vw.w);
                }
                if (tid < 64) cbs[tid] = CB[((size_t)b * 8 + h) * SEQ + kt * 64 + tid];
            }
            __syncthreads();
#pragma unroll 1
            for (int key = 0; key < 64; ++key) {
                if (kt * 64 + key > qb * 256 + 255) break;
                float acc = cbs[key];
#pragma unroll
                for (int d = 0; d < 64; d += 4) { const f32x4 kv = *(const f32x4*)(&Ks[key][d]); acc += q[d] * kv[0] + q[d + 1] * kv[1] + q[d + 2] * kv[2] + q[d + 3] * kv[3]; }
                const bool live = (kt * 64 + key <= qpos);
                if (live && acc > mrun + 16.f) {
                    const float sc = exp2f(mrun - acc);
                    mrun = acc; lrun *= sc;
#pragma unroll
                    for (int d = 0; d < 64; ++d) o[d] *= sc;
                }
                const float pj = live ? exp2f(acc - mrun) : 0.f;
                lrun += pj;
#pragma unroll
                for (int d = 0; d < 64; d += 4) { const f32x4 vv = *(const f32x4*)(&Vs[key][d]); o[d] += pj * vv[0]; o[d + 1] += pj * vv[1]; o[d + 2] += pj * vv[2]; o[d + 3] += pj * vv[3]; }
            }
        }
        const float rl = 1.f / lrun;
        const bf16_t* gp = U + mrow * NU + UG + h * 64;
        bf16_t* yp = Y + mrow * DM + h * 64;
#pragma unroll
        for (int d = 0; d < 64; d += 8) {
            const u32x4 gw = *(const u32x4*)(gp + d);
            u32x4 w;
            w.x = pk2(o[d] * rl * siluf_(bflo(gw.x)), o[d + 1] * rl * siluf_(bfhi(gw.x)));
            w.y = pk2(o[d + 2] * rl * siluf_(bflo(gw.y)), o[d + 3] * rl * siluf_(bfhi(gw.y)));
            w.z = pk2(o[d + 4] * rl * siluf_(bflo(gw.z)), o[d + 5] * rl * siluf_(bfhi(gw.z)));
            w.w = pk2(o[d + 6] * rl * siluf_(bflo(gw.w)), o[d + 7] * rl * siluf_(bfhi(gw.w)));
            *(u32x4*)(yp + d) = w;
        }
    }
}

__global__ void __launch_bounds__(64) k_rwkv_scan(Params p, int l) {
    constexpr int CH = 16;
    __shared__ __attribute__((aligned(16))) float vec[CH][6][64];
    __shared__ float bonus[CH];
    const int i = threadIdx.x;
    const bf16_t* U = (const bf16_t*)(p.ws + WS_U);
    const float* PW = (const float*)(p.ws + WS_PW); const float* PKK = (const float*)(p.ws + WS_PKK); const float* PA = (const float*)(p.ws + WS_PA);
    bf16_t* Y = (bf16_t*)(p.ws + WS_Y);
    for (int bh = blockIdx.x; bh < NB * 4; bh += gridDim.x) {
        const int b = bh >> 2, h = bh & 3, c = h * 64 + i;
        const float mur = p.mu[l * 896 + c], muk = p.mu[l * 896 + 256 + c], muv = p.mu[l * 896 + 512 + c];
        const float kac = p.k_a[l * 256 + c], rkc = p.r_k[l * 256 + c], lng = p.ln_g[l * 256 + c], lnb = p.ln_b[l * 256 + c];
        float S[64];
#pragma unroll
        for (int j = 0; j < 64; ++j) S[j] = 0.f;
        float rp = 0.f, kp = 0.f, vp = 0.f;
        for (int t0 = 0; t0 < SEQ; t0 += CH) {
            __syncthreads();
            for (int tt = 0; tt < CH; ++tt) {
                const size_t m = (size_t)b * SEQ + t0 + tt;
                const float rc = bf2f(U[m * NU + UR + c]), kc = bf2f(U[m * NU + UR + 256 + c]), vc = bf2f(U[m * NU + UR + 512 + c]);
                const float r = rc + (rp - rc) * mur, k = kc + (kp - kc) * muk, v = vc + (vp - vc) * muv;
                rp = rc; kp = kc; vp = vc;
                const float w = PW[m * 256 + c], kk = PKK[m * 256 + c], a = PA[m * 256 + c];
                const float kt = k * (1.f + (a - 1.f) * kac);
                vec[tt][0][i] = w; vec[tt][1][i] = kk; vec[tt][2][i] = kk * a; vec[tt][3][i] = kt; vec[tt][4][i] = r; vec[tt][5][i] = v;
                const float bs = wave_sum(r * kt * rkc);
                if (i == 0) bonus[tt] = bs;
            }
            __syncthreads();
            for (int tt = 0; tt < CH; ++tt) {
                const size_t m = (size_t)b * SEQ + t0 + tt;
                float sa = 0.f;
#pragma unroll
                for (int j = 0; j < 64; j += 4) { const f32x4 kk = *(const f32x4*)(&vec[tt][1][j]); sa += S[j] * kk[0] + S[j + 1] * kk[1] + S[j + 2] * kk[2] + S[j + 3] * kk[3]; }
                sa = -sa;
                const float vi = vec[tt][5][i];
                float oacc = 0.f;
#pragma unroll
                for (int j = 0; j < 64; j += 4) {
                    const f32x4 w = *(const f32x4*)(&vec[tt][0][j]), bb = *(const f32x4*)(&vec[tt][2][j]), kt = *(const f32x4*)(&vec[tt][3][j]), r = *(const f32x4*)(&vec[tt][4][j]);
#pragma unroll
                    for (int e = 0; e < 4; ++e) { S[j + e] = S[j + e] * w[e] + sa * bb[e] + vi * kt[e]; oacc += S[j + e] * r[e]; }
                }
                const float mean = wave_sum(oacc) * (1.f / 64.f);
                const float dv = oacc - mean;
                const float var = wave_sum(dv * dv) * (1.f / 64.f);
                const float on = dv * rsqrtf(var + 64e-5f) * lng + lnb + bonus[tt] * vi;
                const float g = bf2f(U[m * NU + UG + 512 + c]);
                Y[m * DM + 512 + c] = (bf16_t)f2bf(on * siluf_(g));
            }
        }
    }
}

__global__ void __launch_bounds__(256) k_pool(Params p, int l) {
    const bf16_t* U = (const bf16_t*)(p.ws + WS_U);
    bf16_t* Y = (bf16_t*)(p.ws + WS_Y);
    const int c = threadIdx.x, g = c >> 6, w = 2 << g;
    const float scl = p.pool_scale[l * 256 + c];
    for (int m = blockIdx.x; m < MTOK; m += gridDim.x) {
        const int t = m % SEQ;
        const int cnt = (t + 1 < w) ? t + 1 : w;
        float s = 0.f;
        for (int d = 0; d < cnt; ++d) s += bf2f(U[(size_t)(m - d) * NU + UP + c]);
        const float cur = bf2f(U[(size_t)m * NU + UP + c]);
        const float yv = (s / (float)cnt - cur) * scl;
        const float gg = bf2f(U[(size_t)m * NU + UG + 768 + c]);
        Y[(size_t)m * DM + 768 + c] = (bf16_t)f2bf(yv * siluf_(gg));
    }
}

extern "C" void kernel_launch(void* const* d_in, const int* in_sizes, int n_in, void* d_out, int out_size, void* d_ws, size_t ws_size, hipStream_t stream) {
    if (n_in != 23 || ws_size < WS_END) { fprintf(stderr, "kernel_launch: unexpected n_in %d / ws_size %zu\n", n_in, ws_size); return; }
    Params p{};
    const float** f = (const float**)&p;
    for (int i = 0; i < 23; ++i) f[i] = (const float*)d_in[i];
    p.out = (float*)d_out; p.ws = (unsigned char*)d_ws;
    bf16_t* XN = (bf16_t*)(p.ws + WS_XN); bf16_t* Y = (bf16_t*)(p.ws + WS_Y); bf16_t* U = (bf16_t*)(p.ws + WS_U); float* Z = (float*)(p.ws + WS_Z);
    k_weights<<<1024, 256, 0, stream>>>(p);
    k_mod<<<96, 512, 0, stream>>>(p);
    k_rows<<<1024, 512, 0, stream>>>(p, 0, 0);
    for (int l = 0; l < NL; ++l) {
        const bf16_t* WT = (const bf16_t*)(p.ws + WS_WT) + (size_t)l * NU * DM;
        const bf16_t* WOT = (const bf16_t*)(p.ws + WS_WOT) + (size_t)l * DM * DM;
        k_gemm<0><<<2048, 512, 0, stream>>>(XN, WT, U, MTOK, NU, DM, p.q_gain + l * 64, p.k_gain + l * 64);
        k_cum<<<NB, 512, 0, stream>>>(p, l);
        k_rwkv_prep<<<1024, 256, 0, stream>>>(p, l);
        k_attn<<<1024, 256, 0, stream>>>(p);
        k_rwkv_scan<<<32, 64, 0, stream>>>(p, l);
        k_pool<<<2048, 256, 0, stream>>>(p, l);
        k_gemm<1><<<2048, 512, 0, stream>>>(Y, WOT, Z, MTOK, DM, DM, nullptr, nullptr);
        k_rows<<<1024, 512, 0, stream>>>(p, 1, l);
    }
}
```

```cpp
#include <hip/hip_runtime.h>
#include <hip/hip_bf16.h>
#include <cstdio>
#include <cstdint>

constexpr int NB = 8, SEQ = 4096, DM = 1024, MTOK = NB * SEQ, NL = 2;
constexpr int D_IN = 3720, NU = 3840;
constexpr int UQ = 0, UK = 512, UV = 1024, UR = 1536  , UP = 2432  , UG = 2688  , UF = 3712  ;
constexpr int SQ = 0, SF = 1536, SR = 1544, SP = 2440, SG = 2696;
constexpr float C2 = 0.125f * 1.4426950408889634f;
constexpr float LOG2E = 1.4426950408889634f;
constexpr float DECAY_SCALE = 0.6065306597126334f;

typedef unsigned short bf16_t;
typedef short bf16x8 __attribute__((ext_vector_type(8)));
typedef float f32x4 __attribute__((ext_vector_type(4)));
typedef unsigned u32x4 __attribute__((ext_vector_type(4)));
typedef unsigned u32x2 __attribute__((ext_vector_type(2)));

__device__ __forceinline__ unsigned f2bf(float f) { unsigned u = __builtin_bit_cast(unsigned, f); return (u + 0x7fffu + ((u >> 16) & 1u)) >> 16; }
__device__ __forceinline__ unsigned pk2(float lo, float hi) { return f2bf(lo) | (f2bf(hi) << 16); }
__device__ __forceinline__ float bf2f(unsigned short b) { return __builtin_bit_cast(float, (unsigned)b << 16); }
__device__ __forceinline__ float bflo(unsigned w) { return __builtin_bit_cast(float, w << 16); }
__device__ __forceinline__ float bfhi(unsigned w) { return __builtin_bit_cast(float, w & 0xffff0000u); }
__device__ __forceinline__ float sigmoidf_(float x) { return 1.f / (1.f + __expf(-x)); }
__device__ __forceinline__ float siluf_(float x) { return x / (1.f + __expf(-x)); }
__device__ __forceinline__ float wave_sum(float v) {
#pragma unroll
    for (int o = 1; o < 64; o <<= 1) v += __shfl_xor(v, o);
    return v;
}

__device__ __forceinline__ int otid() { int t = threadIdx.x; asm volatile("" : "+v"(t)); return t; }

constexpr size_t MiB = 1u << 20;
constexpr size_t WS_CTL = 0;
constexpr size_t WS_MOD = 1 * MiB;
constexpr size_t WS_WT = 2 * MiB;
constexpr size_t WS_WOT = 18 * MiB;
constexpr size_t WS_CB = 22 * MiB;
constexpr size_t WS_XN = 24 * MiB;
constexpr size_t WS_Y = 88 * MiB;
constexpr size_t WS_U = 152 * MiB;
constexpr size_t WS_Z = 152 * MiB;
constexpr size_t WS_PW = 392 * MiB;
constexpr size_t WS_PKK = 424 * MiB;
constexpr size_t WS_PA = 456 * MiB;
constexpr size_t WS_END = 488 * MiB;
constexpr size_t CTL_ZERO_BYTES = 65536;
constexpr int CW_BAR = 1024;

struct Params {
    const float *x, *c, *ada_w, *ada_b, *norm_pre, *norm_post, *w_in, *q_gain, *k_gain, *f_bias, *mu, *w0, *w2, *a0, *a2, *k_k, *k_a, *r_k, *ln_g, *ln_b,
        *pool_w, *pool_scale, *w_out;
    float* out;
    unsigned char* ws;
};


#define LAS __attribute__((address_space(3)))
constexpr int NTHREADS = 512;
constexpr int LDS_BYTES = 147456;
constexpr int MISC_OFF = LDS_BYTES - 128;

#define XB_TMO      128
#define XB_XCNT(j)  (256  + 64 * (j))
#define XB_XSUB(j)  (1280 + 64 * (j))
#define XB_XGEN(j)  (2304 + 64 * (j))
#define XB_TOP      3328
#define XB_TOPGEN   3392
#define XCD_BAR_WORDS 3456
#define XB_SPIN_CAP (1u << 18)
__device__ __forceinline__ unsigned xb_ld(unsigned* p)              { return __hip_atomic_load(p, __ATOMIC_RELAXED, __HIP_MEMORY_SCOPE_AGENT); }
__device__ __forceinline__ unsigned xb_add(unsigned* p, unsigned v) { return __hip_atomic_fetch_add(p, v, __ATOMIC_RELAXED, __HIP_MEMORY_SCOPE_AGENT); }
__device__ __forceinline__ unsigned xb_xcc_id() { return (unsigned)__builtin_amdgcn_s_getreg((3 << 11) | 20) & 0xFu; }
#define XB_SPIN(cond, bar) do { unsigned _sp = 0; while (cond) { __builtin_amdgcn_s_sleep(1); \
    if ((++_sp & 255u) == 0u) { if (xb_ld(&(bar)[XB_TMO])) break; if (_sp > XB_SPIN_CAP) { atomicAdd(&(bar)[XB_TMO], 1u); break; } } } } while (0)
struct XcdBarrier { unsigned* bar; unsigned x; volatile LAS unsigned* st; };
__device__ __forceinline__ XcdBarrier xcd_barrier_post(unsigned* bar, volatile LAS unsigned* st) {
    XcdBarrier b; b.bar = bar; b.x = xb_xcc_id(); b.st = st;
    if (threadIdx.x == 0) (void)xb_add(&bar[XB_XCNT(b.x)], 1u);
    return b;
}
__device__ __forceinline__ void xcd_barrier_complete(unsigned* bar, unsigned x, unsigned& nloc, unsigned& nx) {
    const unsigned G = gridDim.x * gridDim.y * gridDim.z;
    unsigned sum, cnt, mine, sp = 0u;
    for (;;) {
        sum = 0u; cnt = 0u; mine = 0u;
#pragma unroll
        for (unsigned j = 0; j < 16; ++j) { const unsigned c = xb_ld(&bar[XB_XCNT(j)]); sum += c; cnt += (c > 0u) ? 1u : 0u; mine = (j == x) ? c : mine; }
        if (sum == G) break;
        __builtin_amdgcn_s_sleep(1);
        if ((++sp & 255u) == 0u) { if (xb_ld(&bar[XB_TMO])) break; if (sp > XB_SPIN_CAP) { atomicAdd(&bar[XB_TMO], 1u); break; } }
    }
    nloc = mine > 0u ? mine : 1u; nx = cnt > 0u ? cnt : 1u;
}
__device__ __forceinline__ void xcd_barrier(const XcdBarrier& b) {
    asm volatile("s_waitcnt vmcnt(0)" ::: "memory");
    __syncthreads();
    if (threadIdx.x == 0) {
        unsigned* bar = b.bar;
        __builtin_amdgcn_s_waitcnt(0);
        unsigned nloc = b.st[0], nx = b.st[1];
        if (nloc == 0u) { xcd_barrier_complete(bar, b.x, nloc, nx); b.st[0] = nloc; b.st[1] = nx; }
        const unsigned old = xb_add(&bar[XB_XSUB(b.x)], 1u);
        const unsigned gen = old / nloc;
        if (old + 1u == (gen + 1u) * nloc) {
            __builtin_amdgcn_fence(__ATOMIC_RELEASE, "agent");
            asm volatile("s_waitcnt vmcnt(0)" ::: "memory");
            const unsigned og = xb_add(&bar[XB_TOP], 1u);
            const unsigned tg = og / nx;
            if (og + 1u == (tg + 1u) * nx) xb_add(&bar[XB_TOPGEN], 1u);
            else XB_SPIN(xb_ld(&bar[XB_TOPGEN]) == tg, bar);
            __builtin_amdgcn_fence(__ATOMIC_ACQUIRE, "agent");
            xb_add(&bar[XB_XGEN(b.x)], 1u);
            asm volatile("s_waitcnt vmcnt(0)" ::: "memory");
        } else {
            XB_SPIN(xb_ld(&bar[XB_XGEN(b.x)]) == gen, bar);
            __builtin_amdgcn_fence(__ATOMIC_ACQUIRE, "agent");
            asm volatile("s_waitcnt vmcnt(0)" ::: "memory");
        }
    }
    __syncthreads();
}


__device__ __forceinline__ int src_col(int n) {
    if (n < 1536) return n;
    if (n < UP) return n - UR + SR;
    if (n < UG) return -1;
    if (n < UF) return n - UG + SG;
    if (n < UF + 8) return n - UF + SF;
    return -2;
}
__device__ __forceinline__ void phase_weights(const Params& p, unsigned char* lds) {
    float (*tile)[65] = (float (*)[65])lds;
    const int tid = otid();
    constexpr int T_IN = (NU / 64) * (DM / 64), T_OUT = (DM / 64) * (DM / 64), PER_L = T_IN + T_OUT;
    for (int it = blockIdx.x; it < NL * PER_L; it += gridDim.x) {
        const int l = it / PER_L; int r = it % PER_L;
        if (r < T_IN) {
            const int nt = r / (DM / 64), kt = r % (DM / 64), n0 = nt * 64, k0 = kt * 64;
            const float* W = p.w_in + (size_t)l * DM * D_IN;
            for (int e = tid; e < 64 * 64; e += NTHREADS) {
                const int kk = e >> 6, nn = e & 63, n = n0 + nn, sc = src_col(n);
                float v = 0.f;
                if (sc >= 0) v = W[(size_t)(k0 + kk) * D_IN + sc];
                else if (sc == -1) {
                    const int g = (n - UP) >> 6, d = (n - UP) & 63;
                    const float* pw = p.pool_w + ((size_t)l * 4 + g) * 64 * 64;
                    const float* wr = W + (size_t)(k0 + kk) * D_IN + SP + g * 64;
                    float s = 0.f;
                    for (int cc = 0; cc < 64; ++cc) s += wr[cc] * pw[cc * 64 + d];
                    v = s;
                }
                tile[kk][nn] = v;
            }
            __syncthreads();
            bf16_t* WT = (bf16_t*)(p.ws + WS_WT) + (size_t)l * NU * DM;
            for (int e = tid; e < 64 * 32; e += NTHREADS) {
                const int nn = e >> 5, kp = (e & 31) * 2;
                *(unsigned*)(WT + (size_t)(n0 + nn) * DM + k0 + kp) = pk2(tile[kp][nn], tile[kp + 1][nn]);
            }
            __syncthreads();
        } else {
            r -= T_IN;
            const int nt = r / (DM / 64), kt = r % (DM / 64), n0 = nt * 64, k0 = kt * 64;
            const float* W = p.w_out + (size_t)l * DM * DM;
            for (int e = tid; e < 64 * 64; e += NTHREADS) { const int kk = e >> 6, nn = e & 63; tile[kk][nn] = W[(size_t)(k0 + kk) * DM + n0 + nn]; }
            __syncthreads();
            bf16_t* WOT = (bf16_t*)(p.ws + WS_WOT) + (size_t)l * DM * DM;
            for (int e = tid; e < 64 * 32; e += NTHREADS) {
                const int nn = e >> 5, kp = (e & 31) * 2;
                *(unsigned*)(WOT + (size_t)(n0 + nn) * DM + k0 + kp) = pk2(tile[kp][nn], tile[kp + 1][nn]);
            }
            __syncthreads();
        }
    }
}

__device__ __forceinline__ void phase_mod(const Params& p, unsigned char* lds) {
    float (*sc)[DM] = (float (*)[DM])lds;
    float (*red)[NB][64] = (float (*)[NB][64])(lds + 32768);
    const int tid = otid();
    if ((int)blockIdx.x >= NL * 48) return;
    for (int e = tid; e < NB * DM; e += NTHREADS) sc[e / DM][e % DM] = siluf_(p.c[e]);
    __syncthreads();
    float* mod = (float*)(p.ws + WS_MOD);
    const int kg = tid >> 6, cl = tid & 63;
    for (int it = blockIdx.x; it < NL * 48; it += gridDim.x) {
        const int l = it / 48, n = (it % 48) * 64 + cl;
        const float* W = p.ada_w + (size_t)l * DM * 3072 + n;
        float acc[NB];
#pragma unroll
        for (int b = 0; b < NB; ++b) acc[b] = 0.f;
#pragma unroll 8
        for (int k = kg * 128; k < kg * 128 + 128; ++k) {
            const float w = W[(size_t)k * 3072];
#pragma unroll
            for (int b = 0; b < NB; ++b) acc[b] += sc[b][k] * w;
        }
#pragma unroll
        for (int b = 0; b < NB; ++b) red[kg][b][cl] = acc[b];
        __syncthreads();
        {
            const int b = tid >> 6;
            float s = p.ada_b[l * 3072 + n];
#pragma unroll
            for (int g = 0; g < 8; ++g) s += red[g][b][cl];
            mod[((size_t)l * NB + b) * 3072 + n] = s;
        }
        __syncthreads();
    }
}

__device__ __forceinline__ void row_h_store(const f32x4 (&v)[4], float rinv, const float* npre, const float* mod_lb, bf16_t* xnrow, int lane) {
#pragma unroll
    for (int j = 0; j < 4; ++j) {
        const int c = j * 256 + lane * 4;
        const f32x4 g = *(const f32x4*)(npre + c), sh = *(const f32x4*)(mod_lb + c), scl = *(const f32x4*)(mod_lb + 1024 + c);
        f32x4 h;
#pragma unroll
        for (int i = 0; i < 4; ++i) h[i] = v[j][i] * rinv * g[i] * (1.f + scl[i]) + sh[i];
        u32x2 w; w.x = pk2(h[0], h[1]); w.y = pk2(h[2], h[3]);
        *(u32x2*)(xnrow + c) = w;
    }
}
__device__ __forceinline__ void phase_rows(const Params& p, int mode, int l) {
    const int tid = otid(), lane = tid & 63, wv = tid >> 6;
    const int gw = blockIdx.x * 8 + wv, ngw = gridDim.x * 8;
    const float* mod = (const float*)(p.ws + WS_MOD);
    bf16_t* XN = (bf16_t*)(p.ws + WS_XN);
    const float* Z = (const float*)(p.ws + WS_Z);
    for (int m = gw; m < MTOK; m += ngw) {
        const int b = m / SEQ;
        f32x4 v[4];
        if (mode == 0) {
#pragma unroll
            for (int j = 0; j < 4; ++j) v[j] = *(const f32x4*)(p.x + (size_t)m * DM + j * 256 + lane * 4);
            float s = 0.f;
#pragma unroll
            for (int j = 0; j < 4; ++j) s += v[j][0] * v[j][0] + v[j][1] * v[j][1] + v[j][2] * v[j][2] + v[j][3] * v[j][3];
            const float rinv = rsqrtf(wave_sum(s) * (1.f / DM) + 1e-6f);
            row_h_store(v, rinv, p.norm_pre, mod + ((size_t)0 * NB + b) * 3072, XN + (size_t)m * DM, lane);
        } else {
            f32x4 z[4];
#pragma unroll
            for (int j = 0; j < 4; ++j) z[j] = *(const f32x4*)(Z + (size_t)m * DM + j * 256 + lane * 4);
            float s = 0.f;
#pragma unroll
            for (int j = 0; j < 4; ++j) s += z[j][0] * z[j][0] + z[j][1] * z[j][1] + z[j][2] * z[j][2] + z[j][3] * z[j][3];
            const float rz = rsqrtf(wave_sum(s) * (1.f / DM) + 1e-6f);
            const float* xold = (l == 0) ? p.x : p.out;
            const float* mod_lb = mod + ((size_t)l * NB + b) * 3072;
            float s2 = 0.f;
#pragma unroll
            for (int j = 0; j < 4; ++j) {
                const int c = j * 256 + lane * 4;
                const f32x4 xo = *(const f32x4*)(xold + (size_t)m * DM + c), gp = *(const f32x4*)(p.norm_post + l * DM + c), gt = *(const f32x4*)(mod_lb + 2048 + c);
#pragma unroll
                for (int i = 0; i < 4; ++i) { v[j][i] = xo[i] + gt[i] * (z[j][i] * rz * gp[i]); s2 += v[j][i] * v[j][i]; }
                *(f32x4*)(p.out + (size_t)m * DM + c) = v[j];
            }
            if (l + 1 < NL) {
                const float rinv = rsqrtf(wave_sum(s2) * (1.f / DM) + 1e-6f);
                row_h_store(v, rinv, p.norm_pre + (l + 1) * DM, mod + ((size_t)(l + 1) * NB + b) * 3072, XN + (size_t)m * DM, lane);
            }
        }
    }
}

template <int MODE>
__device__ __forceinline__ void phase_gemm_simple(unsigned char* lds, const bf16_t* A, const bf16_t* Bt, void* Cout, int M, int N, int K, const float* qg, const float* kg) {
    bf16_t (*As)[40] = (bf16_t (*)[40])lds;
    bf16_t (*Bs)[40] = (bf16_t (*)[40])(lds + 128 * 40 * 2);
    const int tid = otid(), lane = tid & 63, wv = tid >> 6;
    const int ntn = N / 64, ntm = M / 128;
    for (int it = blockIdx.x; it < ntm * ntn; it += gridDim.x) {
        const int tm = it / ntn, tn = it % ntn, m0 = tm * 128, n0 = tn * 64;
        f32x4 acc[4];
#pragma unroll
        for (int n = 0; n < 4; ++n) acc[n] = (f32x4){0.f, 0.f, 0.f, 0.f};
        for (int k0 = 0; k0 < K; k0 += 32) {
            {
                const int r = tid >> 2, ch = tid & 3;
                *(u32x4*)(&As[r][ch * 8]) = *(const u32x4*)(A + (size_t)(m0 + r) * K + k0 + ch * 8);
                if (tid < 256) *(u32x4*)(&Bs[r][ch * 8]) = *(const u32x4*)(Bt + (size_t)(n0 + r) * K + k0 + ch * 8);
            }
            __syncthreads();
            const bf16x8 a = *(const bf16x8*)(&As[wv * 16 + (lane & 15)][(lane >> 4) * 8]);
#pragma unroll
            for (int n = 0; n < 4; ++n) {
                const bf16x8 b = *(const bf16x8*)(&Bs[n * 16 + (lane & 15)][(lane >> 4) * 8]);
                acc[n] = __builtin_amdgcn_mfma_f32_16x16x32_bf16(a, b, acc[n], 0, 0, 0);
            }
            __syncthreads();
        }
        if (MODE == 0) {
            bf16_t* C = (bf16_t*)Cout;
            float scale[4] = {1.f, 1.f, 1.f, 1.f};
            float gain[4] = {1.f, 1.f, 1.f, 1.f};
            if (n0 < 1024) {
#pragma unroll
                for (int r = 0; r < 4; ++r) {
                    float s = acc[0][r] * acc[0][r] + acc[1][r] * acc[1][r] + acc[2][r] * acc[2][r] + acc[3][r] * acc[3][r];
                    s += __shfl_xor(s, 1); s += __shfl_xor(s, 2); s += __shfl_xor(s, 4); s += __shfl_xor(s, 8);
                    scale[r] = rsqrtf(s * (1.f / 64.f) + 1e-6f) * (n0 < 512 ? C2 : 1.f);
                }
#pragma unroll
                for (int n = 0; n < 4; ++n) gain[n] = (n0 < 512 ? qg : kg)[n * 16 + (lane & 15)];
            }
#pragma unroll
            for (int n = 0; n < 4; ++n)
#pragma unroll
                for (int r = 0; r < 4; ++r)
                    C[(size_t)(m0 + wv * 16 + (lane >> 4) * 4 + r) * N + n0 + n * 16 + (lane & 15)] = (bf16_t)f2bf(acc[n][r] * scale[r] * gain[n]);
        } else {
            float* C = (float*)Cout;
#pragma unroll
            for (int n = 0; n < 4; ++n)
#pragma unroll
                for (int r = 0; r < 4; ++r) C[(size_t)(m0 + wv * 16 + (lane >> 4) * 4 + r) * N + n0 + n * 16 + (lane & 15)] = acc[n][r];
        }
    }
}

__device__ __forceinline__ void phase_cum(const Params& p, int l, unsigned char* lds) {
    float (*wtot)[8] = (float (*)[8])lds;
    const int tid = otid(), lane = tid & 63, wv = tid >> 6;
    const bf16_t* U = (const bf16_t*)(p.ws + WS_U);
    float* CB = (float*)(p.ws + WS_CB);
    for (int b = blockIdx.x; b < NB; b += gridDim.x) {
        float pre[8][8];
        float run[8];
#pragma unroll
        for (int h = 0; h < 8; ++h) run[h] = 0.f;
#pragma unroll
        for (int i = 0; i < 8; ++i) {
            const u32x4 w = *(const u32x4*)(U + (size_t)(b * SEQ + tid * 8 + i) * NU + UF);
            float f[8] = {bflo(w.x), bfhi(w.x), bflo(w.y), bfhi(w.y), bflo(w.z), bfhi(w.z), bflo(w.w), bfhi(w.w)};
#pragma unroll
            for (int h = 0; h < 8; ++h) {
                const float xx = f[h] + p.f_bias[l * 8 + h];
                const float ls = fminf(xx, 0.f) - log1pf(__expf(-fabsf(xx)));
                run[h] += -ls * LOG2E;
                pre[i][h] = run[h];
            }
        }
        float exc[8];
#pragma unroll
        for (int h = 0; h < 8; ++h) {
            float v = run[h];
#pragma unroll
            for (int o = 1; o < 64; o <<= 1) { const float t = __shfl_up(v, o); if (lane >= o) v += t; }
            if (lane == 63) wtot[wv][h] = v;
            exc[h] = v - run[h];
        }
        __syncthreads();
#pragma unroll
        for (int h = 0; h < 8; ++h) { float base = 0.f; for (int w2 = 0; w2 < wv; ++w2) base += wtot[w2][h]; exc[h] += base; }
#pragma unroll
        for (int h = 0; h < 8; ++h)
#pragma unroll
            for (int i = 0; i < 8; ++i) CB[((size_t)b * 8 + h) * SEQ + tid * 8 + i] = exc[h] + pre[i][h];
        __syncthreads();
    }
}

__device__ __forceinline__ void phase_rwkv_prep(const Params& p, int l, unsigned char* lds) {
    float (*xs)[64] = (float (*)[64])lds;
    const int tid = otid();
    const int c = tid & 255, tg = tid >> 8;
    const bf16_t* U = (const bf16_t*)(p.ws + WS_U);
    float* PW = (float*)(p.ws + WS_PW); float* PKK = (float*)(p.ws + WS_PKK); float* PA = (float*)(p.ws + WS_PA);
#pragma unroll 1
    for (int pass = 0; pass < 2; ++pass) {
        const float* wsrc = pass == 0 ? p.w2 : p.a2;
        float wc[64];
#pragma unroll
        for (int j = 0; j < 64; ++j) wc[j] = wsrc[((size_t)l * 64 + j) * 256 + c];
        const float b0 = (pass == 0 ? p.w0 : p.a0)[l * 256 + c], kkc = p.k_k[l * 256 + c], muk = p.mu[l * 896 + 256 + c];
        for (int tile = blockIdx.x; tile < MTOK / 32; tile += gridDim.x) {
            const int m0 = tile * 32;
            for (int e = tid; e < 32 * 64; e += NTHREADS) {
                const int t = e >> 6, j = e & 63, m = m0 + t, col = UR + 768 + pass * 64 + j;
                const float cur = bf2f(U[(size_t)m * NU + col]);
                const float prev = (m % SEQ) ? bf2f(U[(size_t)(m - 1) * NU + col]) : 0.f;
                const float v = cur + (prev - cur) * p.mu[l * 896 + 768 + pass * 64 + j];
                xs[t][j] = pass == 0 ? tanhf(v) : v;
            }
            __syncthreads();
#pragma unroll 1
            for (int tt = 0; tt < 16; ++tt) {
                const int t = tg * 16 + tt, m = m0 + t;
                float sw = b0;
#pragma unroll
                for (int j = 0; j < 64; j += 4) {
                    const f32x4 xv = *(const f32x4*)(&xs[t][j]);
                    sw += xv[0] * wc[j] + xv[1] * wc[j + 1] + xv[2] * wc[j + 2] + xv[3] * wc[j + 3];
                }
                if (pass == 0) {
                    PW[(size_t)m * 256 + c] = __expf(-DECAY_SCALE * sigmoidf_(sw));
                    const float kc = bf2f(U[(size_t)m * NU + UR + 256 + c]);
                    const float kp = (m % SEQ) ? bf2f(U[(size_t)(m - 1) * NU + UR + 256 + c]) : 0.f;
                    const float kkv = (kc + (kp - kc) * muk) * kkc;
                    const float nrm = sqrtf(wave_sum(kkv * kkv));
                    PKK[(size_t)m * 256 + c] = kkv / fmaxf(nrm, 1e-12f);
                } else {
                    PA[(size_t)m * 256 + c] = sigmoidf_(sw);
                }
            }
            __syncthreads();
        }
    }
}

__device__ __forceinline__ void phase_attn_simple(const Params& p, unsigned char* lds, int first_block) {
    const int tid0 = otid(), tid = tid0 & 255, sub = tid0 >> 8;
    float (*Ks)[64] = (float (*)[64])(lds + sub * 33792);
    float (*Vs)[64] = (float (*)[64])(lds + sub * 33792 + 16384);
    float* cbs = (float*)(lds + sub * 33792 + 32768);
    const bf16_t* U = (const bf16_t*)(p.ws + WS_U);
    const float* CB = (const float*)(p.ws + WS_CB);
    bf16_t* Y = (bf16_t*)(p.ws + WS_Y);
    const int nblk = (int)gridDim.x - first_block;
    if ((int)blockIdx.x < first_block) return;
    for (int it = (int)blockIdx.x - first_block; it < NB * 4 * (SEQ / 256); it += nblk) {
        const int qb = (SEQ / 256 - 1) - it / (NB * 4), bh = (it % (NB * 4)) * 2 + sub, b = bh >> 3, h = bh & 7;
        const int qpos = qb * 256 + tid;
        const size_t mrow = (size_t)b * SEQ + qpos;
        float q[64], o[64];
        {
            const bf16_t* qp = U + mrow * NU + UQ + h * 64;
#pragma unroll
            for (int d = 0; d < 64; d += 8) { const u32x4 w = *(const u32x4*)(qp + d);
                q[d] = bflo(w.x); q[d + 1] = bfhi(w.x); q[d + 2] = bflo(w.y); q[d + 3] = bfhi(w.y); q[d + 4] = bflo(w.z); q[d + 5] = bfhi(w.z); q[d + 6] = bflo(w.w); q[d + 7] = bfhi(w.w); }
        }
#pragma unroll
        for (int d = 0; d < 64; ++d) o[d] = 0.f;
        float mrun = -1e30f, lrun = 0.f;
        const int ntile = (qb * 256 + 256) / 64;
        for (int kt = 0; kt < ntile; ++kt) {
            __syncthreads();
            {
                const int key = tid >> 2, ch = (tid & 3) * 16;
                const bf16_t* kp = U + ((size_t)b * SEQ + kt * 64 + key) * NU + UK + h * 64 + ch;
                const bf16_t* vp = U + ((size_t)b * SEQ + kt * 64 + key) * NU + UV + h * 64 + ch;
#pragma unroll
                for (int hh = 0; hh < 2; ++hh) {
                    const u32x4 kw = *(const u32x4*)(kp + hh * 8), vw = *(const u32x4*)(vp + hh * 8);
                    float* kd = &Ks[key][ch + hh * 8]; float* vd = &Vs[key][ch + hh * 8];
                    kd[0] = bflo(kw.x); kd[1] = bfhi(kw.x); kd[2] = bflo(kw.y); kd[3] = bfhi(kw.y); kd[4] = bflo(kw.z); kd[5] = bfhi(kw.z); kd[6] = bflo(kw.w); kd[7] = bfhi(kw.w);
                    vd[0] = bflo(vw.x); vd[1] = bfhi(vw.x); vd[2] = bflo(vw.y); vd[3] = bfhi(vw.y); vd[4] = bflo(vw.z); vd[5] = bfhi(vw.z); vd[6] = bflo(vw.w); vd[7] = bfhi(vw.w);
                }
                if (tid < 64) cbs[tid] = CB[((size_t)b * 8 + h) * SEQ + kt * 64 + tid];
            }
            __syncthreads();
#pragma unroll 1
            for (int key = 0; key < 64; ++key) {
                float acc = cbs[key];
#pragma unroll
                for (int d = 0; d < 64; d += 4) { const f32x4 kv = *(const f32x4*)(&Ks[key][d]); acc += q[d] * kv[0] + q[d + 1] * kv[1] + q[d + 2] * kv[2] + q[d + 3] * kv[3]; }
                const bool live = (kt * 64 + key <= qpos);
                if (live && acc > mrun + 16.f) {
                    const float sc = exp2f(mrun - acc);
                    mrun = acc; lrun *= sc;
#pragma unroll
                    for (int d = 0; d < 64; ++d) o[d] *= sc;
                }
                const float pj = live ? exp2f(acc - mrun) : 0.f;
                lrun += pj;
#pragma unroll
                for (int d = 0; d < 64; d += 4) { const f32x4 vv = *(const f32x4*)(&Vs[key][d]); o[d] += pj * vv[0]; o[d + 1] += pj * vv[1]; o[d + 2] += pj * vv[2]; o[d + 3] += pj * vv[3]; }
            }
        }
        const float rl = 1.f / lrun;
        const bf16_t* gp = U + mrow * NU + UG + h * 64;
        bf16_t* yp = Y + mrow * DM + h * 64;
#pragma unroll
        for (int d = 0; d < 64; d += 8) {
            const u32x4 gw = *(const u32x4*)(gp + d);
            u32x4 w;
            w.x = pk2(o[d] * rl * siluf_(bflo(gw.x)), o[d + 1] * rl * siluf_(bfhi(gw.x)));
            w.y = pk2(o[d + 2] * rl * siluf_(bflo(gw.y)), o[d + 3] * rl * siluf_(bfhi(gw.y)));
            w.z = pk2(o[d + 4] * rl * siluf_(bflo(gw.z)), o[d + 5] * rl * siluf_(bfhi(gw.z)));
            w.w = pk2(o[d + 6] * rl * siluf_(bflo(gw.w)), o[d + 7] * rl * siluf_(bfhi(gw.w)));
            *(u32x4*)(yp + d) = w;
        }
    }
}

__device__ __forceinline__ void phase_scan_simple(const Params& p, int l, unsigned char* lds) {
    constexpr int CH = 16;
    float (*vec)[6][64] = (float (*)[6][64])lds;
    float* bonus = (float*)(lds + CH * 6 * 64 * 4);
    const int i = otid();
    if (i >= 64) return;
    const bf16_t* U = (const bf16_t*)(p.ws + WS_U);
    const float* PW = (const float*)(p.ws + WS_PW); const float* PKK = (const float*)(p.ws + WS_PKK); const float* PA = (const float*)(p.ws + WS_PA);
    bf16_t* Y = (bf16_t*)(p.ws + WS_Y);
    const int bh = blockIdx.x;
    {
        const int b = bh >> 2, h = bh & 3, c = h * 64 + i;
        const float mur = p.mu[l * 896 + c], muk = p.mu[l * 896 + 256 + c], muv = p.mu[l * 896 + 512 + c];
        const float kac = p.k_a[l * 256 + c], rkc = p.r_k[l * 256 + c], lng = p.ln_g[l * 256 + c], lnb = p.ln_b[l * 256 + c];
        float S[64];
#pragma unroll
        for (int j = 0; j < 64; ++j) S[j] = 0.f;
        float rp = 0.f, kp = 0.f, vp = 0.f;
        for (int t0 = 0; t0 < SEQ; t0 += CH) {
            asm volatile("s_waitcnt lgkmcnt(0)" ::: "memory");
            for (int tt = 0; tt < CH; ++tt) {
                const size_t m = (size_t)b * SEQ + t0 + tt;
                const float rc = bf2f(U[m * NU + UR + c]), kc = bf2f(U[m * NU + UR + 256 + c]), vc = bf2f(U[m * NU + UR + 512 + c]);
                const float r = rc + (rp - rc) * mur, k = kc + (kp - kc) * muk, v = vc + (vp - vc) * muv;
                rp = rc; kp = kc; vp = vc;
                const float w = PW[m * 256 + c], kk = PKK[m * 256 + c], a = PA[m * 256 + c];
                const float kt = k * (1.f + (a - 1.f) * kac);
                vec[tt][0][i] = w; vec[tt][1][i] = kk; vec[tt][2][i] = kk * a; vec[tt][3][i] = kt; vec[tt][4][i] = r; vec[tt][5][i] = v;
                const float bs = wave_sum(r * kt * rkc);
                if (i == 0) bonus[tt] = bs;
            }
            asm volatile("s_waitcnt lgkmcnt(0)" ::: "memory");
            for (int tt = 0; tt < CH; ++tt) {
                const size_t m = (size_t)b * SEQ + t0 + tt;
                float sa = 0.f;
#pragma unroll
                for (int j = 0; j < 64; j += 4) { const f32x4 kk = *(const f32x4*)(&vec[tt][1][j]); sa += S[j] * kk[0] + S[j + 1] * kk[1] + S[j + 2] * kk[2] + S[j + 3] * kk[3]; }
                sa = -sa;
                const float vi = vec[tt][5][i];
                float oacc = 0.f;
#pragma unroll
                for (int j = 0; j < 64; j += 4) {
                    const f32x4 w = *(const f32x4*)(&vec[tt][0][j]), bb = *(const f32x4*)(&vec[tt][2][j]), kt = *(const f32x4*)(&vec[tt][3][j]), r = *(const f32x4*)(&vec[tt][4][j]);
#pragma unroll
                    for (int e = 0; e < 4; ++e) { S[j + e] = S[j + e] * w[e] + sa * bb[e] + vi * kt[e]; oacc += S[j + e] * r[e]; }
                }
                const float mean = wave_sum(oacc) * (1.f / 64.f);
                const float dv = oacc - mean;
                const float var = wave_sum(dv * dv) * (1.f / 64.f);
                const float on = dv * rsqrtf(var + 64e-5f) * lng + lnb + bonus[tt] * vi;
                const float g = bf2f(U[m * NU + UG + 512 + c]);
                Y[m * DM + 512 + c] = (bf16_t)f2bf(on * siluf_(g));
            }
        }
    }
}

__device__ __forceinline__ void phase_pool(const Params& p, int l) {
    const bf16_t* U = (const bf16_t*)(p.ws + WS_U);
    bf16_t* Y = (bf16_t*)(p.ws + WS_Y);
    const int tid = otid(), c = tid & 255, sub = tid >> 8, g = c >> 6, w = 2 << g;
    const float scl = p.pool_scale[l * 256 + c];
    for (int m = blockIdx.x * 2 + sub; m < MTOK; m += gridDim.x * 2) {
        const int t = m % SEQ;
        const int cnt = (t + 1 < w) ? t + 1 : w;
        float s = 0.f;
        for (int d = 0; d < cnt; ++d) s += bf2f(U[(size_t)(m - d) * NU + UP + c]);
        const float cur = bf2f(U[(size_t)m * NU + UP + c]);
        const float yv = (s / (float)cnt - cur) * scl;
        const float gg = bf2f(U[(size_t)m * NU + UG + 768 + c]);
        Y[(size_t)m * DM + 768 + c] = (bf16_t)f2bf(yv * siluf_(gg));
    }
}

__global__ void __launch_bounds__(NTHREADS, 2) mega_fwd(Params p) {
    extern __shared__ __attribute__((aligned(16))) unsigned char lds[];
    volatile LAS unsigned* MISC = (volatile LAS unsigned*)((LAS unsigned char*)lds + MISC_OFF);
    if (threadIdx.x < 32) MISC[threadIdx.x] = 0u;
    __syncthreads();
    XcdBarrier bar = xcd_barrier_post((unsigned*)(p.ws + WS_CTL) + CW_BAR, MISC + 8);
#define GRID_BAR() xcd_barrier(bar)
    bf16_t* XN = (bf16_t*)(p.ws + WS_XN); bf16_t* Y = (bf16_t*)(p.ws + WS_Y); bf16_t* U = (bf16_t*)(p.ws + WS_U); float* Z = (float*)(p.ws + WS_Z);

    phase_weights(p, lds);
    phase_mod(p, lds);
    GRID_BAR();
    phase_rows(p, 0, 0);
    GRID_BAR();
#pragma unroll 1
    for (int l = 0; l < NL; ++l) {
        const bf16_t* WT = (const bf16_t*)(p.ws + WS_WT) + (size_t)l * NU * DM;
        const bf16_t* WOT = (const bf16_t*)(p.ws + WS_WOT) + (size_t)l * DM * DM;
        phase_gemm_simple<0>(lds, XN, WT, U, MTOK, NU, DM, p.q_gain + l * 64, p.k_gain + l * 64);
        GRID_BAR();
        phase_cum(p, l, lds);
        phase_rwkv_prep(p, l, lds);
        phase_pool(p, l);
        GRID_BAR();
        if (blockIdx.x < NB * 4) phase_scan_simple(p, l, lds);
        else phase_attn_simple(p, lds, NB * 4);
        GRID_BAR();
        phase_gemm_simple<1>(lds, Y, WOT, Z, MTOK, DM, DM, nullptr, nullptr);
        GRID_BAR();
        phase_rows(p, 1, l);
        if (l + 1 < NL) GRID_BAR();
    }
}

extern "C" void kernel_launch(void* const* d_in, const int* in_sizes, int n_in, void* d_out, int out_size, void* d_ws, size_t ws_size, hipStream_t stream) {
    static int grid = 0;
    if (grid == 0) {
        if (n_in != 23 || ws_size < WS_END) { fprintf(stderr, "kernel_launch: unexpected n_in %d / ws_size %zu\n", n_in, ws_size); grid = -1; return; }
        int dev = 0, cus = 0, per_cu = 0;
        if (hipGetDevice(&dev) != hipSuccess || hipDeviceGetAttribute(&cus, hipDeviceAttributeMultiprocessorCount, dev) != hipSuccess) { grid = -1; return; }
        if (hipFuncSetAttribute((const void*)mega_fwd, hipFuncAttributeMaxDynamicSharedMemorySize, LDS_BYTES) != hipSuccess) { fprintf(stderr, "kernel_launch: hipFuncSetAttribute failed\n"); grid = -1; return; }
        if (hipOccupancyMaxActiveBlocksPerMultiprocessor(&per_cu, (const void*)mega_fwd, NTHREADS, LDS_BYTES) != hipSuccess || per_cu < 1) { fprintf(stderr, "kernel_launch: occupancy query failed (%d)\n", per_cu); grid = -1; return; }
        grid = cus;
        if (grid <= NB * 4) { fprintf(stderr, "kernel_launch: grid %d too small\n", grid); grid = -1; return; }
    }
    if (grid < 0) return;
    (void)hipMemsetAsync((char*)d_ws + WS_CTL, 0, CTL_ZERO_BYTES, stream);
    Params p{};
    const float** f = (const float**)&p;
    for (int i = 0; i < 23; ++i) f[i] = (const float*)d_in[i];
    p.out = (float*)d_out; p.ws = (unsigned char*)d_ws;
    void* args[] = {&p};
    hipError_t e = hipLaunchCooperativeKernel((const void*)mega_fwd, dim3(grid), dim3(NTHREADS), args, LDS_BYTES, stream);
    if (e != hipSuccess) fprintf(stderr, "cooperative launch failed: %s (grid %d)\n", hipGetErrorString(e), grid);
}
```

```cpp
#include <hip/hip_runtime.h>
#include <hip/hip_bf16.h>
#include <cstdio>
#include <cstdint>

constexpr int NB = 8, SEQ = 4096, DM = 1024, MTOK = NB * SEQ, NL = 2;
constexpr int D_IN = 3720, NU = 3840;
constexpr int UQ = 0, UK = 512, UV = 1024, UR = 1536  , UP = 2432  , UG = 2688  , UF = 3712  ;
constexpr int SQ = 0, SF = 1536, SR = 1544, SP = 2440, SG = 2696;
constexpr float C2 = 0.125f * 1.4426950408889634f;
constexpr float LOG2E = 1.4426950408889634f;
constexpr float DECAY_SCALE = 0.6065306597126334f;

typedef unsigned short bf16_t;
typedef short bf16x8 __attribute__((ext_vector_type(8)));
typedef float f32x4 __attribute__((ext_vector_type(4)));
typedef unsigned u32x4 __attribute__((ext_vector_type(4)));
typedef unsigned u32x2 __attribute__((ext_vector_type(2)));

__device__ __forceinline__ unsigned f2bf(float f) { unsigned u = __builtin_bit_cast(unsigned, f); return (u + 0x7fffu + ((u >> 16) & 1u)) >> 16; }
__device__ __forceinline__ unsigned pk2(float lo, float hi) { return f2bf(lo) | (f2bf(hi) << 16); }
__device__ __forceinline__ float bf2f(unsigned short b) { return __builtin_bit_cast(float, (unsigned)b << 16); }
__device__ __forceinline__ float bflo(unsigned w) { return __builtin_bit_cast(float, w << 16); }
__device__ __forceinline__ float bfhi(unsigned w) { return __builtin_bit_cast(float, w & 0xffff0000u); }
__device__ __forceinline__ float sigmoidf_(float x) { return 1.f / (1.f + __expf(-x)); }
__device__ __forceinline__ float siluf_(float x) { return x / (1.f + __expf(-x)); }
__device__ __forceinline__ float wave_sum(float v) {
#pragma unroll
    for (int o = 1; o < 64; o <<= 1) v += __shfl_xor(v, o);
    return v;
}

__device__ __forceinline__ int otid() { int t = threadIdx.x; asm volatile("" : "+v"(t)); return t; }

constexpr size_t MiB = 1u << 20;
constexpr size_t WS_CTL = 0;
constexpr size_t WS_MOD = 1 * MiB;
constexpr size_t WS_WT = 2 * MiB;
constexpr size_t WS_WOT = 18 * MiB;
constexpr size_t WS_CB = 22 * MiB;
constexpr size_t WS_XN = 24 * MiB;
constexpr size_t WS_O32 = 24 * MiB;
constexpr size_t WS_BON = 23 * MiB;
constexpr size_t WS_PA = 56 * MiB;
constexpr size_t WS_Y = 88 * MiB;
constexpr size_t WS_U = 152 * MiB;
constexpr size_t WS_Z = 152 * MiB;
constexpr size_t WS_REC = 392 * MiB;
constexpr int REC_B = 912;
constexpr size_t WS_END = 508 * MiB;
constexpr size_t CTL_ZERO_BYTES = 65536;
constexpr int CW_ATTQ = 8192;
constexpr int CW_BAR = 1024;

struct Params {
    const float *x, *c, *ada_w, *ada_b, *norm_pre, *norm_post, *w_in, *q_gain, *k_gain, *f_bias, *mu, *w0, *w2, *a0, *a2, *k_k, *k_a, *r_k, *ln_g, *ln_b,
        *pool_w, *pool_scale, *w_out;
    float* out;
    unsigned char* ws;
};


#define LAS __attribute__((address_space(3)))
constexpr int NTHREADS = 512;
constexpr int LDS_BYTES = 147456;
constexpr int MISC_OFF = LDS_BYTES - 128;

#define XB_TMO      128
#define XB_XCNT(j)  (256  + 64 * (j))
#define XB_XSUB(j)  (1280 + 64 * (j))
#define XB_XGEN(j)  (2304 + 64 * (j))
#define XB_TOP      3328
#define XB_TOPGEN   3392
#define XCD_BAR_WORDS 3456
#define XB_SPIN_CAP (1u << 18)
__device__ __forceinline__ unsigned xb_ld(unsigned* p)              { return __hip_atomic_load(p, __ATOMIC_RELAXED, __HIP_MEMORY_SCOPE_AGENT); }
__device__ __forceinline__ unsigned xb_add(unsigned* p, unsigned v) { return __hip_atomic_fetch_add(p, v, __ATOMIC_RELAXED, __HIP_MEMORY_SCOPE_AGENT); }
__device__ __forceinline__ unsigned xb_xcc_id() { return (unsigned)__builtin_amdgcn_s_getreg((3 << 11) | 20) & 0xFu; }
#define XB_SPIN(cond, bar) do { unsigned _sp = 0; while (cond) { __builtin_amdgcn_s_sleep(1); \
    if ((++_sp & 255u) == 0u) { if (xb_ld(&(bar)[XB_TMO])) break; if (_sp > XB_SPIN_CAP) { atomicAdd(&(bar)[XB_TMO], 1u); break; } } } } while (0)
struct XcdBarrier { unsigned* bar; unsigned x; volatile LAS unsigned* st; };
__device__ __forceinline__ XcdBarrier xcd_barrier_post(unsigned* bar, volatile LAS unsigned* st) {
    XcdBarrier b; b.bar = bar; b.x = xb_xcc_id(); b.st = st;
    if (threadIdx.x == 0) (void)xb_add(&bar[XB_XCNT(b.x)], 1u);
    return b;
}
__device__ __forceinline__ void xcd_barrier_complete(unsigned* bar, unsigned x, unsigned& nloc, unsigned& nx) {
    const unsigned G = gridDim.x * gridDim.y * gridDim.z;
    unsigned sum, cnt, mine, sp = 0u;
    for (;;) {
        sum = 0u; cnt = 0u; mine = 0u;
#pragma unroll
        for (unsigned j = 0; j < 16; ++j) { const unsigned c = xb_ld(&bar[XB_XCNT(j)]); sum += c; cnt += (c > 0u) ? 1u : 0u; mine = (j == x) ? c : mine; }
        if (sum == G) break;
        __builtin_amdgcn_s_sleep(1);
        if ((++sp & 255u) == 0u) { if (xb_ld(&bar[XB_TMO])) break; if (sp > XB_SPIN_CAP) { atomicAdd(&bar[XB_TMO], 1u); break; } }
    }
    nloc = mine > 0u ? mine : 1u; nx = cnt > 0u ? cnt : 1u;
}
__device__ __forceinline__ void xcd_barrier(const XcdBarrier& b) {
    asm volatile("s_waitcnt vmcnt(0)" ::: "memory");
    __syncthreads();
    if (threadIdx.x == 0) {
        unsigned* bar = b.bar;
        __builtin_amdgcn_s_waitcnt(0);
        unsigned nloc = b.st[0], nx = b.st[1];
        if (nloc == 0u) { xcd_barrier_complete(bar, b.x, nloc, nx); b.st[0] = nloc; b.st[1] = nx; }
        const unsigned old = xb_add(&bar[XB_XSUB(b.x)], 1u);
        const unsigned gen = old / nloc;
        if (old + 1u == (gen + 1u) * nloc) {
            __builtin_amdgcn_fence(__ATOMIC_RELEASE, "agent");
            asm volatile("s_waitcnt vmcnt(0)" ::: "memory");
            const unsigned og = xb_add(&bar[XB_TOP], 1u);
            const unsigned tg = og / nx;
            if (og + 1u == (tg + 1u) * nx) xb_add(&bar[XB_TOPGEN], 1u);
            else XB_SPIN(xb_ld(&bar[XB_TOPGEN]) == tg, bar);
            __builtin_amdgcn_fence(__ATOMIC_ACQUIRE, "agent");
            xb_add(&bar[XB_XGEN(b.x)], 1u);
            asm volatile("s_waitcnt vmcnt(0)" ::: "memory");
        } else {
            XB_SPIN(xb_ld(&bar[XB_XGEN(b.x)]) == gen, bar);
            __builtin_amdgcn_fence(__ATOMIC_ACQUIRE, "agent");
            asm volatile("s_waitcnt vmcnt(0)" ::: "memory");
        }
    }
    __syncthreads();
}


namespace pg8 {
#define PG8_LAS __attribute__((address_space(3)))
typedef unsigned short bf16_t;
typedef short bf16x8 __attribute__((ext_vector_type(8)));
typedef float f32x4 __attribute__((ext_vector_type(4)));
typedef unsigned u32x4 __attribute__((ext_vector_type(4)));
constexpr int BM = 256, BK = 64, HALF = 128, HTB = HALF * BK * 2  , STAGE_BYTES = 8 * HTB, NXCD = 8, WGM = 8;

__host__ __device__ __forceinline__ int lds_byte(int r, int c) { const int st = (r >> 4) * 2 + (c >> 5), rr = r & 15, cc = c & 31, ob = rr * 64 + cc * 2; return st * 1024 + (ob ^ (((ob >> 9) & 1) << 5)); }
__host__ __device__ __forceinline__ void stage_rc(int b, int& R, int& C) { const int st = b / 1024, sb = b % 1024, swz = sb ^ (((sb >> 9) & 1) << 5); R = (st >> 1) * 16 + swz / 64; C = (st & 1) * 32 + (swz % 64) / 2; }
__host__ __device__ __forceinline__ int perm32(int rho) { const int n = rho >> 4, i = rho & 15; return 8 * (i >> 2) + 4 * n + (i & 3); }

struct Unit { int pm, pn; };
struct Gemm { const bf16_t* A; const bf16_t* Bt; int M, N, K; };

struct StaticOrder {
    int nM, nN, nwg, G, c;
    __host__ __device__ void init(int M, int N, int G_, int c_) { nM = M / BM; nN = N / BM; nwg = nM * nN; G = G_; c = c_; }
    __host__ __device__ bool next(int i, Unit& u) const {
        const long L = (long)i * G + c; if (L >= nwg) return false;
        int wgid = (int)L; { const int q = nwg / NXCD, r = nwg % NXCD, xcd = wgid % NXCD, off = wgid / NXCD; wgid = (xcd < r ? xcd * (q + 1) : r * (q + 1) + (xcd - r) * q) + off; }
        const int nig = WGM * nN, gid = wgid / nig, fm = gid * WGM, gsz = (nM - fm) < WGM ? (nM - fm) : WGM;
        u.pm = fm + ((wgid % nig) % gsz); u.pn = (wgid % nig) / gsz; return true;
    }
    __device__ __forceinline__ void a_ready(const Unit&) const {}
    __device__ __forceinline__ void done(const Unit&) const {}
};

__device__ __forceinline__ unsigned cvt_pk_bf16(float lo, float hi) { unsigned r; asm volatile("v_cvt_pk_bf16_f32 %0, %1, %2" : "=v"(r) : "v"(lo), "v"(hi)); return r; }

struct EpiU {
    static constexpr bool PERM = true, AFTER_DRAIN = false;
    bf16_t* U; const float* qg; const float* kg; int ldc;
    __device__ __forceinline__ void operator()(const f32x4 (&acc)[2][2][4][2], const Unit& u, int wr, int wc, int fr, int fq) const {
        const int row0 = u.pm * BM + wr * 64 + fr;
        if (u.pn < 4) {
            const float* gp = (u.pn < 2 ? qg : kg) + 8 * fq; const float mult = u.pn < 2 ? (0.125f * 1.4426950408889634f) : 1.f;
            f32x4 gv[2][2];
#pragma unroll
            for (int bj = 0; bj < 2; ++bj)
#pragma unroll
                for (int n = 0; n < 2; ++n) gv[bj][n] = *(const f32x4*)(gp + 32 * bj + 4 * n);
            const int col0 = u.pn * BM + 64 * wc + 8 * fq;
#pragma unroll
            for (int ai = 0; ai < 2; ++ai)
#pragma unroll
                for (int m = 0; m < 4; ++m) {
                    float s = 0.f;
#pragma unroll
                    for (int bj = 0; bj < 2; ++bj)
#pragma unroll
                        for (int n = 0; n < 2; ++n) { const f32x4 x = acc[ai][bj][m][n]; s += (x[0] * x[0] + x[1] * x[1]) + (x[2] * x[2] + x[3] * x[3]); }
                    s += __shfl_xor(s, 16); s += __shfl_xor(s, 32);
                    const float sc = rsqrtf(s * (1.f / 64.f) + 1e-6f) * mult;
                    bf16_t* rowp = U + (size_t)(row0 + ai * HALF + m * 16) * ldc + col0;
#pragma unroll
                    for (int bj = 0; bj < 2; ++bj) { const f32x4 v0 = acc[ai][bj][m][0] * sc * gv[bj][0], v1 = acc[ai][bj][m][1] * sc * gv[bj][1];
                        u32x4 w; w.x = cvt_pk_bf16(v0[0], v0[1]); w.y = cvt_pk_bf16(v0[2], v0[3]); w.z = cvt_pk_bf16(v1[0], v1[1]); w.w = cvt_pk_bf16(v1[2], v1[3]);
                        *(u32x4*)(rowp + bj * 32) = w; }
                }
        } else {
            const int col0 = u.pn * BM + wc * 32 + 8 * fq;
#pragma unroll
            for (int ai = 0; ai < 2; ++ai)
#pragma unroll
                for (int m = 0; m < 4; ++m) { bf16_t* rowp = U + (size_t)(row0 + ai * HALF + m * 16) * ldc + col0;
#pragma unroll
                    for (int bj = 0; bj < 2; ++bj) { const f32x4 v0 = acc[ai][bj][m][0], v1 = acc[ai][bj][m][1];
                        u32x4 w; w.x = cvt_pk_bf16(v0[0], v0[1]); w.y = cvt_pk_bf16(v0[2], v0[3]); w.z = cvt_pk_bf16(v1[0], v1[1]); w.w = cvt_pk_bf16(v1[2], v1[3]);
                        *(u32x4*)(rowp + bj * HALF) = w; } }
        }
    }
};
struct EpiF32 {
    static constexpr bool PERM = false, AFTER_DRAIN = false;
    float* C; int ldc;
    __device__ __forceinline__ void operator()(const f32x4 (&acc)[2][2][4][2], const Unit& u, int wr, int wc, int fr, int fq) const {
        const int row0 = u.pm * BM + wr * 64 + fr, col0 = u.pn * BM + wc * 32 + 4 * fq;
#pragma unroll
        for (int ai = 0; ai < 2; ++ai)
#pragma unroll
            for (int m = 0; m < 4; ++m) { float* rowp = C + (size_t)(row0 + ai * HALF + m * 16) * ldc + col0;
#pragma unroll
                for (int bj = 0; bj < 2; ++bj)
#pragma unroll
                    for (int n = 0; n < 2; ++n) *(f32x4*)(rowp + bj * HALF + n * 16) = acc[ai][bj][m][n]; }
    }
};

template <class Epi, class Sched, bool ALIGN_EPI = false, bool SP2 = false>
__device__ __forceinline__ void gemm_phase(PG8_LAS unsigned char* lds, const Gemm g, const Sched& S, const Epi& E) {
    int tid_ = threadIdx.x; asm volatile("" : "+v"(tid_));
    const int tid = tid_, wid = __builtin_amdgcn_readfirstlane(tid >> 6), lane = tid & 63, wr = wid >> 2, wc = wid & 3, fr = lane & 15, fq = lane >> 4;
    const int K = g.K, nt = K / BK;
    unsigned voffA[2], voffB[2];
#pragma unroll
    for (int i = 0; i < 2; ++i) { int R, C; stage_rc(tid * 16 + i * 8192, R, C); const int Rb = Epi::PERM ? ((R & ~31) + perm32(R & 31)) : R;
        voffA[i] = (unsigned)(R * K + C) * 2u; voffB[i] = (unsigned)(Rb * K + C) * 2u; }
    const size_t kstep = (size_t)(BK * 2);
    const size_t hstep = (size_t)HALF * K * 2;
    const size_t tstep = 2 * hstep;
    const unsigned ldsw = (unsigned)wid * 1024u;
    const int aoff = lds_byte(wr * 64 + fr, fq * 8), boff = lds_byte(wc * 32 + fr, fq * 8);
#define PG8_SA(b, h) (((b) * 2 + (h)) * HTB)
#define PG8_SB(b, h) ((4 + (b) * 2 + (h)) * HTB)
#define PG8_STAGE(bufoff, gbase, voff) do { _Pragma("unroll") for (int _i = 0; _i < 2; ++_i) \
        __builtin_amdgcn_global_load_lds((const unsigned*)((const char*)(gbase) + (voff)[_i]), (PG8_LAS unsigned*)(lds + (bufoff) + ldsw + _i * 8192), 16, 0, 0); } while (0)
#define PG8_LDA(dst, b, h) do { _Pragma("unroll") for (int m = 0; m < 4; ++m) _Pragma("unroll") for (int k = 0; k < 2; ++k) dst[m][k] = *(const PG8_LAS bf16x8*)(lds + PG8_SA(b, h) + aoff + m * 2048 + k * 1024); } while (0)
#define PG8_LDB(dst, b, h) do { _Pragma("unroll") for (int n = 0; n < 2; ++n) _Pragma("unroll") for (int k = 0; k < 2; ++k) dst[n][k] = *(const PG8_LAS bf16x8*)(lds + PG8_SB(b, h) + boff + n * 2048 + k * 1024); } while (0)
#define PG8_MMA(ai, bj, At, Bt) do { __builtin_amdgcn_s_setprio(1); _Pragma("unroll") for (int m = 0; m < 4; ++m) _Pragma("unroll") for (int n = 0; n < 2; ++n) _Pragma("unroll") for (int k = 0; k < 2; ++k) \
        acc[ai][bj][m][n] = __builtin_amdgcn_mfma_f32_16x16x32_bf16(Bt[n][k], At[m][k], acc[ai][bj][m][n], 0, 0, 0); __builtin_amdgcn_s_setprio(0); } while (0)
#define PG8_WAIT_V(n) asm volatile("s_waitcnt vmcnt(" #n ")" ::: "memory")
#define PG8_WAIT_L(n) asm volatile("s_waitcnt lgkmcnt(" #n ")" ::: "memory")
#define PG8_BAR __builtin_amdgcn_s_barrier()
#define PG8_SCHED __builtin_amdgcn_sched_barrier(0)
    Unit cur, nxt; int ui = 0;
    if (!S.next(0, cur)) return;
    f32x4 acc[2][2][4][2];
#pragma unroll
    for (int a = 0; a < 2; ++a)
#pragma unroll
        for (int b = 0; b < 2; ++b)
#pragma unroll
            for (int m = 0; m < 4; ++m)
#pragma unroll
                for (int n = 0; n < 2; ++n) acc[a][b][m][n] = (f32x4){0.f, 0.f, 0.f, 0.f};
    bf16x8 At[4][2], B0[2][2], B1[2][2];
    const char* cA = (const char*)g.A + (size_t)cur.pm * tstep; const char* cB = (const char*)g.Bt + (size_t)cur.pn * tstep;
    S.a_ready(cur);
    if constexpr (SP2) {
        PG8_STAGE(PG8_SB(0, 0), cB, voffB); PG8_STAGE(PG8_SB(0, 1), cB + hstep, voffB); PG8_STAGE(PG8_SA(0, 0), cA, voffA); PG8_STAGE(PG8_SA(0, 1), cA + hstep, voffA);
        if (wr == 1) PG8_BAR;
        PG8_WAIT_V(2); PG8_BAR;
        PG8_STAGE(PG8_SB(1, 0), cB + kstep, voffB); PG8_STAGE(PG8_SA(1, 0), cA + kstep, voffA); PG8_STAGE(PG8_SB(1, 1), cB + hstep + kstep, voffB);
        PG8_WAIT_V(6); PG8_BAR;
    } else {
        PG8_STAGE(PG8_SB(0, 0), cB, voffB); PG8_STAGE(PG8_SA(0, 0), cA, voffA); PG8_STAGE(PG8_SB(0, 1), cB + hstep, voffB); PG8_STAGE(PG8_SA(0, 1), cA + hstep, voffA);
        if (wr == 1) PG8_BAR;
        PG8_WAIT_V(4); PG8_BAR;
        PG8_STAGE(PG8_SB(1, 0), cB + kstep, voffB); PG8_STAGE(PG8_SA(1, 0), cA + kstep, voffA); PG8_STAGE(PG8_SB(1, 1), cB + hstep + kstep, voffB);
        PG8_WAIT_V(6); PG8_BAR;
    }
    for (;;) {
        const bool has_next = S.next(ui + 1, nxt);
        const char* nA = has_next ? (const char*)g.A + (size_t)nxt.pm * tstep : cA; const char* nB = has_next ? (const char*)g.Bt + (size_t)nxt.pn * tstep : cB;
        for (int t = 0; t < nt; t += 2) {
            const bool last = (t == nt - 2);
            const char* a1 = cA + (size_t)(t + 1) * kstep;
            const char* a2 = last ? nA : cA + (size_t)(t + 2) * kstep; const char* b2 = last ? nB : cB + (size_t)(t + 2) * kstep;
            const char* a3 = a2 + kstep; const char* b3 = b2 + kstep;
            if (last && has_next) S.a_ready(nxt);
            if constexpr (SP2) {
            PG8_LDB(B0, 0, 0); PG8_LDB(B1, 0, 1); PG8_SCHED; PG8_LDA(At, 0, 0); PG8_STAGE(PG8_SA(1, 1), a1 + hstep, voffA);
            PG8_WAIT_V(8); PG8_WAIT_L(0); PG8_BAR; PG8_MMA(0, 0, At, B0); PG8_MMA(0, 1, At, B1); PG8_BAR; PG8_SCHED;
            PG8_LDA(At, 0, 1); PG8_STAGE(PG8_SB(0, 0), b2, voffB); PG8_STAGE(PG8_SB(0, 1), b2 + hstep, voffB); PG8_STAGE(PG8_SA(0, 0), a2, voffA);
            PG8_WAIT_V(8); PG8_WAIT_L(0); PG8_BAR; PG8_MMA(1, 0, At, B0); PG8_MMA(1, 1, At, B1); PG8_BAR; PG8_SCHED;
            PG8_LDB(B0, 1, 0); PG8_LDB(B1, 1, 1); PG8_SCHED; PG8_LDA(At, 1, 0); PG8_STAGE(PG8_SA(0, 1), a2 + hstep, voffA);
            PG8_WAIT_V(8); PG8_WAIT_L(0); PG8_BAR; PG8_MMA(0, 0, At, B0); PG8_MMA(0, 1, At, B1); PG8_BAR; PG8_SCHED;
            PG8_LDA(At, 1, 1); PG8_STAGE(PG8_SB(1, 0), b3, voffB); PG8_STAGE(PG8_SB(1, 1), b3 + hstep, voffB); PG8_STAGE(PG8_SA(1, 0), a3, voffA);
            PG8_WAIT_V(8); PG8_WAIT_L(0); PG8_BAR; PG8_MMA(1, 0, At, B0); PG8_MMA(1, 1, At, B1); PG8_BAR; PG8_SCHED;
            } else {
            PG8_LDB(B0, 0, 0); PG8_SCHED; PG8_LDA(At, 0, 0); PG8_STAGE(PG8_SA(1, 1), a1 + hstep, voffA);
            PG8_WAIT_L(8); PG8_BAR; PG8_WAIT_L(0); PG8_MMA(0, 0, At, B0); PG8_BAR; PG8_SCHED;
            PG8_LDB(B1, 0, 1); PG8_STAGE(PG8_SB(0, 0), b2, voffB);
            PG8_BAR; PG8_WAIT_L(0); PG8_MMA(0, 1, At, B1); PG8_BAR;
            PG8_LDA(At, 0, 1); PG8_STAGE(PG8_SA(0, 0), a2, voffA);
            PG8_BAR; PG8_WAIT_L(0); PG8_MMA(1, 0, At, B0); PG8_BAR; PG8_SCHED;
            PG8_STAGE(PG8_SB(0, 1), b2 + hstep, voffB);
            PG8_WAIT_V(6); PG8_BAR; PG8_MMA(1, 1, At, B1); PG8_BAR;
            PG8_LDB(B0, 1, 0); PG8_SCHED; PG8_LDA(At, 1, 0); PG8_STAGE(PG8_SA(0, 1), a2 + hstep, voffA);
            PG8_WAIT_L(8); PG8_BAR; PG8_WAIT_L(0); PG8_MMA(0, 0, At, B0); PG8_BAR; PG8_SCHED;
            PG8_LDB(B1, 1, 1); PG8_STAGE(PG8_SB(1, 0), b3, voffB);
            PG8_BAR; PG8_WAIT_L(0); PG8_MMA(0, 1, At, B1); PG8_BAR;
            PG8_LDA(At, 1, 1); PG8_STAGE(PG8_SA(1, 0), a3, voffA);
            PG8_BAR; PG8_WAIT_L(0); PG8_MMA(1, 0, At, B0); PG8_BAR; PG8_SCHED;
            PG8_STAGE(PG8_SB(1, 1), b3 + hstep, voffB);
            PG8_WAIT_V(6); PG8_BAR; PG8_MMA(1, 1, At, B1); PG8_BAR;
            }
        }
        if constexpr (ALIGN_EPI) { if (wr == 0) PG8_BAR; }
        if constexpr (!Epi::AFTER_DRAIN) { E(acc, cur, wr, wc, fr, fq); S.done(cur); }
        if (!has_next) break;
#pragma unroll
        for (int a = 0; a < 2; ++a)
#pragma unroll
            for (int b = 0; b < 2; ++b)
#pragma unroll
                for (int m = 0; m < 4; ++m)
#pragma unroll
                    for (int n = 0; n < 2; ++n) acc[a][b][m][n] = (f32x4){0.f, 0.f, 0.f, 0.f};
        cur = nxt; cA = nA; cB = nB; ++ui;
        if constexpr (ALIGN_EPI) { if (wr == 1) PG8_BAR; }
    }
    PG8_WAIT_V(0);
    if constexpr (!ALIGN_EPI) { if (wr == 0) PG8_BAR; }
    PG8_BAR;
    if constexpr (Epi::AFTER_DRAIN) { E.fused(acc, cur, wr, wc, fr, fq, lds, wid, lane); S.done(cur); }
#undef PG8_SA
#undef PG8_SB
#undef PG8_STAGE
#undef PG8_LDA
#undef PG8_LDB
#undef PG8_MMA
#undef PG8_WAIT_V
#undef PG8_WAIT_L
#undef PG8_BAR
#undef PG8_SCHED
}
}

#include <hip/hip_bf16.h>
#include <cmath>
namespace attn_body {
using bf16=__hip_bfloat16;
using bf16x8=__attribute__((ext_vector_type(8)))short;
using s16x4=__attribute__((ext_vector_type(4)))short;
using f32x16=__attribute__((ext_vector_type(16)))float;
using u32x4=__attribute__((ext_vector_type(4)))unsigned;
constexpr int BATCH=8,NHEAD=8,SEQ=4096,D=64,DM=3840,OPITCH=1024;
constexpr int NW=8,QBLK=32,QB=QBLK*NW,KVBLK=64,NQB=SEQ/QB;
constexpr int ATTN_PITCH=DM, ATTN_UNIT_ROWS=QB;
__device__ __forceinline__ int crow(int r,int hi){return (r&3)+8*(r>>2)+4*hi;}
#define SBAR() __builtin_amdgcn_sched_barrier(0)
__device__ __forceinline__ void cmask(f32x16&p0,f32x16&p1,int jb,int qrel,int hi){
  const float NEG=-INFINITY; int kb=64*jb+4*hi;
  #pragma unroll
  for(int r=0;r<16;++r){int kv=kb+(r&3)+8*(r>>2); if(kv>qrel)p0[r]=NEG; if(kv+32>qrel)p1[r]=NEG;}
}

constexpr int NSLOT=3, SLOTB=8192;
constexpr int LDS_K=0, LDS_V=NSLOT*SLOTB, LDS_WS=2*NSLOT*SLOTB, LDS_OST=LDS_WS+NW*64*4, LDS_CB=LDS_OST+NW*4096, LDS_BYTES=LDS_CB+SEQ*4+1024;
constexpr float C2=0.125f*1.4426950408889634f;
__device__ __forceinline__ void glds16(const void*gsrc,unsigned lds_dst){unsigned keep;
  asm volatile("s_mov_b32 %0, m0\n\ts_mov_b32 m0, %2\n\ts_nop 0\n\tglobal_load_lds_dwordx4 %1, off\n\ts_mov_b32 m0, %0":"=&s"(keep):"v"(gsrc),"s"(lds_dst):"memory");}
__device__ __forceinline__ float max3f(float a,float b,float c){float r;asm("v_max3_f32 %0, %1, %2, %3":"=v"(r):"v"(a),"v"(b),"v"(c));return r;}
__device__ __forceinline__ float max2f(float a,float b){float r;asm("v_max_f32_e32 %0, %1, %2":"=v"(r):"v"(a),"v"(b));return r;}
__device__ __forceinline__ float fadd_s(float a,float b){float r;asm("v_add_f32_e32 %0, %1, %2":"=v"(r):"v"(a),"v"(b));return r;}
__device__ __forceinline__ float fsub_s(float a,float b){float r;asm("v_sub_f32_e32 %0, %1, %2":"=v"(r):"v"(a),"v"(b));return r;}
typedef float f32x4v __attribute__((ext_vector_type(4))); typedef float f32x2_t __attribute__((ext_vector_type(2))); typedef __bf16 bf16x2_t __attribute__((ext_vector_type(2)));
__device__ __forceinline__ unsigned cvtpk_s(float lo,float hi){f32x2_t v={lo,hi};bf16x2_t b=__builtin_convertvector(v,bf16x2_t);return __builtin_bit_cast(unsigned,b);}
#define WAIT_BAR(N) asm volatile("s_waitcnt vmcnt(" #N ") lgkmcnt(0)\n\ts_barrier":::"memory")

__device__ __forceinline__ void qkt(f32x16&p0,f32x16&p1,const char*Kslot,const bf16x8*qr,int r32,int hi){
  const char*kb=Kslot+hi*1024+r32*16;
  #pragma unroll
  for(int d0=0;d0<4;++d0){
    const bf16x8 b0=*reinterpret_cast<const bf16x8*>(kb+d0*2048);
    const bf16x8 b1=*reinterpret_cast<const bf16x8*>(kb+d0*2048+512);
    p0=__builtin_amdgcn_mfma_f32_32x32x16_bf16(b0,qr[d0],p0,0,0,0);p1=__builtin_amdgcn_mfma_f32_32x32x16_bf16(b1,qr[d0],p1,0,0,0);}
}
typedef __attribute__((address_space(3))) const char* lds_cptr;
typedef short v4i16_t __attribute__((ext_vector_type(4)));
__device__ __forceinline__ void kload8(bf16x8*kf,lds_cptr kp){
  kf[0]=*(const __attribute__((address_space(3))) bf16x8*)(kp);      kf[1]=*(const __attribute__((address_space(3))) bf16x8*)(kp+512);
  kf[2]=*(const __attribute__((address_space(3))) bf16x8*)(kp+2048); kf[3]=*(const __attribute__((address_space(3))) bf16x8*)(kp+2560);
  kf[4]=*(const __attribute__((address_space(3))) bf16x8*)(kp+4096); kf[5]=*(const __attribute__((address_space(3))) bf16x8*)(kp+4608);
  kf[6]=*(const __attribute__((address_space(3))) bf16x8*)(kp+6144); kf[7]=*(const __attribute__((address_space(3))) bf16x8*)(kp+6656);
}
__device__ __forceinline__ void kload2(bf16x8*kf,lds_cptr kp,int j){ kf[2*j]=*(const __attribute__((address_space(3))) bf16x8*)(kp+j*2048); kf[2*j+1]=*(const __attribute__((address_space(3))) bf16x8*)(kp+j*2048+512); }
__device__ __forceinline__ s16x4 vtr(lds_cptr p){ return __builtin_bit_cast(s16x4,__builtin_amdgcn_ds_read_tr16_b64_v4i16((__attribute__((address_space(3))) v4i16_t*)p)); }
__device__ __forceinline__ float rowmax(const f32x16&p0,const f32x16&p1){
  float a=max3f(p0[0],p0[1],p1[0]),b=max3f(p0[2],p0[3],p1[1]);a=max3f(a,p1[2],p1[3]);
  #pragma unroll
  for(int r=4;r<16;r+=4){a=max3f(a,p0[r],p0[r+1]);b=max3f(b,p0[r+2],p0[r+3]);a=max3f(a,p1[r],p1[r+1]);b=max3f(b,p1[r+2],p1[r+3]);}
  const float m=max2f(a,b);
  auto rr=__builtin_amdgcn_permlane32_swap(__float_as_uint(m),__float_as_uint(m),false,false);
  return max2f(__uint_as_float(rr[0]),__uint_as_float(rr[1]));
}
__device__ __forceinline__ void pv(f32x16*o,int vb,bf16x8 pa0,bf16x8 pa1,bf16x8 pa2,bf16x8 pa3){
  #pragma unroll
  for(int d0=0;d0<2;++d0){s16x4 lo[4],hi[4];
    #pragma unroll
    for(int ks=0;ks<4;++ks){
      asm volatile("ds_read_b64_tr_b16 %0,%1 offset:%c2":"=&v"(lo[ks]):"v"(vb),"i"(d0*4096+ks*1024):"memory");
      asm volatile("ds_read_b64_tr_b16 %0,%1 offset:%c2":"=&v"(hi[ks]):"v"(vb),"i"(d0*4096+ks*1024+512):"memory");}
    asm volatile("s_waitcnt lgkmcnt(0)":::"memory");SBAR();
    #define PK(k) (bf16x8){lo[k][0],lo[k][1],lo[k][2],lo[k][3],hi[k][0],hi[k][1],hi[k][2],hi[k][3]}
    o[d0]=__builtin_amdgcn_mfma_f32_32x32x16_bf16(pa0,PK(0),o[d0],0,0,0);
    o[d0]=__builtin_amdgcn_mfma_f32_32x32x16_bf16(pa1,PK(1),o[d0],0,0,0);
    o[d0]=__builtin_amdgcn_mfma_f32_32x32x16_bf16(pa2,PK(2),o[d0],0,0,0);
    o[d0]=__builtin_amdgcn_mfma_f32_32x32x16_bf16(pa3,PK(3),o[d0],0,0,0);
    #undef PK
  }
}

#ifndef ATTN_STORE16
#define ATTN_STORE16(p,v) (*(u32x4*)(p)=(v))
#endif
template<int THRL> __device__ __forceinline__ void attn_unit(int b,int h,int qb,const bf16*Q,const bf16*__restrict__ K,const bf16*__restrict__ V,const bf16*Gt,const float*CBg,bf16*O,char*shm){
  int tid_=threadIdx.x; asm volatile("":"+v"(tid_)); const int tid=tid_,lane=tid&63,r32=lane&31,hi=lane>>5; const int wid=__builtin_amdgcn_readfirstlane(tid>>6);
  const long rowbase=(long)b*SEQ; const int q0=qb*QB;
  const bf16*Qw=Q+(rowbase+q0+wid*QBLK)*DM+h*D;
  const bf16*Kh=K+rowbase*DM+h*D,*Vh=V+rowbase*DM+h*D;
  const unsigned lds0=(unsigned)(uintptr_t)shm;
  float*wsf=(float*)(shm+LDS_WS)+wid*64;
  const bf16*ksrc=Kh+(long)lane*DM+wid*8;
  const bf16*vsrc=Vh+(long)(16*(wid&3)+(lane>>2))*DM+(wid>>2)*32+(lane&3)*8;
  const unsigned kdst=lds0+LDS_K+wid*1024, vdst=lds0+LDS_V+wid*1024;
  #define DMA_K(t,slot) glds16(ksrc+(long)(t)*KVBLK*DM,(unsigned)__builtin_amdgcn_readfirstlane(kdst+(slot)))
  #define DMA_V(t,slot) glds16(vsrc+(long)(t)*KVBLK*DM,(unsigned)__builtin_amdgcn_readfirstlane(vdst+(slot)))
  const int vb0=(int)(lds0+LDS_V)+((lane>>4)&1)*32+(lane&3)*8+(4*hi+((lane&15)>>2))*64;
  const char*Kbase=shm+LDS_K; bf16x8 kf[8];
  const lds_cptr shm3=(lds_cptr)shm; const lds_cptr kp0=shm3+LDS_K+hi*1024+r32*16; const lds_cptr vp0=shm3+LDS_V+((lane>>4)&1)*32+(lane&3)*8+(4*hi+((lane&15)>>2))*64;
  const int NT=(q0+QB)/KVBLK;
  { const float*cbsrc=CBg+((long)b*NHEAD+h)*SEQ; float*cbl=(float*)(shm+LDS_CB);
    #pragma unroll
    for(int i=0;i<2;++i){ const int e=(i*512+tid)*4; if(e<q0+QB){ const f32x4v v=*reinterpret_cast<const f32x4v*>(cbsrc+e); *reinterpret_cast<f32x4v*>(cbl+e)=v; } } }
  DMA_K(0,0);DMA_V(0,0);DMA_K(1,SLOTB);
  bf16x8 qr[4];
  #pragma unroll
  for(int d0=0;d0<4;++d0)qr[d0]=*reinterpret_cast<const bf16x8*>(&Qw[(long)r32*DM+d0*16+hi*8]);
  float mhat=0.f,l_reg=0.f;f32x16 o[2];o[0]=f32x16{};o[1]=f32x16{};
  const int qrel=wid*QBLK+r32;
  #define CMASK(P0,P1,t) do{int jb_=(t)-(NT-4); if(jb_>=0)cmask(P0,P1,jb_,qrel,hi);}while(0)
  bool resc=false; f32x16 pA0,pA1,pB0,pB1;
  #define START(P0,P1) do{ const float rm=rowmax(P0,P1); resc=false; \
    { const float dl=__builtin_fmaxf(rm,-16.f); mhat=fadd_s(mhat,dl); mh2=cbq+mhat; \
      _Pragma("unroll") for(int r=0;r<16;++r){P0[r]=fsub_s(P0[r],dl);P1[r]=fsub_s(P1[r],dl);} } \
    _Pragma("unroll") for(int r=0;r<16;++r)P0[r]=__builtin_amdgcn_exp2f(P0[r]); }while(0)
  #define RESC() do{ if(resc){ asm volatile("s_waitcnt lgkmcnt(0)":::"memory"); \
      _Pragma("unroll") for(int d_=0;d_<2;++d_) _Pragma("unroll") for(int r=0;r<16;++r)o[d_][r]*=wsf[crow(r,hi)]; } }while(0)
  int sl_prev=0,sl_cur=0,sl_next=SLOTB;
  #define ROT() do{sl_prev=sl_cur;sl_cur=sl_next;sl_next=(sl_next==(NSLOT-1)*SLOTB)?0:sl_next+SLOTB;}while(0)
  DMA_K(2,2*SLOTB);
  WAIT_BAR(3);
  const lds_cptr cbp=(lds_cptr)shm+LDS_CB+hi*16;
  const float cbq=*(const __attribute__((address_space(3))) float*)((lds_cptr)shm+LDS_CB+4*(q0+wid*QBLK+r32));
  float mh2=cbq;
  #define CBINIT(P0,P1,t) do{ _Pragma("unroll") for(int g_=0;g_<4;++g_){ \
      const f32x4v c0_=*(const __attribute__((address_space(3))) f32x4v*)(cbp+(t)*256+g_*32), c1_=*(const __attribute__((address_space(3))) f32x4v*)(cbp+(t)*256+g_*32+128); \
      _Pragma("unroll") for(int i_=0;i_<4;++i_){P0[4*g_+i_]=c0_[i_]-mh2;P1[4*g_+i_]=c1_[i_]-mh2;} } }while(0)
  CBINIT(pA0,pA1,0);
  qkt(pA0,pA1,Kbase,qr,r32,hi);asm volatile("s_nop 15\n\ts_nop 7":"+v"(pA0),"+v"(pA1));CMASK(pA0,pA1,0);
  START(pA0,pA1);
  _Pragma("unroll") for(int r=0;r<16;++r)pA1[r]=__builtin_amdgcn_exp2f(pA1[r]);
  CBINIT(pB0,pB1,1);
  WAIT_BAR(0);
  DMA_K(3,0);DMA_V(1,SLOTB);
  ROT();
  kload8(kf,kp0+sl_cur);
  WAIT_BAR(2);
  s16x4 vlo[8],vhi[8]; u32x4 pw0,pw1,pw2,pw3;
  #define PKW(P,B) cvtpk_s(P[B],P[B+1])
  #define PAF(k) __builtin_bit_cast(bf16x8,pw##k)
  #define VFR(i) (bf16x8){vlo[i][0],vlo[i][1],vlo[i][2],vlo[i][3],vhi[i][0],vhi[i][1],vhi[i][2],vhi[i][3]}
  #define PIN(x) asm volatile("":"+v"(x))
  #define MX3(a,b,c) __builtin_fmaxf(__builtin_fmaxf((a),(b)),(c))
  #define GAPA(MF,A0,A1,A2,A3,W0,W1,PW) do{ MF; sacc+=A0; sacc+=A1; sacc+=A2; sacc+=A3; PIN(sacc); W0; W1; PIN(PW); SBAR(); }while(0)
  #define EX(v) __builtin_amdgcn_exp2f(v)
  #define GAPB(MF,X,B,PN,CBO) do{ MF; X[B]=EX(X[B]); X[B+1]=EX(X[B+1]); X[B+2]=EX(X[B+2]); X[B+3]=EX(X[B+3]); PIN(X); \
    { const f32x4v c_=*(const __attribute__((address_space(3))) f32x4v*)(cbn_+(CBO)); PN[B]=c_[0]-mh2; PN[B+1]=c_[1]-mh2; PN[B+2]=c_[2]-mh2; PN[B+3]=c_[3]-mh2; PIN(PN); } SBAR(); }while(0)
  #define VRD(i) do{ vlo[i]=vtr(vp_+(((i)>>2)*4096+((i)&3)*1024)); vhi[i]=vtr(vp_+(((i)>>2)*4096+((i)&3)*1024+512)); }while(0)
  #define KRD(G,j) do{ if(G){ kload2(kf,kp0+sl_next,j); SBAR(); } }while(0)
  #define STEP(C0,C1,P0,P1,t,GK,GV,GL) do{ SBAR(); \
    const lds_cptr vp_=vp0+sl_prev; \
    VRD(0); SBAR(); float sacc=(P0[0]+P0[1]); \
    GAPA(C0=__builtin_amdgcn_mfma_f32_32x32x16_bf16(kf[0],qr[0],C0,0,0,0), P0[2],P0[3],P0[4],P0[5],     pw0[0]=PKW(P0,0), pw0[1]=PKW(P0,2), pw0); \
    VRD(4); SBAR(); GAPA(C1=__builtin_amdgcn_mfma_f32_32x32x16_bf16(kf[1],qr[0],C1,0,0,0), P0[6],P0[7],P0[8],P0[9],     pw0[2]=PKW(P0,4), pw0[3]=PKW(P0,6), pw0); \
    VRD(1); SBAR(); GAPA(C0=__builtin_amdgcn_mfma_f32_32x32x16_bf16(kf[2],qr[1],C0,0,0,0),   P0[10],P0[11],P0[12],P0[13], pw1[0]=PKW(P0,8), pw1[1]=PKW(P0,10), pw1); \
    VRD(5); SBAR(); GAPA(C1=__builtin_amdgcn_mfma_f32_32x32x16_bf16(kf[3],qr[1],C1,0,0,0),   P0[14],P0[15],P1[0],P1[1],   pw1[2]=PKW(P0,12),pw1[3]=PKW(P0,14), pw1); \
    VRD(2); SBAR(); GAPA(C0=__builtin_amdgcn_mfma_f32_32x32x16_bf16(kf[4],qr[2],C0,0,0,0),   P1[2],P1[3],P1[4],P1[5],     pw2[0]=PKW(P1,0), pw2[1]=PKW(P1,2), pw2); \
    VRD(6); SBAR(); GAPA(C1=__builtin_amdgcn_mfma_f32_32x32x16_bf16(kf[5],qr[2],C1,0,0,0),   P1[6],P1[7],P1[8],P1[9],     pw2[2]=PKW(P1,4), pw2[3]=PKW(P1,6), pw2); \
    VRD(3); SBAR(); GAPA(C0=__builtin_amdgcn_mfma_f32_32x32x16_bf16(kf[6],qr[3],C0,0,0,0),   P1[10],P1[11],P1[12],P1[13], pw3[0]=PKW(P1,8), pw3[1]=PKW(P1,10), pw3); \
    VRD(7); SBAR(); GAPA(C1=__builtin_amdgcn_mfma_f32_32x32x16_bf16(kf[7],qr[3],C1,0,0,0),   P1[14],P1[15],0.f,0.f,       pw3[2]=PKW(P1,12),pw3[3]=PKW(P1,14), pw3); \
    l_reg+=sacc; \
    if(GK){DMA_K((t)+3,sl_cur);} if(GV){DMA_V((t)+1,sl_next);} \
    CMASK(C0,C1,t); \
    { float a=MX3(C0[0],C0[1],C1[0]),b=MX3(C0[2],C0[3],C1[1]); a=MX3(a,C1[2],C1[3]); \
      _Pragma("unroll") for(int r=4;r<16;r+=4){a=MX3(a,C0[r],C0[r+1]);b=MX3(b,C0[r+2],C0[r+3]);a=MX3(a,C1[r],C1[r+1]);b=MX3(b,C1[r+2],C1[r+3]);} \
      float rm=__builtin_fmaxf(a,b); { auto rr=__builtin_amdgcn_permlane32_swap(__float_as_uint(rm),__float_as_uint(rm),false,false); rm=__builtin_fmaxf(__uint_as_float(rr[0]),__uint_as_float(rr[1])); } \
      resc=false; \
      if(__builtin_expect(__any(rm>(float)THRL),0)){ const float dl=__builtin_fmaxf(rm,0.f); mhat+=dl; \
        _Pragma("unroll") for(int r=0;r<16;++r){C0[r]-=dl;C1[r]-=dl;} \
        mh2=cbq+mhat; \
        const float f=__builtin_amdgcn_exp2f(-dl); l_reg*=f; if(hi==0)wsf[r32]=f; resc=true; } } \
    SBAR(); \
    const lds_cptr cbn_=cbp+((t)+1)*256;                      \
    GAPB(o[0]=__builtin_amdgcn_mfma_f32_32x32x16_bf16(PAF(0),VFR(0),o[0],0,0,0), C0,0, P0,0); \
    GAPB(o[1]=__builtin_amdgcn_mfma_f32_32x32x16_bf16(PAF(0),VFR(4),o[1],0,0,0), C0,4, P0,32); \
    KRD(GL,0); GAPB(o[0]=__builtin_amdgcn_mfma_f32_32x32x16_bf16(PAF(1),VFR(1),o[0],0,0,0), C0,8, P0,64); \
    KRD(GL,1); GAPB(o[1]=__builtin_amdgcn_mfma_f32_32x32x16_bf16(PAF(1),VFR(5),o[1],0,0,0), C0,12, P0,96); \
    KRD(GL,2); GAPB(o[0]=__builtin_amdgcn_mfma_f32_32x32x16_bf16(PAF(2),VFR(2),o[0],0,0,0), C1,0, P1,128); \
    KRD(GL,3); GAPB(o[1]=__builtin_amdgcn_mfma_f32_32x32x16_bf16(PAF(2),VFR(6),o[1],0,0,0), C1,4, P1,160); \
    GAPB(o[0]=__builtin_amdgcn_mfma_f32_32x32x16_bf16(PAF(3),VFR(3),o[0],0,0,0), C1,8, P1,192); \
    GAPB(o[1]=__builtin_amdgcn_mfma_f32_32x32x16_bf16(PAF(3),VFR(7),o[1],0,0,0), C1,12, P1,224); \
    }while(0)
  int t=1;
  #undef CMASK
  #define CMASK(P0,P1,t) do{}while(0)
  for(;t+5<NT;t+=2){
    STEP(pB0,pB1,pA0,pA1,t,true,true,true);     WAIT_BAR(2); RESC(); ROT();
    STEP(pA0,pA1,pB0,pB1,t+1,true,true,true);   WAIT_BAR(2); RESC(); ROT();
  }
  #undef CMASK
  #define CMASK(P0,P1,t) do{int jb_=(t)-(NT-4); if(jb_>=0)cmask(P0,P1,jb_,qrel,hi);}while(0)
  #define ENDW(tt) do{ if((tt)+3<NT){WAIT_BAR(2);} else if((tt)+2<NT){WAIT_BAR(1);} else {WAIT_BAR(0);} }while(0)
  for(;t+1<NT;t+=2){
    STEP(pB0,pB1,pA0,pA1,t,(t+3<NT),(t+1<NT),(t+1<NT));       ENDW(t);   RESC(); ROT();
    STEP(pA0,pA1,pB0,pB1,t+1,(t+4<NT),(t+2<NT),(t+2<NT));     ENDW(t+1); RESC(); ROT();
  }
  STEP(pB0,pB1,pA0,pA1,NT-1,false,false,false); RESC();
  { float sacc=pB0[0]+pB0[1]; _Pragma("unroll") for(int r=2;r<16;++r)sacc+=pB0[r]; _Pragma("unroll") for(int r=0;r<16;++r)sacc+=pB1[r]; l_reg+=sacc;
    pw0=(u32x4){PKW(pB0,0),PKW(pB0,2),PKW(pB0,4),PKW(pB0,6)};pw1=(u32x4){PKW(pB0,8),PKW(pB0,10),PKW(pB0,12),PKW(pB0,14)};pw2=(u32x4){PKW(pB1,0),PKW(pB1,2),PKW(pB1,4),PKW(pB1,6)};pw3=(u32x4){PKW(pB1,8),PKW(pB1,10),PKW(pB1,12),PKW(pB1,14)};
    SBAR(); pv(o,vb0+sl_cur,PAF(0),PAF(1),PAF(2),PAF(3)); }
  #undef PKW
  #undef PAF
  #undef VFR
  #undef PIN
  #undef MX3
  #undef GAPA
  #undef GAPB
  #undef EX
  #undef VRD
  #undef KRD
  #undef STEP
  #undef ENDW
  {auto rr=__builtin_amdgcn_permlane32_swap(__float_as_uint(l_reg),__float_as_uint(l_reg),false,false);l_reg=__uint_as_float(rr[0])+__uint_as_float(rr[1]);}
  if(hi==0)wsf[32+r32]=l_reg;asm volatile("s_waitcnt lgkmcnt(0)":::"memory");
  float rli[16];
  #pragma unroll
  for(int r=0;r<16;++r)rli[r]=__builtin_amdgcn_rcpf(wsf[32+crow(r,hi)]);
  bf16*Ow=O+(rowbase+q0+wid*QBLK)*OPITCH+h*D; const bf16*Gw=Gt+(rowbase+q0+wid*QBLK)*DM+h*D;
  { bf16*stg=(bf16*)(shm+LDS_OST)+wid*2048;
    #pragma unroll
    for(int r=0;r<16;++r){const int orow=crow(r,hi);
      #pragma unroll
      for(int d0=0;d0<2;++d0)stg[orow*64+d0*32+r32]=__float2bfloat16(o[d0][r]*rli[r]);}
    asm volatile("s_waitcnt lgkmcnt(0)":::"memory");
    #pragma unroll
    for(int i=0;i<4;++i){const int row=i*8+(lane>>3),ch=lane&7; const u32x4 v=*(const u32x4*)(stg+row*64+ch*8); const u32x4 gq=*(const u32x4*)(Gw+(long)row*DM+ch*8); u32x4 w_;
      #pragma unroll
      for(int k=0;k<4;++k){ const float g0=__builtin_bit_cast(float,gq[k]<<16), g1=__builtin_bit_cast(float,gq[k]&0xffff0000u), x0=__builtin_bit_cast(float,v[k]<<16), x1=__builtin_bit_cast(float,v[k]&0xffff0000u);
        w_[k]=cvtpk_s(x0*g0*__builtin_amdgcn_rcpf(1.f+__builtin_amdgcn_exp2f(-1.4426950408889634f*g0)), x1*g1*__builtin_amdgcn_rcpf(1.f+__builtin_amdgcn_exp2f(-1.4426950408889634f*g1))); }
      ATTN_STORE16(Ow+(long)row*OPITCH+ch*8,w_);} }
  asm volatile("s_waitcnt lgkmcnt(0)\n\ts_barrier":::"memory");
  #undef CBINIT
  #undef DMA_K
  #undef DMA_V
  #undef CMASK
  #undef START
  #undef RESC
  #undef ROT
}
constexpr int ATTN_LDS_BYTES=LDS_BYTES;
struct AttnTensors { const bf16* Q; const bf16* K; const bf16* V; const bf16* G; const float* CB; bf16* O; };
struct AttnUnit { int bh; int qb; };
struct QueueOrder {
  unsigned* ctr; volatile __attribute__((address_space(3))) unsigned* slot;
  __device__ __forceinline__ bool next(int,AttnUnit&u)const{
    if(threadIdx.x==0){ *slot=__hip_atomic_fetch_add(ctr,1u,__ATOMIC_RELAXED,__HIP_MEMORY_SCOPE_AGENT); }
    __syncthreads(); const unsigned t=*slot; __syncthreads();
    if(t>=(unsigned)(BATCH*NHEAD*NQB))return false; u.qb=NQB-1-(int)(t/(BATCH*NHEAD)); u.bh=(int)(t%(BATCH*NHEAD)); return true; }
  __device__ __forceinline__ void a_ready(const AttnUnit&)const{}
  __device__ __forceinline__ void done(const AttnUnit&)const{}
};
template<class Sched,int THRL=8> __device__ __forceinline__ void attn_phase(char*lds,const AttnTensors&T,const Sched&S){
  AttnUnit u;
  for(int i=0;S.next(i,u);++i){ S.a_ready(u); attn_unit<THRL>(u.bh/NHEAD,u.bh%NHEAD,u.qb,T.Q,T.K,T.V,T.G,T.CB,T.O,lds); S.done(u); }
}
#undef SBAR
#undef WAIT_BAR
}

__device__ __forceinline__ int src_col(int n) {
    if (n < 1024) { const int cp = n & 255; return (n & ~255) + 64 * ((cp >> 5) & 3) + 32 * (cp >> 7) + (cp & 31); }
    if (n < 1536) return n;
    if (n < UP) return n - UR + SR;
    if (n < UG) return -1;
    if (n < UF) return n - UG + SG;
    if (n < UF + 8) return n - UF + SF;
    return -2;
}
__device__ __forceinline__ void phase_weights(const Params& p, unsigned char* lds) {
    float (*tile)[65] = (float (*)[65])lds;
    const int tid = otid();
    constexpr int T_IN = (NU / 64) * (DM / 64), T_OUT = (DM / 64) * (DM / 64), PER_L = T_IN + T_OUT;
    for (int it = blockIdx.x; it < NL * PER_L; it += gridDim.x) {
        const int l = it / PER_L; int r = it % PER_L;
        if (r < T_IN) {
            const int nt = r / (DM / 64), kt = r % (DM / 64), n0 = nt * 64, k0 = kt * 64;
            const float* W = p.w_in + (size_t)l * DM * D_IN;
            for (int e = tid; e < 64 * 64; e += NTHREADS) {
                const int kk = e >> 6, nn = e & 63, n = n0 + nn, sc = src_col(n);
                float v = 0.f;
                if (sc >= 0) v = W[(size_t)(k0 + kk) * D_IN + sc];
                else if (sc == -1) {
                    const int g = (n - UP) >> 6, d = (n - UP) & 63;
                    const float* pw = p.pool_w + ((size_t)l * 4 + g) * 64 * 64;
                    const float* wr = W + (size_t)(k0 + kk) * D_IN + SP + g * 64;
                    float s = 0.f;
                    for (int cc = 0; cc < 64; ++cc) s += wr[cc] * pw[cc * 64 + d];
                    v = s;
                }
                tile[kk][nn] = v;
            }
            __syncthreads();
            bf16_t* WT = (bf16_t*)(p.ws + WS_WT) + (size_t)l * NU * DM;
            for (int e = tid; e < 64 * 32; e += NTHREADS) {
                const int nn = e >> 5, kp = (e & 31) * 2;
                *(unsigned*)(WT + (size_t)(n0 + nn) * DM + k0 + kp) = pk2(tile[kp][nn], tile[kp + 1][nn]);
            }
            __syncthreads();
        } else {
            r -= T_IN;
            const int nt = r / (DM / 64), kt = r % (DM / 64), n0 = nt * 64, k0 = kt * 64;
            const float* W = p.w_out + (size_t)l * DM * DM;
            for (int e = tid; e < 64 * 64; e += NTHREADS) { const int kk = e >> 6, nn = e & 63; tile[kk][nn] = W[(size_t)(k0 + kk) * DM + n0 + nn]; }
            __syncthreads();
            bf16_t* WOT = (bf16_t*)(p.ws + WS_WOT) + (size_t)l * DM * DM;
            for (int e = tid; e < 64 * 32; e += NTHREADS) {
                const int nn = e >> 5, kp = (e & 31) * 2;
                *(unsigned*)(WOT + (size_t)(n0 + nn) * DM + k0 + kp) = pk2(tile[kp][nn], tile[kp + 1][nn]);
            }
            __syncthreads();
        }
    }
}

__device__ __forceinline__ void phase_mod(const Params& p, unsigned char* lds) {
    float (*sc)[DM] = (float (*)[DM])lds;
    float (*red)[NB][64] = (float (*)[NB][64])(lds + 32768);
    const int tid = otid();
    if ((int)blockIdx.x >= NL * 48) return;
    for (int e = tid; e < NB * DM; e += NTHREADS) sc[e / DM][e % DM] = siluf_(p.c[e]);
    __syncthreads();
    float* mod = (float*)(p.ws + WS_MOD);
    const int kg = tid >> 6, cl = tid & 63;
    for (int it = blockIdx.x; it < NL * 48; it += gridDim.x) {
        const int l = it / 48, n = (it % 48) * 64 + cl;
        const float* W = p.ada_w + (size_t)l * DM * 3072 + n;
        float acc[NB];
#pragma unroll
        for (int b = 0; b < NB; ++b) acc[b] = 0.f;
#pragma unroll 8
        for (int k = kg * 128; k < kg * 128 + 128; ++k) {
            const float w = W[(size_t)k * 3072];
#pragma unroll
            for (int b = 0; b < NB; ++b) acc[b] += sc[b][k] * w;
        }
#pragma unroll
        for (int b = 0; b < NB; ++b) red[kg][b][cl] = acc[b];
        __syncthreads();
        {
            const int b = tid >> 6;
            float s = p.ada_b[l * 3072 + n];
#pragma unroll
            for (int g = 0; g < 8; ++g) s += red[g][b][cl];
            mod[((size_t)l * NB + b) * 3072 + n] = s;
        }
        __syncthreads();
    }
}

__device__ __forceinline__ void row_h_store(const f32x4 (&v)[4], float rinv, const float* npre, const float* mod_lb, bf16_t* xnrow, int lane) {
#pragma unroll
    for (int j = 0; j < 4; ++j) {
        const int c = j * 256 + lane * 4;
        const f32x4 g = *(const f32x4*)(npre + c), sh = *(const f32x4*)(mod_lb + c), scl = *(const f32x4*)(mod_lb + 1024 + c);
        f32x4 h;
#pragma unroll
        for (int i = 0; i < 4; ++i) h[i] = v[j][i] * rinv * g[i] * (1.f + scl[i]) + sh[i];
        u32x2 w; w.x = pk2(h[0], h[1]); w.y = pk2(h[2], h[3]);
        *(u32x2*)(xnrow + c) = w;
    }
}
__device__ __forceinline__ void phase_rows(const Params& p, int mode, int l) {
    const int tid = otid(), lane = tid & 63, wv = tid >> 6;
    const int gw = blockIdx.x * 8 + wv, ngw = gridDim.x * 8;
    const float* mod = (const float*)(p.ws + WS_MOD);
    bf16_t* XN = (bf16_t*)(p.ws + WS_XN);
    const float* Z = (const float*)(p.ws + WS_Z);
    for (int m = gw; m < MTOK; m += ngw) {
        const int b = m / SEQ;
        f32x4 v[4];
        if (mode == 0) {
#pragma unroll
            for (int j = 0; j < 4; ++j) v[j] = *(const f32x4*)(p.x + (size_t)m * DM + j * 256 + lane * 4);
            float s = 0.f;
#pragma unroll
            for (int j = 0; j < 4; ++j) s += v[j][0] * v[j][0] + v[j][1] * v[j][1] + v[j][2] * v[j][2] + v[j][3] * v[j][3];
            const float rinv = rsqrtf(wave_sum(s) * (1.f / DM) + 1e-6f);
            row_h_store(v, rinv, p.norm_pre, mod + ((size_t)0 * NB + b) * 3072, XN + (size_t)m * DM, lane);
        } else {
            f32x4 z[4];
#pragma unroll
            for (int j = 0; j < 4; ++j) z[j] = *(const f32x4*)(Z + (size_t)m * DM + j * 256 + lane * 4);
            float s = 0.f;
#pragma unroll
            for (int j = 0; j < 4; ++j) s += z[j][0] * z[j][0] + z[j][1] * z[j][1] + z[j][2] * z[j][2] + z[j][3] * z[j][3];
            const float rz = rsqrtf(wave_sum(s) * (1.f / DM) + 1e-6f);
            const float* xold = (l == 0) ? p.x : p.out;
            const float* mod_lb = mod + ((size_t)l * NB + b) * 3072;
            float s2 = 0.f;
#pragma unroll
            for (int j = 0; j < 4; ++j) {
                const int c = j * 256 + lane * 4;
                const f32x4 xo = *(const f32x4*)(xold + (size_t)m * DM + c), gp = *(const f32x4*)(p.norm_post + l * DM + c), gt = *(const f32x4*)(mod_lb + 2048 + c);
#pragma unroll
                for (int i = 0; i < 4; ++i) { v[j][i] = xo[i] + gt[i] * (z[j][i] * rz * gp[i]); s2 += v[j][i] * v[j][i]; }
                *(f32x4*)(p.out + (size_t)m * DM + c) = v[j];
            }
            if (l + 1 < NL) {
                const float rinv = rsqrtf(wave_sum(s2) * (1.f / DM) + 1e-6f);
                row_h_store(v, rinv, p.norm_pre + (l + 1) * DM, mod + ((size_t)(l + 1) * NB + b) * 3072, XN + (size_t)m * DM, lane);
            }
        }
    }
}

template <int MODE>
__device__ __forceinline__ void phase_gemm_simple(unsigned char* lds, const bf16_t* A, const bf16_t* Bt, void* Cout, int M, int N, int K, const float* qg, const float* kg) {
    bf16_t (*As)[40] = (bf16_t (*)[40])lds;
    bf16_t (*Bs)[40] = (bf16_t (*)[40])(lds + 128 * 40 * 2);
    const int tid = otid(), lane = tid & 63, wv = tid >> 6;
    const int ntn = N / 64, ntm = M / 128;
    for (int it = blockIdx.x; it < ntm * ntn; it += gridDim.x) {
        const int tm = it / ntn, tn = it % ntn, m0 = tm * 128, n0 = tn * 64;
        f32x4 acc[4];
#pragma unroll
        for (int n = 0; n < 4; ++n) acc[n] = (f32x4){0.f, 0.f, 0.f, 0.f};
        for (int k0 = 0; k0 < K; k0 += 32) {
            {
                const int r = tid >> 2, ch = tid & 3;
                *(u32x4*)(&As[r][ch * 8]) = *(const u32x4*)(A + (size_t)(m0 + r) * K + k0 + ch * 8);
                if (tid < 256) *(u32x4*)(&Bs[r][ch * 8]) = *(const u32x4*)(Bt + (size_t)(n0 + r) * K + k0 + ch * 8);
            }
            __syncthreads();
            const bf16x8 a = *(const bf16x8*)(&As[wv * 16 + (lane & 15)][(lane >> 4) * 8]);
#pragma unroll
            for (int n = 0; n < 4; ++n) {
                const bf16x8 b = *(const bf16x8*)(&Bs[n * 16 + (lane & 15)][(lane >> 4) * 8]);
                acc[n] = __builtin_amdgcn_mfma_f32_16x16x32_bf16(a, b, acc[n], 0, 0, 0);
            }
            __syncthreads();
        }
        if (MODE == 0) {
            bf16_t* C = (bf16_t*)Cout;
            float scale[4] = {1.f, 1.f, 1.f, 1.f};
            float gain[4] = {1.f, 1.f, 1.f, 1.f};
            if (n0 < 1024) {
#pragma unroll
                for (int r = 0; r < 4; ++r) {
                    float s = acc[0][r] * acc[0][r] + acc[1][r] * acc[1][r] + acc[2][r] * acc[2][r] + acc[3][r] * acc[3][r];
                    s += __shfl_xor(s, 1); s += __shfl_xor(s, 2); s += __shfl_xor(s, 4); s += __shfl_xor(s, 8);
                    scale[r] = rsqrtf(s * (1.f / 64.f) + 1e-6f) * (n0 < 512 ? C2 : 1.f);
                }
#pragma unroll
                for (int n = 0; n < 4; ++n) gain[n] = (n0 < 512 ? qg : kg)[n * 16 + (lane & 15)];
            }
#pragma unroll
            for (int n = 0; n < 4; ++n)
#pragma unroll
                for (int r = 0; r < 4; ++r)
                    C[(size_t)(m0 + wv * 16 + (lane >> 4) * 4 + r) * N + n0 + n * 16 + (lane & 15)] = (bf16_t)f2bf(acc[n][r] * scale[r] * gain[n]);
        } else {
            float* C = (float*)Cout;
#pragma unroll
            for (int n = 0; n < 4; ++n)
#pragma unroll
                for (int r = 0; r < 4; ++r) C[(size_t)(m0 + wv * 16 + (lane >> 4) * 4 + r) * N + n0 + n * 16 + (lane & 15)] = acc[n][r];
        }
    }
}

__device__ __forceinline__ void phase_cum(const Params& p, int l, unsigned char* lds) {
    float (*wtot)[8] = (float (*)[8])lds;
    const int tid = otid(), lane = tid & 63, wv = tid >> 6;
    const bf16_t* U = (const bf16_t*)(p.ws + WS_U);
    float* CB = (float*)(p.ws + WS_CB);
    for (int b = blockIdx.x; b < NB; b += gridDim.x) {
        float pre[8][8];
        float run[8];
#pragma unroll
        for (int h = 0; h < 8; ++h) run[h] = 0.f;
#pragma unroll
        for (int i = 0; i < 8; ++i) {
            const u32x4 w = *(const u32x4*)(U + (size_t)(b * SEQ + tid * 8 + i) * NU + UF);
            float f[8] = {bflo(w.x), bfhi(w.x), bflo(w.y), bfhi(w.y), bflo(w.z), bfhi(w.z), bflo(w.w), bfhi(w.w)};
#pragma unroll
            for (int h = 0; h < 8; ++h) {
                const float xx = f[h] + p.f_bias[l * 8 + h];
                const float ls = fminf(xx, 0.f) - log1pf(__expf(-fabsf(xx)));
                run[h] += -ls * LOG2E;
                pre[i][h] = run[h];
            }
        }
        float exc[8];
#pragma unroll
        for (int h = 0; h < 8; ++h) {
            float v = run[h];
#pragma unroll
            for (int o = 1; o < 64; o <<= 1) { const float t = __shfl_up(v, o); if (lane >= o) v += t; }
            if (lane == 63) wtot[wv][h] = v;
            exc[h] = v - run[h];
        }
        __syncthreads();
#pragma unroll
        for (int h = 0; h < 8; ++h) { float base = 0.f; for (int w2 = 0; w2 < wv; ++w2) base += wtot[w2][h]; exc[h] += base; }
#pragma unroll
        for (int h = 0; h < 8; ++h)
#pragma unroll
            for (int i = 0; i < 8; ++i) CB[((size_t)b * 8 + h) * SEQ + tid * 8 + i] = exc[h] + pre[i][h];
        __syncthreads();
    }
}

typedef _Float16 h8 __attribute__((ext_vector_type(8)));
typedef _Float16 h4 __attribute__((ext_vector_type(4)));
typedef float f32x2 __attribute__((ext_vector_type(2)));
template <int CTRL> __device__ __forceinline__ float dpp_add(float x) {
    const int y = __builtin_amdgcn_update_dpp(0, __builtin_bit_cast(int, x), CTRL, 0xF, 0xF, true);
    return x + __builtin_bit_cast(float, y);
}
__device__ __forceinline__ float row16_sum(float x) {
    x = dpp_add<0xB1>(x); x = dpp_add<0x4E>(x); x = dpp_add<0x141>(x); x = dpp_add<0x140>(x); return x;
}
__device__ __forceinline__ float wave_sum_fast(float x) {
    x = row16_sum(x);
    { const unsigned xi = __builtin_bit_cast(unsigned, x); auto rr = __builtin_amdgcn_permlane16_swap(xi, xi, false, false); const unsigned r0 = rr[0], r1 = rr[1]; x = __builtin_bit_cast(float, r0) + __builtin_bit_cast(float, r1); }
    { const unsigned xi = __builtin_bit_cast(unsigned, x); auto rr = __builtin_amdgcn_permlane32_swap(xi, xi, false, false); const unsigned r0 = rr[0], r1 = rr[1]; x = __builtin_bit_cast(float, r0) + __builtin_bit_cast(float, r1); }
    return x;
}
constexpr int PREP_XS = 0, PREP_REC = 8192;
__device__ __forceinline__ void phase_rwkv_prep(const Params& p, int l, unsigned char* lds) {
    float (*xs)[64] = (float (*)[64])(lds + PREP_XS);
    const int tid = otid(), lane = tid & 63;
    const int c = tid & 255, tg = tid >> 8, h = c >> 6;
    const bf16_t* U = (const bf16_t*)(p.ws + WS_U);
    float* PA = (float*)(p.ws + WS_PA); float* BON = (float*)(p.ws + WS_BON);
    unsigned char* REC = p.ws + WS_REC;
#pragma unroll 1
    for (int pass = 0; pass < 2; ++pass) {
        const float* wsrc = pass == 0 ? p.a2 : p.w2;
        float wc[64];
#pragma unroll
        for (int j = 0; j < 64; ++j) wc[j] = wsrc[((size_t)l * 64 + j) * 256 + c];
        const float b0 = (pass == 0 ? p.a0 : p.w0)[l * 256 + c];
        const int xcol = UR + 768 + (pass == 0 ? 64 : 0), mucol = l * 896 + 768 + (pass == 0 ? 64 : 0);
        for (int tile = blockIdx.x; tile < MTOK / 32; tile += gridDim.x) {
            const int m0 = tile * 32;
            for (int e = tid; e < 32 * 64; e += NTHREADS) {
                const int t = e >> 6, j = e & 63, m = m0 + t;
                const float cur = bf2f(U[(size_t)m * NU + xcol + j]);
                const float prev = (m % SEQ) ? bf2f(U[(size_t)(m - 1) * NU + xcol + j]) : 0.f;
                const float v = cur + (prev - cur) * p.mu[mucol + j];
                xs[t][j] = pass == 0 ? v : tanhf(v);
            }
            __syncthreads();
            if (pass == 0) {
#pragma unroll 1
                for (int tt = 0; tt < 16; ++tt) {
                    const int t = tg * 16 + tt, m = m0 + t;
                    float sw = b0;
#pragma unroll
                    for (int j = 0; j < 64; j += 4) { const f32x4 xv = *(const f32x4*)(&xs[t][j]); sw += xv[0] * wc[j] + xv[1] * wc[j + 1] + xv[2] * wc[j + 2] + xv[3] * wc[j + 3]; }
                    PA[(size_t)m * 256 + c] = sigmoidf_(sw);
                }
            } else {
                const float mur = p.mu[l * 896 + c], muk = p.mu[l * 896 + 256 + c], muv = p.mu[l * 896 + 512 + c];
                const float kkc = p.k_k[l * 256 + c], kac = p.k_a[l * 256 + c], rkc = p.r_k[l * 256 + c];
#pragma unroll 1
                for (int hg = 0; hg < 2; ++hg) {
                const int mb = m0 + tg * 16 + hg * 8;
                const bf16_t* ub = U + (size_t)mb * NU + UR + c;
                unsigned short rr_[9], kr_[9], vr_[9]; float aa_[8];
                const bool first = (mb % SEQ) == 0;
#pragma unroll
                for (int i = 0; i < 9; ++i) { const bf16_t* q = ub + (ptrdiff_t)(i - 1 + ((i == 0 && first) ? 1 : 0)) * NU; rr_[i] = q[0]; kr_[i] = q[256]; vr_[i] = q[512]; }
#pragma unroll
                for (int i = 0; i < 8; ++i) aa_[i] = PA[(size_t)(mb + i) * 256 + c];
#pragma unroll
                for (int tt = 0; tt < 8; ++tt) {
                    const int t = tg * 16 + hg * 8 + tt, m = mb + tt;
                    float sw = b0;
#pragma unroll
                    for (int j = 0; j < 64; j += 4) { const f32x4 xv = *(const f32x4*)(&xs[t][j]); sw += xv[0] * wc[j] + xv[1] * wc[j + 1] + xv[2] * wc[j + 2] + xv[3] * wc[j + 3]; }
                    const float w = __expf(-DECAY_SCALE * sigmoidf_(sw));
                    const float pz = (tt == 0 && first) ? 0.f : 1.f;
                    const float rc = bf2f(rr_[tt + 1]), kc = bf2f(kr_[tt + 1]), vc = bf2f(vr_[tt + 1]);
                    const float r = rc + (bf2f(rr_[tt]) * pz - rc) * mur, k = kc + (bf2f(kr_[tt]) * pz - kc) * muk, v = vc + (bf2f(vr_[tt]) * pz - vc) * muv;
                    const float a = aa_[tt];
                    const float kkv = k * kkc;
                    const float kk = kkv / fmaxf(sqrtf(wave_sum_fast(kkv * kkv)), 1e-12f);
                    const float kt = k * (1.f + (a - 1.f) * kac), bb = kk * a;
                    const float br = wave_sum_fast(bb * r), kr = wave_sum_fast(kt * r), bs = wave_sum_fast(r * kt * rkc);
                    unsigned char* rp = lds + PREP_REC + (h * 32 + t) * REC_B;
                    _Float16* A1 = (_Float16*)rp + (lane >> 2) * 8 + (lane & 3); _Float16* A2 = (_Float16*)(rp + 256) + (lane >> 2) * 8 + (lane & 3);
                    A1[0] = (_Float16)(-kk); A1[4] = (_Float16)(w * r); A2[0] = (_Float16)w; A2[4] = (_Float16)bb; ((_Float16*)(rp + 512))[lane] = (_Float16)kt;
                    ((float*)(rp + 640))[lane] = v;
                    if (lane == 0) { ((float*)(rp + 896))[0] = br; ((float*)(rp + 896))[1] = kr; ((float*)(rp + 896))[2] = 0.f; ((float*)(rp + 896))[3] = 0.f; BON[(size_t)m * 4 + h] = bs; }
                }
                }
                __syncthreads();
                {
                    const int b = m0 / SEQ, t0 = m0 % SEQ;
#pragma unroll 1
                    for (int e = tid; e < 4 * 32 * REC_B / 16; e += NTHREADS) {
                        const int hh = e / (32 * REC_B / 16), off = (e % (32 * REC_B / 16)) * 16;
                        *(u32x4*)(REC + ((size_t)(b * 4 + hh) * SEQ + t0) * REC_B + off) = *(const u32x4*)(lds + PREP_REC + hh * 32 * REC_B + off);
                    }
                }
            }
            __syncthreads();
        }
    }
}

__device__ __forceinline__ float mixlo(unsigned hh, float x, float y) { float d; asm("v_fma_mix_f32 %0, %1, %2, %3 op_sel_hi:[1,0,0]" : "=v"(d) : "v"(hh), "v"(x), "v"(y)); return d; }
__device__ __forceinline__ float mixhi(unsigned hh, float x, float y) { float d; asm("v_fma_mix_f32 %0, %1, %2, %3 op_sel:[1,0,0] op_sel_hi:[1,0,0]" : "=v"(d) : "v"(hh), "v"(x), "v"(y)); return d; }
__device__ __forceinline__ float mixlo0(unsigned hh, float x) { float d; asm("v_fma_mix_f32 %0, %1, %2, 0 op_sel_hi:[1,0,0]" : "=v"(d) : "v"(hh), "v"(x)); return d; }
__device__ __forceinline__ float mixhi0(unsigned hh, float x) { float d; asm("v_fma_mix_f32 %0, %1, %2, 0 op_sel:[1,0,0] op_sel_hi:[1,0,0]" : "=v"(d) : "v"(hh), "v"(x)); return d; }
constexpr int SC_CH = 16, SC_BUFB = 15360;
constexpr int SC_OBUF = 2 * SC_BUFB;
struct ScanVec { u32x4 a1, a2; u32x2 a3; float vr; f32x2 sc; };
__device__ __forceinline__ void phase_scan(const Params& p, int l, unsigned char* lds_, int pr) {
    LAS unsigned char* lds = (LAS unsigned char*)lds_;
    const int tid = otid(), lane = tid & 63, wv = __builtin_amdgcn_readfirstlane(tid >> 6);
    const int bh = pr >> 1, half = pr & 1;
    const int jl = lane & 15, rl = wv * 4 + (lane >> 4);
    float* O32 = (float*)(p.ws + WS_O32);
    const unsigned char* recb = p.ws + WS_REC + (size_t)bh * SEQ * REC_B;
    const int b = bh >> 2, h = bh & 3;
    float S0 = 0.f, S1 = 0.f, S2 = 0.f, S3 = 0.f;
#define SC_DMA(cc, bo) do { const unsigned char* g = recb + (size_t)(cc) * SC_CH * REC_B + tid * 16; \
        __builtin_amdgcn_global_load_lds((const unsigned*)g, (LAS unsigned*)(lds + (bo) + wv * 1024), 16, 0, 0); \
        if (wv < 7) __builtin_amdgcn_global_load_lds((const unsigned*)(g + 8192), (LAS unsigned*)(lds + (bo) + 8192 + wv * 1024), 16, 0, 0); } while (0)
#define SC_READ(V, sp) do { V.a1 = *(const LAS u32x4*)((sp) + 16 * jl); V.a2 = *(const LAS u32x4*)((sp) + 256 + 16 * jl); V.a3 = *(const LAS u32x2*)((sp) + 512 + 8 * jl); \
        V.vr = *(const LAS float*)((sp) + 640 + 4 * (half * 32 + rl)); V.sc = *(const LAS f32x2*)((sp) + 896); } while (0)
    SC_DMA(0, 0);
    __syncthreads();
#pragma unroll 1
    for (int cc = 0; cc < SEQ / SC_CH; ++cc) {
        const int cur = (cc & 1) * SC_BUFB, nxt = SC_BUFB - cur;
        if (cc + 1 < SEQ / SC_CH) SC_DMA(cc + 1, nxt);
        LAS float* ob = (LAS float*)(lds + SC_OBUF) + (cc & 1) * (SC_CH * 32);
        ScanVec V, N;
        SC_READ(V, lds + cur);
#pragma unroll
        for (int st = 0; st < SC_CH; ++st) {
            if (st + 1 < SC_CH) SC_READ(N, lds + cur + (st + 1) * REC_B);
            float sa = mixhi(V.a1[0], S1, mixlo0(V.a1[0], S0)) + mixhi(V.a1[1], S3, mixlo0(V.a1[1], S2));
            float q = mixhi(V.a1[2], S1, mixlo0(V.a1[2], S0)) + mixhi(V.a1[3], S3, mixlo0(V.a1[3], S2));
            sa = row16_sum(sa); q = row16_sum(q);
            S0 = mixlo(V.a2[0], S0, mixlo(V.a2[2], sa, mixlo0(V.a3[0], V.vr)));
            S1 = mixhi(V.a2[0], S1, mixhi(V.a2[2], sa, mixhi0(V.a3[0], V.vr)));
            S2 = mixlo(V.a2[1], S2, mixlo(V.a2[3], sa, mixlo0(V.a3[1], V.vr)));
            S3 = mixhi(V.a2[1], S3, mixhi(V.a2[3], sa, mixhi0(V.a3[1], V.vr)));
            ob[st * 32 + rl] = q + sa * V.sc[0] + V.vr * V.sc[1];
            if (st + 1 < SC_CH) V = N;
        }
        __syncthreads();
        {
            const int st = tid >> 5, r = tid & 31;
            O32[((size_t)b * SEQ + cc * SC_CH + st) * 256 + h * 64 + half * 32 + r] = ob[st * 32 + r];
        }
    }
#undef SC_DMA
#undef SC_READ
}

__device__ __forceinline__ void phase_rwkv_fin(const Params& p, int l) {
    const int tid = otid(), lane = tid & 63, wv = tid >> 6;
    const bf16_t* U = (const bf16_t*)(p.ws + WS_U);
    const float* O32 = (const float*)(p.ws + WS_O32); const float* BON = (const float*)(p.ws + WS_BON);
    bf16_t* Y = (bf16_t*)(p.ws + WS_Y);
    const int ngw = gridDim.x * 8;
    for (int m = blockIdx.x * 8 + wv; m < MTOK; m += ngw) {
        float o[4], vc[4], vp[4], g[4], bn[4];
        const bool has_prev = (m % SEQ) != 0;
#pragma unroll
        for (int h = 0; h < 4; ++h) {
            const int c = h * 64 + lane;
            o[h] = O32[(size_t)m * 256 + c];
            vc[h] = bf2f(U[(size_t)m * NU + UR + 512 + c]);
            vp[h] = bf2f(U[(size_t)(m - (has_prev ? 1 : 0)) * NU + UR + 512 + c]);
            g[h] = bf2f(U[(size_t)m * NU + UG + 512 + c]);
            bn[h] = BON[(size_t)m * 4 + h];
        }
#pragma unroll
        for (int h = 0; h < 4; ++h) {
            const int c = h * 64 + lane;
            const float mean = wave_sum_fast(o[h]) * (1.f / 64.f);
            const float dv = o[h] - mean;
            const float var = wave_sum_fast(dv * dv) * (1.f / 64.f);
            const float v = vc[h] + ((has_prev ? vp[h] : 0.f) - vc[h]) * p.mu[l * 896 + 512 + c];
            const float on = dv * rsqrtf(var + 64e-5f) * p.ln_g[l * 256 + c] + p.ln_b[l * 256 + c] + bn[h] * v;
            Y[(size_t)m * DM + 512 + c] = (bf16_t)f2bf(on * siluf_(g[h]));
        }
    }
}

__device__ __forceinline__ void phase_pool(const Params& p, int l) {
    const bf16_t* U = (const bf16_t*)(p.ws + WS_U);
    bf16_t* Y = (bf16_t*)(p.ws + WS_Y);
    const int tid = otid(), c = tid & 255, sub = tid >> 8, g = c >> 6, w = 2 << g;
    const float scl = p.pool_scale[l * 256 + c];
    for (int it = blockIdx.x * 2 + sub; it < MTOK / 64; it += gridDim.x * 2) {
        const int m0 = it * 64, t0 = m0 % SEQ;
        const bf16_t* up = U + (size_t)m0 * NU + UP + c;
        float s = 0.f;
        for (int d = 1; d < w; ++d) if (t0 - d >= 0) s += bf2f(up[-(ptrdiff_t)d * NU]);
#pragma unroll 4
        for (int i = 0; i < 64; ++i) {
            const int t = t0 + i;
            const float cur = bf2f(up[(size_t)i * NU]);
            s += cur;
            const int cnt = (t + 1 < w) ? t + 1 : w;
            const float yv = (s / (float)cnt - cur) * scl;
            const float gg = bf2f(U[(size_t)(m0 + i) * NU + UG + 768 + c]);
            Y[(size_t)(m0 + i) * DM + 768 + c] = (bf16_t)f2bf(yv * siluf_(gg));
            if (t - w + 1 >= 0) s -= bf2f(up[(ptrdiff_t)(i - w + 1) * NU]);
        }
    }
}

__global__ void __launch_bounds__(NTHREADS, 2) mega_fwd(Params p) {
    extern __shared__ __attribute__((aligned(16))) unsigned char lds[];
    volatile LAS unsigned* MISC = (volatile LAS unsigned*)((LAS unsigned char*)lds + MISC_OFF);
    if (threadIdx.x < 32) MISC[threadIdx.x] = 0u;
    __syncthreads();
    XcdBarrier bar = xcd_barrier_post((unsigned*)(p.ws + WS_CTL) + CW_BAR, MISC + 8);
#define GRID_BAR() xcd_barrier(bar)
    bf16_t* XN = (bf16_t*)(p.ws + WS_XN); bf16_t* Y = (bf16_t*)(p.ws + WS_Y); bf16_t* U = (bf16_t*)(p.ws + WS_U); float* Z = (float*)(p.ws + WS_Z);

    phase_weights(p, lds);
    phase_mod(p, lds);
    GRID_BAR();
    phase_rows(p, 0, 0);
    GRID_BAR();
#pragma unroll 1
    for (int l = 0; l < NL; ++l) {
        const bf16_t* WT = (const bf16_t*)(p.ws + WS_WT) + (size_t)l * NU * DM;
        const bf16_t* WOT = (const bf16_t*)(p.ws + WS_WOT) + (size_t)l * DM * DM;
        {
            pg8::Gemm g{XN, WT, MTOK, NU, DM}; pg8::StaticOrder S; S.init(MTOK, NU, (int)gridDim.x, (int)blockIdx.x);
            pg8::EpiU E{U, p.q_gain + l * 64, p.k_gain + l * 64, NU};
            pg8::gemm_phase<pg8::EpiU, pg8::StaticOrder, true, true>((LAS unsigned char*)lds, g, S, E);
        }
        GRID_BAR();
        phase_cum(p, l, lds);
        phase_rwkv_prep(p, l, lds);
        phase_pool(p, l);
        GRID_BAR();
        if (blockIdx.x < NB * 8) phase_scan(p, l, lds, (int)blockIdx.x);
        {
            const attn_body::AttnTensors AT{(const attn_body::bf16*)(U + UQ), (const attn_body::bf16*)(U + UK), (const attn_body::bf16*)(U + UV), (const attn_body::bf16*)(U + UG),
                                            (const float*)(p.ws + WS_CB), (attn_body::bf16*)Y};
            const attn_body::QueueOrder S{(unsigned*)(p.ws + WS_CTL) + CW_ATTQ + l * 64, MISC + 16};
            attn_body::attn_phase<attn_body::QueueOrder>((char*)lds, AT, S);
        }
        GRID_BAR();
        phase_rwkv_fin(p, l);
        GRID_BAR();
        {
            pg8::Gemm g{Y, WOT, MTOK, DM, DM}; pg8::StaticOrder S; S.init(MTOK, DM, (int)gridDim.x, (int)blockIdx.x);
            pg8::EpiF32 E{Z, DM};
            pg8::gemm_phase<pg8::EpiF32, pg8::StaticOrder, true, true>((LAS unsigned char*)lds, g, S, E);
        }
        GRID_BAR();
        phase_rows(p, 1, l);
        if (l + 1 < NL) GRID_BAR();
    }
}

extern "C" void kernel_launch(void* const* d_in, const int* in_sizes, int n_in, void* d_out, int out_size, void* d_ws, size_t ws_size, hipStream_t stream) {
    static int grid = 0;
    if (grid == 0) {
        if (n_in != 23 || ws_size < WS_END) { fprintf(stderr, "kernel_launch: unexpected n_in %d / ws_size %zu\n", n_in, ws_size); grid = -1; return; }
        int dev = 0, cus = 0, per_cu = 0;
        if (hipGetDevice(&dev) != hipSuccess || hipDeviceGetAttribute(&cus, hipDeviceAttributeMultiprocessorCount, dev) != hipSuccess) { grid = -1; return; }
        if (hipFuncSetAttribute((const void*)mega_fwd, hipFuncAttributeMaxDynamicSharedMemorySize, LDS_BYTES) != hipSuccess) { fprintf(stderr, "kernel_launch: hipFuncSetAttribute failed\n"); grid = -1; return; }
        if (hipOccupancyMaxActiveBlocksPerMultiprocessor(&per_cu, (const void*)mega_fwd, NTHREADS, LDS_BYTES) != hipSuccess || per_cu < 1) { fprintf(stderr, "kernel_launch: occupancy query failed (%d)\n", per_cu); grid = -1; return; }
        grid = cus;
        if (grid <= NB * 8) { fprintf(stderr, "kernel_launch: grid %d too small\n", grid); grid = -1; return; }
    }
    if (grid < 0) return;
    (void)hipMemsetAsync((char*)d_ws + WS_CTL, 0, CTL_ZERO_BYTES, stream);
    Params p{};
    const float** f = (const float**)&p;
    for (int i = 0; i < 23; ++i) f[i] = (const float*)d_in[i];
    p.out = (float*)d_out; p.ws = (unsigned char*)d_ws;
    void* args[] = {&p};
    hipError_t e = hipLaunchCooperativeKernel((const void*)mega_fwd, dim3(grid), dim3(NTHREADS), args, LDS_BYTES, stream);
    if (e != hipSuccess) fprintf(stderr, "cooperative launch failed: %s (grid %d)\n", hipGetErrorString(e), grid);
}
```

```cpp
#include <hip/hip_runtime.h>
#include <hip/hip_bf16.h>
#include <cstdio>
#include <cstdint>

constexpr int NB = 8, SEQ = 4096, DM = 1024, MTOK = NB * SEQ, NL = 2;
constexpr int D_IN = 3720, NU = 3840;
constexpr int UQ = 0, UK = 512, UV = 1024, UR = 1536  , UP = 2432  , UG = 2688  , UF = 3712  ;
constexpr int SQ = 0, SF = 1536, SR = 1544, SP = 2440, SG = 2696;
constexpr float C2 = 0.125f * 1.4426950408889634f;
constexpr float LOG2E = 1.4426950408889634f;
constexpr float DECAY_SCALE = 0.6065306597126334f;

typedef unsigned short bf16_t;
typedef short bf16x8 __attribute__((ext_vector_type(8)));
typedef float f32x4 __attribute__((ext_vector_type(4)));
typedef unsigned u32x4 __attribute__((ext_vector_type(4)));
typedef unsigned u32x2 __attribute__((ext_vector_type(2)));

__device__ __forceinline__ unsigned f2bf(float f) { unsigned u = __builtin_bit_cast(unsigned, f); return (u + 0x7fffu + ((u >> 16) & 1u)) >> 16; }
__device__ __forceinline__ unsigned pk2(float lo, float hi) { return f2bf(lo) | (f2bf(hi) << 16); }
__device__ __forceinline__ float bf2f(unsigned short b) { return __builtin_bit_cast(float, (unsigned)b << 16); }
__device__ __forceinline__ float bflo(unsigned w) { return __builtin_bit_cast(float, w << 16); }
__device__ __forceinline__ float bfhi(unsigned w) { return __builtin_bit_cast(float, w & 0xffff0000u); }
__device__ __forceinline__ float sigmoidf_(float x) { return 1.f / (1.f + __expf(-x)); }
__device__ __forceinline__ float siluf_(float x) { return x / (1.f + __expf(-x)); }
__device__ __forceinline__ float wave_sum(float v) {
#pragma unroll
    for (int o = 1; o < 64; o <<= 1) v += __shfl_xor(v, o);
    return v;
}

__device__ __forceinline__ int otid() { int t = threadIdx.x; asm volatile("" : "+v"(t)); return t; }

constexpr size_t MiB = 1u << 20;
constexpr size_t WS_CTL = 0;
constexpr size_t WS_MOD = 1 * MiB;
constexpr size_t WS_WT = 2 * MiB;
constexpr size_t WS_WOT = 18 * MiB;
constexpr size_t WS_CB = 22 * MiB;
constexpr size_t WS_XN = 24 * MiB;
constexpr size_t WS_O32 = 24 * MiB;
constexpr size_t WS_BON = 23 * MiB;
constexpr size_t WS_PA = 56 * MiB;
constexpr size_t WS_Y = 88 * MiB;
constexpr size_t WS_U = 152 * MiB;
constexpr size_t WS_Z = 152 * MiB;
constexpr size_t WS_CHK = 392 * MiB;
constexpr int CHK_B = 24576;
constexpr int NCHK = SEQ / 32;
constexpr size_t WS_END = 488 * MiB;
constexpr size_t CTL_ZERO_BYTES = 65536;
constexpr int CW_ATTQ = 8192;
constexpr int CW_BAR = 1024;

struct Params {
    const float *x, *c, *ada_w, *ada_b, *norm_pre, *norm_post, *w_in, *q_gain, *k_gain, *f_bias, *mu, *w0, *w2, *a0, *a2, *k_k, *k_a, *r_k, *ln_g, *ln_b,
        *pool_w, *pool_scale, *w_out;
    float* out;
    unsigned char* ws;
};


#define LAS __attribute__((address_space(3)))
constexpr int NTHREADS = 512;
constexpr int LDS_BYTES = 147456;
constexpr int MISC_OFF = LDS_BYTES - 128;

#define XB_TMO      128
#define XB_XCNT(j)  (256  + 64 * (j))
#define XB_XSUB(j)  (1280 + 64 * (j))
#define XB_XGEN(j)  (2304 + 64 * (j))
#define XB_TOP      3328
#define XB_TOPGEN   3392
#define XCD_BAR_WORDS 3456
#define XB_SPIN_CAP (1u << 18)
__device__ __forceinline__ unsigned xb_ld(unsigned* p)              { return __hip_atomic_load(p, __ATOMIC_RELAXED, __HIP_MEMORY_SCOPE_AGENT); }
__device__ __forceinline__ unsigned xb_add(unsigned* p, unsigned v) { return __hip_atomic_fetch_add(p, v, __ATOMIC_RELAXED, __HIP_MEMORY_SCOPE_AGENT); }
__device__ __forceinline__ unsigned xb_xcc_id() { return (unsigned)__builtin_amdgcn_s_getreg((3 << 11) | 20) & 0xFu; }
#define XB_SPIN(cond, bar) do { unsigned _sp = 0; while (cond) { __builtin_amdgcn_s_sleep(1); \
    if ((++_sp & 255u) == 0u) { if (xb_ld(&(bar)[XB_TMO])) break; if (_sp > XB_SPIN_CAP) { atomicAdd(&(bar)[XB_TMO], 1u); break; } } } } while (0)
struct XcdBarrier { unsigned* bar; unsigned x; volatile LAS unsigned* st; };
__device__ __forceinline__ XcdBarrier xcd_barrier_post(unsigned* bar, volatile LAS unsigned* st) {
    XcdBarrier b; b.bar = bar; b.x = xb_xcc_id(); b.st = st;
    if (threadIdx.x == 0) (void)xb_add(&bar[XB_XCNT(b.x)], 1u);
    return b;
}
__device__ __forceinline__ void xcd_barrier_complete(unsigned* bar, unsigned x, unsigned& nloc, unsigned& nx) {
    const unsigned G = gridDim.x * gridDim.y * gridDim.z;
    unsigned sum, cnt, mine, sp = 0u;
    for (;;) {
        sum = 0u; cnt = 0u; mine = 0u;
#pragma unroll
        for (unsigned j = 0; j < 16; ++j) { const unsigned c = xb_ld(&bar[XB_XCNT(j)]); sum += c; cnt += (c > 0u) ? 1u : 0u; mine = (j == x) ? c : mine; }
        if (sum == G) break;
        __builtin_amdgcn_s_sleep(1);
        if ((++sp & 255u) == 0u) { if (xb_ld(&bar[XB_TMO])) break; if (sp > XB_SPIN_CAP) { atomicAdd(&bar[XB_TMO], 1u); break; } }
    }
    nloc = mine > 0u ? mine : 1u; nx = cnt > 0u ? cnt : 1u;
}
__device__ __forceinline__ void xcd_barrier(const XcdBarrier& b) {
    asm volatile("s_waitcnt vmcnt(0)" ::: "memory");
    __syncthreads();
    if (threadIdx.x == 0) {
        unsigned* bar = b.bar;
        __builtin_amdgcn_s_waitcnt(0);
        unsigned nloc = b.st[0], nx = b.st[1];
        if (nloc == 0u) { xcd_barrier_complete(bar, b.x, nloc, nx); b.st[0] = nloc; b.st[1] = nx; }
        const unsigned old = xb_add(&bar[XB_XSUB(b.x)], 1u);
        const unsigned gen = old / nloc;
        if (old + 1u == (gen + 1u) * nloc) {
            __builtin_amdgcn_fence(__ATOMIC_RELEASE, "agent");
            asm volatile("s_waitcnt vmcnt(0)" ::: "memory");
            const unsigned og = xb_add(&bar[XB_TOP], 1u);
            const unsigned tg = og / nx;
            if (og + 1u == (tg + 1u) * nx) xb_add(&bar[XB_TOPGEN], 1u);
            else XB_SPIN(xb_ld(&bar[XB_TOPGEN]) == tg, bar);
            __builtin_amdgcn_fence(__ATOMIC_ACQUIRE, "agent");
            xb_add(&bar[XB_XGEN(b.x)], 1u);
            asm volatile("s_waitcnt vmcnt(0)" ::: "memory");
        } else {
            XB_SPIN(xb_ld(&bar[XB_XGEN(b.x)]) == gen, bar);
            __builtin_amdgcn_fence(__ATOMIC_ACQUIRE, "agent");
            asm volatile("s_waitcnt vmcnt(0)" ::: "memory");
        }
    }
    __syncthreads();
}


namespace pg8 {
#define PG8_LAS __attribute__((address_space(3)))
typedef unsigned short bf16_t;
typedef short bf16x8 __attribute__((ext_vector_type(8)));
typedef float f32x4 __attribute__((ext_vector_type(4)));
typedef unsigned u32x4 __attribute__((ext_vector_type(4)));
constexpr int BM = 256, BK = 64, HALF = 128, HTB = HALF * BK * 2  , STAGE_BYTES = 8 * HTB, NXCD = 8, WGM = 8;

__host__ __device__ __forceinline__ int lds_byte(int r, int c) { const int st = (r >> 4) * 2 + (c >> 5), rr = r & 15, cc = c & 31, ob = rr * 64 + cc * 2; return st * 1024 + (ob ^ (((ob >> 9) & 1) << 5)); }
__host__ __device__ __forceinline__ void stage_rc(int b, int& R, int& C) { const int st = b / 1024, sb = b % 1024, swz = sb ^ (((sb >> 9) & 1) << 5); R = (st >> 1) * 16 + swz / 64; C = (st & 1) * 32 + (swz % 64) / 2; }
__host__ __device__ __forceinline__ int perm32(int rho) { const int n = rho >> 4, i = rho & 15; return 8 * (i >> 2) + 4 * n + (i & 3); }

struct Unit { int pm, pn; };
struct Gemm { const bf16_t* A; const bf16_t* Bt; int M, N, K; };

struct StaticOrder {
    int nM, nN, nwg, G, c;
    __host__ __device__ void init(int M, int N, int G_, int c_) { nM = M / BM; nN = N / BM; nwg = nM * nN; G = G_; c = c_; }
    __host__ __device__ bool next(int i, Unit& u) const {
        const long L = (long)i * G + c; if (L >= nwg) return false;
        int wgid = (int)L; { const int q = nwg / NXCD, r = nwg % NXCD, xcd = wgid % NXCD, off = wgid / NXCD; wgid = (xcd < r ? xcd * (q + 1) : r * (q + 1) + (xcd - r) * q) + off; }
        const int nig = WGM * nN, gid = wgid / nig, fm = gid * WGM, gsz = (nM - fm) < WGM ? (nM - fm) : WGM;
        u.pm = fm + ((wgid % nig) % gsz); u.pn = (wgid % nig) / gsz; return true;
    }
    __device__ __forceinline__ void a_ready(const Unit&) const {}
    __device__ __forceinline__ void done(const Unit&) const {}
};

__device__ __forceinline__ unsigned cvt_pk_bf16(float lo, float hi) { unsigned r; asm volatile("v_cvt_pk_bf16_f32 %0, %1, %2" : "=v"(r) : "v"(lo), "v"(hi)); return r; }

struct EpiU {
    static constexpr bool PERM = true, AFTER_DRAIN = false;
    bf16_t* U; const float* qg; const float* kg; int ldc;
    __device__ __forceinline__ void operator()(const f32x4 (&acc)[2][2][4][2], const Unit& u, int wr, int wc, int fr, int fq) const {
        const int row0 = u.pm * BM + wr * 64 + fr;
        if (u.pn < 4) {
            const float* gp = (u.pn < 2 ? qg : kg) + 8 * fq; const float mult = u.pn < 2 ? (0.125f * 1.4426950408889634f) : 1.f;
            f32x4 gv[2][2];
#pragma unroll
            for (int bj = 0; bj < 2; ++bj)
#pragma unroll
                for (int n = 0; n < 2; ++n) gv[bj][n] = *(const f32x4*)(gp + 32 * bj + 4 * n);
            const int col0 = u.pn * BM + 64 * wc + 8 * fq;
#pragma unroll
            for (int ai = 0; ai < 2; ++ai)
#pragma unroll
                for (int m = 0; m < 4; ++m) {
                    float s = 0.f;
#pragma unroll
                    for (int bj = 0; bj < 2; ++bj)
#pragma unroll
                        for (int n = 0; n < 2; ++n) { const f32x4 x = acc[ai][bj][m][n]; s += (x[0] * x[0] + x[1] * x[1]) + (x[2] * x[2] + x[3] * x[3]); }
                    s += __shfl_xor(s, 16); s += __shfl_xor(s, 32);
                    const float sc = rsqrtf(s * (1.f / 64.f) + 1e-6f) * mult;
                    bf16_t* rowp = U + (size_t)(row0 + ai * HALF + m * 16) * ldc + col0;
#pragma unroll
                    for (int bj = 0; bj < 2; ++bj) { const f32x4 v0 = acc[ai][bj][m][0] * sc * gv[bj][0], v1 = acc[ai][bj][m][1] * sc * gv[bj][1];
                        u32x4 w; w.x = cvt_pk_bf16(v0[0], v0[1]); w.y = cvt_pk_bf16(v0[2], v0[3]); w.z = cvt_pk_bf16(v1[0], v1[1]); w.w = cvt_pk_bf16(v1[2], v1[3]);
                        *(u32x4*)(rowp + bj * 32) = w; }
                }
        } else {
            const int col0 = u.pn * BM + wc * 32 + 8 * fq;
#pragma unroll
            for (int ai = 0; ai < 2; ++ai)
#pragma unroll
                for (int m = 0; m < 4; ++m) { bf16_t* rowp = U + (size_t)(row0 + ai * HALF + m * 16) * ldc + col0;
#pragma unroll
                    for (int bj = 0; bj < 2; ++bj) { const f32x4 v0 = acc[ai][bj][m][0], v1 = acc[ai][bj][m][1];
                        u32x4 w; w.x = cvt_pk_bf16(v0[0], v0[1]); w.y = cvt_pk_bf16(v0[2], v0[3]); w.z = cvt_pk_bf16(v1[0], v1[1]); w.w = cvt_pk_bf16(v1[2], v1[3]);
                        *(u32x4*)(rowp + bj * HALF) = w; } }
        }
    }
};
struct EpiF32 {
    static constexpr bool PERM = false, AFTER_DRAIN = false;
    float* C; int ldc;
    __device__ __forceinline__ void operator()(const f32x4 (&acc)[2][2][4][2], const Unit& u, int wr, int wc, int fr, int fq) const {
        const int row0 = u.pm * BM + wr * 64 + fr, col0 = u.pn * BM + wc * 32 + 4 * fq;
#pragma unroll
        for (int ai = 0; ai < 2; ++ai)
#pragma unroll
            for (int m = 0; m < 4; ++m) { float* rowp = C + (size_t)(row0 + ai * HALF + m * 16) * ldc + col0;
#pragma unroll
                for (int bj = 0; bj < 2; ++bj)
#pragma unroll
                    for (int n = 0; n < 2; ++n) *(f32x4*)(rowp + bj * HALF + n * 16) = acc[ai][bj][m][n]; }
    }
};

template <class Epi, class Sched, bool ALIGN_EPI = false, bool SP2 = false>
__device__ __forceinline__ void gemm_phase(PG8_LAS unsigned char* lds, const Gemm g, const Sched& S, const Epi& E) {
    int tid_ = threadIdx.x; asm volatile("" : "+v"(tid_));
    const int tid = tid_, wid = __builtin_amdgcn_readfirstlane(tid >> 6), lane = tid & 63, wr = wid >> 2, wc = wid & 3, fr = lane & 15, fq = lane >> 4;
    const int K = g.K, nt = K / BK;
    unsigned voffA[2], voffB[2];
#pragma unroll
    for (int i = 0; i < 2; ++i) { int R, C; stage_rc(tid * 16 + i * 8192, R, C); const int Rb = Epi::PERM ? ((R & ~31) + perm32(R & 31)) : R;
        voffA[i] = (unsigned)(R * K + C) * 2u; voffB[i] = (unsigned)(Rb * K + C) * 2u; }
    const size_t kstep = (size_t)(BK * 2);
    const size_t hstep = (size_t)HALF * K * 2;
    const size_t tstep = 2 * hstep;
    const unsigned ldsw = (unsigned)wid * 1024u;
    const int aoff = lds_byte(wr * 64 + fr, fq * 8), boff = lds_byte(wc * 32 + fr, fq * 8);
#define PG8_SA(b, h) (((b) * 2 + (h)) * HTB)
#define PG8_SB(b, h) ((4 + (b) * 2 + (h)) * HTB)
#define PG8_STAGE(bufoff, gbase, voff) do { _Pragma("unroll") for (int _i = 0; _i < 2; ++_i) \
        __builtin_amdgcn_global_load_lds((const unsigned*)((const char*)(gbase) + (voff)[_i]), (PG8_LAS unsigned*)(lds + (bufoff) + ldsw + _i * 8192), 16, 0, 0); } while (0)
#define PG8_LDA(dst, b, h) do { _Pragma("unroll") for (int m = 0; m < 4; ++m) _Pragma("unroll") for (int k = 0; k < 2; ++k) dst[m][k] = *(const PG8_LAS bf16x8*)(lds + PG8_SA(b, h) + aoff + m * 2048 + k * 1024); } while (0)
#define PG8_LDB(dst, b, h) do { _Pragma("unroll") for (int n = 0; n < 2; ++n) _Pragma("unroll") for (int k = 0; k < 2; ++k) dst[n][k] = *(const PG8_LAS bf16x8*)(lds + PG8_SB(b, h) + boff + n * 2048 + k * 1024); } while (0)
#define PG8_MMA(ai, bj, At, Bt) do { __builtin_amdgcn_s_setprio(1); _Pragma("unroll") for (int m = 0; m < 4; ++m) _Pragma("unroll") for (int n = 0; n < 2; ++n) _Pragma("unroll") for (int k = 0; k < 2; ++k) \
        acc[ai][bj][m][n] = __builtin_amdgcn_mfma_f32_16x16x32_bf16(Bt[n][k], At[m][k], acc[ai][bj][m][n], 0, 0, 0); __builtin_amdgcn_s_setprio(0); } while (0)
#define PG8_WAIT_V(n) asm volatile("s_waitcnt vmcnt(" #n ")" ::: "memory")
#define PG8_WAIT_L(n) asm volatile("s_waitcnt lgkmcnt(" #n ")" ::: "memory")
#define PG8_BAR __builtin_amdgcn_s_barrier()
#define PG8_SCHED __builtin_amdgcn_sched_barrier(0)
    Unit cur, nxt; int ui = 0;
    if (!S.next(0, cur)) return;
    f32x4 acc[2][2][4][2];
#pragma unroll
    for (int a = 0; a < 2; ++a)
#pragma unroll
        for (int b = 0; b < 2; ++b)
#pragma unroll
            for (int m = 0; m < 4; ++m)
#pragma unroll
                for (int n = 0; n < 2; ++n) acc[a][b][m][n] = (f32x4){0.f, 0.f, 0.f, 0.f};
    bf16x8 At[4][2], B0[2][2], B1[2][2];
    const char* cA = (const char*)g.A + (size_t)cur.pm * tstep; const char* cB = (const char*)g.Bt + (size_t)cur.pn * tstep;
    S.a_ready(cur);
    if constexpr (SP2) {
        PG8_STAGE(PG8_SB(0, 0), cB, voffB); PG8_STAGE(PG8_SB(0, 1), cB + hstep, voffB); PG8_STAGE(PG8_SA(0, 0), cA, voffA); PG8_STAGE(PG8_SA(0, 1), cA + hstep, voffA);
        if (wr == 1) PG8_BAR;
        PG8_WAIT_V(2); PG8_BAR;
        PG8_STAGE(PG8_SB(1, 0), cB + kstep, voffB); PG8_STAGE(PG8_SA(1, 0), cA + kstep, voffA); PG8_STAGE(PG8_SB(1, 1), cB + hstep + kstep, voffB);
        PG8_WAIT_V(6); PG8_BAR;
    } else {
        PG8_STAGE(PG8_SB(0, 0), cB, voffB); PG8_STAGE(PG8_SA(0, 0), cA, voffA); PG8_STAGE(PG8_SB(0, 1), cB + hstep, voffB); PG8_STAGE(PG8_SA(0, 1), cA + hstep, voffA);
        if (wr == 1) PG8_BAR;
        PG8_WAIT_V(4); PG8_BAR;
        PG8_STAGE(PG8_SB(1, 0), cB + kstep, voffB); PG8_STAGE(PG8_SA(1, 0), cA + kstep, voffA); PG8_STAGE(PG8_SB(1, 1), cB + hstep + kstep, voffB);
        PG8_WAIT_V(6); PG8_BAR;
    }
    for (;;) {
        const bool has_next = S.next(ui + 1, nxt);
        const char* nA = has_next ? (const char*)g.A + (size_t)nxt.pm * tstep : cA; const char* nB = has_next ? (const char*)g.Bt + (size_t)nxt.pn * tstep : cB;
        for (int t = 0; t < nt; t += 2) {
            const bool last = (t == nt - 2);
            const char* a1 = cA + (size_t)(t + 1) * kstep;
            const char* a2 = last ? nA : cA + (size_t)(t + 2) * kstep; const char* b2 = last ? nB : cB + (size_t)(t + 2) * kstep;
            const char* a3 = a2 + kstep; const char* b3 = b2 + kstep;
            if (last && has_next) S.a_ready(nxt);
            if constexpr (SP2) {
            PG8_LDB(B0, 0, 0); PG8_LDB(B1, 0, 1); PG8_SCHED; PG8_LDA(At, 0, 0); PG8_STAGE(PG8_SA(1, 1), a1 + hstep, voffA);
            PG8_WAIT_V(8); PG8_WAIT_L(0); PG8_BAR; PG8_MMA(0, 0, At, B0); PG8_MMA(0, 1, At, B1); PG8_BAR; PG8_SCHED;
            PG8_LDA(At, 0, 1); PG8_STAGE(PG8_SB(0, 0), b2, voffB); PG8_STAGE(PG8_SB(0, 1), b2 + hstep, voffB); PG8_STAGE(PG8_SA(0, 0), a2, voffA);
            PG8_WAIT_V(8); PG8_WAIT_L(0); PG8_BAR; PG8_MMA(1, 0, At, B0); PG8_MMA(1, 1, At, B1); PG8_BAR; PG8_SCHED;
            PG8_LDB(B0, 1, 0); PG8_LDB(B1, 1, 1); PG8_SCHED; PG8_LDA(At, 1, 0); PG8_STAGE(PG8_SA(0, 1), a2 + hstep, voffA);
            PG8_WAIT_V(8); PG8_WAIT_L(0); PG8_BAR; PG8_MMA(0, 0, At, B0); PG8_MMA(0, 1, At, B1); PG8_BAR; PG8_SCHED;
            PG8_LDA(At, 1, 1); PG8_STAGE(PG8_SB(1, 0), b3, voffB); PG8_STAGE(PG8_SB(1, 1), b3 + hstep, voffB); PG8_STAGE(PG8_SA(1, 0), a3, voffA);
            PG8_WAIT_V(8); PG8_WAIT_L(0); PG8_BAR; PG8_MMA(1, 0, At, B0); PG8_MMA(1, 1, At, B1); PG8_BAR; PG8_SCHED;
            } else {
            PG8_LDB(B0, 0, 0); PG8_SCHED; PG8_LDA(At, 0, 0); PG8_STAGE(PG8_SA(1, 1), a1 + hstep, voffA);
            PG8_WAIT_L(8); PG8_BAR; PG8_WAIT_L(0); PG8_MMA(0, 0, At, B0); PG8_BAR; PG8_SCHED;
            PG8_LDB(B1, 0, 1); PG8_STAGE(PG8_SB(0, 0), b2, voffB);
            PG8_BAR; PG8_WAIT_L(0); PG8_MMA(0, 1, At, B1); PG8_BAR;
            PG8_LDA(At, 0, 1); PG8_STAGE(PG8_SA(0, 0), a2, voffA);
            PG8_BAR; PG8_WAIT_L(0); PG8_MMA(1, 0, At, B0); PG8_BAR; PG8_SCHED;
            PG8_STAGE(PG8_SB(0, 1), b2 + hstep, voffB);
            PG8_WAIT_V(6); PG8_BAR; PG8_MMA(1, 1, At, B1); PG8_BAR;
            PG8_LDB(B0, 1, 0); PG8_SCHED; PG8_LDA(At, 1, 0); PG8_STAGE(PG8_SA(0, 1), a2 + hstep, voffA);
            PG8_WAIT_L(8); PG8_BAR; PG8_WAIT_L(0); PG8_MMA(0, 0, At, B0); PG8_BAR; PG8_SCHED;
            PG8_LDB(B1, 1, 1); PG8_STAGE(PG8_SB(1, 0), b3, voffB);
            PG8_BAR; PG8_WAIT_L(0); PG8_MMA(0, 1, At, B1); PG8_BAR;
            PG8_LDA(At, 1, 1); PG8_STAGE(PG8_SA(1, 0), a3, voffA);
            PG8_BAR; PG8_WAIT_L(0); PG8_MMA(1, 0, At, B0); PG8_BAR; PG8_SCHED;
            PG8_STAGE(PG8_SB(1, 1), b3 + hstep, voffB);
            PG8_WAIT_V(6); PG8_BAR; PG8_MMA(1, 1, At, B1); PG8_BAR;
            }
        }
        if constexpr (ALIGN_EPI) { if (wr == 0) PG8_BAR; }
        if constexpr (!Epi::AFTER_DRAIN) { E(acc, cur, wr, wc, fr, fq); S.done(cur); }
        if (!has_next) break;
#pragma unroll
        for (int a = 0; a < 2; ++a)
#pragma unroll
            for (int b = 0; b < 2; ++b)
#pragma unroll
                for (int m = 0; m < 4; ++m)
#pragma unroll
                    for (int n = 0; n < 2; ++n) acc[a][b][m][n] = (f32x4){0.f, 0.f, 0.f, 0.f};
        cur = nxt; cA = nA; cB = nB; ++ui;
        if constexpr (ALIGN_EPI) { if (wr == 1) PG8_BAR; }
    }
    PG8_WAIT_V(0);
    if constexpr (!ALIGN_EPI) { if (wr == 0) PG8_BAR; }
    PG8_BAR;
    if constexpr (Epi::AFTER_DRAIN) { E.fused(acc, cur, wr, wc, fr, fq, lds, wid, lane); S.done(cur); }
#undef PG8_SA
#undef PG8_SB
#undef PG8_STAGE
#undef PG8_LDA
#undef PG8_LDB
#undef PG8_MMA
#undef PG8_WAIT_V
#undef PG8_WAIT_L
#undef PG8_BAR
#undef PG8_SCHED
}
}

#include <hip/hip_bf16.h>
#include <cmath>
namespace attn_body {
using bf16=__hip_bfloat16;
using bf16x8=__attribute__((ext_vector_type(8)))short;
using s16x4=__attribute__((ext_vector_type(4)))short;
using f32x16=__attribute__((ext_vector_type(16)))float;
using u32x4=__attribute__((ext_vector_type(4)))unsigned;
constexpr int BATCH=8,NHEAD=8,SEQ=4096,D=64,DM=3840,OPITCH=1024;
constexpr int NW=8,QBLK=32,QB=QBLK*NW,KVBLK=64,NQB=SEQ/QB;
constexpr int ATTN_PITCH=DM, ATTN_UNIT_ROWS=QB;
__device__ __forceinline__ int crow(int r,int hi){return (r&3)+8*(r>>2)+4*hi;}
#define SBAR() __builtin_amdgcn_sched_barrier(0)
__device__ __forceinline__ void cmask(f32x16&p0,f32x16&p1,int jb,int qrel,int hi){
  const float NEG=-INFINITY; int kb=64*jb+4*hi;
  #pragma unroll
  for(int r=0;r<16;++r){int kv=kb+(r&3)+8*(r>>2); if(kv>qrel)p0[r]=NEG; if(kv+32>qrel)p1[r]=NEG;}
}

constexpr int NSLOT=3, SLOTB=8192;
constexpr int LDS_K=0, LDS_V=NSLOT*SLOTB, LDS_WS=2*NSLOT*SLOTB, LDS_OST=LDS_WS+NW*64*4, LDS_CB=LDS_OST+NW*4096, LDS_BYTES=LDS_CB+SEQ*4+1024;
constexpr float C2=0.125f*1.4426950408889634f;
__device__ __forceinline__ void glds16(const void*gsrc,unsigned lds_dst){unsigned keep;
  asm volatile("s_mov_b32 %0, m0\n\ts_mov_b32 m0, %2\n\ts_nop 0\n\tglobal_load_lds_dwordx4 %1, off\n\ts_mov_b32 m0, %0":"=&s"(keep):"v"(gsrc),"s"(lds_dst):"memory");}
__device__ __forceinline__ float max3f(float a,float b,float c){float r;asm("v_max3_f32 %0, %1, %2, %3":"=v"(r):"v"(a),"v"(b),"v"(c));return r;}
__device__ __forceinline__ float max2f(float a,float b){float r;asm("v_max_f32_e32 %0, %1, %2":"=v"(r):"v"(a),"v"(b));return r;}
__device__ __forceinline__ float fadd_s(float a,float b){float r;asm("v_add_f32_e32 %0, %1, %2":"=v"(r):"v"(a),"v"(b));return r;}
__device__ __forceinline__ float fsub_s(float a,float b){float r;asm("v_sub_f32_e32 %0, %1, %2":"=v"(r):"v"(a),"v"(b));return r;}
typedef float f32x4v __attribute__((ext_vector_type(4))); typedef float f32x2_t __attribute__((ext_vector_type(2))); typedef __bf16 bf16x2_t __attribute__((ext_vector_type(2)));
__device__ __forceinline__ unsigned cvtpk_s(float lo,float hi){f32x2_t v={lo,hi};bf16x2_t b=__builtin_convertvector(v,bf16x2_t);return __builtin_bit_cast(unsigned,b);}
#define WAIT_BAR(N) asm volatile("s_waitcnt vmcnt(" #N ") lgkmcnt(0)\n\ts_barrier":::"memory")

__device__ __forceinline__ void qkt(f32x16&p0,f32x16&p1,const char*Kslot,const bf16x8*qr,int r32,int hi){
  const char*kb=Kslot+hi*1024+r32*16;
  #pragma unroll
  for(int d0=0;d0<4;++d0){
    const bf16x8 b0=*reinterpret_cast<const bf16x8*>(kb+d0*2048);
    const bf16x8 b1=*reinterpret_cast<const bf16x8*>(kb+d0*2048+512);
    p0=__builtin_amdgcn_mfma_f32_32x32x16_bf16(b0,qr[d0],p0,0,0,0);p1=__builtin_amdgcn_mfma_f32_32x32x16_bf16(b1,qr[d0],p1,0,0,0);}
}
typedef __attribute__((address_space(3))) const char* lds_cptr;
typedef short v4i16_t __attribute__((ext_vector_type(4)));
__device__ __forceinline__ void kload8(bf16x8*kf,lds_cptr kp){
  kf[0]=*(const __attribute__((address_space(3))) bf16x8*)(kp);      kf[1]=*(const __attribute__((address_space(3))) bf16x8*)(kp+512);
  kf[2]=*(const __attribute__((address_space(3))) bf16x8*)(kp+2048); kf[3]=*(const __attribute__((address_space(3))) bf16x8*)(kp+2560);
  kf[4]=*(const __attribute__((address_space(3))) bf16x8*)(kp+4096); kf[5]=*(const __attribute__((address_space(3))) bf16x8*)(kp+4608);
  kf[6]=*(const __attribute__((address_space(3))) bf16x8*)(kp+6144); kf[7]=*(const __attribute__((address_space(3))) bf16x8*)(kp+6656);
}
__device__ __forceinline__ void kload2(bf16x8*kf,lds_cptr kp,int j){ kf[2*j]=*(const __attribute__((address_space(3))) bf16x8*)(kp+j*2048); kf[2*j+1]=*(const __attribute__((address_space(3))) bf16x8*)(kp+j*2048+512); }
__device__ __forceinline__ s16x4 vtr(lds_cptr p){ return __builtin_bit_cast(s16x4,__builtin_amdgcn_ds_read_tr16_b64_v4i16((__attribute__((address_space(3))) v4i16_t*)p)); }
__device__ __forceinline__ float rowmax(const f32x16&p0,const f32x16&p1){
  float a=max3f(p0[0],p0[1],p1[0]),b=max3f(p0[2],p0[3],p1[1]);a=max3f(a,p1[2],p1[3]);
  #pragma unroll
  for(int r=4;r<16;r+=4){a=max3f(a,p0[r],p0[r+1]);b=max3f(b,p0[r+2],p0[r+3]);a=max3f(a,p1[r],p1[r+1]);b=max3f(b,p1[r+2],p1[r+3]);}
  const float m=max2f(a,b);
  auto rr=__builtin_amdgcn_permlane32_swap(__float_as_uint(m),__float_as_uint(m),false,false);
  return max2f(__uint_as_float(rr[0]),__uint_as_float(rr[1]));
}
__device__ __forceinline__ void pv(f32x16*o,int vb,bf16x8 pa0,bf16x8 pa1,bf16x8 pa2,bf16x8 pa3){
  #pragma unroll
  for(int d0=0;d0<2;++d0){s16x4 lo[4],hi[4];
    #pragma unroll
    for(int ks=0;ks<4;++ks){
      asm volatile("ds_read_b64_tr_b16 %0,%1 offset:%c2":"=&v"(lo[ks]):"v"(vb),"i"(d0*4096+ks*1024):"memory");
      asm volatile("ds_read_b64_tr_b16 %0,%1 offset:%c2":"=&v"(hi[ks]):"v"(vb),"i"(d0*4096+ks*1024+512):"memory");}
    asm volatile("s_waitcnt lgkmcnt(0)":::"memory");SBAR();
    #define PK(k) (bf16x8){lo[k][0],lo[k][1],lo[k][2],lo[k][3],hi[k][0],hi[k][1],hi[k][2],hi[k][3]}
    o[d0]=__builtin_amdgcn_mfma_f32_32x32x16_bf16(pa0,PK(0),o[d0],0,0,0);
    o[d0]=__builtin_amdgcn_mfma_f32_32x32x16_bf16(pa1,PK(1),o[d0],0,0,0);
    o[d0]=__builtin_amdgcn_mfma_f32_32x32x16_bf16(pa2,PK(2),o[d0],0,0,0);
    o[d0]=__builtin_amdgcn_mfma_f32_32x32x16_bf16(pa3,PK(3),o[d0],0,0,0);
    #undef PK
  }
}

#ifndef ATTN_STORE16
#define ATTN_STORE16(p,v) (*(u32x4*)(p)=(v))
#endif
template<int THRL> __device__ __forceinline__ void attn_unit(int b,int h,int qb,const bf16*Q,const bf16*__restrict__ K,const bf16*__restrict__ V,const bf16*Gt,const float*CBg,bf16*O,char*shm){
  int tid_=threadIdx.x; asm volatile("":"+v"(tid_)); const int tid=tid_,lane=tid&63,r32=lane&31,hi=lane>>5; const int wid=__builtin_amdgcn_readfirstlane(tid>>6);
  const long rowbase=(long)b*SEQ; const int q0=qb*QB;
  const bf16*Qw=Q+(rowbase+q0+wid*QBLK)*DM+h*D;
  const bf16*Kh=K+rowbase*DM+h*D,*Vh=V+rowbase*DM+h*D;
  const unsigned lds0=(unsigned)(uintptr_t)shm;
  float*wsf=(float*)(shm+LDS_WS)+wid*64;
  const bf16*ksrc=Kh+(long)lane*DM+wid*8;
  const bf16*vsrc=Vh+(long)(16*(wid&3)+(lane>>2))*DM+(wid>>2)*32+(lane&3)*8;
  const unsigned kdst=lds0+LDS_K+wid*1024, vdst=lds0+LDS_V+wid*1024;
  #define DMA_K(t,slot) glds16(ksrc+(long)(t)*KVBLK*DM,(unsigned)__builtin_amdgcn_readfirstlane(kdst+(slot)))
  #define DMA_V(t,slot) glds16(vsrc+(long)(t)*KVBLK*DM,(unsigned)__builtin_amdgcn_readfirstlane(vdst+(slot)))
  const int vb0=(int)(lds0+LDS_V)+((lane>>4)&1)*32+(lane&3)*8+(4*hi+((lane&15)>>2))*64;
  const char*Kbase=shm+LDS_K; bf16x8 kf[8];
  const lds_cptr shm3=(lds_cptr)shm; const lds_cptr kp0=shm3+LDS_K+hi*1024+r32*16; const lds_cptr vp0=shm3+LDS_V+((lane>>4)&1)*32+(lane&3)*8+(4*hi+((lane&15)>>2))*64;
  const int NT=(q0+QB)/KVBLK;
  { const float*cbsrc=CBg+((long)b*NHEAD+h)*SEQ; float*cbl=(float*)(shm+LDS_CB);
    #pragma unroll
    for(int i=0;i<2;++i){ const int e=(i*512+tid)*4; if(e<q0+QB){ const f32x4v v=*reinterpret_cast<const f32x4v*>(cbsrc+e); *reinterpret_cast<f32x4v*>(cbl+e)=v; } } }
  DMA_K(0,0);DMA_V(0,0);DMA_K(1,SLOTB);
  bf16x8 qr[4];
  #pragma unroll
  for(int d0=0;d0<4;++d0)qr[d0]=*reinterpret_cast<const bf16x8*>(&Qw[(long)r32*DM+d0*16+hi*8]);
  float mhat=0.f,l_reg=0.f;f32x16 o[2];o[0]=f32x16{};o[1]=f32x16{};
  const int qrel=wid*QBLK+r32;
  #define CMASK(P0,P1,t) do{int jb_=(t)-(NT-4); if(jb_>=0)cmask(P0,P1,jb_,qrel,hi);}while(0)
  bool resc=false; f32x16 pA0,pA1,pB0,pB1;
  #define START(P0,P1) do{ const float rm=rowmax(P0,P1); resc=false; \
    { const float dl=__builtin_fmaxf(rm,-16.f); mhat=fadd_s(mhat,dl); mh2=cbq+mhat; \
      _Pragma("unroll") for(int r=0;r<16;++r){P0[r]=fsub_s(P0[r],dl);P1[r]=fsub_s(P1[r],dl);} } \
    _Pragma("unroll") for(int r=0;r<16;++r)P0[r]=__builtin_amdgcn_exp2f(P0[r]); }while(0)
  #define RESC() do{ if(resc){ asm volatile("s_waitcnt lgkmcnt(0)":::"memory"); \
      _Pragma("unroll") for(int d_=0;d_<2;++d_) _Pragma("unroll") for(int r=0;r<16;++r)o[d_][r]*=wsf[crow(r,hi)]; } }while(0)
  int sl_prev=0,sl_cur=0,sl_next=SLOTB;
  #define ROT() do{sl_prev=sl_cur;sl_cur=sl_next;sl_next=(sl_next==(NSLOT-1)*SLOTB)?0:sl_next+SLOTB;}while(0)
  DMA_K(2,2*SLOTB);
  WAIT_BAR(3);
  const lds_cptr cbp=(lds_cptr)shm+LDS_CB+hi*16;
  const float cbq=*(const __attribute__((address_space(3))) float*)((lds_cptr)shm+LDS_CB+4*(q0+wid*QBLK+r32));
  float mh2=cbq;
  #define CBINIT(P0,P1,t) do{ _Pragma("unroll") for(int g_=0;g_<4;++g_){ \
      const f32x4v c0_=*(const __attribute__((address_space(3))) f32x4v*)(cbp+(t)*256+g_*32), c1_=*(const __attribute__((address_space(3))) f32x4v*)(cbp+(t)*256+g_*32+128); \
      _Pragma("unroll") for(int i_=0;i_<4;++i_){P0[4*g_+i_]=c0_[i_]-mh2;P1[4*g_+i_]=c1_[i_]-mh2;} } }while(0)
  CBINIT(pA0,pA1,0);
  qkt(pA0,pA1,Kbase,qr,r32,hi);asm volatile("s_nop 15\n\ts_nop 7":"+v"(pA0),"+v"(pA1));CMASK(pA0,pA1,0);
  START(pA0,pA1);
  _Pragma("unroll") for(int r=0;r<16;++r)pA1[r]=__builtin_amdgcn_exp2f(pA1[r]);
  CBINIT(pB0,pB1,1);
  WAIT_BAR(0);
  DMA_K(3,0);DMA_V(1,SLOTB);
  ROT();
  kload8(kf,kp0+sl_cur);
  WAIT_BAR(2);
  s16x4 vlo[8],vhi[8]; u32x4 pw0,pw1,pw2,pw3;
  #define PKW(P,B) cvtpk_s(P[B],P[B+1])
  #define PAF(k) __builtin_bit_cast(bf16x8,pw##k)
  #define VFR(i) (bf16x8){vlo[i][0],vlo[i][1],vlo[i][2],vlo[i][3],vhi[i][0],vhi[i][1],vhi[i][2],vhi[i][3]}
  #define PIN(x) asm volatile("":"+v"(x))
  #define MX3(a,b,c) __builtin_fmaxf(__builtin_fmaxf((a),(b)),(c))
  #define GAPA(MF,A0,A1,A2,A3,W0,W1,PW) do{ MF; sacc+=A0; sacc+=A1; sacc+=A2; sacc+=A3; PIN(sacc); W0; W1; PIN(PW); SBAR(); }while(0)
  #define EX(v) __builtin_amdgcn_exp2f(v)
  #define GAPB(MF,X,B,PN,CBO) do{ MF; X[B]=EX(X[B]); X[B+1]=EX(X[B+1]); X[B+2]=EX(X[B+2]); X[B+3]=EX(X[B+3]); PIN(X); \
    { const f32x4v c_=*(const __attribute__((address_space(3))) f32x4v*)(cbn_+(CBO)); PN[B]=c_[0]-mh2; PN[B+1]=c_[1]-mh2; PN[B+2]=c_[2]-mh2; PN[B+3]=c_[3]-mh2; PIN(PN); } SBAR(); }while(0)
  #define VRD(i) do{ vlo[i]=vtr(vp_+(((i)>>2)*4096+((i)&3)*1024)); vhi[i]=vtr(vp_+(((i)>>2)*4096+((i)&3)*1024+512)); }while(0)
  #define KRD(G,j) do{ if(G){ kload2(kf,kp0+sl_next,j); SBAR(); } }while(0)
  #define STEP(C0,C1,P0,P1,t,GK,GV,GL) do{ SBAR(); \
    const lds_cptr vp_=vp0+sl_prev; \
    VRD(0); SBAR(); float sacc=(P0[0]+P0[1]); \
    GAPA(C0=__builtin_amdgcn_mfma_f32_32x32x16_bf16(kf[0],qr[0],C0,0,0,0), P0[2],P0[3],P0[4],P0[5],     pw0[0]=PKW(P0,0), pw0[1]=PKW(P0,2), pw0); \
    VRD(4); SBAR(); GAPA(C1=__builtin_amdgcn_mfma_f32_32x32x16_bf16(kf[1],qr[0],C1,0,0,0), P0[6],P0[7],P0[8],P0[9],     pw0[2]=PKW(P0,4), pw0[3]=PKW(P0,6), pw0); \
    VRD(1); SBAR(); GAPA(C0=__builtin_amdgcn_mfma_f32_32x32x16_bf16(kf[2],qr[1],C0,0,0,0),   P0[10],P0[11],P0[12],P0[13], pw1[0]=PKW(P0,8), pw1[1]=PKW(P0,10), pw1); \
    VRD(5); SBAR(); GAPA(C1=__builtin_amdgcn_mfma_f32_32x32x16_bf16(kf[3],qr[1],C1,0,0,0),   P0[14],P0[15],P1[0],P1[1],   pw1[2]=PKW(P0,12),pw1[3]=PKW(P0,14), pw1); \
    VRD(2); SBAR(); GAPA(C0=__builtin_amdgcn_mfma_f32_32x32x16_bf16(kf[4],qr[2],C0,0,0,0),   P1[2],P1[3],P1[4],P1[5],     pw2[0]=PKW(P1,0), pw2[1]=PKW(P1,2), pw2); \
    VRD(6); SBAR(); GAPA(C1=__builtin_amdgcn_mfma_f32_32x32x16_bf16(kf[5],qr[2],C1,0,0,0),   P1[6],P1[7],P1[8],P1[9],     pw2[2]=PKW(P1,4), pw2[3]=PKW(P1,6), pw2); \
    VRD(3); SBAR(); GAPA(C0=__builtin_amdgcn_mfma_f32_32x32x16_bf16(kf[6],qr[3],C0,0,0,0),   P1[10],P1[11],P1[12],P1[13], pw3[0]=PKW(P1,8), pw3[1]=PKW(P1,10), pw3); \
    VRD(7); SBAR(); GAPA(C1=__builtin_amdgcn_mfma_f32_32x32x16_bf16(kf[7],qr[3],C1,0,0,0),   P1[14],P1[15],0.f,0.f,       pw3[2]=PKW(P1,12),pw3[3]=PKW(P1,14), pw3); \
    l_reg+=sacc; \
    if(GK){DMA_K((t)+3,sl_cur);} if(GV){DMA_V((t)+1,sl_next);} \
    CMASK(C0,C1,t); \
    { float a=MX3(C0[0],C0[1],C1[0]),b=MX3(C0[2],C0[3],C1[1]); a=MX3(a,C1[2],C1[3]); \
      _Pragma("unroll") for(int r=4;r<16;r+=4){a=MX3(a,C0[r],C0[r+1]);b=MX3(b,C0[r+2],C0[r+3]);a=MX3(a,C1[r],C1[r+1]);b=MX3(b,C1[r+2],C1[r+3]);} \
      float rm=__builtin_fmaxf(a,b); { auto rr=__builtin_amdgcn_permlane32_swap(__float_as_uint(rm),__float_as_uint(rm),false,false); rm=__builtin_fmaxf(__uint_as_float(rr[0]),__uint_as_float(rr[1])); } \
      resc=false; \
      if(__builtin_expect(__any(rm>(float)THRL),0)){ const float dl=__builtin_fmaxf(rm,0.f); mhat+=dl; \
        _Pragma("unroll") for(int r=0;r<16;++r){C0[r]-=dl;C1[r]-=dl;} \
        mh2=cbq+mhat; \
        const float f=__builtin_amdgcn_exp2f(-dl); l_reg*=f; if(hi==0)wsf[r32]=f; resc=true; } } \
    SBAR(); \
    const lds_cptr cbn_=cbp+((t)+1)*256;                      \
    GAPB(o[0]=__builtin_amdgcn_mfma_f32_32x32x16_bf16(PAF(0),VFR(0),o[0],0,0,0), C0,0, P0,0); \
    GAPB(o[1]=__builtin_amdgcn_mfma_f32_32x32x16_bf16(PAF(0),VFR(4),o[1],0,0,0), C0,4, P0,32); \
    KRD(GL,0); GAPB(o[0]=__builtin_amdgcn_mfma_f32_32x32x16_bf16(PAF(1),VFR(1),o[0],0,0,0), C0,8, P0,64); \
    KRD(GL,1); GAPB(o[1]=__builtin_amdgcn_mfma_f32_32x32x16_bf16(PAF(1),VFR(5),o[1],0,0,0), C0,12, P0,96); \
    KRD(GL,2); GAPB(o[0]=__builtin_amdgcn_mfma_f32_32x32x16_bf16(PAF(2),VFR(2),o[0],0,0,0), C1,0, P1,128); \
    KRD(GL,3); GAPB(o[1]=__builtin_amdgcn_mfma_f32_32x32x16_bf16(PAF(2),VFR(6),o[1],0,0,0), C1,4, P1,160); \
    GAPB(o[0]=__builtin_amdgcn_mfma_f32_32x32x16_bf16(PAF(3),VFR(3),o[0],0,0,0), C1,8, P1,192); \
    GAPB(o[1]=__builtin_amdgcn_mfma_f32_32x32x16_bf16(PAF(3),VFR(7),o[1],0,0,0), C1,12, P1,224); \
    }while(0)
  int t=1;
  #undef CMASK
  #define CMASK(P0,P1,t) do{}while(0)
  for(;t+5<NT;t+=2){
    STEP(pB0,pB1,pA0,pA1,t,true,true,true);     WAIT_BAR(2); RESC(); ROT();
    STEP(pA0,pA1,pB0,pB1,t+1,true,true,true);   WAIT_BAR(2); RESC(); ROT();
  }
  #undef CMASK
  #define CMASK(P0,P1,t) do{int jb_=(t)-(NT-4); if(jb_>=0)cmask(P0,P1,jb_,qrel,hi);}while(0)
  #define ENDW(tt) do{ if((tt)+3<NT){WAIT_BAR(2);} else if((tt)+2<NT){WAIT_BAR(1);} else {WAIT_BAR(0);} }while(0)
  for(;t+1<NT;t+=2){
    STEP(pB0,pB1,pA0,pA1,t,(t+3<NT),(t+1<NT),(t+1<NT));       ENDW(t);   RESC(); ROT();
    STEP(pA0,pA1,pB0,pB1,t+1,(t+4<NT),(t+2<NT),(t+2<NT));     ENDW(t+1); RESC(); ROT();
  }
  STEP(pB0,pB1,pA0,pA1,NT-1,false,false,false); RESC();
  { float sacc=pB0[0]+pB0[1]; _Pragma("unroll") for(int r=2;r<16;++r)sacc+=pB0[r]; _Pragma("unroll") for(int r=0;r<16;++r)sacc+=pB1[r]; l_reg+=sacc;
    pw0=(u32x4){PKW(pB0,0),PKW(pB0,2),PKW(pB0,4),PKW(pB0,6)};pw1=(u32x4){PKW(pB0,8),PKW(pB0,10),PKW(pB0,12),PKW(pB0,14)};pw2=(u32x4){PKW(pB1,0),PKW(pB1,2),PKW(pB1,4),PKW(pB1,6)};pw3=(u32x4){PKW(pB1,8),PKW(pB1,10),PKW(pB1,12),PKW(pB1,14)};
    SBAR(); pv(o,vb0+sl_cur,PAF(0),PAF(1),PAF(2),PAF(3)); }
  #undef PKW
  #undef PAF
  #undef VFR
  #undef PIN
  #undef MX3
  #undef GAPA
  #undef GAPB
  #undef EX
  #undef VRD
  #undef KRD
  #undef STEP
  #undef ENDW
  {auto rr=__builtin_amdgcn_permlane32_swap(__float_as_uint(l_reg),__float_as_uint(l_reg),false,false);l_reg=__uint_as_float(rr[0])+__uint_as_float(rr[1]);}
  if(hi==0)wsf[32+r32]=l_reg;asm volatile("s_waitcnt lgkmcnt(0)":::"memory");
  float rli[16];
  #pragma unroll
  for(int r=0;r<16;++r)rli[r]=__builtin_amdgcn_rcpf(wsf[32+crow(r,hi)]);
  bf16*Ow=O+(rowbase+q0+wid*QBLK)*OPITCH+h*D; const bf16*Gw=Gt+(rowbase+q0+wid*QBLK)*DM+h*D;
  { bf16*stg=(bf16*)(shm+LDS_OST)+wid*2048;
    #pragma unroll
    for(int r=0;r<16;++r){const int orow=crow(r,hi);
      #pragma unroll
      for(int d0=0;d0<2;++d0)stg[orow*64+d0*32+r32]=__float2bfloat16(o[d0][r]*rli[r]);}
    asm volatile("s_waitcnt lgkmcnt(0)":::"memory");
    #pragma unroll
    for(int i=0;i<4;++i){const int row=i*8+(lane>>3),ch=lane&7; const u32x4 v=*(const u32x4*)(stg+row*64+ch*8); const u32x4 gq=*(const u32x4*)(Gw+(long)row*DM+ch*8); u32x4 w_;
      #pragma unroll
      for(int k=0;k<4;++k){ const float g0=__builtin_bit_cast(float,gq[k]<<16), g1=__builtin_bit_cast(float,gq[k]&0xffff0000u), x0=__builtin_bit_cast(float,v[k]<<16), x1=__builtin_bit_cast(float,v[k]&0xffff0000u);
        w_[k]=cvtpk_s(x0*g0*__builtin_amdgcn_rcpf(1.f+__builtin_amdgcn_exp2f(-1.4426950408889634f*g0)), x1*g1*__builtin_amdgcn_rcpf(1.f+__builtin_amdgcn_exp2f(-1.4426950408889634f*g1))); }
      ATTN_STORE16(Ow+(long)row*OPITCH+ch*8,w_);} }
  asm volatile("s_waitcnt lgkmcnt(0)\n\ts_barrier":::"memory");
  #undef CBINIT
  #undef DMA_K
  #undef DMA_V
  #undef CMASK
  #undef START
  #undef RESC
  #undef ROT
}
constexpr int ATTN_LDS_BYTES=LDS_BYTES;
struct AttnTensors { const bf16* Q; const bf16* K; const bf16* V; const bf16* G; const float* CB; bf16* O; };
struct AttnUnit { int bh; int qb; };
struct QueueOrder {
  unsigned* ctr; volatile __attribute__((address_space(3))) unsigned* slot;
  __device__ __forceinline__ bool next(int,AttnUnit&u)const{
    if(threadIdx.x==0){ *slot=__hip_atomic_fetch_add(ctr,1u,__ATOMIC_RELAXED,__HIP_MEMORY_SCOPE_AGENT); }
    __syncthreads(); const unsigned t=*slot; __syncthreads();
    if(t>=(unsigned)(BATCH*NHEAD*NQB))return false; u.qb=NQB-1-(int)(t/(BATCH*NHEAD)); u.bh=(int)(t%(BATCH*NHEAD)); return true; }
  __device__ __forceinline__ void a_ready(const AttnUnit&)const{}
  __device__ __forceinline__ void done(const AttnUnit&)const{}
};
template<class Sched,int THRL=8> __device__ __forceinline__ void attn_phase(char*lds,const AttnTensors&T,const Sched&S){
  AttnUnit u;
  for(int i=0;S.next(i,u);++i){ S.a_ready(u); attn_unit<THRL>(u.bh/NHEAD,u.bh%NHEAD,u.qb,T.Q,T.K,T.V,T.G,T.CB,T.O,lds); S.done(u); }
}
#undef SBAR
#undef WAIT_BAR
}

__device__ __forceinline__ int src_col(int n) {
    if (n < 1024) { const int cp = n & 255; return (n & ~255) + 64 * ((cp >> 5) & 3) + 32 * (cp >> 7) + (cp & 31); }
    if (n < 1536) return n;
    if (n < UP) return n - UR + SR;
    if (n < UG) return -1;
    if (n < UF) return n - UG + SG;
    if (n < UF + 8) return n - UF + SF;
    return -2;
}
__device__ __forceinline__ void phase_weights(const Params& p, unsigned char* lds) {
    float (*tile)[65] = (float (*)[65])lds;
    const int tid = otid();
    constexpr int T_IN = (NU / 64) * (DM / 64), T_OUT = (DM / 64) * (DM / 64), PER_L = T_IN + T_OUT;
    for (int it = blockIdx.x; it < NL * PER_L; it += gridDim.x) {
        const int l = it / PER_L; int r = it % PER_L;
        if (r < T_IN) {
            const int nt = r / (DM / 64), kt = r % (DM / 64), n0 = nt * 64, k0 = kt * 64;
            const float* W = p.w_in + (size_t)l * DM * D_IN;
            for (int e = tid; e < 64 * 64; e += NTHREADS) {
                const int kk = e >> 6, nn = e & 63, n = n0 + nn, sc = src_col(n);
                float v = 0.f;
                if (sc >= 0) v = W[(size_t)(k0 + kk) * D_IN + sc];
                else if (sc == -1) {
                    const int g = (n - UP) >> 6, d = (n - UP) & 63;
                    const float* pw = p.pool_w + ((size_t)l * 4 + g) * 64 * 64;
                    const float* wr = W + (size_t)(k0 + kk) * D_IN + SP + g * 64;
                    float s = 0.f;
                    for (int cc = 0; cc < 64; ++cc) s += wr[cc] * pw[cc * 64 + d];
                    v = s;
                }
                tile[kk][nn] = v;
            }
            __syncthreads();
            bf16_t* WT = (bf16_t*)(p.ws + WS_WT) + (size_t)l * NU * DM;
            for (int e = tid; e < 64 * 32; e += NTHREADS) {
                const int nn = e >> 5, kp = (e & 31) * 2;
                *(unsigned*)(WT + (size_t)(n0 + nn) * DM + k0 + kp) = pk2(tile[kp][nn], tile[kp + 1][nn]);
            }
            __syncthreads();
        } else {
            r -= T_IN;
            const int nt = r / (DM / 64), kt = r % (DM / 64), n0 = nt * 64, k0 = kt * 64;
            const float* W = p.w_out + (size_t)l * DM * DM;
            for (int e = tid; e < 64 * 64; e += NTHREADS) { const int kk = e >> 6, nn = e & 63; tile[kk][nn] = W[(size_t)(k0 + kk) * DM + n0 + nn]; }
            __syncthreads();
            bf16_t* WOT = (bf16_t*)(p.ws + WS_WOT) + (size_t)l * DM * DM;
            for (int e = tid; e < 64 * 32; e += NTHREADS) {
                const int nn = e >> 5, kp = (e & 31) * 2;
                *(unsigned*)(WOT + (size_t)(n0 + nn) * DM + k0 + kp) = pk2(tile[kp][nn], tile[kp + 1][nn]);
            }
            __syncthreads();
        }
    }
}

__device__ __forceinline__ void phase_mod(const Params& p, unsigned char* lds) {
    float (*sc)[DM] = (float (*)[DM])lds;
    float (*red)[NB][64] = (float (*)[NB][64])(lds + 32768);
    const int tid = otid();
    if ((int)blockIdx.x >= NL * 48) return;
    for (int e = tid; e < NB * DM; e += NTHREADS) sc[e / DM][e % DM] = siluf_(p.c[e]);
    __syncthreads();
    float* mod = (float*)(p.ws + WS_MOD);
    const int kg = tid >> 6, cl = tid & 63;
    for (int it = blockIdx.x; it < NL * 48; it += gridDim.x) {
        const int l = it / 48, n = (it % 48) * 64 + cl;
        const float* W = p.ada_w + (size_t)l * DM * 3072 + n;
        float acc[NB];
#pragma unroll
        for (int b = 0; b < NB; ++b) acc[b] = 0.f;
#pragma unroll 8
        for (int k = kg * 128; k < kg * 128 + 128; ++k) {
            const float w = W[(size_t)k * 3072];
#pragma unroll
            for (int b = 0; b < NB; ++b) acc[b] += sc[b][k] * w;
        }
#pragma unroll
        for (int b = 0; b < NB; ++b) red[kg][b][cl] = acc[b];
        __syncthreads();
        {
            const int b = tid >> 6;
            float s = p.ada_b[l * 3072 + n];
#pragma unroll
            for (int g = 0; g < 8; ++g) s += red[g][b][cl];
            mod[((size_t)l * NB + b) * 3072 + n] = s;
        }
        __syncthreads();
    }
}

__device__ __forceinline__ void row_h_store(const f32x4 (&v)[4], float rinv, const float* npre, const float* mod_lb, bf16_t* xnrow, int lane) {
#pragma unroll
    for (int j = 0; j < 4; ++j) {
        const int c = j * 256 + lane * 4;
        const f32x4 g = *(const f32x4*)(npre + c), sh = *(const f32x4*)(mod_lb + c), scl = *(const f32x4*)(mod_lb + 1024 + c);
        f32x4 h;
#pragma unroll
        for (int i = 0; i < 4; ++i) h[i] = v[j][i] * rinv * g[i] * (1.f + scl[i]) + sh[i];
        u32x2 w; w.x = pk2(h[0], h[1]); w.y = pk2(h[2], h[3]);
        *(u32x2*)(xnrow + c) = w;
    }
}
__device__ __forceinline__ void phase_rows(const Params& p, int mode, int l) {
    const int tid = otid(), lane = tid & 63, wv = tid >> 6;
    const int gw = blockIdx.x * 8 + wv, ngw = gridDim.x * 8;
    const float* mod = (const float*)(p.ws + WS_MOD);
    bf16_t* XN = (bf16_t*)(p.ws + WS_XN);
    const float* Z = (const float*)(p.ws + WS_Z);
    for (int m = gw; m < MTOK; m += ngw) {
        const int b = m / SEQ;
        f32x4 v[4];
        if (mode == 0) {
#pragma unroll
            for (int j = 0; j < 4; ++j) v[j] = *(const f32x4*)(p.x + (size_t)m * DM + j * 256 + lane * 4);
            float s = 0.f;
#pragma unroll
            for (int j = 0; j < 4; ++j) s += v[j][0] * v[j][0] + v[j][1] * v[j][1] + v[j][2] * v[j][2] + v[j][3] * v[j][3];
            const float rinv = rsqrtf(wave_sum(s) * (1.f / DM) + 1e-6f);
            row_h_store(v, rinv, p.norm_pre, mod + ((size_t)0 * NB + b) * 3072, XN + (size_t)m * DM, lane);
        } else {
            f32x4 z[4];
#pragma unroll
            for (int j = 0; j < 4; ++j) z[j] = *(const f32x4*)(Z + (size_t)m * DM + j * 256 + lane * 4);
            float s = 0.f;
#pragma unroll
            for (int j = 0; j < 4; ++j) s += z[j][0] * z[j][0] + z[j][1] * z[j][1] + z[j][2] * z[j][2] + z[j][3] * z[j][3];
            const float rz = rsqrtf(wave_sum(s) * (1.f / DM) + 1e-6f);
            const float* xold = (l == 0) ? p.x : p.out;
            const float* mod_lb = mod + ((size_t)l * NB + b) * 3072;
            float s2 = 0.f;
#pragma unroll
            for (int j = 0; j < 4; ++j) {
                const int c = j * 256 + lane * 4;
                const f32x4 xo = *(const f32x4*)(xold + (size_t)m * DM + c), gp = *(const f32x4*)(p.norm_post + l * DM + c), gt = *(const f32x4*)(mod_lb + 2048 + c);
#pragma unroll
                for (int i = 0; i < 4; ++i) { v[j][i] = xo[i] + gt[i] * (z[j][i] * rz * gp[i]); s2 += v[j][i] * v[j][i]; }
                *(f32x4*)(p.out + (size_t)m * DM + c) = v[j];
            }
            if (l + 1 < NL) {
                const float rinv = rsqrtf(wave_sum(s2) * (1.f / DM) + 1e-6f);
                row_h_store(v, rinv, p.norm_pre + (l + 1) * DM, mod + ((size_t)(l + 1) * NB + b) * 3072, XN + (size_t)m * DM, lane);
            }
        }
    }
}

template <int MODE>
__device__ __forceinline__ void phase_gemm_simple(unsigned char* lds, const bf16_t* A, const bf16_t* Bt, void* Cout, int M, int N, int K, const float* qg, const float* kg) {
    bf16_t (*As)[40] = (bf16_t (*)[40])lds;
    bf16_t (*Bs)[40] = (bf16_t (*)[40])(lds + 128 * 40 * 2);
    const int tid = otid(), lane = tid & 63, wv = tid >> 6;
    const int ntn = N / 64, ntm = M / 128;
    for (int it = blockIdx.x; it < ntm * ntn; it += gridDim.x) {
        const int tm = it / ntn, tn = it % ntn, m0 = tm * 128, n0 = tn * 64;
        f32x4 acc[4];
#pragma unroll
        for (int n = 0; n < 4; ++n) acc[n] = (f32x4){0.f, 0.f, 0.f, 0.f};
        for (int k0 = 0; k0 < K; k0 += 32) {
            {
                const int r = tid >> 2, ch = tid & 3;
                *(u32x4*)(&As[r][ch * 8]) = *(const u32x4*)(A + (size_t)(m0 + r) * K + k0 + ch * 8);
                if (tid < 256) *(u32x4*)(&Bs[r][ch * 8]) = *(const u32x4*)(Bt + (size_t)(n0 + r) * K + k0 + ch * 8);
            }
            __syncthreads();
            const bf16x8 a = *(const bf16x8*)(&As[wv * 16 + (lane & 15)][(lane >> 4) * 8]);
#pragma unroll
            for (int n = 0; n < 4; ++n) {
                const bf16x8 b = *(const bf16x8*)(&Bs[n * 16 + (lane & 15)][(lane >> 4) * 8]);
                acc[n] = __builtin_amdgcn_mfma_f32_16x16x32_bf16(a, b, acc[n], 0, 0, 0);
            }
            __syncthreads();
        }
        if (MODE == 0) {
            bf16_t* C = (bf16_t*)Cout;
            float scale[4] = {1.f, 1.f, 1.f, 1.f};
            float gain[4] = {1.f, 1.f, 1.f, 1.f};
            if (n0 < 1024) {
#pragma unroll
                for (int r = 0; r < 4; ++r) {
                    float s = acc[0][r] * acc[0][r] + acc[1][r] * acc[1][r] + acc[2][r] * acc[2][r] + acc[3][r] * acc[3][r];
                    s += __shfl_xor(s, 1); s += __shfl_xor(s, 2); s += __shfl_xor(s, 4); s += __shfl_xor(s, 8);
                    scale[r] = rsqrtf(s * (1.f / 64.f) + 1e-6f) * (n0 < 512 ? C2 : 1.f);
                }
#pragma unroll
                for (int n = 0; n < 4; ++n) gain[n] = (n0 < 512 ? qg : kg)[n * 16 + (lane & 15)];
            }
#pragma unroll
            for (int n = 0; n < 4; ++n)
#pragma unroll
                for (int r = 0; r < 4; ++r)
                    C[(size_t)(m0 + wv * 16 + (lane >> 4) * 4 + r) * N + n0 + n * 16 + (lane & 15)] = (bf16_t)f2bf(acc[n][r] * scale[r] * gain[n]);
        } else {
            float* C = (float*)Cout;
#pragma unroll
            for (int n = 0; n < 4; ++n)
#pragma unroll
                for (int r = 0; r < 4; ++r) C[(size_t)(m0 + wv * 16 + (lane >> 4) * 4 + r) * N + n0 + n * 16 + (lane & 15)] = acc[n][r];
        }
    }
}

__device__ __forceinline__ void phase_cum(const Params& p, int l, unsigned char* lds) {
    float (*wtot)[8] = (float (*)[8])lds;
    const int tid = otid(), lane = tid & 63, wv = tid >> 6;
    const bf16_t* U = (const bf16_t*)(p.ws + WS_U);
    float* CB = (float*)(p.ws + WS_CB);
    for (int b = blockIdx.x; b < NB; b += gridDim.x) {
        float pre[8][8];
        float run[8];
#pragma unroll
        for (int h = 0; h < 8; ++h) run[h] = 0.f;
#pragma unroll
        for (int i = 0; i < 8; ++i) {
            const u32x4 w = *(const u32x4*)(U + (size_t)(b * SEQ + tid * 8 + i) * NU + UF);
            float f[8] = {bflo(w.x), bfhi(w.x), bflo(w.y), bfhi(w.y), bflo(w.z), bfhi(w.z), bflo(w.w), bfhi(w.w)};
#pragma unroll
            for (int h = 0; h < 8; ++h) {
                const float xx = f[h] + p.f_bias[l * 8 + h];
                const float ls = fminf(xx, 0.f) - log1pf(__expf(-fabsf(xx)));
                run[h] += -ls * LOG2E;
                pre[i][h] = run[h];
            }
        }
        float exc[8];
#pragma unroll
        for (int h = 0; h < 8; ++h) {
            float v = run[h];
#pragma unroll
            for (int o = 1; o < 64; o <<= 1) { const float t = __shfl_up(v, o); if (lane >= o) v += t; }
            if (lane == 63) wtot[wv][h] = v;
            exc[h] = v - run[h];
        }
        __syncthreads();
#pragma unroll
        for (int h = 0; h < 8; ++h) { float base = 0.f; for (int w2 = 0; w2 < wv; ++w2) base += wtot[w2][h]; exc[h] += base; }
#pragma unroll
        for (int h = 0; h < 8; ++h)
#pragma unroll
            for (int i = 0; i < 8; ++i) CB[((size_t)b * 8 + h) * SEQ + tid * 8 + i] = exc[h] + pre[i][h];
        __syncthreads();
    }
}

typedef _Float16 h8 __attribute__((ext_vector_type(8)));
typedef _Float16 h4 __attribute__((ext_vector_type(4)));
typedef float f32x2 __attribute__((ext_vector_type(2)));
template <int CTRL> __device__ __forceinline__ float dpp_add(float x) {
    const int y = __builtin_amdgcn_update_dpp(0, __builtin_bit_cast(int, x), CTRL, 0xF, 0xF, true);
    return x + __builtin_bit_cast(float, y);
}
__device__ __forceinline__ float row16_sum(float x) {
    x = dpp_add<0xB1>(x); x = dpp_add<0x4E>(x); x = dpp_add<0x141>(x); x = dpp_add<0x140>(x); return x;
}
__device__ __forceinline__ float wave_sum_fast(float x) {
    x = row16_sum(x);
    { const unsigned xi = __builtin_bit_cast(unsigned, x); auto rr = __builtin_amdgcn_permlane16_swap(xi, xi, false, false); const unsigned r0 = rr[0], r1 = rr[1]; x = __builtin_bit_cast(float, r0) + __builtin_bit_cast(float, r1); }
    { const unsigned xi = __builtin_bit_cast(unsigned, x); auto rr = __builtin_amdgcn_permlane32_swap(xi, xi, false, false); const unsigned r0 = rr[0], r1 = rr[1]; x = __builtin_bit_cast(float, r0) + __builtin_bit_cast(float, r1); }
    return x;
}
__device__ __forceinline__ f32x4 mma_nt16(f32x4 acc, const LAS unsigned char* A, int pa, const LAS unsigned char* Bt, int pb, int K, int lane) {
    const LAS unsigned char* ap = A + (lane & 15) * pa + (lane >> 4) * 16;
    const LAS unsigned char* bp = Bt + (lane & 15) * pb + (lane >> 4) * 16;
#pragma unroll
    for (int k = 0; k < K; k += 32) {
        const bf16x8 a = *(const LAS bf16x8*)(ap + 2 * k), b = *(const LAS bf16x8*)(bp + 2 * k);
        acc = __builtin_amdgcn_mfma_f32_16x16x32_bf16(a, b, acc, 0, 0, 0);
    }
    return acc;
}
constexpr int CK_W2T = 0, CK_A2T = 9216, CK_XW = 18432, CK_XA = 23040, CK_SWF = 27648, CK_SAF = 35968, CK_TOT = 44288, CK_EGL = 46336;
constexpr int CK_KT = 46592, CK_RT = 51200, CK_BH = 55808, CK_KH = 60416, CK_RHS = 65024, CK_VT = 81920, CK_BBT = 87040, CK_KBT = 92160, CK_LF = 97280;
constexpr int CK_AAK = 101888, CK_AQB = 104448, CK_AQK = 107008, CK_W1T = 109568, CK_W2N = 114688, CK_OUT = 119808;
constexpr int P72 = 144, P40 = 80, PSF = 65 * 4, PRHS = 132 * 4, PLF = 36 * 4;
__device__ __forceinline__ void phase_rwkv_chunk(const Params& p, int l, unsigned char* lds_) {
    LAS unsigned char* lds = (LAS unsigned char*)lds_;
    const int tid = otid(), lane = tid & 63, wv = __builtin_amdgcn_readfirstlane(tid >> 6);
    const int h = (int)blockIdx.x & 3, c = h * 64 + lane;
    const bf16_t* U = (const bf16_t*)(p.ws + WS_U);
    float* BON = (float*)(p.ws + WS_BON);
    unsigned char* CHK = p.ws + WS_CHK;
    for (int e = tid; e < 2 * 64 * 64; e += NTHREADS) {
        const int which = e >> 12, k = (e >> 6) & 63, cc = e & 63;
        const float v = (which ? p.a2 : p.w2)[((size_t)l * 64 + k) * 256 + h * 64 + cc];
        *(LAS bf16_t*)(lds + (which ? CK_A2T : CK_W2T) + cc * P72 + k * 2) = (bf16_t)f2bf(v);
    }
    const float mur = p.mu[l * 896 + c], muk = p.mu[l * 896 + 256 + c], muv = p.mu[l * 896 + 512 + c], muw = p.mu[l * 896 + 768 + lane], mua = p.mu[l * 896 + 832 + lane];
    const float w0c = p.w0[l * 256 + c], a0c = p.a0[l * 256 + c], kkc = p.k_k[l * 256 + c], kac = p.k_a[l * 256 + c], rkc = p.r_k[l * 256 + c];
    const int fr = lane & 15, fq = lane >> 4;
    for (int q = (int)blockIdx.x >> 2; q < NB * NCHK; q += (int)gridDim.x >> 2) {
        const int b = q / NCHK, ch = q % NCHK;
        int lz_ = 0; asm volatile("" : "+v"(lz_)); LAS unsigned char* L_ = lds + lz_;
        const size_t m0 = (size_t)b * SEQ + ch * 32;
        float rl[4], kl[4], vl[4];
        {
            const bf16_t* ub = U + (m0 + 4 * wv) * NU + UR;
            const bool first = (ch == 0 && wv == 0);
            unsigned short xr[5], xk[5], xv[5], xw_[5], xa_[5];
#pragma unroll
            for (int u = 0; u < 5; ++u) { const bf16_t* q_ = ub + (ptrdiff_t)(u - 1 + ((u == 0 && first) ? 1 : 0)) * NU;
                xr[u] = q_[c]; xk[u] = q_[256 + c]; xv[u] = q_[512 + c]; xw_[u] = q_[768 + lane]; xa_[u] = q_[832 + lane]; }
#pragma unroll
            for (int u = 0; u < 4; ++u) {
                const float pz = (u == 0 && first) ? 0.f : 1.f;
                const float rc = bf2f(xr[u + 1]), kc = bf2f(xk[u + 1]), vc = bf2f(xv[u + 1]), wc = bf2f(xw_[u + 1]), ac = bf2f(xa_[u + 1]);
                rl[u] = rc + (bf2f(xr[u]) * pz - rc) * mur; kl[u] = kc + (bf2f(xk[u]) * pz - kc) * muk; vl[u] = vc + (bf2f(xv[u]) * pz - vc) * muv;
                const float wl = wc + (bf2f(xw_[u]) * pz - wc) * muw, al = ac + (bf2f(xa_[u]) * pz - ac) * mua;
                const int t = 4 * wv + u;
                *(LAS bf16_t*)(L_ + CK_XW + t * P72 + lane * 2) = (bf16_t)f2bf(tanhf(wl));
                *(LAS bf16_t*)(L_ + CK_XA + t * P72 + lane * 2) = (bf16_t)f2bf(al);
            }
        }
        __syncthreads();
        {
            const int mi = wv >> 2, tr = (wv >> 1) & 1;
#pragma unroll
            for (int i = 0; i < 2; ++i) {
                const int tc = 2 * (wv & 1) + i;
                f32x4 acc = {0.f, 0.f, 0.f, 0.f};
                acc = mma_nt16(acc, L_ + (mi ? CK_XA : CK_XW) + 16 * tr * P72, P72, L_ + (mi ? CK_A2T : CK_W2T) + 16 * tc * P72, P72, 64, lane);
#pragma unroll
                for (int r = 0; r < 4; ++r) *(LAS float*)(L_ + (mi ? CK_SAF : CK_SWF) + (16 * tr + 4 * fq + r) * PSF + (16 * tc + fr) * 4) = acc[r];
            }
        }
        __syncthreads();
        float lw[4], kkv[4], ktv[4], bbv[4], gl[4];
        {
            float run = 0.f;
#pragma unroll
            for (int u = 0; u < 4; ++u) {
                const int t = 4 * wv + u;
                const float sw = *(const LAS float*)(L_ + CK_SWF + t * PSF + lane * 4) + w0c, sa = *(const LAS float*)(L_ + CK_SAF + t * PSF + lane * 4) + a0c;
                lw[u] = -DECAY_SCALE * sigmoidf_(sw);
                const float a = sigmoidf_(sa);
                const float kx = kl[u] * kkc;
                kkv[u] = kx / fmaxf(sqrtf(wave_sum_fast(kx * kx)), 1e-12f);
                ktv[u] = kl[u] * (1.f + (a - 1.f) * kac); bbv[u] = kkv[u] * a;
                const float bs = wave_sum_fast(rl[u] * ktv[u] * rkc);
                if (lane == 0) BON[(m0 + t) * 4 + h] = bs;
                run += lw[u]; gl[u] = run;
            }
            *(LAS float*)(L_ + CK_TOT + (wv * 64 + lane) * 4) = run;
        }
        __syncthreads();
        {
            float off = 0.f, tot = 0.f;
#pragma unroll
            for (int g = 0; g < 8; ++g) { const float x = *(const LAS float*)(L_ + CK_TOT + (g * 64 + lane) * 4); tot += x; off += (g < wv) ? x : 0.f; }
            if (wv == 0) *(LAS float*)(L_ + CK_EGL + lane * 4) = __expf(tot);
            unsigned vp[2], bp[2], kp[2];
#pragma unroll
            for (int u = 0; u < 4; ++u) {
                const int t = 4 * wv + u;
                const float G = off + gl[u];
                const float e1 = __expf(G - lw[u]), e2 = __expf(G), inv = __expf(-G), el = __expf(tot - G);
                const float ktl = kkv[u] * e1;
                *(LAS bf16_t*)(L_ + CK_KT + t * P72 + lane * 2) = (bf16_t)f2bf(ktl);
                *(LAS float*)(L_ + CK_RHS + t * PRHS + lane * 4) = ktl;
                *(LAS bf16_t*)(L_ + CK_RT + t * P72 + lane * 2) = (bf16_t)f2bf(rl[u] * e2);
                *(LAS bf16_t*)(L_ + CK_BH + t * P72 + lane * 2) = (bf16_t)f2bf(bbv[u] * inv);
                *(LAS bf16_t*)(L_ + CK_KH + t * P72 + lane * 2) = (bf16_t)f2bf(ktv[u] * inv);
                const unsigned vb = f2bf(vl[u]), bb_ = f2bf(bbv[u] * el), kb_ = f2bf(ktv[u] * el);
                if (u & 1) { vp[u >> 1] |= vb << 16; bp[u >> 1] |= bb_ << 16; kp[u >> 1] |= kb_ << 16; } else { vp[u >> 1] = vb; bp[u >> 1] = bb_; kp[u >> 1] = kb_; }
            }
            *(LAS u32x2*)(L_ + CK_VT + lane * P40 + wv * 8) = (u32x2){vp[0], vp[1]};
            *(LAS u32x2*)(L_ + CK_BBT + lane * P40 + wv * 8) = (u32x2){bp[0], bp[1]};
            *(LAS u32x2*)(L_ + CK_KBT + lane * P40 + wv * 8) = (u32x2){kp[0], kp[1]};
        }
        __syncthreads();
        {
            const int mi = wv >> 1, tr = wv & 1;
            const LAS unsigned char* A = L_ + ((mi < 2) ? CK_KT : CK_RT) + 16 * tr * P72;
            const LAS unsigned char* Bm = L_ + ((mi & 1) ? CK_KH : CK_BH);
#pragma unroll
            for (int tc = 0; tc < 2; ++tc) {
                f32x4 acc = {0.f, 0.f, 0.f, 0.f};
                acc = mma_nt16(acc, A, P72, Bm + 16 * tc * P72, P72, 64, lane);
#pragma unroll
                for (int r = 0; r < 4; ++r) {
                    const int t = 16 * tr + 4 * fq + r, s_ = 16 * tc + fr;
                    const float x = (mi < 2 ? (s_ < t) : (s_ <= t)) ? acc[r] : 0.f;
                    if (mi == 0) *(LAS float*)(L_ + CK_LF + s_ * PLF + t * 4) = x;
                    else *(LAS bf16_t*)(L_ + (mi == 1 ? CK_AAK : (mi == 2 ? CK_AQB : CK_AQK)) + t * P40 + s_ * 2) = (bf16_t)f2bf(x);
                }
            }
        }
        __syncthreads();
        {
            const int tr = wv >> 2, ic = wv & 3;
            f32x4 acc = {0.f, 0.f, 0.f, 0.f};
            acc = mma_nt16(acc, L_ + CK_AAK + 16 * tr * P40, P40, L_ + CK_VT + 16 * ic * P40, P40, 32, lane);
#pragma unroll
            for (int r = 0; r < 4; ++r) *(LAS float*)(L_ + CK_RHS + (16 * tr + 4 * fq + r) * PRHS + (64 + 16 * ic + fr) * 4) = acc[r];
        }
        __syncthreads();
        if (tid < 128) {
            LAS unsigned char* colp = L_ + CK_RHS + tid * 4;
#pragma unroll 1
            for (int B = 0; B < 4; ++B) {
                float acc[8];
#pragma unroll
                for (int i = 0; i < 8; ++i) acc[i] = *(const LAS float*)(colp + (8 * B + i) * PRHS);
#pragma unroll 4
                for (int s_ = 0; s_ < 8 * B; ++s_) {
                    const float ws = *(const LAS float*)(colp + s_ * PRHS);
                    const f32x4 l0 = *(const LAS f32x4*)(L_ + CK_LF + s_ * PLF + (8 * B) * 4), l1 = *(const LAS f32x4*)(L_ + CK_LF + s_ * PLF + (8 * B + 4) * 4);
#pragma unroll
                    for (int i = 0; i < 4; ++i) { acc[i] -= l0[i] * ws; acc[4 + i] -= l1[i] * ws; }
                }
#pragma unroll
                for (int i = 0; i < 7; ++i) {
                    const f32x4 l0 = *(const LAS f32x4*)(L_ + CK_LF + (8 * B + i) * PLF + (8 * B) * 4), l1 = *(const LAS f32x4*)(L_ + CK_LF + (8 * B + i) * PLF + (8 * B + 4) * 4);
#pragma unroll
                    for (int i2 = i + 1; i2 < 8; ++i2) acc[i2] -= (i2 < 4 ? l0[i2 & 3] : l1[i2 & 3]) * acc[i];
                }
#pragma unroll
                for (int i = 0; i < 8; ++i) *(LAS float*)(colp + (8 * B + i) * PRHS) = acc[i];
            }
            LAS unsigned char* dst = L_ + (tid < 64 ? CK_W1T : CK_W2N) + (tid & 63) * P40;
#pragma unroll
            for (int g = 0; g < 4; ++g) {
                float wv_[8];
#pragma unroll
                for (int e = 0; e < 8; ++e) wv_[e] = -*(const LAS float*)(colp + (8 * g + e) * PRHS);
                u32x4 w;
                w.x = pk2(wv_[0], wv_[1]); w.y = pk2(wv_[2], wv_[3]); w.z = pk2(wv_[4], wv_[5]); w.w = pk2(wv_[6], wv_[7]);
                *(LAS u32x4*)(dst + g * 16) = w;
            }
        }
        __syncthreads();
        {
            {
                const int tr = wv >> 2, cc = wv & 3;
                f32x4 acc;
#pragma unroll
                for (int r = 0; r < 4; ++r) acc[r] = bf2f(*(const LAS bf16_t*)(L_ + CK_RT + (16 * tr + 4 * fq + r) * P72 + (16 * cc + fr) * 2));
                acc = mma_nt16(acc, L_ + CK_AQB + 16 * tr * P40, P40, L_ + CK_W1T + 16 * cc * P40, P40, 32, lane);
#pragma unroll
                for (int r = 0; r < 4; ++r) *(LAS bf16_t*)(L_ + CK_OUT + (16 * tr + 4 * fq + r) * 128 + (16 * cc + fr) * 2) = (bf16_t)f2bf(acc[r]);
                f32x4 ac2 = {0.f, 0.f, 0.f, 0.f};
                ac2 = mma_nt16(ac2, L_ + CK_AQK + 16 * tr * P40, P40, L_ + CK_VT + 16 * cc * P40, P40, 32, lane);
                ac2 = mma_nt16(ac2, L_ + CK_AQB + 16 * tr * P40, P40, L_ + CK_W2N + 16 * cc * P40, P40, 32, lane);
#pragma unroll
                for (int r = 0; r < 4; ++r) *(LAS bf16_t*)(L_ + CK_OUT + 4096 + (16 * tr + 4 * fq + r) * 128 + (16 * cc + fr) * 2) = (bf16_t)f2bf(ac2[r]);
            }
#pragma unroll
            for (int i = 0; i < 2; ++i) {
                const int tl = 2 * wv + i, rr = tl >> 2, cc = tl & 3;
                f32x4 acc = {0.f, 0.f, 0.f, 0.f};
                acc = mma_nt16(acc, L_ + CK_BBT + 16 * rr * P40, P40, L_ + CK_W1T + 16 * cc * P40, P40, 32, lane);
#pragma unroll
                for (int r = 0; r < 4; ++r) { const int jp = 16 * rr + 4 * fq + r, j = 16 * cc + fr;
                    const float x = acc[r] + ((jp == j) ? *(const LAS float*)(L_ + CK_EGL + j * 4) : 0.f);
                    *(LAS bf16_t*)(L_ + CK_OUT + 8192 + jp * 128 + j * 2) = (bf16_t)f2bf(x); }
                f32x4 ac2 = {0.f, 0.f, 0.f, 0.f};
                ac2 = mma_nt16(ac2, L_ + CK_VT + 16 * rr * P40, P40, L_ + CK_KBT + 16 * cc * P40, P40, 32, lane);
                ac2 = mma_nt16(ac2, L_ + CK_W2N + 16 * rr * P40, P40, L_ + CK_BBT + 16 * cc * P40, P40, 32, lane);
#pragma unroll
                for (int r = 0; r < 4; ++r) *(LAS bf16_t*)(L_ + CK_OUT + 16384 + (16 * rr + 4 * fq + r) * 128 + (16 * cc + fr) * 2) = (bf16_t)f2bf(ac2[r]);
            }
        }
        __syncthreads();
        {
            unsigned char* dst = CHK + ((size_t)(b * 4 + h) * NCHK + ch) * CHK_B;
#pragma unroll
            for (int i = 0; i < 3; ++i) *(u32x4*)(dst + (i * NTHREADS + tid) * 16) = *(const LAS u32x4*)(L_ + CK_OUT + (i * NTHREADS + tid) * 16);
        }
        __syncthreads();
    }
}

__device__ __forceinline__ void glds16g(const void* gsrc, unsigned lds_dst) { unsigned keep;
    asm volatile("s_mov_b32 %0, m0\n\ts_mov_b32 m0, %2\n\ts_nop 0\n\tglobal_load_lds_dwordx4 %1, off\n\ts_mov_b32 m0, %0" : "=&s"(keep) : "v"(gsrc), "s"(lds_dst) : "memory"); }
constexpr int CN_RING = 0, CN_SB = 3 * CHK_B;
__device__ __forceinline__ void phase_rwkv_chain(const Params& p, unsigned char* lds_, int bh) {
    LAS unsigned char* lds = (LAS unsigned char*)lds_;
    const int tid = otid(), lane = tid & 63, wv = __builtin_amdgcn_readfirstlane(tid >> 6);
    const int fr = lane & 15, fq = lane >> 4, b = bh >> 2, h = bh & 3;
    const unsigned char* rec = p.ws + WS_CHK + (size_t)bh * NCHK * CHK_B;
    float* O32 = (float*)(p.ws + WS_O32);
    const unsigned lds0 = (unsigned)(size_t)lds;
#define CN_DMA(cc) do { const unsigned char* g = rec + (size_t)(cc) * CHK_B + tid * 16; const unsigned d = (unsigned)__builtin_amdgcn_readfirstlane((int)(lds0 + CN_RING + ((cc) % 3) * CHK_B + wv * 1024)); \
        glds16g(g, d); glds16g(g + 8192, d + 8192); glds16g(g + 16384, d + 16384); } while (0)
    for (int e = tid; e < 2 * 64 * 72 / 2; e += NTHREADS) *(LAS unsigned*)(lds + CN_SB + e * 4) = 0u;
    CN_DMA(0); CN_DMA(1);
    asm volatile("s_waitcnt vmcnt(0) lgkmcnt(0)\n\ts_barrier" ::: "memory");
#pragma unroll 1
    for (int cc = 0; cc < NCHK; ++cc) {
        if (cc + 2 < NCHK) CN_DMA(cc + 2);
        int lz_ = 0; asm volatile("" : "+v"(lz_)); LAS unsigned char* L_ = lds + lz_;
        const LAS unsigned char* R = L_ + CN_RING + (cc % 3) * CHK_B;
        const LAS unsigned char* Sc = L_ + CN_SB + (cc & 1) * (64 * P72);
        LAS unsigned char* Sn = L_ + CN_SB + ((cc + 1) & 1) * (64 * P72);
        {
            const int tr = wv >> 2, ic = wv & 3;
            f32x4 acc;
#pragma unroll
            for (int r = 0; r < 4; ++r) acc[r] = bf2f(*(const LAS bf16_t*)(R + 4096 + (16 * tr + 4 * fq + r) * 128 + (16 * ic + fr) * 2));
            acc = mma_nt16(acc, R + 16 * tr * 128, 128, Sc + 16 * ic * P72, P72, 64, lane);
            float* op = O32 + ((size_t)b * SEQ + cc * 32 + 16 * tr + 4 * fq) * 256 + h * 64 + 16 * ic + fr;
#pragma unroll
            for (int r = 0; r < 4; ++r) op[(size_t)r * 256] = acc[r];
        }
#pragma unroll
        for (int i = 0; i < 2; ++i) {
            const int tl = 2 * wv + i, ir = tl >> 2, jc = tl & 3;
            f32x4 acc;
#pragma unroll
            for (int r = 0; r < 4; ++r) acc[r] = bf2f(*(const LAS bf16_t*)(R + 16384 + (16 * ir + 4 * fq + r) * 128 + (16 * jc + fr) * 2));
            acc = mma_nt16(acc, Sc + 16 * ir * P72, P72, R + 8192 + 16 * jc * 128, 128, 64, lane);
#pragma unroll
            for (int r = 0; r < 4; ++r) *(LAS bf16_t*)(Sn + (16 * ir + 4 * fq + r) * P72 + (16 * jc + fr) * 2) = (bf16_t)f2bf(acc[r]);
        }
        if (cc + 2 < NCHK) asm volatile("s_waitcnt vmcnt(11) lgkmcnt(0)\n\ts_barrier" ::: "memory");
        else asm volatile("s_waitcnt vmcnt(0) lgkmcnt(0)\n\ts_barrier" ::: "memory");
    }
#undef CN_DMA
}

__device__ __forceinline__ void phase_rwkv_fin(const Params& p, int l) {
    const int tid = otid(), lane = tid & 63, wv = tid >> 6;
    const bf16_t* U = (const bf16_t*)(p.ws + WS_U);
    const float* O32 = (const float*)(p.ws + WS_O32); const float* BON = (const float*)(p.ws + WS_BON);
    bf16_t* Y = (bf16_t*)(p.ws + WS_Y);
    const int ngw = gridDim.x * 8;
    for (int m = blockIdx.x * 8 + wv; m < MTOK; m += ngw) {
        float o[4], vc[4], vp[4], g[4], bn[4];
        const bool has_prev = (m % SEQ) != 0;
#pragma unroll
        for (int h = 0; h < 4; ++h) {
            const int c = h * 64 + lane;
            o[h] = O32[(size_t)m * 256 + c];
            vc[h] = bf2f(U[(size_t)m * NU + UR + 512 + c]);
            vp[h] = bf2f(U[(size_t)(m - (has_prev ? 1 : 0)) * NU + UR + 512 + c]);
            g[h] = bf2f(U[(size_t)m * NU + UG + 512 + c]);
            bn[h] = BON[(size_t)m * 4 + h];
        }
#pragma unroll
        for (int h = 0; h < 4; ++h) {
            const int c = h * 64 + lane;
            const float mean = wave_sum_fast(o[h]) * (1.f / 64.f);
            const float dv = o[h] - mean;
            const float var = wave_sum_fast(dv * dv) * (1.f / 64.f);
            const float v = vc[h] + ((has_prev ? vp[h] : 0.f) - vc[h]) * p.mu[l * 896 + 512 + c];
            const float on = dv * rsqrtf(var + 64e-5f) * p.ln_g[l * 256 + c] + p.ln_b[l * 256 + c] + bn[h] * v;
            Y[(size_t)m * DM + 512 + c] = (bf16_t)f2bf(on * siluf_(g[h]));
        }
    }
}

__device__ __forceinline__ void phase_pool(const Params& p, int l) {
    const bf16_t* U = (const bf16_t*)(p.ws + WS_U);
    bf16_t* Y = (bf16_t*)(p.ws + WS_Y);
    const int tid = otid(), c = tid & 255, sub = tid >> 8, g = c >> 6, w = 2 << g;
    const float scl = p.pool_scale[l * 256 + c];
    for (int it = blockIdx.x * 2 + sub; it < MTOK / 64; it += gridDim.x * 2) {
        const int m0 = it * 64, t0 = m0 % SEQ;
        const bf16_t* up = U + (size_t)m0 * NU + UP + c;
        float s = 0.f;
        for (int d = 1; d < w; ++d) if (t0 - d >= 0) s += bf2f(up[-(ptrdiff_t)d * NU]);
#pragma unroll 4
        for (int i = 0; i < 64; ++i) {
            const int t = t0 + i;
            const float cur = bf2f(up[(size_t)i * NU]);
            s += cur;
            const int cnt = (t + 1 < w) ? t + 1 : w;
            const float yv = (s / (float)cnt - cur) * scl;
            const float gg = bf2f(U[(size_t)(m0 + i) * NU + UG + 768 + c]);
            Y[(size_t)(m0 + i) * DM + 768 + c] = (bf16_t)f2bf(yv * siluf_(gg));
            if (t - w + 1 >= 0) s -= bf2f(up[(ptrdiff_t)(i - w + 1) * NU]);
        }
    }
}

__global__ void __launch_bounds__(NTHREADS, 2) mega_fwd(Params p) {
    extern __shared__ __attribute__((aligned(16))) unsigned char lds[];
    volatile LAS unsigned* MISC = (volatile LAS unsigned*)((LAS unsigned char*)lds + MISC_OFF);
    if (threadIdx.x < 32) MISC[threadIdx.x] = 0u;
    __syncthreads();
    XcdBarrier bar = xcd_barrier_post((unsigned*)(p.ws + WS_CTL) + CW_BAR, MISC + 8);
#define GRID_BAR() xcd_barrier(bar)
    bf16_t* XN = (bf16_t*)(p.ws + WS_XN); bf16_t* Y = (bf16_t*)(p.ws + WS_Y); bf16_t* U = (bf16_t*)(p.ws + WS_U); float* Z = (float*)(p.ws + WS_Z);

    phase_weights(p, lds);
    phase_mod(p, lds);
    GRID_BAR();
    phase_rows(p, 0, 0);
    GRID_BAR();
#pragma unroll 1
    for (int l = 0; l < NL; ++l) {
        const bf16_t* WT = (const bf16_t*)(p.ws + WS_WT) + (size_t)l * NU * DM;
        const bf16_t* WOT = (const bf16_t*)(p.ws + WS_WOT) + (size_t)l * DM * DM;
        {
            pg8::Gemm g{XN, WT, MTOK, NU, DM}; pg8::StaticOrder S; S.init(MTOK, NU, (int)gridDim.x, (int)blockIdx.x);
            pg8::EpiU E{U, p.q_gain + l * 64, p.k_gain + l * 64, NU};
            pg8::gemm_phase<pg8::EpiU, pg8::StaticOrder, true, true>((LAS unsigned char*)lds, g, S, E);
        }
        GRID_BAR();
        phase_cum(p, l, lds);
        phase_rwkv_chunk(p, l, lds);
        phase_pool(p, l);
        GRID_BAR();
        if (blockIdx.x < NB * 4) phase_rwkv_chain(p, lds, (int)blockIdx.x);
        {
            const attn_body::AttnTensors AT{(const attn_body::bf16*)(U + UQ), (const attn_body::bf16*)(U + UK), (const attn_body::bf16*)(U + UV), (const attn_body::bf16*)(U + UG),
                                            (const float*)(p.ws + WS_CB), (attn_body::bf16*)Y};
            const attn_body::QueueOrder S{(unsigned*)(p.ws + WS_CTL) + CW_ATTQ + l * 64, MISC + 16};
            attn_body::attn_phase<attn_body::QueueOrder>((char*)lds, AT, S);
        }
        GRID_BAR();
        phase_rwkv_fin(p, l);
        GRID_BAR();
        {
            pg8::Gemm g{Y, WOT, MTOK, DM, DM}; pg8::StaticOrder S; S.init(MTOK, DM, (int)gridDim.x, (int)blockIdx.x);
            pg8::EpiF32 E{Z, DM};
            pg8::gemm_phase<pg8::EpiF32, pg8::StaticOrder, true, true>((LAS unsigned char*)lds, g, S, E);
        }
        GRID_BAR();
        phase_rows(p, 1, l);
        if (l + 1 < NL) GRID_BAR();
    }
}

extern "C" void kernel_launch(void* const* d_in, const int* in_sizes, int n_in, void* d_out, int out_size, void* d_ws, size_t ws_size, hipStream_t stream) {
    static int grid = 0;
    if (grid == 0) {
        if (n_in != 23 || ws_size < WS_END) { fprintf(stderr, "kernel_launch: unexpected n_in %d / ws_size %zu\n", n_in, ws_size); grid = -1; return; }
        int dev = 0, cus = 0, per_cu = 0;
        if (hipGetDevice(&dev) != hipSuccess || hipDeviceGetAttribute(&cus, hipDeviceAttributeMultiprocessorCount, dev) != hipSuccess) { grid = -1; return; }
        if (hipFuncSetAttribute((const void*)mega_fwd, hipFuncAttributeMaxDynamicSharedMemorySize, LDS_BYTES) != hipSuccess) { fprintf(stderr, "kernel_launch: hipFuncSetAttribute failed\n"); grid = -1; return; }
        if (hipOccupancyMaxActiveBlocksPerMultiprocessor(&per_cu, (const void*)mega_fwd, NTHREADS, LDS_BYTES) != hipSuccess || per_cu < 1) { fprintf(stderr, "kernel_launch: occupancy query failed (%d)\n", per_cu); grid = -1; return; }
        grid = cus;
        if (grid <= NB * 8) { fprintf(stderr, "kernel_launch: grid %d too small\n", grid); grid = -1; return; }
    }
    if (grid < 0) return;
    (void)hipMemsetAsync((char*)d_ws + WS_CTL, 0, CTL_ZERO_BYTES, stream);
    Params p{};
    const float** f = (const float**)&p;
    for (int i = 0; i < 23; ++i) f[i] = (const float*)d_in[i];
    p.out = (float*)d_out; p.ws = (unsigned char*)d_ws;
    void* args[] = {&p};
    hipError_t e = hipLaunchCooperativeKernel((const void*)mega_fwd, dim3(grid), dim3(NTHREADS), args, LDS_BYTES, stream);
    if (e != hipSuccess) fprintf(stderr, "cooperative launch failed: %s (grid %d)\n", hipGetErrorString(e), grid);
}
```

```cpp
#include <hip/hip_runtime.h>
#include <hip/hip_bf16.h>
#include <cstdio>
#include <cstdint>

constexpr int NB = 8, SEQ = 4096, DM = 1024, MTOK = NB * SEQ, NL = 2;
constexpr int D_IN = 3720, NU = 3840;
constexpr int UQ = 0, UK = 512, UV = 1024, UR = 1536  , UP = 2432  , UG = 2688  , UF = 3712  ;
constexpr int SQ = 0, SF = 1536, SR = 1544, SP = 2440, SG = 2696;
constexpr float C2 = 0.125f * 1.4426950408889634f;
constexpr float LOG2E = 1.4426950408889634f;
constexpr float DECAY_SCALE = 0.6065306597126334f;

typedef unsigned short bf16_t;
typedef short bf16x8 __attribute__((ext_vector_type(8)));
typedef float f32x4 __attribute__((ext_vector_type(4)));
typedef unsigned u32x4 __attribute__((ext_vector_type(4)));
typedef unsigned u32x2 __attribute__((ext_vector_type(2)));

__device__ __forceinline__ unsigned f2bf(float f) { unsigned u = __builtin_bit_cast(unsigned, f); return (u + 0x7fffu + ((u >> 16) & 1u)) >> 16; }
__device__ __forceinline__ unsigned pk2(float lo, float hi) { return f2bf(lo) | (f2bf(hi) << 16); }
__device__ __forceinline__ float bf2f(unsigned short b) { return __builtin_bit_cast(float, (unsigned)b << 16); }
__device__ __forceinline__ float bflo(unsigned w) { return __builtin_bit_cast(float, w << 16); }
__device__ __forceinline__ float bfhi(unsigned w) { return __builtin_bit_cast(float, w & 0xffff0000u); }
__device__ __forceinline__ float sigmoidf_(float x) { return 1.f / (1.f + __expf(-x)); }
__device__ __forceinline__ float siluf_(float x) { return x / (1.f + __expf(-x)); }
__device__ __forceinline__ float wave_sum(float v) {
#pragma unroll
    for (int o = 1; o < 64; o <<= 1) v += __shfl_xor(v, o);
    return v;
}

__device__ __forceinline__ int otid() { int t = threadIdx.x; asm volatile("" : "+v"(t)); return t; }

constexpr size_t MiB = 1u << 20;
constexpr size_t WS_CTL = 0;
constexpr size_t WS_MOD = 1 * MiB;
constexpr size_t WS_WT = 2 * MiB;
constexpr size_t WS_WOT = 18 * MiB;
constexpr size_t WS_CB = 22 * MiB;
constexpr size_t WS_XN = 24 * MiB;
constexpr size_t WS_O32 = 24 * MiB;
constexpr size_t WS_BON = 23 * MiB;
constexpr size_t WS_PA = 56 * MiB;
constexpr size_t WS_Y = 88 * MiB;
constexpr size_t WS_U = 152 * MiB;
constexpr size_t WS_Z = 152 * MiB;
constexpr size_t WS_CHK = 392 * MiB;
constexpr int CHK_B = 24576;
constexpr int NCHK = SEQ / 32;
constexpr size_t WS_END = 488 * MiB;
constexpr size_t CTL_ZERO_BYTES = 65536;
constexpr int CW_ATTQ = 8192;
constexpr int CW_BAR = 1024;

struct Params {
    const float *x, *c, *ada_w, *ada_b, *norm_pre, *norm_post, *w_in, *q_gain, *k_gain, *f_bias, *mu, *w0, *w2, *a0, *a2, *k_k, *k_a, *r_k, *ln_g, *ln_b,
        *pool_w, *pool_scale, *w_out;
    float* out;
    unsigned char* ws;
};


#define LAS __attribute__((address_space(3)))
constexpr int NTHREADS = 512;
constexpr int LDS_BYTES = 147456;
constexpr int MISC_OFF = LDS_BYTES - 128;

#define XB_TMO      128
#define XB_XCNT(j)  (256  + 64 * (j))
#define XB_XSUB(j)  (1280 + 64 * (j))
#define XB_XGEN(j)  (2304 + 64 * (j))
#define XB_TOP      3328
#define XB_TOPGEN   3392
#define XCD_BAR_WORDS 3456
#define XB_SPIN_CAP (1u << 18)
__device__ __forceinline__ unsigned xb_ld(unsigned* p)              { return __hip_atomic_load(p, __ATOMIC_RELAXED, __HIP_MEMORY_SCOPE_AGENT); }
__device__ __forceinline__ unsigned xb_add(unsigned* p, unsigned v) { return __hip_atomic_fetch_add(p, v, __ATOMIC_RELAXED, __HIP_MEMORY_SCOPE_AGENT); }
__device__ __forceinline__ unsigned xb_xcc_id() { return (unsigned)__builtin_amdgcn_s_getreg((3 << 11) | 20) & 0xFu; }
#define XB_SPIN(cond, bar) do { unsigned _sp = 0; while (cond) { __builtin_amdgcn_s_sleep(1); \
    if ((++_sp & 255u) == 0u) { if (xb_ld(&(bar)[XB_TMO])) break; if (_sp > XB_SPIN_CAP) { atomicAdd(&(bar)[XB_TMO], 1u); break; } } } } while (0)
struct XcdBarrier { unsigned* bar; unsigned x; volatile LAS unsigned* st; };
__device__ __forceinline__ XcdBarrier xcd_barrier_post(unsigned* bar, volatile LAS unsigned* st) {
    XcdBarrier b; b.bar = bar; b.x = xb_xcc_id(); b.st = st;
    if (threadIdx.x == 0) (void)xb_add(&bar[XB_XCNT(b.x)], 1u);
    return b;
}
__device__ __forceinline__ void xcd_barrier_complete(unsigned* bar, unsigned x, unsigned& nloc, unsigned& nx) {
    const unsigned G = gridDim.x * gridDim.y * gridDim.z;
    unsigned sum, cnt, mine, sp = 0u;
    for (;;) {
        sum = 0u; cnt = 0u; mine = 0u;
#pragma unroll
        for (unsigned j = 0; j < 16; ++j) { const unsigned c = xb_ld(&bar[XB_XCNT(j)]); sum += c; cnt += (c > 0u) ? 1u : 0u; mine = (j == x) ? c : mine; }
        if (sum == G) break;
        __builtin_amdgcn_s_sleep(1);
        if ((++sp & 255u) == 0u) { if (xb_ld(&bar[XB_TMO])) break; if (sp > XB_SPIN_CAP) { atomicAdd(&bar[XB_TMO], 1u); break; } }
    }
    nloc = mine > 0u ? mine : 1u; nx = cnt > 0u ? cnt : 1u;
}
__device__ __forceinline__ void xcd_barrier(const XcdBarrier& b) {
    asm volatile("s_waitcnt vmcnt(0)" ::: "memory");
    __syncthreads();
    if (threadIdx.x == 0) {
        unsigned* bar = b.bar;
        __builtin_amdgcn_s_waitcnt(0);
        unsigned nloc = b.st[0], nx = b.st[1];
        if (nloc == 0u) { xcd_barrier_complete(bar, b.x, nloc, nx); b.st[0] = nloc; b.st[1] = nx; }
        const unsigned old = xb_add(&bar[XB_XSUB(b.x)], 1u);
        const unsigned gen = old / nloc;
        if (old + 1u == (gen + 1u) * nloc) {
            __builtin_amdgcn_fence(__ATOMIC_RELEASE, "agent");
            asm volatile("s_waitcnt vmcnt(0)" ::: "memory");
            const unsigned og = xb_add(&bar[XB_TOP], 1u);
            const unsigned tg = og / nx;
            if (og + 1u == (tg + 1u) * nx) xb_add(&bar[XB_TOPGEN], 1u);
            else XB_SPIN(xb_ld(&bar[XB_TOPGEN]) == tg, bar);
            __builtin_amdgcn_fence(__ATOMIC_ACQUIRE, "agent");
            xb_add(&bar[XB_XGEN(b.x)], 1u);
            asm volatile("s_waitcnt vmcnt(0)" ::: "memory");
        } else {
            XB_SPIN(xb_ld(&bar[XB_XGEN(b.x)]) == gen, bar);
            __builtin_amdgcn_fence(__ATOMIC_ACQUIRE, "agent");
            asm volatile("s_waitcnt vmcnt(0)" ::: "memory");
        }
    }
    __syncthreads();
}


namespace pg8 {
#define PG8_LAS __attribute__((address_space(3)))
typedef unsigned short bf16_t;
typedef short bf16x8 __attribute__((ext_vector_type(8)));
typedef float f32x4 __attribute__((ext_vector_type(4)));
typedef unsigned u32x4 __attribute__((ext_vector_type(4)));
constexpr int BM = 256, BK = 64, HALF = 128, HTB = HALF * BK * 2  , STAGE_BYTES = 8 * HTB, NXCD = 8, WGM = 8;

__host__ __device__ __forceinline__ int lds_byte(int r, int c) { const int st = (r >> 4) * 2 + (c >> 5), rr = r & 15, cc = c & 31, ob = rr * 64 + cc * 2; return st * 1024 + (ob ^ (((ob >> 9) & 1) << 5)); }
__host__ __device__ __forceinline__ void stage_rc(int b, int& R, int& C) { const int st = b / 1024, sb = b % 1024, swz = sb ^ (((sb >> 9) & 1) << 5); R = (st >> 1) * 16 + swz / 64; C = (st & 1) * 32 + (swz % 64) / 2; }
__host__ __device__ __forceinline__ int perm32(int rho) { const int n = rho >> 4, i = rho & 15; return 8 * (i >> 2) + 4 * n + (i & 3); }

struct Unit { int pm, pn; };
struct Gemm { const bf16_t* A; const bf16_t* Bt; int M, N, K; };

struct StaticOrder {
    int nM, nN, nwg, G, c;
    __host__ __device__ void init(int M, int N, int G_, int c_) { nM = M / BM; nN = N / BM; nwg = nM * nN; G = G_; c = c_; }
    __host__ __device__ bool next(int i, Unit& u) const {
        const long L = (long)i * G + c; if (L >= nwg) return false;
        int wgid = (int)L; { const int q = nwg / NXCD, r = nwg % NXCD, xcd = wgid % NXCD, off = wgid / NXCD; wgid = (xcd < r ? xcd * (q + 1) : r * (q + 1) + (xcd - r) * q) + off; }
        const int nig = WGM * nN, gid = wgid / nig, fm = gid * WGM, gsz = (nM - fm) < WGM ? (nM - fm) : WGM;
        u.pm = fm + ((wgid % nig) % gsz); u.pn = (wgid % nig) / gsz; return true;
    }
    __device__ __forceinline__ void a_ready(const Unit&) const {}
    __device__ __forceinline__ void done(const Unit&) const {}
};

__device__ __forceinline__ unsigned cvt_pk_bf16(float lo, float hi) { unsigned r; asm volatile("v_cvt_pk_bf16_f32 %0, %1, %2" : "=v"(r) : "v"(lo), "v"(hi)); return r; }

struct EpiU {
    static constexpr bool PERM = true, AFTER_DRAIN = false;
    bf16_t* U; const float* qg; const float* kg; int ldc;
    __device__ __forceinline__ void operator()(const f32x4 (&acc)[2][2][4][2], const Unit& u, int wr, int wc, int fr, int fq) const {
        const int row0 = u.pm * BM + wr * 64 + fr;
        if (u.pn < 4) {
            const float* gp = (u.pn < 2 ? qg : kg) + 8 * fq; const float mult = u.pn < 2 ? (0.125f * 1.4426950408889634f) : 1.f;
            f32x4 gv[2][2];
#pragma unroll
            for (int bj = 0; bj < 2; ++bj)
#pragma unroll
                for (int n = 0; n < 2; ++n) gv[bj][n] = *(const f32x4*)(gp + 32 * bj + 4 * n);
            const int col0 = u.pn * BM + 64 * wc + 8 * fq;
#pragma unroll
            for (int ai = 0; ai < 2; ++ai)
#pragma unroll
                for (int m = 0; m < 4; ++m) {
                    float s = 0.f;
#pragma unroll
                    for (int bj = 0; bj < 2; ++bj)
#pragma unroll
                        for (int n = 0; n < 2; ++n) { const f32x4 x = acc[ai][bj][m][n]; s += (x[0] * x[0] + x[1] * x[1]) + (x[2] * x[2] + x[3] * x[3]); }
                    s += __shfl_xor(s, 16); s += __shfl_xor(s, 32);
                    const float sc = rsqrtf(s * (1.f / 64.f) + 1e-6f) * mult;
                    bf16_t* rowp = U + (size_t)(row0 + ai * HALF + m * 16) * ldc + col0;
#pragma unroll
                    for (int bj = 0; bj < 2; ++bj) { const f32x4 v0 = acc[ai][bj][m][0] * sc * gv[bj][0], v1 = acc[ai][bj][m][1] * sc * gv[bj][1];
                        u32x4 w; w.x = cvt_pk_bf16(v0[0], v0[1]); w.y = cvt_pk_bf16(v0[2], v0[3]); w.z = cvt_pk_bf16(v1[0], v1[1]); w.w = cvt_pk_bf16(v1[2], v1[3]);
                        *(u32x4*)(rowp + bj * 32) = w; }
                }
        } else {
            const int col0 = u.pn * BM + wc * 32 + 8 * fq;
#pragma unroll
            for (int ai = 0; ai < 2; ++ai)
#pragma unroll
                for (int m = 0; m < 4; ++m) { bf16_t* rowp = U + (size_t)(row0 + ai * HALF + m * 16) * ldc + col0;
#pragma unroll
                    for (int bj = 0; bj < 2; ++bj) { const f32x4 v0 = acc[ai][bj][m][0], v1 = acc[ai][bj][m][1];
                        u32x4 w; w.x = cvt_pk_bf16(v0[0], v0[1]); w.y = cvt_pk_bf16(v0[2], v0[3]); w.z = cvt_pk_bf16(v1[0], v1[1]); w.w = cvt_pk_bf16(v1[2], v1[3]);
                        *(u32x4*)(rowp + bj * HALF) = w; } }
        }
    }
};
struct EpiF32 {
    static constexpr bool PERM = false, AFTER_DRAIN = false;
    float* C; int ldc;
    __device__ __forceinline__ void operator()(const f32x4 (&acc)[2][2][4][2], const Unit& u, int wr, int wc, int fr, int fq) const {
        const int row0 = u.pm * BM + wr * 64 + fr, col0 = u.pn * BM + wc * 32 + 4 * fq;
#pragma unroll
        for (int ai = 0; ai < 2; ++ai)
#pragma unroll
            for (int m = 0; m < 4; ++m) { float* rowp = C + (size_t)(row0 + ai * HALF + m * 16) * ldc + col0;
#pragma unroll
                for (int bj = 0; bj < 2; ++bj)
#pragma unroll
                    for (int n = 0; n < 2; ++n) *(f32x4*)(rowp + bj * HALF + n * 16) = acc[ai][bj][m][n]; }
    }
};

template <class Epi, class Sched, bool ALIGN_EPI = false, bool SP2 = false>
__device__ __forceinline__ void gemm_phase(PG8_LAS unsigned char* lds, const Gemm g, const Sched& S, const Epi& E) {
    int tid_ = threadIdx.x; asm volatile("" : "+v"(tid_));
    const int tid = tid_, wid = __builtin_amdgcn_readfirstlane(tid >> 6), lane = tid & 63, wr = wid >> 2, wc = wid & 3, fr = lane & 15, fq = lane >> 4;
    const int K = g.K, nt = K / BK;
    unsigned voffA[2], voffB[2];
#pragma unroll
    for (int i = 0; i < 2; ++i) { int R, C; stage_rc(tid * 16 + i * 8192, R, C); const int Rb = Epi::PERM ? ((R & ~31) + perm32(R & 31)) : R;
        voffA[i] = (unsigned)(R * K + C) * 2u; voffB[i] = (unsigned)(Rb * K + C) * 2u; }
    const size_t kstep = (size_t)(BK * 2);
    const size_t hstep = (size_t)HALF * K * 2;
    const size_t tstep = 2 * hstep;
    const unsigned ldsw = (unsigned)wid * 1024u;
    const int aoff = lds_byte(wr * 64 + fr, fq * 8), boff = lds_byte(wc * 32 + fr, fq * 8);
#define PG8_SA(b, h) (((b) * 2 + (h)) * HTB)
#define PG8_SB(b, h) ((4 + (b) * 2 + (h)) * HTB)
#define PG8_STAGE(bufoff, gbase, voff) do { _Pragma("unroll") for (int _i = 0; _i < 2; ++_i) \
        __builtin_amdgcn_global_load_lds((const unsigned*)((const char*)(gbase) + (voff)[_i]), (PG8_LAS unsigned*)(lds + (bufoff) + ldsw + _i * 8192), 16, 0, 0); } while (0)
#define PG8_LDA(dst, b, h) do { _Pragma("unroll") for (int m = 0; m < 4; ++m) _Pragma("unroll") for (int k = 0; k < 2; ++k) dst[m][k] = *(const PG8_LAS bf16x8*)(lds + PG8_SA(b, h) + aoff + m * 2048 + k * 1024); } while (0)
#define PG8_LDB(dst, b, h) do { _Pragma("unroll") for (int n = 0; n < 2; ++n) _Pragma("unroll") for (int k = 0; k < 2; ++k) dst[n][k] = *(const PG8_LAS bf16x8*)(lds + PG8_SB(b, h) + boff + n * 2048 + k * 1024); } while (0)
#define PG8_MMA(ai, bj, At, Bt) do { __builtin_amdgcn_s_setprio(1); _Pragma("unroll") for (int m = 0; m < 4; ++m) _Pragma("unroll") for (int n = 0; n < 2; ++n) _Pragma("unroll") for (int k = 0; k < 2; ++k) \
        acc[ai][bj][m][n] = __builtin_amdgcn_mfma_f32_16x16x32_bf16(Bt[n][k], At[m][k], acc[ai][bj][m][n], 0, 0, 0); __builtin_amdgcn_s_setprio(0); } while (0)
#define PG8_WAIT_V(n) asm volatile("s_waitcnt vmcnt(" #n ")" ::: "memory")
#define PG8_WAIT_L(n) asm volatile("s_waitcnt lgkmcnt(" #n ")" ::: "memory")
#define PG8_BAR __builtin_amdgcn_s_barrier()
#define PG8_SCHED __builtin_amdgcn_sched_barrier(0)
    Unit cur, nxt; int ui = 0;
    if (!S.next(0, cur)) return;
    f32x4 acc[2][2][4][2];
#pragma unroll
    for (int a = 0; a < 2; ++a)
#pragma unroll
        for (int b = 0; b < 2; ++b)
#pragma unroll
            for (int m = 0; m < 4; ++m)
#pragma unroll
                for (int n = 0; n < 2; ++n) acc[a][b][m][n] = (f32x4){0.f, 0.f, 0.f, 0.f};
    bf16x8 At[4][2], B0[2][2], B1[2][2];
    const char* cA = (const char*)g.A + (size_t)cur.pm * tstep; const char* cB = (const char*)g.Bt + (size_t)cur.pn * tstep;
    S.a_ready(cur);
    if constexpr (SP2) {
        PG8_STAGE(PG8_SB(0, 0), cB, voffB); PG8_STAGE(PG8_SB(0, 1), cB + hstep, voffB); PG8_STAGE(PG8_SA(0, 0), cA, voffA); PG8_STAGE(PG8_SA(0, 1), cA + hstep, voffA);
        if (wr == 1) PG8_BAR;
        PG8_WAIT_V(2); PG8_BAR;
        PG8_STAGE(PG8_SB(1, 0), cB + kstep, voffB); PG8_STAGE(PG8_SA(1, 0), cA + kstep, voffA); PG8_STAGE(PG8_SB(1, 1), cB + hstep + kstep, voffB);
        PG8_WAIT_V(6); PG8_BAR;
    } else {
        PG8_STAGE(PG8_SB(0, 0), cB, voffB); PG8_STAGE(PG8_SA(0, 0), cA, voffA); PG8_STAGE(PG8_SB(0, 1), cB + hstep, voffB); PG8_STAGE(PG8_SA(0, 1), cA + hstep, voffA);
        if (wr == 1) PG8_BAR;
        PG8_WAIT_V(4); PG8_BAR;
        PG8_STAGE(PG8_SB(1, 0), cB + kstep, voffB); PG8_STAGE(PG8_SA(1, 0), cA + kstep, voffA); PG8_STAGE(PG8_SB(1, 1), cB + hstep + kstep, voffB);
        PG8_WAIT_V(6); PG8_BAR;
    }
    for (;;) {
        const bool has_next = S.next(ui + 1, nxt);
        const char* nA = has_next ? (const char*)g.A + (size_t)nxt.pm * tstep : cA; const char* nB = has_next ? (const char*)g.Bt + (size_t)nxt.pn * tstep : cB;
        for (int t = 0; t < nt; t += 2) {
            const bool last = (t == nt - 2);
            const char* a1 = cA + (size_t)(t + 1) * kstep;
            const char* a2 = last ? nA : cA + (size_t)(t + 2) * kstep; const char* b2 = last ? nB : cB + (size_t)(t + 2) * kstep;
            const char* a3 = a2 + kstep; const char* b3 = b2 + kstep;
            if (last && has_next) S.a_ready(nxt);
            if constexpr (SP2) {
            PG8_LDB(B0, 0, 0); PG8_LDB(B1, 0, 1); PG8_SCHED; PG8_LDA(At, 0, 0); PG8_STAGE(PG8_SA(1, 1), a1 + hstep, voffA);
            PG8_WAIT_V(8); PG8_WAIT_L(0); PG8_BAR; PG8_MMA(0, 0, At, B0); PG8_MMA(0, 1, At, B1); PG8_BAR; PG8_SCHED;
            PG8_LDA(At, 0, 1); PG8_STAGE(PG8_SB(0, 0), b2, voffB); PG8_STAGE(PG8_SB(0, 1), b2 + hstep, voffB); PG8_STAGE(PG8_SA(0, 0), a2, voffA);
            PG8_WAIT_V(8); PG8_WAIT_L(0); PG8_BAR; PG8_MMA(1, 0, At, B0); PG8_MMA(1, 1, At, B1); PG8_BAR; PG8_SCHED;
            PG8_LDB(B0, 1, 0); PG8_LDB(B1, 1, 1); PG8_SCHED; PG8_LDA(At, 1, 0); PG8_STAGE(PG8_SA(0, 1), a2 + hstep, voffA);
            PG8_WAIT_V(8); PG8_WAIT_L(0); PG8_BAR; PG8_MMA(0, 0, At, B0); PG8_MMA(0, 1, At, B1); PG8_BAR; PG8_SCHED;
            PG8_LDA(At, 1, 1); PG8_STAGE(PG8_SB(1, 0), b3, voffB); PG8_STAGE(PG8_SB(1, 1), b3 + hstep, voffB); PG8_STAGE(PG8_SA(1, 0), a3, voffA);
            PG8_WAIT_V(8); PG8_WAIT_L(0); PG8_BAR; PG8_MMA(1, 0, At, B0); PG8_MMA(1, 1, At, B1); PG8_BAR; PG8_SCHED;
            } else {
            PG8_LDB(B0, 0, 0); PG8_SCHED; PG8_LDA(At, 0, 0); PG8_STAGE(PG8_SA(1, 1), a1 + hstep, voffA);
            PG8_WAIT_L(8); PG8_BAR; PG8_WAIT_L(0); PG8_MMA(0, 0, At, B0); PG8_BAR; PG8_SCHED;
            PG8_LDB(B1, 0, 1); PG8_STAGE(PG8_SB(0, 0), b2, voffB);
            PG8_BAR; PG8_WAIT_L(0); PG8_MMA(0, 1, At, B1); PG8_BAR;
            PG8_LDA(At, 0, 1); PG8_STAGE(PG8_SA(0, 0), a2, voffA);
            PG8_BAR; PG8_WAIT_L(0); PG8_MMA(1, 0, At, B0); PG8_BAR; PG8_SCHED;
            PG8_STAGE(PG8_SB(0, 1), b2 + hstep, voffB);
            PG8_WAIT_V(6); PG8_BAR; PG8_MMA(1, 1, At, B1); PG8_BAR;
            PG8_LDB(B0, 1, 0); PG8_SCHED; PG8_LDA(At, 1, 0); PG8_STAGE(PG8_SA(0, 1), a2 + hstep, voffA);
            PG8_WAIT_L(8); PG8_BAR; PG8_WAIT_L(0); PG8_MMA(0, 0, At, B0); PG8_BAR; PG8_SCHED;
            PG8_LDB(B1, 1, 1); PG8_STAGE(PG8_SB(1, 0), b3, voffB);
            PG8_BAR; PG8_WAIT_L(0); PG8_MMA(0, 1, At, B1); PG8_BAR;
            PG8_LDA(At, 1, 1); PG8_STAGE(PG8_SA(1, 0), a3, voffA);
            PG8_BAR; PG8_WAIT_L(0); PG8_MMA(1, 0, At, B0); PG8_BAR; PG8_SCHED;
            PG8_STAGE(PG8_SB(1, 1), b3 + hstep, voffB);
            PG8_WAIT_V(6); PG8_BAR; PG8_MMA(1, 1, At, B1); PG8_BAR;
            }
        }
        if constexpr (ALIGN_EPI) { if (wr == 0) PG8_BAR; }
        if constexpr (!Epi::AFTER_DRAIN) { E(acc, cur, wr, wc, fr, fq); S.done(cur); }
        if (!has_next) break;
#pragma unroll
        for (int a = 0; a < 2; ++a)
#pragma unroll
            for (int b = 0; b < 2; ++b)
#pragma unroll
                for (int m = 0; m < 4; ++m)
#pragma unroll
                    for (int n = 0; n < 2; ++n) acc[a][b][m][n] = (f32x4){0.f, 0.f, 0.f, 0.f};
        cur = nxt; cA = nA; cB = nB; ++ui;
        if constexpr (ALIGN_EPI) { if (wr == 1) PG8_BAR; }
    }
    PG8_WAIT_V(0);
    if constexpr (!ALIGN_EPI) { if (wr == 0) PG8_BAR; }
    PG8_BAR;
    if constexpr (Epi::AFTER_DRAIN) { E.fused(acc, cur, wr, wc, fr, fq, lds, wid, lane); S.done(cur); }
#undef PG8_SA
#undef PG8_SB
#undef PG8_STAGE
#undef PG8_LDA
#undef PG8_LDB
#undef PG8_MMA
#undef PG8_WAIT_V
#undef PG8_WAIT_L
#undef PG8_BAR
#undef PG8_SCHED
}
}

#include <hip/hip_bf16.h>
#include <cmath>
namespace attn_body {
using bf16=__hip_bfloat16;
using bf16x8=__attribute__((ext_vector_type(8)))short;
using s16x4=__attribute__((ext_vector_type(4)))short;
using f32x16=__attribute__((ext_vector_type(16)))float;
using u32x4=__attribute__((ext_vector_type(4)))unsigned;
constexpr int BATCH=8,NHEAD=8,SEQ=4096,D=64,DM=3840,OPITCH=1024;
constexpr int NW=8,QBLK=32,QB=QBLK*NW,KVBLK=64,NQB=SEQ/QB;
constexpr int ATTN_PITCH=DM, ATTN_UNIT_ROWS=QB;
__device__ __forceinline__ int crow(int r,int hi){return (r&3)+8*(r>>2)+4*hi;}
#define SBAR() __builtin_amdgcn_sched_barrier(0)
__device__ __forceinline__ void cmask(f32x16&p0,f32x16&p1,int jb,int qrel,int hi){
  const float NEG=-INFINITY; int kb=64*jb+4*hi;
  #pragma unroll
  for(int r=0;r<16;++r){int kv=kb+(r&3)+8*(r>>2); if(kv>qrel)p0[r]=NEG; if(kv+32>qrel)p1[r]=NEG;}
}

constexpr int NSLOT=3, SLOTB=8192;
constexpr int LDS_K=0, LDS_V=NSLOT*SLOTB, LDS_WS=2*NSLOT*SLOTB, LDS_OST=LDS_WS+NW*64*4, LDS_CB=LDS_OST+NW*4096, LDS_BYTES=LDS_CB+SEQ*4+1024;
constexpr float C2=0.125f*1.4426950408889634f;
__device__ __forceinline__ void glds16(const void*gsrc,unsigned lds_dst){unsigned keep;
  asm volatile("s_mov_b32 %0, m0\n\ts_mov_b32 m0, %2\n\ts_nop 0\n\tglobal_load_lds_dwordx4 %1, off\n\ts_mov_b32 m0, %0":"=&s"(keep):"v"(gsrc),"s"(lds_dst):"memory");}
__device__ __forceinline__ float max3f(float a,float b,float c){float r;asm("v_max3_f32 %0, %1, %2, %3":"=v"(r):"v"(a),"v"(b),"v"(c));return r;}
__device__ __forceinline__ float max2f(float a,float b){float r;asm("v_max_f32_e32 %0, %1, %2":"=v"(r):"v"(a),"v"(b));return r;}
__device__ __forceinline__ float fadd_s(float a,float b){float r;asm("v_add_f32_e32 %0, %1, %2":"=v"(r):"v"(a),"v"(b));return r;}
__device__ __forceinline__ float fsub_s(float a,float b){float r;asm("v_sub_f32_e32 %0, %1, %2":"=v"(r):"v"(a),"v"(b));return r;}
typedef float f32x4v __attribute__((ext_vector_type(4))); typedef float f32x2_t __attribute__((ext_vector_type(2))); typedef __bf16 bf16x2_t __attribute__((ext_vector_type(2)));
__device__ __forceinline__ unsigned cvtpk_s(float lo,float hi){f32x2_t v={lo,hi};bf16x2_t b=__builtin_convertvector(v,bf16x2_t);return __builtin_bit_cast(unsigned,b);}
#define WAIT_BAR(N) asm volatile("s_waitcnt vmcnt(" #N ") lgkmcnt(0)\n\ts_barrier":::"memory")

__device__ __forceinline__ void qkt(f32x16&p0,f32x16&p1,const char*Kslot,const bf16x8*qr,int r32,int hi){
  const char*kb=Kslot+hi*1024+r32*16;
  #pragma unroll
  for(int d0=0;d0<4;++d0){
    const bf16x8 b0=*reinterpret_cast<const bf16x8*>(kb+d0*2048);
    const bf16x8 b1=*reinterpret_cast<const bf16x8*>(kb+d0*2048+512);
    p0=__builtin_amdgcn_mfma_f32_32x32x16_bf16(b0,qr[d0],p0,0,0,0);p1=__builtin_amdgcn_mfma_f32_32x32x16_bf16(b1,qr[d0],p1,0,0,0);}
}
typedef __attribute__((address_space(3))) const char* lds_cptr;
typedef short v4i16_t __attribute__((ext_vector_type(4)));
__device__ __forceinline__ void kload8(bf16x8*kf,lds_cptr kp){
  kf[0]=*(const __attribute__((address_space(3))) bf16x8*)(kp);      kf[1]=*(const __attribute__((address_space(3))) bf16x8*)(kp+512);
  kf[2]=*(const __attribute__((address_space(3))) bf16x8*)(kp+2048); kf[3]=*(const __attribute__((address_space(3))) bf16x8*)(kp+2560);
  kf[4]=*(const __attribute__((address_space(3))) bf16x8*)(kp+4096); kf[5]=*(const __attribute__((address_space(3))) bf16x8*)(kp+4608);
  kf[6]=*(const __attribute__((address_space(3))) bf16x8*)(kp+6144); kf[7]=*(const __attribute__((address_space(3))) bf16x8*)(kp+6656);
}
__device__ __forceinline__ void kload2(bf16x8*kf,lds_cptr kp,int j){ kf[2*j]=*(const __attribute__((address_space(3))) bf16x8*)(kp+j*2048); kf[2*j+1]=*(const __attribute__((address_space(3))) bf16x8*)(kp+j*2048+512); }
__device__ __forceinline__ s16x4 vtr(lds_cptr p){ return __builtin_bit_cast(s16x4,__builtin_amdgcn_ds_read_tr16_b64_v4i16((__attribute__((address_space(3))) v4i16_t*)p)); }
__device__ __forceinline__ float rowmax(const f32x16&p0,const f32x16&p1){
  float a=max3f(p0[0],p0[1],p1[0]),b=max3f(p0[2],p0[3],p1[1]);a=max3f(a,p1[2],p1[3]);
  #pragma unroll
  for(int r=4;r<16;r+=4){a=max3f(a,p0[r],p0[r+1]);b=max3f(b,p0[r+2],p0[r+3]);a=max3f(a,p1[r],p1[r+1]);b=max3f(b,p1[r+2],p1[r+3]);}
  const float m=max2f(a,b);
  auto rr=__builtin_amdgcn_permlane32_swap(__float_as_uint(m),__float_as_uint(m),false,false);
  return max2f(__uint_as_float(rr[0]),__uint_as_float(rr[1]));
}
__device__ __forceinline__ void pv(f32x16*o,int vb,bf16x8 pa0,bf16x8 pa1,bf16x8 pa2,bf16x8 pa3){
  #pragma unroll
  for(int d0=0;d0<2;++d0){s16x4 lo[4],hi[4];
    #pragma unroll
    for(int ks=0;ks<4;++ks){
      asm volatile("ds_read_b64_tr_b16 %0,%1 offset:%c2":"=&v"(lo[ks]):"v"(vb),"i"(d0*4096+ks*1024):"memory");
      asm volatile("ds_read_b64_tr_b16 %0,%1 offset:%c2":"=&v"(hi[ks]):"v"(vb),"i"(d0*4096+ks*1024+512):"memory");}
    asm volatile("s_waitcnt lgkmcnt(0)":::"memory");SBAR();
    #define PK(k) (bf16x8){lo[k][0],lo[k][1],lo[k][2],lo[k][3],hi[k][0],hi[k][1],hi[k][2],hi[k][3]}
    o[d0]=__builtin_amdgcn_mfma_f32_32x32x16_bf16(pa0,PK(0),o[d0],0,0,0);
    o[d0]=__builtin_amdgcn_mfma_f32_32x32x16_bf16(pa1,PK(1),o[d0],0,0,0);
    o[d0]=__builtin_amdgcn_mfma_f32_32x32x16_bf16(pa2,PK(2),o[d0],0,0,0);
    o[d0]=__builtin_amdgcn_mfma_f32_32x32x16_bf16(pa3,PK(3),o[d0],0,0,0);
    #undef PK
  }
}

#ifndef ATTN_STORE16
#define ATTN_STORE16(p,v) (*(u32x4*)(p)=(v))
#endif
template<int THRL> __device__ __forceinline__ void attn_unit(int b,int h,int qb,const bf16*Q,const bf16*__restrict__ K,const bf16*__restrict__ V,const bf16*Gt,const float*CBg,bf16*O,char*shm){
  int tid_=threadIdx.x; asm volatile("":"+v"(tid_)); const int tid=tid_,lane=tid&63,r32=lane&31,hi=lane>>5; const int wid=__builtin_amdgcn_readfirstlane(tid>>6);
  const long rowbase=(long)b*SEQ; const int q0=qb*QB;
  const bf16*Qw=Q+(rowbase+q0+wid*QBLK)*DM+h*D;
  const bf16*Kh=K+rowbase*DM+h*D,*Vh=V+rowbase*DM+h*D;
  const unsigned lds0=(unsigned)(uintptr_t)shm;
  float*wsf=(float*)(shm+LDS_WS)+wid*64;
  const bf16*ksrc=Kh+(long)lane*DM+wid*8;
  const bf16*vsrc=Vh+(long)(16*(wid&3)+(lane>>2))*DM+(wid>>2)*32+(lane&3)*8;
  const unsigned kdst=lds0+LDS_K+wid*1024, vdst=lds0+LDS_V+wid*1024;
  #define DMA_K(t,slot) glds16(ksrc+(long)(t)*KVBLK*DM,(unsigned)__builtin_amdgcn_readfirstlane(kdst+(slot)))
  #define DMA_V(t,slot) glds16(vsrc+(long)(t)*KVBLK*DM,(unsigned)__builtin_amdgcn_readfirstlane(vdst+(slot)))
  const int vb0=(int)(lds0+LDS_V)+((lane>>4)&1)*32+(lane&3)*8+(4*hi+((lane&15)>>2))*64;
  const char*Kbase=shm+LDS_K; bf16x8 kf[8];
  const lds_cptr shm3=(lds_cptr)shm; const lds_cptr kp0=shm3+LDS_K+hi*1024+r32*16; const lds_cptr vp0=shm3+LDS_V+((lane>>4)&1)*32+(lane&3)*8+(4*hi+((lane&15)>>2))*64;
  const int NT=(q0+QB)/KVBLK;
  { const float*cbsrc=CBg+((long)b*NHEAD+h)*SEQ; float*cbl=(float*)(shm+LDS_CB);
    #pragma unroll
    for(int i=0;i<2;++i){ const int e=(i*512+tid)*4; if(e<q0+QB){ const f32x4v v=*reinterpret_cast<const f32x4v*>(cbsrc+e); *reinterpret_cast<f32x4v*>(cbl+e)=v; } } }
  DMA_K(0,0);DMA_V(0,0);DMA_K(1,SLOTB);
  bf16x8 qr[4];
  #pragma unroll
  for(int d0=0;d0<4;++d0)qr[d0]=*reinterpret_cast<const bf16x8*>(&Qw[(long)r32*DM+d0*16+hi*8]);
  float mhat=0.f,l_reg=0.f;f32x16 o[2];o[0]=f32x16{};o[1]=f32x16{};
  const int qrel=wid*QBLK+r32;
  #define CMASK(P0,P1,t) do{int jb_=(t)-(NT-4); if(jb_>=0)cmask(P0,P1,jb_,qrel,hi);}while(0)
  bool resc=false; f32x16 pA0,pA1,pB0,pB1;
  #define START(P0,P1) do{ const float rm=rowmax(P0,P1); resc=false; \
    { const float dl=__builtin_fmaxf(rm,-16.f); mhat=fadd_s(mhat,dl); mh2=cbq+mhat; \
      _Pragma("unroll") for(int r=0;r<16;++r){P0[r]=fsub_s(P0[r],dl);P1[r]=fsub_s(P1[r],dl);} } \
    _Pragma("unroll") for(int r=0;r<16;++r)P0[r]=__builtin_amdgcn_exp2f(P0[r]); }while(0)
  #define RESC() do{ if(resc){ asm volatile("s_waitcnt lgkmcnt(0)":::"memory"); \
      _Pragma("unroll") for(int d_=0;d_<2;++d_) _Pragma("unroll") for(int r=0;r<16;++r)o[d_][r]*=wsf[crow(r,hi)]; } }while(0)
  int sl_prev=0,sl_cur=0,sl_next=SLOTB;
  #define ROT() do{sl_prev=sl_cur;sl_cur=sl_next;sl_next=(sl_next==(NSLOT-1)*SLOTB)?0:sl_next+SLOTB;}while(0)
  DMA_K(2,2*SLOTB);
  WAIT_BAR(3);
  const lds_cptr cbp=(lds_cptr)shm+LDS_CB+hi*16;
  const float cbq=*(const __attribute__((address_space(3))) float*)((lds_cptr)shm+LDS_CB+4*(q0+wid*QBLK+r32));
  float mh2=cbq;
  #define CBINIT(P0,P1,t) do{ _Pragma("unroll") for(int g_=0;g_<4;++g_){ \
      const f32x4v c0_=*(const __attribute__((address_space(3))) f32x4v*)(cbp+(t)*256+g_*32), c1_=*(const __attribute__((address_space(3))) f32x4v*)(cbp+(t)*256+g_*32+128); \
      _Pragma("unroll") for(int i_=0;i_<4;++i_){P0[4*g_+i_]=c0_[i_]-mh2;P1[4*g_+i_]=c1_[i_]-mh2;} } }while(0)
  CBINIT(pA0,pA1,0);
  qkt(pA0,pA1,Kbase,qr,r32,hi);asm volatile("s_nop 15\n\ts_nop 7":"+v"(pA0),"+v"(pA1));CMASK(pA0,pA1,0);
  START(pA0,pA1);
  _Pragma("unroll") for(int r=0;r<16;++r)pA1[r]=__builtin_amdgcn_exp2f(pA1[r]);
  CBINIT(pB0,pB1,1);
  WAIT_BAR(0);
  DMA_K(3,0);DMA_V(1,SLOTB);
  ROT();
  kload8(kf,kp0+sl_cur);
  WAIT_BAR(2);
  s16x4 vlo[8],vhi[8]; u32x4 pw0,pw1,pw2,pw3;
  #define PKW(P,B) cvtpk_s(P[B],P[B+1])
  #define PAF(k) __builtin_bit_cast(bf16x8,pw##k)
  #define VFR(i) (bf16x8){vlo[i][0],vlo[i][1],vlo[i][2],vlo[i][3],vhi[i][0],vhi[i][1],vhi[i][2],vhi[i][3]}
  #define PIN(x) asm volatile("":"+v"(x))
  #define MX3(a,b,c) __builtin_fmaxf(__builtin_fmaxf((a),(b)),(c))
  #define GAPA(MF,A0,A1,A2,A3,W0,W1,PW) do{ MF; sacc+=A0; sacc+=A1; sacc+=A2; sacc+=A3; PIN(sacc); W0; W1; PIN(PW); SBAR(); }while(0)
  #define EX(v) __builtin_amdgcn_exp2f(v)
  #define GAPB(MF,X,B,PN,CBO) do{ MF; X[B]=EX(X[B]); X[B+1]=EX(X[B+1]); X[B+2]=EX(X[B+2]); X[B+3]=EX(X[B+3]); PIN(X); \
    { const f32x4v c_=*(const __attribute__((address_space(3))) f32x4v*)(cbn_+(CBO)); PN[B]=c_[0]-mh2; PN[B+1]=c_[1]-mh2; PN[B+2]=c_[2]-mh2; PN[B+3]=c_[3]-mh2; PIN(PN); } SBAR(); }while(0)
  #define VRD(i) do{ vlo[i]=vtr(vp_+(((i)>>2)*4096+((i)&3)*1024)); vhi[i]=vtr(vp_+(((i)>>2)*4096+((i)&3)*1024+512)); }while(0)
  #define KRD(G,j) do{ if(G){ kload2(kf,kp0+sl_next,j); SBAR(); } }while(0)
  #define STEP(C0,C1,P0,P1,t,GK,GV,GL) do{ SBAR(); \
    const lds_cptr vp_=vp0+sl_prev; \
    VRD(0); SBAR(); float sacc=(P0[0]+P0[1]); \
    GAPA(C0=__builtin_amdgcn_mfma_f32_32x32x16_bf16(kf[0],qr[0],C0,0,0,0), P0[2],P0[3],P0[4],P0[5],     pw0[0]=PKW(P0,0), pw0[1]=PKW(P0,2), pw0); \
    VRD(4); SBAR(); GAPA(C1=__builtin_amdgcn_mfma_f32_32x32x16_bf16(kf[1],qr[0],C1,0,0,0), P0[6],P0[7],P0[8],P0[9],     pw0[2]=PKW(P0,4), pw0[3]=PKW(P0,6), pw0); \
    VRD(1); SBAR(); GAPA(C0=__builtin_amdgcn_mfma_f32_32x32x16_bf16(kf[2],qr[1],C0,0,0,0),   P0[10],P0[11],P0[12],P0[13], pw1[0]=PKW(P0,8), pw1[1]=PKW(P0,10), pw1); \
    VRD(5); SBAR(); GAPA(C1=__builtin_amdgcn_mfma_f32_32x32x16_bf16(kf[3],qr[1],C1,0,0,0),   P0[14],P0[15],P1[0],P1[1],   pw1[2]=PKW(P0,12),pw1[3]=PKW(P0,14), pw1); \
    VRD(2); SBAR(); GAPA(C0=__builtin_amdgcn_mfma_f32_32x32x16_bf16(kf[4],qr[2],C0,0,0,0),   P1[2],P1[3],P1[4],P1[5],     pw2[0]=PKW(P1,0), pw2[1]=PKW(P1,2), pw2); \
    VRD(6); SBAR(); GAPA(C1=__builtin_amdgcn_mfma_f32_32x32x16_bf16(kf[5],qr[2],C1,0,0,0),   P1[6],P1[7],P1[8],P1[9],     pw2[2]=PKW(P1,4), pw2[3]=PKW(P1,6), pw2); \
    VRD(3); SBAR(); GAPA(C0=__builtin_amdgcn_mfma_f32_32x32x16_bf16(kf[6],qr[3],C0,0,0,0),   P1[10],P1[11],P1[12],P1[13], pw3[0]=PKW(P1,8), pw3[1]=PKW(P1,10), pw3); \
    VRD(7); SBAR(); GAPA(C1=__builtin_amdgcn_mfma_f32_32x32x16_bf16(kf[7],qr[3],C1,0,0,0),   P1[14],P1[15],0.f,0.f,       pw3[2]=PKW(P1,12),pw3[3]=PKW(P1,14), pw3); \
    l_reg+=sacc; \
    if(GK){DMA_K((t)+3,sl_cur);} if(GV){DMA_V((t)+1,sl_next);} \
    CMASK(C0,C1,t); \
    { float a=MX3(C0[0],C0[1],C1[0]),b=MX3(C0[2],C0[3],C1[1]); a=MX3(a,C1[2],C1[3]); \
      _Pragma("unroll") for(int r=4;r<16;r+=4){a=MX3(a,C0[r],C0[r+1]);b=MX3(b,C0[r+2],C0[r+3]);a=MX3(a,C1[r],C1[r+1]);b=MX3(b,C1[r+2],C1[r+3]);} \
      float rm=__builtin_fmaxf(a,b); { auto rr=__builtin_amdgcn_permlane32_swap(__float_as_uint(rm),__float_as_uint(rm),false,false); rm=__builtin_fmaxf(__uint_as_float(rr[0]),__uint_as_float(rr[1])); } \
      resc=false; \
      if(__builtin_expect(__any(rm>(float)THRL),0)){ const float dl=__builtin_fmaxf(rm,0.f); mhat+=dl; \
        _Pragma("unroll") for(int r=0;r<16;++r){C0[r]-=dl;C1[r]-=dl;} \
        mh2=cbq+mhat; \
        const float f=__builtin_amdgcn_exp2f(-dl); l_reg*=f; if(hi==0)wsf[r32]=f; resc=true; } } \
    SBAR(); \
    const lds_cptr cbn_=cbp+((t)+1)*256;                      \
    GAPB(o[0]=__builtin_amdgcn_mfma_f32_32x32x16_bf16(PAF(0),VFR(0),o[0],0,0,0), C0,0, P0,0); \
    GAPB(o[1]=__builtin_amdgcn_mfma_f32_32x32x16_bf16(PAF(0),VFR(4),o[1],0,0,0), C0,4, P0,32); \
    KRD(GL,0); GAPB(o[0]=__builtin_amdgcn_mfma_f32_32x32x16_bf16(PAF(1),VFR(1),o[0],0,0,0), C0,8, P0,64); \
    KRD(GL,1); GAPB(o[1]=__builtin_amdgcn_mfma_f32_32x32x16_bf16(PAF(1),VFR(5),o[1],0,0,0), C0,12, P0,96); \
    KRD(GL,2); GAPB(o[0]=__builtin_amdgcn_mfma_f32_32x32x16_bf16(PAF(2),VFR(2),o[0],0,0,0), C1,0, P1,128); \
    KRD(GL,3); GAPB(o[1]=__builtin_amdgcn_mfma_f32_32x32x16_bf16(PAF(2),VFR(6),o[1],0,0,0), C1,4, P1,160); \
    GAPB(o[0]=__builtin_amdgcn_mfma_f32_32x32x16_bf16(PAF(3),VFR(3),o[0],0,0,0), C1,8, P1,192); \
    GAPB(o[1]=__builtin_amdgcn_mfma_f32_32x32x16_bf16(PAF(3),VFR(7),o[1],0,0,0), C1,12, P1,224); \
    }while(0)
  int t=1;
  #undef CMASK
  #define CMASK(P0,P1,t) do{}while(0)
  for(;t+5<NT;t+=2){
    STEP(pB0,pB1,pA0,pA1,t,true,true,true);     WAIT_BAR(2); RESC(); ROT();
    STEP(pA0,pA1,pB0,pB1,t+1,true,true,true);   WAIT_BAR(2); RESC(); ROT();
  }
  #undef CMASK
  #define CMASK(P0,P1,t) do{int jb_=(t)-(NT-4); if(jb_>=0)cmask(P0,P1,jb_,qrel,hi);}while(0)
  #define ENDW(tt) do{ if((tt)+3<NT){WAIT_BAR(2);} else if((tt)+2<NT){WAIT_BAR(1);} else {WAIT_BAR(0);} }while(0)
  for(;t+1<NT;t+=2){
    STEP(pB0,pB1,pA0,pA1,t,(t+3<NT),(t+1<NT),(t+1<NT));       ENDW(t);   RESC(); ROT();
    STEP(pA0,pA1,pB0,pB1,t+1,(t+4<NT),(t+2<NT),(t+2<NT));     ENDW(t+1); RESC(); ROT();
  }
  STEP(pB0,pB1,pA0,pA1,NT-1,false,false,false); RESC();
  { float sacc=pB0[0]+pB0[1]; _Pragma("unroll") for(int r=2;r<16;++r)sacc+=pB0[r]; _Pragma("unroll") for(int r=0;r<16;++r)sacc+=pB1[r]; l_reg+=sacc;
    pw0=(u32x4){PKW(pB0,0),PKW(pB0,2),PKW(pB0,4),PKW(pB0,6)};pw1=(u32x4){PKW(pB0,8),PKW(pB0,10),PKW(pB0,12),PKW(pB0,14)};pw2=(u32x4){PKW(pB1,0),PKW(pB1,2),PKW(pB1,4),PKW(pB1,6)};pw3=(u32x4){PKW(pB1,8),PKW(pB1,10),PKW(pB1,12),PKW(pB1,14)};
    SBAR(); pv(o,vb0+sl_cur,PAF(0),PAF(1),PAF(2),PAF(3)); }
  #undef PKW
  #undef PAF
  #undef VFR
  #undef PIN
  #undef MX3
  #undef GAPA
  #undef GAPB
  #undef EX
  #undef VRD
  #undef KRD
  #undef STEP
  #undef ENDW
  {auto rr=__builtin_amdgcn_permlane32_swap(__float_as_uint(l_reg),__float_as_uint(l_reg),false,false);l_reg=__uint_as_float(rr[0])+__uint_as_float(rr[1]);}
  if(hi==0)wsf[32+r32]=l_reg;asm volatile("s_waitcnt lgkmcnt(0)":::"memory");
  float rli[16];
  #pragma unroll
  for(int r=0;r<16;++r)rli[r]=__builtin_amdgcn_rcpf(wsf[32+crow(r,hi)]);
  bf16*Ow=O+(rowbase+q0+wid*QBLK)*OPITCH+h*D; const bf16*Gw=Gt+(rowbase+q0+wid*QBLK)*DM+h*D;
  { bf16*stg=(bf16*)(shm+LDS_OST)+wid*2048;
    #pragma unroll
    for(int r=0;r<16;++r){const int orow=crow(r,hi);
      #pragma unroll
      for(int d0=0;d0<2;++d0)stg[orow*64+d0*32+r32]=__float2bfloat16(o[d0][r]*rli[r]);}
    asm volatile("s_waitcnt lgkmcnt(0)":::"memory");
    #pragma unroll
    for(int i=0;i<4;++i){const int row=i*8+(lane>>3),ch=lane&7; const u32x4 v=*(const u32x4*)(stg+row*64+ch*8); const u32x4 gq=*(const u32x4*)(Gw+(long)row*DM+ch*8); u32x4 w_;
      #pragma unroll
      for(int k=0;k<4;++k){ const float g0=__builtin_bit_cast(float,gq[k]<<16), g1=__builtin_bit_cast(float,gq[k]&0xffff0000u), x0=__builtin_bit_cast(float,v[k]<<16), x1=__builtin_bit_cast(float,v[k]&0xffff0000u);
        w_[k]=cvtpk_s(x0*g0*__builtin_amdgcn_rcpf(1.f+__builtin_amdgcn_exp2f(-1.4426950408889634f*g0)), x1*g1*__builtin_amdgcn_rcpf(1.f+__builtin_amdgcn_exp2f(-1.4426950408889634f*g1))); }
      ATTN_STORE16(Ow+(long)row*OPITCH+ch*8,w_);} }
  asm volatile("s_waitcnt lgkmcnt(0)\n\ts_barrier":::"memory");
  #undef CBINIT
  #undef DMA_K
  #undef DMA_V
  #undef CMASK
  #undef START
  #undef RESC
  #undef ROT
}
constexpr int ATTN_LDS_BYTES=LDS_BYTES;
struct AttnTensors { const bf16* Q; const bf16* K; const bf16* V; const bf16* G; const float* CB; bf16* O; };
struct AttnUnit { int bh; int qb; };
struct QueueOrder {
  unsigned* ctr; volatile __attribute__((address_space(3))) unsigned* slot;
  __device__ __forceinline__ bool next(int,AttnUnit&u)const{
    if(threadIdx.x==0){ *slot=__hip_atomic_fetch_add(ctr,1u,__ATOMIC_RELAXED,__HIP_MEMORY_SCOPE_AGENT); }
    __syncthreads(); const unsigned t=*slot; __syncthreads();
    if(t>=(unsigned)(BATCH*NHEAD*NQB))return false; u.qb=NQB-1-(int)(t/(BATCH*NHEAD)); u.bh=(int)(t%(BATCH*NHEAD)); return true; }
  __device__ __forceinline__ void a_ready(const AttnUnit&)const{}
  __device__ __forceinline__ void done(const AttnUnit&)const{}
};
template<class Sched,int THRL=8> __device__ __forceinline__ void attn_phase(char*lds,const AttnTensors&T,const Sched&S){
  AttnUnit u;
  for(int i=0;S.next(i,u);++i){ S.a_ready(u); attn_unit<THRL>(u.bh/NHEAD,u.bh%NHEAD,u.qb,T.Q,T.K,T.V,T.G,T.CB,T.O,lds); S.done(u); }
}
#undef SBAR
#undef WAIT_BAR
}

__device__ __forceinline__ int src_col(int n) {
    if (n < 1024) { const int cp = n & 255; return (n & ~255) + 64 * ((cp >> 5) & 3) + 32 * (cp >> 7) + (cp & 31); }
    if (n < 1536) return n;
    if (n < UP) return n - UR + SR;
    if (n < UG) return -1;
    if (n < UF) return n - UG + SG;
    if (n < UF + 8) return n - UF + SF;
    return -2;
}
__device__ __forceinline__ void phase_weights(const Params& p, unsigned char* lds) {
    float (*tile)[65] = (float (*)[65])lds;
    const int tid = otid();
    constexpr int T_IN = (NU / 64) * (DM / 64), T_OUT = (DM / 64) * (DM / 64), PER_L = T_IN + T_OUT;
    for (int it = blockIdx.x; it < NL * PER_L; it += gridDim.x) {
        const int l = it / PER_L; int r = it % PER_L;
        if (r < T_IN) {
            const int nt = r / (DM / 64), kt = r % (DM / 64), n0 = nt * 64, k0 = kt * 64;
            const float* W = p.w_in + (size_t)l * DM * D_IN;
            for (int e = tid; e < 64 * 64; e += NTHREADS) {
                const int kk = e >> 6, nn = e & 63, n = n0 + nn, sc = src_col(n);
                float v = 0.f;
                if (sc >= 0) v = W[(size_t)(k0 + kk) * D_IN + sc];
                else if (sc == -1) {
                    const int g = (n - UP) >> 6, d = (n - UP) & 63;
                    const float* pw = p.pool_w + ((size_t)l * 4 + g) * 64 * 64;
                    const float* wr = W + (size_t)(k0 + kk) * D_IN + SP + g * 64;
                    float s = 0.f;
                    for (int cc = 0; cc < 64; ++cc) s += wr[cc] * pw[cc * 64 + d];
                    v = s;
                }
                tile[kk][nn] = v;
            }
            __syncthreads();
            bf16_t* WT = (bf16_t*)(p.ws + WS_WT) + (size_t)l * NU * DM;
            for (int e = tid; e < 64 * 32; e += NTHREADS) {
                const int nn = e >> 5, kp = (e & 31) * 2;
                *(unsigned*)(WT + (size_t)(n0 + nn) * DM + k0 + kp) = pk2(tile[kp][nn], tile[kp + 1][nn]);
            }
            __syncthreads();
        } else {
            r -= T_IN;
            const int nt = r / (DM / 64), kt = r % (DM / 64), n0 = nt * 64, k0 = kt * 64;
            const float* W = p.w_out + (size_t)l * DM * DM;
            for (int e = tid; e < 64 * 64; e += NTHREADS) { const int kk = e >> 6, nn = e & 63; tile[kk][nn] = W[(size_t)(k0 + kk) * DM + n0 + nn]; }
            __syncthreads();
            bf16_t* WOT = (bf16_t*)(p.ws + WS_WOT) + (size_t)l * DM * DM;
            for (int e = tid; e < 64 * 32; e += NTHREADS) {
                const int nn = e >> 5, kp = (e & 31) * 2;
                *(unsigned*)(WOT + (size_t)(n0 + nn) * DM + k0 + kp) = pk2(tile[kp][nn], tile[kp + 1][nn]);
            }
            __syncthreads();
        }
    }
}

__device__ __forceinline__ void phase_mod(const Params& p, unsigned char* lds) {
    float (*sc)[DM] = (float (*)[DM])lds;
    float (*red)[NB][64] = (float (*)[NB][64])(lds + 32768);
    const int tid = otid();
    if ((int)blockIdx.x >= NL * 48) return;
    for (int e = tid; e < NB * DM; e += NTHREADS) sc[e / DM][e % DM] = siluf_(p.c[e]);
    __syncthreads();
    float* mod = (float*)(p.ws + WS_MOD);
    const int kg = tid >> 6, cl = tid & 63;
    for (int it = blockIdx.x; it < NL * 48; it += gridDim.x) {
        const int l = it / 48, n = (it % 48) * 64 + cl;
        const float* W = p.ada_w + (size_t)l * DM * 3072 + n;
        float acc[NB];
#pragma unroll
        for (int b = 0; b < NB; ++b) acc[b] = 0.f;
#pragma unroll 8
        for (int k = kg * 128; k < kg * 128 + 128; ++k) {
            const float w = W[(size_t)k * 3072];
#pragma unroll
            for (int b = 0; b < NB; ++b) acc[b] += sc[b][k] * w;
        }
#pragma unroll
        for (int b = 0; b < NB; ++b) red[kg][b][cl] = acc[b];
        __syncthreads();
        {
            const int b = tid >> 6;
            float s = p.ada_b[l * 3072 + n];
#pragma unroll
            for (int g = 0; g < 8; ++g) s += red[g][b][cl];
            mod[((size_t)l * NB + b) * 3072 + n] = s;
        }
        __syncthreads();
    }
}

__device__ __forceinline__ void row_h_store(const f32x4 (&v)[4], float rinv, const float* npre, const float* mod_lb, bf16_t* xnrow, int lane) {
#pragma unroll
    for (int j = 0; j < 4; ++j) {
        const int c = j * 256 + lane * 4;
        const f32x4 g = *(const f32x4*)(npre + c), sh = *(const f32x4*)(mod_lb + c), scl = *(const f32x4*)(mod_lb + 1024 + c);
        f32x4 h;
#pragma unroll
        for (int i = 0; i < 4; ++i) h[i] = v[j][i] * rinv * g[i] * (1.f + scl[i]) + sh[i];
        u32x2 w; w.x = pk2(h[0], h[1]); w.y = pk2(h[2], h[3]);
        *(u32x2*)(xnrow + c) = w;
    }
}
__device__ __forceinline__ void phase_rows(const Params& p, int mode, int l) {
    const int tid = otid(), lane = tid & 63, wv = tid >> 6;
    const int gw = blockIdx.x * 8 + wv, ngw = gridDim.x * 8;
    const float* mod = (const float*)(p.ws + WS_MOD);
    bf16_t* XN = (bf16_t*)(p.ws + WS_XN);
    const float* Z = (const float*)(p.ws + WS_Z);
    for (int m = gw; m < MTOK; m += ngw) {
        const int b = m / SEQ;
        f32x4 v[4];
        if (mode == 0) {
#pragma unroll
            for (int j = 0; j < 4; ++j) v[j] = *(const f32x4*)(p.x + (size_t)m * DM + j * 256 + lane * 4);
            float s = 0.f;
#pragma unroll
            for (int j = 0; j < 4; ++j) s += v[j][0] * v[j][0] + v[j][1] * v[j][1] + v[j][2] * v[j][2] + v[j][3] * v[j][3];
            const float rinv = rsqrtf(wave_sum(s) * (1.f / DM) + 1e-6f);
            row_h_store(v, rinv, p.norm_pre, mod + ((size_t)0 * NB + b) * 3072, XN + (size_t)m * DM, lane);
        } else {
            f32x4 z[4];
#pragma unroll
            for (int j = 0; j < 4; ++j) z[j] = *(const f32x4*)(Z + (size_t)m * DM + j * 256 + lane * 4);
            float s = 0.f;
#pragma unroll
            for (int j = 0; j < 4; ++j) s += z[j][0] * z[j][0] + z[j][1] * z[j][1] + z[j][2] * z[j][2] + z[j][3] * z[j][3];
            const float rz = rsqrtf(wave_sum(s) * (1.f / DM) + 1e-6f);
            const float* xold = (l == 0) ? p.x : p.out;
            const float* mod_lb = mod + ((size_t)l * NB + b) * 3072;
            float s2 = 0.f;
#pragma unroll
            for (int j = 0; j < 4; ++j) {
                const int c = j * 256 + lane * 4;
                const f32x4 xo = *(const f32x4*)(xold + (size_t)m * DM + c), gp = *(const f32x4*)(p.norm_post + l * DM + c), gt = *(const f32x4*)(mod_lb + 2048 + c);
#pragma unroll
                for (int i = 0; i < 4; ++i) { v[j][i] = xo[i] + gt[i] * (z[j][i] * rz * gp[i]); s2 += v[j][i] * v[j][i]; }
                *(f32x4*)(p.out + (size_t)m * DM + c) = v[j];
            }
            if (l + 1 < NL) {
                const float rinv = rsqrtf(wave_sum(s2) * (1.f / DM) + 1e-6f);
                row_h_store(v, rinv, p.norm_pre + (l + 1) * DM, mod + ((size_t)(l + 1) * NB + b) * 3072, XN + (size_t)m * DM, lane);
            }
        }
    }
}

template <int MODE>
__device__ __forceinline__ void phase_gemm_simple(unsigned char* lds, const bf16_t* A, const bf16_t* Bt, void* Cout, int M, int N, int K, const float* qg, const float* kg) {
    bf16_t (*As)[40] = (bf16_t (*)[40])lds;
    bf16_t (*Bs)[40] = (bf16_t (*)[40])(lds + 128 * 40 * 2);
    const int tid = otid(), lane = tid & 63, wv = tid >> 6;
    const int ntn = N / 64, ntm = M / 128;
    for (int it = blockIdx.x; it < ntm * ntn; it += gridDim.x) {
        const int tm = it / ntn, tn = it % ntn, m0 = tm * 128, n0 = tn * 64;
        f32x4 acc[4];
#pragma unroll
        for (int n = 0; n < 4; ++n) acc[n] = (f32x4){0.f, 0.f, 0.f, 0.f};
        for (int k0 = 0; k0 < K; k0 += 32) {
            {
                const int r = tid >> 2, ch = tid & 3;
                *(u32x4*)(&As[r][ch * 8]) = *(const u32x4*)(A + (size_t)(m0 + r) * K + k0 + ch * 8);
                if (tid < 256) *(u32x4*)(&Bs[r][ch * 8]) = *(const u32x4*)(Bt + (size_t)(n0 + r) * K + k0 + ch * 8);
            }
            __syncthreads();
            const bf16x8 a = *(const bf16x8*)(&As[wv * 16 + (lane & 15)][(lane >> 4) * 8]);
#pragma unroll
            for (int n = 0; n < 4; ++n) {
                const bf16x8 b = *(const bf16x8*)(&Bs[n * 16 + (lane & 15)][(lane >> 4) * 8]);
                acc[n] = __builtin_amdgcn_mfma_f32_16x16x32_bf16(a, b, acc[n], 0, 0, 0);
            }
            __syncthreads();
        }
        if (MODE == 0) {
            bf16_t* C = (bf16_t*)Cout;
            float scale[4] = {1.f, 1.f, 1.f, 1.f};
            float gain[4] = {1.f, 1.f, 1.f, 1.f};
            if (n0 < 1024) {
#pragma unroll
                for (int r = 0; r < 4; ++r) {
                    float s = acc[0][r] * acc[0][r] + acc[1][r] * acc[1][r] + acc[2][r] * acc[2][r] + acc[3][r] * acc[3][r];
                    s += __shfl_xor(s, 1); s += __shfl_xor(s, 2); s += __shfl_xor(s, 4); s += __shfl_xor(s, 8);
                    scale[r] = rsqrtf(s * (1.f / 64.f) + 1e-6f) * (n0 < 512 ? C2 : 1.f);
                }
#pragma unroll
                for (int n = 0; n < 4; ++n) gain[n] = (n0 < 512 ? qg : kg)[n * 16 + (lane & 15)];
            }
#pragma unroll
            for (int n = 0; n < 4; ++n)
#pragma unroll
                for (int r = 0; r < 4; ++r)
                    C[(size_t)(m0 + wv * 16 + (lane >> 4) * 4 + r) * N + n0 + n * 16 + (lane & 15)] = (bf16_t)f2bf(acc[n][r] * scale[r] * gain[n]);
        } else {
            float* C = (float*)Cout;
#pragma unroll
            for (int n = 0; n < 4; ++n)
#pragma unroll
                for (int r = 0; r < 4; ++r) C[(size_t)(m0 + wv * 16 + (lane >> 4) * 4 + r) * N + n0 + n * 16 + (lane & 15)] = acc[n][r];
        }
    }
}

__device__ __forceinline__ void phase_cum(const Params& p, int l, unsigned char* lds) {
    float (*wtot)[8] = (float (*)[8])lds;
    const int tid = otid(), lane = tid & 63, wv = tid >> 6;
    const bf16_t* U = (const bf16_t*)(p.ws + WS_U);
    float* CB = (float*)(p.ws + WS_CB);
    for (int b = blockIdx.x; b < NB; b += gridDim.x) {
        float pre[8][8];
        float run[8];
#pragma unroll
        for (int h = 0; h < 8; ++h) run[h] = 0.f;
#pragma unroll
        for (int i = 0; i < 8; ++i) {
            const u32x4 w = *(const u32x4*)(U + (size_t)(b * SEQ + tid * 8 + i) * NU + UF);
            float f[8] = {bflo(w.x), bfhi(w.x), bflo(w.y), bfhi(w.y), bflo(w.z), bfhi(w.z), bflo(w.w), bfhi(w.w)};
#pragma unroll
            for (int h = 0; h < 8; ++h) {
                const float xx = f[h] + p.f_bias[l * 8 + h];
                const float ls = fminf(xx, 0.f) - __logf(1.f + __expf(-fabsf(xx)));
                run[h] += -ls * LOG2E;
                pre[i][h] = run[h];
            }
        }
        float exc[8];
#pragma unroll
        for (int h = 0; h < 8; ++h) {
            float v = run[h];
#pragma unroll
            for (int o = 1; o < 64; o <<= 1) { const float t = __shfl_up(v, o); if (lane >= o) v += t; }
            if (lane == 63) wtot[wv][h] = v;
            exc[h] = v - run[h];
        }
        __syncthreads();
#pragma unroll
        for (int h = 0; h < 8; ++h) { float base = 0.f; for (int w2 = 0; w2 < wv; ++w2) base += wtot[w2][h]; exc[h] += base; }
#pragma unroll
        for (int h = 0; h < 8; ++h)
#pragma unroll
            for (int i = 0; i < 8; ++i) CB[((size_t)b * 8 + h) * SEQ + tid * 8 + i] = exc[h] + pre[i][h];
        __syncthreads();
    }
}

typedef _Float16 h8 __attribute__((ext_vector_type(8)));
typedef _Float16 h4 __attribute__((ext_vector_type(4)));
typedef float f32x2 __attribute__((ext_vector_type(2)));
template <int CTRL> __device__ __forceinline__ float dpp_add(float x) {
    const int y = __builtin_amdgcn_update_dpp(0, __builtin_bit_cast(int, x), CTRL, 0xF, 0xF, true);
    return x + __builtin_bit_cast(float, y);
}
__device__ __forceinline__ float row16_sum(float x) {
    x = dpp_add<0xB1>(x); x = dpp_add<0x4E>(x); x = dpp_add<0x141>(x); x = dpp_add<0x140>(x); return x;
}
__device__ __forceinline__ float wave_sum_fast(float x) {
    x = row16_sum(x);
    { const unsigned xi = __builtin_bit_cast(unsigned, x); auto rr = __builtin_amdgcn_permlane16_swap(xi, xi, false, false); const unsigned r0 = rr[0], r1 = rr[1]; x = __builtin_bit_cast(float, r0) + __builtin_bit_cast(float, r1); }
    { const unsigned xi = __builtin_bit_cast(unsigned, x); auto rr = __builtin_amdgcn_permlane32_swap(xi, xi, false, false); const unsigned r0 = rr[0], r1 = rr[1]; x = __builtin_bit_cast(float, r0) + __builtin_bit_cast(float, r1); }
    return x;
}
__device__ __forceinline__ f32x4 mma_nt16(f32x4 acc, const LAS unsigned char* A, int pa, const LAS unsigned char* Bt, int pb, int K, int lane) {
    const LAS unsigned char* ap = A + (lane & 15) * pa + (lane >> 4) * 16;
    const LAS unsigned char* bp = Bt + (lane & 15) * pb + (lane >> 4) * 16;
#pragma unroll
    for (int k = 0; k < K; k += 32) {
        const bf16x8 a = *(const LAS bf16x8*)(ap + 2 * k), b = *(const LAS bf16x8*)(bp + 2 * k);
        acc = __builtin_amdgcn_mfma_f32_16x16x32_bf16(a, b, acc, 0, 0, 0);
    }
    return acc;
}
constexpr int CK_W2T = 0, CK_A2T = 9216, CK_XW = 18432, CK_XA = 23040, CK_SWF = 27648, CK_SAF = 35968, CK_TOT = 44288, CK_EGL = 46336;
constexpr int CK_KT = 46592, CK_RT = 51200, CK_BH = 55808, CK_KH = 60416, CK_RHS = 65024, CK_VT = 81920, CK_BBT = 87040, CK_KBT = 92160, CK_LF = 97280;
constexpr int CK_AAK = 101888, CK_AQB = 104448, CK_AQK = 107008, CK_W1T = 109568, CK_W2N = 114688, CK_OUT = 119808;
constexpr int P72 = 144, P40 = 80, PSF = 65 * 4, PRHS = 132 * 4, PLF = 36 * 4;
__device__ __forceinline__ void phase_rwkv_chunk(const Params& p, int l, unsigned char* lds_) {
    LAS unsigned char* lds = (LAS unsigned char*)lds_;
    const int tid = otid(), lane = tid & 63, wv = __builtin_amdgcn_readfirstlane(tid >> 6);
    const int h = (int)blockIdx.x & 3, c = h * 64 + lane;
    const bf16_t* U = (const bf16_t*)(p.ws + WS_U);
    float* BON = (float*)(p.ws + WS_BON);
    unsigned char* CHK = p.ws + WS_CHK;
    for (int e = tid; e < 2 * 64 * 64; e += NTHREADS) {
        const int which = e >> 12, k = (e >> 6) & 63, cc = e & 63;
        const float v = (which ? p.a2 : p.w2)[((size_t)l * 64 + k) * 256 + h * 64 + cc];
        *(LAS bf16_t*)(lds + (which ? CK_A2T : CK_W2T) + cc * P72 + k * 2) = (bf16_t)f2bf(v);
    }
    const float mur = p.mu[l * 896 + c], muk = p.mu[l * 896 + 256 + c], muv = p.mu[l * 896 + 512 + c], muw = p.mu[l * 896 + 768 + lane], mua = p.mu[l * 896 + 832 + lane];
    const float w0c = p.w0[l * 256 + c], a0c = p.a0[l * 256 + c], kkc = p.k_k[l * 256 + c], kac = p.k_a[l * 256 + c], rkc = p.r_k[l * 256 + c];
    const int fr = lane & 15, fq = lane >> 4;
    unsigned short xr[5], xk[5], xv[5], xw_[5], xa_[5];
#define CK_LOAD(qq) do { const int b_ = (qq) / NCHK, ch_ = (qq) % NCHK; const bf16_t* ub = U + ((size_t)b_ * SEQ + ch_ * 32 + 4 * wv) * NU + UR; const bool first_ = (ch_ == 0 && wv == 0); \
        _Pragma("unroll") for (int u = 0; u < 5; ++u) { const bf16_t* q_ = ub + (ptrdiff_t)(u - 1 + ((u == 0 && first_) ? 1 : 0)) * NU; \
            xr[u] = q_[c]; xk[u] = q_[256 + c]; xv[u] = q_[512 + c]; xw_[u] = q_[768 + lane]; xa_[u] = q_[832 + lane]; } } while (0)
    if (((int)blockIdx.x >> 2) < NB * NCHK) CK_LOAD((int)blockIdx.x >> 2);
    for (int q = (int)blockIdx.x >> 2; q < NB * NCHK; q += (int)gridDim.x >> 2) {
        const int b = q / NCHK, ch = q % NCHK;
        int lz_ = 0; asm volatile("" : "+v"(lz_)); LAS unsigned char* L_ = lds + lz_;
        const size_t m0 = (size_t)b * SEQ + ch * 32;
        float rl[4], kl[4], vl[4];
        {
            const bool first = (ch == 0 && wv == 0);
#pragma unroll
            for (int u = 0; u < 4; ++u) {
                const float pz = (u == 0 && first) ? 0.f : 1.f;
                const float rc = bf2f(xr[u + 1]), kc = bf2f(xk[u + 1]), vc = bf2f(xv[u + 1]), wc = bf2f(xw_[u + 1]), ac = bf2f(xa_[u + 1]);
                rl[u] = rc + (bf2f(xr[u]) * pz - rc) * mur; kl[u] = kc + (bf2f(xk[u]) * pz - kc) * muk; vl[u] = vc + (bf2f(xv[u]) * pz - vc) * muv;
                const float wl = wc + (bf2f(xw_[u]) * pz - wc) * muw, al = ac + (bf2f(xa_[u]) * pz - ac) * mua;
                const int t = 4 * wv + u;
                *(LAS bf16_t*)(L_ + CK_XW + t * P72 + lane * 2) = (bf16_t)f2bf(tanhf(wl));
                *(LAS bf16_t*)(L_ + CK_XA + t * P72 + lane * 2) = (bf16_t)f2bf(al);
            }
            const int qn = q + ((int)gridDim.x >> 2);
            if (qn < NB * NCHK) CK_LOAD(qn);
        }
        __syncthreads();
        {
            const int mi = wv >> 2, tr = (wv >> 1) & 1;
#pragma unroll
            for (int i = 0; i < 2; ++i) {
                const int tc = 2 * (wv & 1) + i;
                f32x4 acc = {0.f, 0.f, 0.f, 0.f};
                acc = mma_nt16(acc, L_ + (mi ? CK_XA : CK_XW) + 16 * tr * P72, P72, L_ + (mi ? CK_A2T : CK_W2T) + 16 * tc * P72, P72, 64, lane);
#pragma unroll
                for (int r = 0; r < 4; ++r) *(LAS float*)(L_ + (mi ? CK_SAF : CK_SWF) + (16 * tr + 4 * fq + r) * PSF + (16 * tc + fr) * 4) = acc[r];
            }
        }
        __syncthreads();
        float lw[4], kkv[4], ktv[4], bbv[4], gl[4];
        {
            float run = 0.f;
#pragma unroll
            for (int u = 0; u < 4; ++u) {
                const int t = 4 * wv + u;
                const float sw = *(const LAS float*)(L_ + CK_SWF + t * PSF + lane * 4) + w0c, sa = *(const LAS float*)(L_ + CK_SAF + t * PSF + lane * 4) + a0c;
                lw[u] = -DECAY_SCALE * sigmoidf_(sw);
                const float a = sigmoidf_(sa);
                const float kx = kl[u] * kkc;
                kkv[u] = kx / fmaxf(sqrtf(wave_sum_fast(kx * kx)), 1e-12f);
                ktv[u] = kl[u] * (1.f + (a - 1.f) * kac); bbv[u] = kkv[u] * a;
                const float bs = wave_sum_fast(rl[u] * ktv[u] * rkc);
                if (lane == 0) BON[(m0 + t) * 4 + h] = bs;
                run += lw[u]; gl[u] = run;
            }
            *(LAS float*)(L_ + CK_TOT + (wv * 64 + lane) * 4) = run;
        }
        __syncthreads();
        {
            float off = 0.f, tot = 0.f;
#pragma unroll
            for (int g = 0; g < 8; ++g) { const float x = *(const LAS float*)(L_ + CK_TOT + (g * 64 + lane) * 4); tot += x; off += (g < wv) ? x : 0.f; }
            if (wv == 0) *(LAS float*)(L_ + CK_EGL + lane * 4) = __expf(tot);
            unsigned vp[2], bp[2], kp[2];
#pragma unroll
            for (int u = 0; u < 4; ++u) {
                const int t = 4 * wv + u;
                const float G = off + gl[u];
                const float e1 = __expf(G - lw[u]), e2 = __expf(G), inv = __expf(-G), el = __expf(tot - G);
                const float ktl = kkv[u] * e1;
                *(LAS bf16_t*)(L_ + CK_KT + t * P72 + lane * 2) = (bf16_t)f2bf(ktl);
                *(LAS float*)(L_ + CK_RHS + t * PRHS + lane * 4) = ktl;
                *(LAS bf16_t*)(L_ + CK_RT + t * P72 + lane * 2) = (bf16_t)f2bf(rl[u] * e2);
                *(LAS bf16_t*)(L_ + CK_BH + t * P72 + lane * 2) = (bf16_t)f2bf(bbv[u] * inv);
                *(LAS bf16_t*)(L_ + CK_KH + t * P72 + lane * 2) = (bf16_t)f2bf(ktv[u] * inv);
                const unsigned vb = f2bf(vl[u]), bb_ = f2bf(bbv[u] * el), kb_ = f2bf(ktv[u] * el);
                if (u & 1) { vp[u >> 1] |= vb << 16; bp[u >> 1] |= bb_ << 16; kp[u >> 1] |= kb_ << 16; } else { vp[u >> 1] = vb; bp[u >> 1] = bb_; kp[u >> 1] = kb_; }
            }
            *(LAS u32x2*)(L_ + CK_VT + lane * P40 + wv * 8) = (u32x2){vp[0], vp[1]};
            *(LAS u32x2*)(L_ + CK_BBT + lane * P40 + wv * 8) = (u32x2){bp[0], bp[1]};
            *(LAS u32x2*)(L_ + CK_KBT + lane * P40 + wv * 8) = (u32x2){kp[0], kp[1]};
        }
        __syncthreads();
        {
            const int mi = wv >> 1, tr = wv & 1;
            const LAS unsigned char* A = L_ + ((mi < 2) ? CK_KT : CK_RT) + 16 * tr * P72;
            const LAS unsigned char* Bm = L_ + ((mi & 1) ? CK_KH : CK_BH);
#pragma unroll
            for (int tc = 0; tc < 2; ++tc) {
                f32x4 acc = {0.f, 0.f, 0.f, 0.f};
                acc = mma_nt16(acc, A, P72, Bm + 16 * tc * P72, P72, 64, lane);
#pragma unroll
                for (int r = 0; r < 4; ++r) {
                    const int t = 16 * tr + 4 * fq + r, s_ = 16 * tc + fr;
                    const float x = (mi < 2 ? (s_ < t) : (s_ <= t)) ? acc[r] : 0.f;
                    if (mi == 0) *(LAS float*)(L_ + CK_LF + s_ * PLF + t * 4) = x;
                    else *(LAS bf16_t*)(L_ + (mi == 1 ? CK_AAK : (mi == 2 ? CK_AQB : CK_AQK)) + t * P40 + s_ * 2) = (bf16_t)f2bf(x);
                }
            }
        }
        __syncthreads();
        {
            const int tr = wv >> 2, ic = wv & 3;
            f32x4 acc = {0.f, 0.f, 0.f, 0.f};
            acc = mma_nt16(acc, L_ + CK_AAK + 16 * tr * P40, P40, L_ + CK_VT + 16 * ic * P40, P40, 32, lane);
#pragma unroll
            for (int r = 0; r < 4; ++r) *(LAS float*)(L_ + CK_RHS + (16 * tr + 4 * fq + r) * PRHS + (64 + 16 * ic + fr) * 4) = acc[r];
        }
        __syncthreads();
        {
            const int col = tid >> 2, part = tid & 3;
            LAS unsigned char* colp = L_ + CK_RHS + col * 4;
#pragma unroll 1
            for (int B = 0; B < 4; ++B) {
                float acc[8];
#pragma unroll
                for (int i = 0; i < 8; ++i) acc[i] = (part == 0) ? *(const LAS float*)(colp + (8 * B + i) * PRHS) : 0.f;
#pragma unroll 2
                for (int s_ = part; s_ < 8 * B; s_ += 4) {
                    const float ws = *(const LAS float*)(colp + s_ * PRHS);
                    const f32x4 l0 = *(const LAS f32x4*)(L_ + CK_LF + s_ * PLF + (8 * B) * 4), l1 = *(const LAS f32x4*)(L_ + CK_LF + s_ * PLF + (8 * B + 4) * 4);
#pragma unroll
                    for (int i = 0; i < 4; ++i) { acc[i] -= l0[i] * ws; acc[4 + i] -= l1[i] * ws; }
                }
#pragma unroll
                for (int i = 0; i < 8; ++i) { acc[i] = dpp_add<0xB1>(acc[i]); acc[i] = dpp_add<0x4E>(acc[i]); }
                f32x4 lb[7][2];
#pragma unroll
                for (int i = 0; i < 7; ++i) { lb[i][0] = *(const LAS f32x4*)(L_ + CK_LF + (8 * B + i) * PLF + (8 * B) * 4); lb[i][1] = *(const LAS f32x4*)(L_ + CK_LF + (8 * B + i) * PLF + (8 * B + 4) * 4); }
#pragma unroll
                for (int i = 0; i < 7; ++i)
#pragma unroll
                    for (int i2 = i + 1; i2 < 8; ++i2) acc[i2] -= lb[i][i2 >> 2][i2 & 3] * acc[i];
                if (part == 0) {
#pragma unroll
                    for (int i = 0; i < 8; ++i) *(LAS float*)(colp + (8 * B + i) * PRHS) = acc[i];
                }
                if (part == 0) {
                    u32x4 w; w.x = pk2(-acc[0], -acc[1]); w.y = pk2(-acc[2], -acc[3]); w.z = pk2(-acc[4], -acc[5]); w.w = pk2(-acc[6], -acc[7]);
                    *(LAS u32x4*)(L_ + (col < 64 ? CK_W1T : CK_W2N) + (col & 63) * P40 + B * 16) = w;
                }
                asm volatile("s_waitcnt lgkmcnt(0)" ::: "memory");
            }
        }
        __syncthreads();
        {
            {
                const int tr = wv >> 2, cc = wv & 3;
                f32x4 acc;
#pragma unroll
                for (int r = 0; r < 4; ++r) acc[r] = bf2f(*(const LAS bf16_t*)(L_ + CK_RT + (16 * tr + 4 * fq + r) * P72 + (16 * cc + fr) * 2));
                acc = mma_nt16(acc, L_ + CK_AQB + 16 * tr * P40, P40, L_ + CK_W1T + 16 * cc * P40, P40, 32, lane);
#pragma unroll
                for (int r = 0; r < 4; ++r) *(LAS bf16_t*)(L_ + CK_OUT + (16 * tr + 4 * fq + r) * 128 + (16 * cc + fr) * 2) = (bf16_t)f2bf(acc[r]);
                f32x4 ac2 = {0.f, 0.f, 0.f, 0.f};
                ac2 = mma_nt16(ac2, L_ + CK_AQK + 16 * tr * P40, P40, L_ + CK_VT + 16 * cc * P40, P40, 32, lane);
                ac2 = mma_nt16(ac2, L_ + CK_AQB + 16 * tr * P40, P40, L_ + CK_W2N + 16 * cc * P40, P40, 32, lane);
#pragma unroll
                for (int r = 0; r < 4; ++r) *(LAS bf16_t*)(L_ + CK_OUT + 4096 + (16 * tr + 4 * fq + r) * 128 + (16 * cc + fr) * 2) = (bf16_t)f2bf(ac2[r]);
            }
#pragma unroll
            for (int i = 0; i < 2; ++i) {
                const int tl = 2 * wv + i, rr = tl >> 2, cc = tl & 3;
                f32x4 acc = {0.f, 0.f, 0.f, 0.f};
                acc = mma_nt16(acc, L_ + CK_BBT + 16 * rr * P40, P40, L_ + CK_W1T + 16 * cc * P40, P40, 32, lane);
#pragma unroll
                for (int r = 0; r < 4; ++r) { const int jp = 16 * rr + 4 * fq + r, j = 16 * cc + fr;
                    const float x = acc[r] + ((jp == j) ? *(const LAS float*)(L_ + CK_EGL + j * 4) : 0.f);
                    *(LAS bf16_t*)(L_ + CK_OUT + 8192 + jp * 128 + j * 2) = (bf16_t)f2bf(x); }
                f32x4 ac2 = {0.f, 0.f, 0.f, 0.f};
                ac2 = mma_nt16(ac2, L_ + CK_VT + 16 * rr * P40, P40, L_ + CK_KBT + 16 * cc * P40, P40, 32, lane);
                ac2 = mma_nt16(ac2, L_ + CK_W2N + 16 * rr * P40, P40, L_ + CK_BBT + 16 * cc * P40, P40, 32, lane);
#pragma unroll
                for (int r = 0; r < 4; ++r) *(LAS bf16_t*)(L_ + CK_OUT + 16384 + (16 * rr + 4 * fq + r) * 128 + (16 * cc + fr) * 2) = (bf16_t)f2bf(ac2[r]);
            }
        }
        __syncthreads();
        {
            unsigned char* dst = CHK + ((size_t)(b * 4 + h) * NCHK + ch) * CHK_B;
#pragma unroll
            for (int i = 0; i < 3; ++i) *(u32x4*)(dst + (i * NTHREADS + tid) * 16) = *(const LAS u32x4*)(L_ + CK_OUT + (i * NTHREADS + tid) * 16);
        }
        __syncthreads();
    }
}

#undef CK_LOAD
__device__ __forceinline__ void glds16g(const void* gsrc, unsigned lds_dst) { unsigned keep;
    asm volatile("s_mov_b32 %0, m0\n\ts_mov_b32 m0, %2\n\ts_nop 0\n\tglobal_load_lds_dwordx4 %1, off\n\ts_mov_b32 m0, %0" : "=&s"(keep) : "v"(gsrc), "s"(lds_dst) : "memory"); }
constexpr int CN_NBUF = 5, CN_RING = 0, CN_SB = CN_NBUF * CHK_B;
__device__ __forceinline__ void phase_rwkv_chain(const Params& p, unsigned char* lds_, int bh) {
    LAS unsigned char* lds = (LAS unsigned char*)lds_;
    const int tid = otid(), lane = tid & 63, wv = __builtin_amdgcn_readfirstlane(tid >> 6);
    const int fr = lane & 15, fq = lane >> 4, b = bh >> 2, h = bh & 3;
    const unsigned char* rec = p.ws + WS_CHK + (size_t)bh * NCHK * CHK_B;
    float* O32 = (float*)(p.ws + WS_O32);
    const unsigned lds0 = (unsigned)(size_t)lds;
#define CN_DMA(cc) do { const unsigned char* g = rec + (size_t)(cc) * CHK_B + tid * 16; const unsigned d = (unsigned)__builtin_amdgcn_readfirstlane((int)(lds0 + CN_RING + ((cc) % CN_NBUF) * CHK_B + wv * 1024)); \
        glds16g(g, d); glds16g(g + 8192, d + 8192); glds16g(g + 16384, d + 16384); } while (0)
    for (int e = tid; e < 2 * 64 * 72 / 2; e += NTHREADS) *(LAS unsigned*)(lds + CN_SB + e * 4) = 0u;
    CN_DMA(0); CN_DMA(1); CN_DMA(2); CN_DMA(3);
    asm volatile("s_waitcnt vmcnt(0) lgkmcnt(0)\n\ts_barrier" ::: "memory");
#pragma unroll 1
    for (int cc = 0; cc < NCHK; ++cc) {
        if (cc + 4 < NCHK) CN_DMA(cc + 4);
        int lz_ = 0; asm volatile("" : "+v"(lz_)); LAS unsigned char* L_ = lds + lz_;
        const LAS unsigned char* R = L_ + CN_RING + (cc % CN_NBUF) * CHK_B;
        const LAS unsigned char* Sc = L_ + CN_SB + (cc & 1) * (64 * P72);
        LAS unsigned char* Sn = L_ + CN_SB + ((cc + 1) & 1) * (64 * P72);
        {
            const int tr = wv >> 2, ic = wv & 3;
            f32x4 acc;
#pragma unroll
            for (int r = 0; r < 4; ++r) acc[r] = bf2f(*(const LAS bf16_t*)(R + 4096 + (16 * tr + 4 * fq + r) * 128 + (16 * ic + fr) * 2));
            acc = mma_nt16(acc, R + 16 * tr * 128, 128, Sc + 16 * ic * P72, P72, 64, lane);
            float* op = O32 + ((size_t)b * SEQ + cc * 32 + 16 * tr + 4 * fq) * 256 + h * 64 + 16 * ic + fr;
#pragma unroll
            for (int r = 0; r < 4; ++r) op[(size_t)r * 256] = acc[r];
        }
#pragma unroll
        for (int i = 0; i < 2; ++i) {
            const int tl = 2 * wv + i, ir = tl >> 2, jc = tl & 3;
            f32x4 acc;
#pragma unroll
            for (int r = 0; r < 4; ++r) acc[r] = bf2f(*(const LAS bf16_t*)(R + 16384 + (16 * ir + 4 * fq + r) * 128 + (16 * jc + fr) * 2));
            acc = mma_nt16(acc, Sc + 16 * ir * P72, P72, R + 8192 + 16 * jc * 128, 128, 64, lane);
#pragma unroll
            for (int r = 0; r < 4; ++r) *(LAS bf16_t*)(Sn + (16 * ir + 4 * fq + r) * P72 + (16 * jc + fr) * 2) = (bf16_t)f2bf(acc[r]);
        }
        if (cc + 4 < NCHK) asm volatile("s_waitcnt vmcnt(9) lgkmcnt(0)\n\ts_barrier" ::: "memory");
        else asm volatile("s_waitcnt vmcnt(0) lgkmcnt(0)\n\ts_barrier" ::: "memory");
    }
#undef CN_DMA
}

__device__ __forceinline__ void phase_rwkv_fin(const Params& p, int l) {
    const int tid = otid(), lane = tid & 63, wv = tid >> 6;
    const bf16_t* U = (const bf16_t*)(p.ws + WS_U);
    const float* O32 = (const float*)(p.ws + WS_O32); const float* BON = (const float*)(p.ws + WS_BON);
    bf16_t* Y = (bf16_t*)(p.ws + WS_Y);
    const int ngw = gridDim.x * 8;
    for (int m2 = blockIdx.x * 8 + wv; m2 < MTOK / 2; m2 += ngw) {
        float o[8], vc[8], vp[8], g[8], bn[8];
#pragma unroll
        for (int k = 0; k < 8; ++k) {
            const int m = 2 * m2 + (k >> 2), h = k & 3, c = h * 64 + lane;
            const bool has_prev = (m % SEQ) != 0;
            o[k] = O32[(size_t)m * 256 + c];
            vc[k] = bf2f(U[(size_t)m * NU + UR + 512 + c]);
            vp[k] = has_prev ? bf2f(U[(size_t)(m - 1) * NU + UR + 512 + c]) : 0.f;
            g[k] = bf2f(U[(size_t)m * NU + UG + 512 + c]);
            bn[k] = BON[(size_t)m * 4 + h];
        }
#pragma unroll
        for (int k = 0; k < 8; ++k) {
            const int m = 2 * m2 + (k >> 2), h = k & 3, c = h * 64 + lane;
            const float mean = wave_sum_fast(o[k]) * (1.f / 64.f);
            const float dv = o[k] - mean;
            const float var = wave_sum_fast(dv * dv) * (1.f / 64.f);
            const float v = vc[k] + (vp[k] - vc[k]) * p.mu[l * 896 + 512 + c];
            const float on = dv * rsqrtf(var + 64e-5f) * p.ln_g[l * 256 + c] + p.ln_b[l * 256 + c] + bn[k] * v;
            Y[(size_t)m * DM + 512 + c] = (bf16_t)f2bf(on * g[k] * __builtin_amdgcn_rcpf(1.f + __expf(-g[k])));
        }
    }
}

template <int W> __device__ __forceinline__ void pool_item(const bf16_t* up, bf16_t* yp, int t0, float scl) {
    unsigned short xc[16], xp[W - 1], gg[16];
#pragma unroll
    for (int i = 0; i < 16; ++i) { xc[i] = up[(size_t)i * NU]; gg[i] = up[(size_t)i * NU + (UG + 768 - UP)]; }
#pragma unroll
    for (int d = 1; d < W; ++d) xp[d - 1] = (t0 - d >= 0) ? up[-(ptrdiff_t)d * NU] : (unsigned short)0;
    float s = 0.f;
#pragma unroll
    for (int d = 1; d < W; ++d) s += bf2f(xp[d - 1]);
#pragma unroll
    for (int i = 0; i < 16; ++i) {
        const int t = t0 + i;
        const float cur = bf2f(xc[i]);
        s += cur;
        const int cnt = (t + 1 < W) ? t + 1 : W;
        const float yv = (s * __builtin_amdgcn_rcpf((float)cnt) - cur) * scl;
        const float gv = bf2f(gg[i]);
        yp[(size_t)i * DM] = (bf16_t)f2bf(yv * gv * __builtin_amdgcn_rcpf(1.f + __expf(-gv)));
        const int k = i - W + 1;
        s -= (k >= 0) ? bf2f(xc[k >= 0 ? k : 0]) : bf2f(xp[k < 0 ? -k - 1 : 0]);
    }
}
__device__ __forceinline__ void phase_pool(const Params& p, int l) {
    const bf16_t* U = (const bf16_t*)(p.ws + WS_U);
    bf16_t* Y = (bf16_t*)(p.ws + WS_Y);
    const int tid = otid(), c = tid & 255, sub = tid >> 8, g = __builtin_amdgcn_readfirstlane(c >> 6);
    const float scl = p.pool_scale[l * 256 + c];
    for (int it = blockIdx.x * 2 + sub; it < MTOK / 16; it += gridDim.x * 2) {
        const int m0 = it * 16, t0 = m0 % SEQ;
        const bf16_t* up = U + (size_t)m0 * NU + UP + c;
        bf16_t* yp = Y + (size_t)m0 * DM + 768 + c;
        if (g == 0) pool_item<2>(up, yp, t0, scl); else if (g == 1) pool_item<4>(up, yp, t0, scl); else if (g == 2) pool_item<8>(up, yp, t0, scl); else pool_item<16>(up, yp, t0, scl);
    }
}

__global__ void __launch_bounds__(NTHREADS, 2) mega_fwd(Params p) {
    extern __shared__ __attribute__((aligned(16))) unsigned char lds[];
    volatile LAS unsigned* MISC = (volatile LAS unsigned*)((LAS unsigned char*)lds + MISC_OFF);
    if (threadIdx.x < 32) MISC[threadIdx.x] = 0u;
    __syncthreads();
    XcdBarrier bar = xcd_barrier_post((unsigned*)(p.ws + WS_CTL) + CW_BAR, MISC + 8);
#define GRID_BAR() do { XcdBarrier b_ = bar; unsigned* bp_ = (unsigned*)(p.ws + WS_CTL) + CW_BAR; asm volatile("" : "+s"(bp_)); b_.bar = bp_; xcd_barrier(b_); } while (0)
    bf16_t* XN = (bf16_t*)(p.ws + WS_XN); bf16_t* Y = (bf16_t*)(p.ws + WS_Y); bf16_t* U = (bf16_t*)(p.ws + WS_U); float* Z = (float*)(p.ws + WS_Z);

    phase_weights(p, lds);
    phase_mod(p, lds);
    GRID_BAR();
    phase_rows(p, 0, 0);
    GRID_BAR();
#pragma unroll 1
    for (int l = 0; l < NL; ++l) {
        const bf16_t* WT = (const bf16_t*)(p.ws + WS_WT) + (size_t)l * NU * DM;
        const bf16_t* WOT = (const bf16_t*)(p.ws + WS_WOT) + (size_t)l * DM * DM;
        {
            pg8::Gemm g{XN, WT, MTOK, NU, DM}; pg8::StaticOrder S; S.init(MTOK, NU, (int)gridDim.x, (int)blockIdx.x);
            pg8::EpiU E{U, p.q_gain + l * 64, p.k_gain + l * 64, NU};
            pg8::gemm_phase<pg8::EpiU, pg8::StaticOrder, true, true>((LAS unsigned char*)lds, g, S, E);
        }
        GRID_BAR();
        phase_cum(p, l, lds);
        phase_rwkv_chunk(p, l, lds);
        phase_pool(p, l);
        GRID_BAR();
        if (blockIdx.x < NB * 4) phase_rwkv_chain(p, lds, (int)blockIdx.x);
        {
            const attn_body::AttnTensors AT{(const attn_body::bf16*)(U + UQ), (const attn_body::bf16*)(U + UK), (const attn_body::bf16*)(U + UV), (const attn_body::bf16*)(U + UG),
                                            (const float*)(p.ws + WS_CB), (attn_body::bf16*)Y};
            const attn_body::QueueOrder S{(unsigned*)(p.ws + WS_CTL) + CW_ATTQ + l * 64, MISC + 16};
            attn_body::attn_phase<attn_body::QueueOrder>((char*)lds, AT, S);
        }
        GRID_BAR();
        phase_rwkv_fin(p, l);
        GRID_BAR();
        {
            pg8::Gemm g{Y, WOT, MTOK, DM, DM}; pg8::StaticOrder S; S.init(MTOK, DM, (int)gridDim.x, (int)blockIdx.x);
            pg8::EpiF32 E{Z, DM};
            pg8::gemm_phase<pg8::EpiF32, pg8::StaticOrder, true, true>((LAS unsigned char*)lds, g, S, E);
        }
        GRID_BAR();
        phase_rows(p, 1, l);
        if (l + 1 < NL) GRID_BAR();
    }
}

extern "C" void kernel_launch(void* const* d_in, const int* in_sizes, int n_in, void* d_out, int out_size, void* d_ws, size_t ws_size, hipStream_t stream) {
    static int grid = 0;
    if (grid == 0) {
        if (n_in != 23 || ws_size < WS_END) { fprintf(stderr, "kernel_launch: unexpected n_in %d / ws_size %zu\n", n_in, ws_size); grid = -1; return; }
        int dev = 0, cus = 0, per_cu = 0;
        if (hipGetDevice(&dev) != hipSuccess || hipDeviceGetAttribute(&cus, hipDeviceAttributeMultiprocessorCount, dev) != hipSuccess) { grid = -1; return; }
        if (hipFuncSetAttribute((const void*)mega_fwd, hipFuncAttributeMaxDynamicSharedMemorySize, LDS_BYTES) != hipSuccess) { fprintf(stderr, "kernel_launch: hipFuncSetAttribute failed\n"); grid = -1; return; }
        if (hipOccupancyMaxActiveBlocksPerMultiprocessor(&per_cu, (const void*)mega_fwd, NTHREADS, LDS_BYTES) != hipSuccess || per_cu < 1) { fprintf(stderr, "kernel_launch: occupancy query failed (%d)\n", per_cu); grid = -1; return; }
        grid = cus;
        if (grid <= NB * 8) { fprintf(stderr, "kernel_launch: grid %d too small\n", grid); grid = -1; return; }
    }
    if (grid < 0) return;
    (void)hipMemsetAsync((char*)d_ws + WS_CTL, 0, CTL_ZERO_BYTES, stream);
    Params p{};
    const float** f = (const float**)&p;
    for (int i = 0; i < 23; ++i) f[i] = (const float*)d_in[i];
    p.out = (float*)d_out; p.ws = (unsigned char*)d_ws;
    void* args[] = {&p};
    hipError_t e = hipLaunchCooperativeKernel((const void*)mega_fwd, dim3(grid), dim3(NTHREADS), args, LDS_BYTES, stream);
    if (e != hipSuccess) fprintf(stderr, "cooperative launch failed: %s (grid %d)\n", hipGetErrorString(e), grid);
}
```

```cpp
#include <hip/hip_runtime.h>
#include <hip/hip_bf16.h>
#include <cstdio>
#include <cstdint>

constexpr int NB = 8, SEQ = 4096, DM = 1024, MTOK = NB * SEQ, NL = 2;
constexpr int D_IN = 3720, NU = 3840;
constexpr int UQ = 0, UK = 512, UV = 1024, UR = 1536  , UP = 2432  , UG = 2688  , UF = 3712  ;
constexpr int SQ = 0, SF = 1536, SR = 1544, SP = 2440, SG = 2696;
constexpr float C2 = 0.125f * 1.4426950408889634f;
constexpr float LOG2E = 1.4426950408889634f;
constexpr float DECAY_SCALE = 0.6065306597126334f;

typedef unsigned short bf16_t;
typedef short bf16x8 __attribute__((ext_vector_type(8)));
typedef float f32x4 __attribute__((ext_vector_type(4)));
typedef unsigned u32x4 __attribute__((ext_vector_type(4)));
typedef unsigned u32x2 __attribute__((ext_vector_type(2)));

__device__ __forceinline__ unsigned f2bf(float f) { unsigned u = __builtin_bit_cast(unsigned, f); return (u + 0x7fffu + ((u >> 16) & 1u)) >> 16; }
__device__ __forceinline__ unsigned pk2(float lo, float hi) { return f2bf(lo) | (f2bf(hi) << 16); }
__device__ __forceinline__ float bf2f(unsigned short b) { return __builtin_bit_cast(float, (unsigned)b << 16); }
__device__ __forceinline__ float bflo(unsigned w) { return __builtin_bit_cast(float, w << 16); }
__device__ __forceinline__ float bfhi(unsigned w) { return __builtin_bit_cast(float, w & 0xffff0000u); }
__device__ __forceinline__ float sigmoidf_(float x) { return 1.f / (1.f + __expf(-x)); }
__device__ __forceinline__ float siluf_(float x) { return x / (1.f + __expf(-x)); }
__device__ __forceinline__ float wave_sum(float v) {
#pragma unroll
    for (int o = 1; o < 64; o <<= 1) v += __shfl_xor(v, o);
    return v;
}

__device__ __forceinline__ int otid() { int t = threadIdx.x; asm volatile("" : "+v"(t)); return t; }

constexpr size_t MiB = 1u << 20;
constexpr size_t WS_CTL = 0;
constexpr size_t WS_MOD = 1 * MiB;
constexpr size_t WS_WT = 2 * MiB;
constexpr size_t WS_WOT = 18 * MiB;
constexpr size_t WS_CB = 22 * MiB;
constexpr size_t WS_XN = 24 * MiB;
constexpr size_t WS_O32 = 24 * MiB;
constexpr size_t WS_BON = 23 * MiB;
constexpr size_t WS_PA = 56 * MiB;
constexpr size_t WS_Y = 88 * MiB;
constexpr size_t WS_U = 152 * MiB;
constexpr size_t WS_Z = 152 * MiB;
constexpr size_t WS_CHK = 392 * MiB;
constexpr int CHK_B = 24576;
constexpr int NCHK = SEQ / 32;
constexpr size_t WS_END = 488 * MiB;
constexpr size_t CTL_ZERO_BYTES = 65536;
constexpr int CW_ATTQ = 8192;
constexpr int CW_BAR = 1024;

struct Params {
    const float *x, *c, *ada_w, *ada_b, *norm_pre, *norm_post, *w_in, *q_gain, *k_gain, *f_bias, *mu, *w0, *w2, *a0, *a2, *k_k, *k_a, *r_k, *ln_g, *ln_b,
        *pool_w, *pool_scale, *w_out;
    float* out;
    unsigned char* ws;
};


#define LAS __attribute__((address_space(3)))
constexpr int NTHREADS = 512;
constexpr int LDS_BYTES = 147456;
constexpr int MISC_OFF = LDS_BYTES - 128;

#define XB_TMO      128
#define XB_XCNT(j)  (256  + 64 * (j))
#define XB_XSUB(j)  (1280 + 64 * (j))
#define XB_XGEN(j)  (2304 + 64 * (j))
#define XB_TOP      3328
#define XB_TOPGEN   3392
#define XCD_BAR_WORDS 3456
#define XB_SPIN_CAP (1u << 18)
__device__ __forceinline__ unsigned xb_ld(unsigned* p)              { return __hip_atomic_load(p, __ATOMIC_RELAXED, __HIP_MEMORY_SCOPE_AGENT); }
__device__ __forceinline__ unsigned xb_add(unsigned* p, unsigned v) { return __hip_atomic_fetch_add(p, v, __ATOMIC_RELAXED, __HIP_MEMORY_SCOPE_AGENT); }
__device__ __forceinline__ unsigned xb_xcc_id() { return (unsigned)__builtin_amdgcn_s_getreg((3 << 11) | 20) & 0xFu; }
#define XB_SPIN(cond, bar) do { unsigned _sp = 0; while (cond) { __builtin_amdgcn_s_sleep(1); \
    if ((++_sp & 255u) == 0u) { if (xb_ld(&(bar)[XB_TMO])) break; if (_sp > XB_SPIN_CAP) { atomicAdd(&(bar)[XB_TMO], 1u); break; } } } } while (0)
struct XcdBarrier { unsigned* bar; unsigned x; volatile LAS unsigned* st; };
__device__ __forceinline__ XcdBarrier xcd_barrier_post(unsigned* bar, volatile LAS unsigned* st) {
    XcdBarrier b; b.bar = bar; b.x = xb_xcc_id(); b.st = st;
    if (threadIdx.x == 0) (void)xb_add(&bar[XB_XCNT(b.x)], 1u);
    return b;
}
__device__ __forceinline__ void xcd_barrier_complete(unsigned* bar, unsigned x, unsigned& nloc, unsigned& nx) {
    const unsigned G = gridDim.x * gridDim.y * gridDim.z;
    unsigned sum, cnt, mine, sp = 0u;
    for (;;) {
        sum = 0u; cnt = 0u; mine = 0u;
#pragma unroll
        for (unsigned j = 0; j < 16; ++j) { const unsigned c = xb_ld(&bar[XB_XCNT(j)]); sum += c; cnt += (c > 0u) ? 1u : 0u; mine = (j == x) ? c : mine; }
        if (sum == G) break;
        __builtin_amdgcn_s_sleep(1);
        if ((++sp & 255u) == 0u) { if (xb_ld(&bar[XB_TMO])) break; if (sp > XB_SPIN_CAP) { atomicAdd(&bar[XB_TMO], 1u); break; } }
    }
    nloc = mine > 0u ? mine : 1u; nx = cnt > 0u ? cnt : 1u;
}
__device__ __forceinline__ void xcd_barrier(const XcdBarrier& b) {
    asm volatile("s_waitcnt vmcnt(0)" ::: "memory");
    __syncthreads();
    if (threadIdx.x == 0) {
        unsigned* bar = b.bar;
        __builtin_amdgcn_s_waitcnt(0);
        unsigned nloc = b.st[0], nx = b.st[1];
        if (nloc == 0u) { xcd_barrier_complete(bar, b.x, nloc, nx); b.st[0] = nloc; b.st[1] = nx; }
        const unsigned old = xb_add(&bar[XB_XSUB(b.x)], 1u);
        const unsigned gen = old / nloc;
        if (old + 1u == (gen + 1u) * nloc) {
            __builtin_amdgcn_fence(__ATOMIC_RELEASE, "agent");
            asm volatile("s_waitcnt vmcnt(0)" ::: "memory");
            const unsigned og = xb_add(&bar[XB_TOP], 1u);
            const unsigned tg = og / nx;
            if (og + 1u == (tg + 1u) * nx) xb_add(&bar[XB_TOPGEN], 1u);
            else XB_SPIN(xb_ld(&bar[XB_TOPGEN]) == tg, bar);
            __builtin_amdgcn_fence(__ATOMIC_ACQUIRE, "agent");
            xb_add(&bar[XB_XGEN(b.x)], 1u);
            asm volatile("s_waitcnt vmcnt(0)" ::: "memory");
        } else {
            XB_SPIN(xb_ld(&bar[XB_XGEN(b.x)]) == gen, bar);
            __builtin_amdgcn_fence(__ATOMIC_ACQUIRE, "agent");
            asm volatile("s_waitcnt vmcnt(0)" ::: "memory");
        }
    }
    __syncthreads();
}


namespace pg8 {
#define PG8_LAS __attribute__((address_space(3)))
typedef unsigned short bf16_t;
typedef short bf16x8 __attribute__((ext_vector_type(8)));
typedef float f32x4 __attribute__((ext_vector_type(4)));
typedef unsigned u32x4 __attribute__((ext_vector_type(4)));
constexpr int BM = 256, BK = 64, HALF = 128, HTB = HALF * BK * 2  , STAGE_BYTES = 8 * HTB, NXCD = 8, WGM = 8;

__host__ __device__ __forceinline__ int lds_byte(int r, int c) { const int st = (r >> 4) * 2 + (c >> 5), rr = r & 15, cc = c & 31, ob = rr * 64 + cc * 2; return st * 1024 + (ob ^ (((ob >> 9) & 1) << 5)); }
__host__ __device__ __forceinline__ void stage_rc(int b, int& R, int& C) { const int st = b / 1024, sb = b % 1024, swz = sb ^ (((sb >> 9) & 1) << 5); R = (st >> 1) * 16 + swz / 64; C = (st & 1) * 32 + (swz % 64) / 2; }
__host__ __device__ __forceinline__ int perm32(int rho) { const int n = rho >> 4, i = rho & 15; return 8 * (i >> 2) + 4 * n + (i & 3); }

struct Unit { int pm, pn; };
struct Gemm { const bf16_t* A; const bf16_t* Bt; int M, N, K; };

struct StaticOrder {
    int nM, nN, nwg, G, c;
    __host__ __device__ void init(int M, int N, int G_, int c_) { nM = M / BM; nN = N / BM; nwg = nM * nN; G = G_; c = c_; }
    __host__ __device__ bool next(int i, Unit& u) const {
        const long L = (long)i * G + c; if (L >= nwg) return false;
        int wgid = (int)L; { const int q = nwg / NXCD, r = nwg % NXCD, xcd = wgid % NXCD, off = wgid / NXCD; wgid = (xcd < r ? xcd * (q + 1) : r * (q + 1) + (xcd - r) * q) + off; }
        const int nig = WGM * nN, gid = wgid / nig, fm = gid * WGM, gsz = (nM - fm) < WGM ? (nM - fm) : WGM;
        u.pm = fm + ((wgid % nig) % gsz); u.pn = (wgid % nig) / gsz; return true;
    }
    __device__ __forceinline__ void a_ready(const Unit&) const {}
    __device__ __forceinline__ void done(const Unit&) const {}
};

__device__ __forceinline__ unsigned cvt_pk_bf16(float lo, float hi) { unsigned r; asm volatile("v_cvt_pk_bf16_f32 %0, %1, %2" : "=v"(r) : "v"(lo), "v"(hi)); return r; }

struct EpiU {
    static constexpr bool PERM = true, AFTER_DRAIN = false;
    bf16_t* U; const float* qg; const float* kg; int ldc;
    __device__ __forceinline__ void operator()(const f32x4 (&acc)[2][2][4][2], const Unit& u, int wr, int wc, int fr, int fq) const {
        const int row0 = u.pm * BM + wr * 64 + fr;
        if (u.pn < 4) {
            const float* gp = (u.pn < 2 ? qg : kg) + 8 * fq; const float mult = u.pn < 2 ? (0.125f * 1.4426950408889634f) : 1.f;
            f32x4 gv[2][2];
#pragma unroll
            for (int bj = 0; bj < 2; ++bj)
#pragma unroll
                for (int n = 0; n < 2; ++n) gv[bj][n] = *(const f32x4*)(gp + 32 * bj + 4 * n);
            const int col0 = u.pn * BM + 64 * wc + 8 * fq;
#pragma unroll
            for (int ai = 0; ai < 2; ++ai)
#pragma unroll
                for (int m = 0; m < 4; ++m) {
                    float s = 0.f;
#pragma unroll
                    for (int bj = 0; bj < 2; ++bj)
#pragma unroll
                        for (int n = 0; n < 2; ++n) { const f32x4 x = acc[ai][bj][m][n]; s += (x[0] * x[0] + x[1] * x[1]) + (x[2] * x[2] + x[3] * x[3]); }
                    s += __shfl_xor(s, 16); s += __shfl_xor(s, 32);
                    const float sc = rsqrtf(s * (1.f / 64.f) + 1e-6f) * mult;
                    bf16_t* rowp = U + (size_t)(row0 + ai * HALF + m * 16) * ldc + col0;
#pragma unroll
                    for (int bj = 0; bj < 2; ++bj) { const f32x4 v0 = acc[ai][bj][m][0] * sc * gv[bj][0], v1 = acc[ai][bj][m][1] * sc * gv[bj][1];
                        u32x4 w; w.x = cvt_pk_bf16(v0[0], v0[1]); w.y = cvt_pk_bf16(v0[2], v0[3]); w.z = cvt_pk_bf16(v1[0], v1[1]); w.w = cvt_pk_bf16(v1[2], v1[3]);
                        *(u32x4*)(rowp + bj * 32) = w; }
                }
        } else {
            const int col0 = u.pn * BM + wc * 32 + 8 * fq;
#pragma unroll
            for (int ai = 0; ai < 2; ++ai)
#pragma unroll
                for (int m = 0; m < 4; ++m) { bf16_t* rowp = U + (size_t)(row0 + ai * HALF + m * 16) * ldc + col0;
#pragma unroll
                    for (int bj = 0; bj < 2; ++bj) { const f32x4 v0 = acc[ai][bj][m][0], v1 = acc[ai][bj][m][1];
                        u32x4 w; w.x = cvt_pk_bf16(v0[0], v0[1]); w.y = cvt_pk_bf16(v0[2], v0[3]); w.z = cvt_pk_bf16(v1[0], v1[1]); w.w = cvt_pk_bf16(v1[2], v1[3]);
                        *(u32x4*)(rowp + bj * HALF) = w; } }
        }
    }
};
struct EpiB16 {
    static constexpr bool PERM = true, AFTER_DRAIN = false;
    bf16_t* C; int ldc;
    __device__ __forceinline__ void operator()(const f32x4 (&acc)[2][2][4][2], const Unit& u, int wr, int wc, int fr, int fq) const {
        const int row0 = u.pm * BM + wr * 64 + fr, col0 = u.pn * BM + wc * 32 + 8 * fq;
#pragma unroll
        for (int ai = 0; ai < 2; ++ai)
#pragma unroll
            for (int m = 0; m < 4; ++m) { bf16_t* rowp = C + (size_t)(row0 + ai * HALF + m * 16) * ldc + col0;
#pragma unroll
                for (int bj = 0; bj < 2; ++bj) { const f32x4 v0 = acc[ai][bj][m][0], v1 = acc[ai][bj][m][1];
                    u32x4 w; w.x = cvt_pk_bf16(v0[0], v0[1]); w.y = cvt_pk_bf16(v0[2], v0[3]); w.z = cvt_pk_bf16(v1[0], v1[1]); w.w = cvt_pk_bf16(v1[2], v1[3]);
                    *(u32x4*)(rowp + bj * HALF) = w; } }
    }
};
struct EpiF32 {
    static constexpr bool PERM = false, AFTER_DRAIN = false;
    float* C; int ldc;
    __device__ __forceinline__ void operator()(const f32x4 (&acc)[2][2][4][2], const Unit& u, int wr, int wc, int fr, int fq) const {
        const int row0 = u.pm * BM + wr * 64 + fr, col0 = u.pn * BM + wc * 32 + 4 * fq;
#pragma unroll
        for (int ai = 0; ai < 2; ++ai)
#pragma unroll
            for (int m = 0; m < 4; ++m) { float* rowp = C + (size_t)(row0 + ai * HALF + m * 16) * ldc + col0;
#pragma unroll
                for (int bj = 0; bj < 2; ++bj)
#pragma unroll
                    for (int n = 0; n < 2; ++n) *(f32x4*)(rowp + bj * HALF + n * 16) = acc[ai][bj][m][n]; }
    }
};

template <class Epi, class Sched, bool ALIGN_EPI = false, bool SP2 = false>
__device__ __forceinline__ void gemm_phase(PG8_LAS unsigned char* lds, const Gemm g, const Sched& S, const Epi& E) {
    int tid_ = threadIdx.x; asm volatile("" : "+v"(tid_));
    const int tid = tid_, wid = __builtin_amdgcn_readfirstlane(tid >> 6), lane = tid & 63, wr = wid >> 2, wc = wid & 3, fr = lane & 15, fq = lane >> 4;
    const int K = g.K, nt = K / BK;
    unsigned voffA[2], voffB[2];
#pragma unroll
    for (int i = 0; i < 2; ++i) { int R, C; stage_rc(tid * 16 + i * 8192, R, C); const int Rb = Epi::PERM ? ((R & ~31) + perm32(R & 31)) : R;
        voffA[i] = (unsigned)(R * K + C) * 2u; voffB[i] = (unsigned)(Rb * K + C) * 2u; }
    const size_t kstep = (size_t)(BK * 2);
    const size_t hstep = (size_t)HALF * K * 2;
    const size_t tstep = 2 * hstep;
    const unsigned ldsw = (unsigned)wid * 1024u;
    const int aoff = lds_byte(wr * 64 + fr, fq * 8), boff = lds_byte(wc * 32 + fr, fq * 8);
#define PG8_SA(b, h) (((b) * 2 + (h)) * HTB)
#define PG8_SB(b, h) ((4 + (b) * 2 + (h)) * HTB)
#define PG8_STAGE(bufoff, gbase, voff) do { _Pragma("unroll") for (int _i = 0; _i < 2; ++_i) \
        __builtin_amdgcn_global_load_lds((const unsigned*)((const char*)(gbase) + (voff)[_i]), (PG8_LAS unsigned*)(lds + (bufoff) + ldsw + _i * 8192), 16, 0, 0); } while (0)
#define PG8_LDA(dst, b, h) do { _Pragma("unroll") for (int m = 0; m < 4; ++m) _Pragma("unroll") for (int k = 0; k < 2; ++k) dst[m][k] = *(const PG8_LAS bf16x8*)(lds + PG8_SA(b, h) + aoff + m * 2048 + k * 1024); } while (0)
#define PG8_LDB(dst, b, h) do { _Pragma("unroll") for (int n = 0; n < 2; ++n) _Pragma("unroll") for (int k = 0; k < 2; ++k) dst[n][k] = *(const PG8_LAS bf16x8*)(lds + PG8_SB(b, h) + boff + n * 2048 + k * 1024); } while (0)
#define PG8_MMA(ai, bj, At, Bt) do { __builtin_amdgcn_s_setprio(1); _Pragma("unroll") for (int m = 0; m < 4; ++m) _Pragma("unroll") for (int n = 0; n < 2; ++n) _Pragma("unroll") for (int k = 0; k < 2; ++k) \
        acc[ai][bj][m][n] = __builtin_amdgcn_mfma_f32_16x16x32_bf16(Bt[n][k], At[m][k], acc[ai][bj][m][n], 0, 0, 0); __builtin_amdgcn_s_setprio(0); } while (0)
#define PG8_WAIT_V(n) asm volatile("s_waitcnt vmcnt(" #n ")" ::: "memory")
#define PG8_WAIT_L(n) asm volatile("s_waitcnt lgkmcnt(" #n ")" ::: "memory")
#define PG8_BAR __builtin_amdgcn_s_barrier()
#define PG8_SCHED __builtin_amdgcn_sched_barrier(0)
    Unit cur, nxt; int ui = 0;
    if (!S.next(0, cur)) return;
    f32x4 acc[2][2][4][2];
#pragma unroll
    for (int a = 0; a < 2; ++a)
#pragma unroll
        for (int b = 0; b < 2; ++b)
#pragma unroll
            for (int m = 0; m < 4; ++m)
#pragma unroll
                for (int n = 0; n < 2; ++n) acc[a][b][m][n] = (f32x4){0.f, 0.f, 0.f, 0.f};
    bf16x8 At[4][2], B0[2][2], B1[2][2];
    const char* cA = (const char*)g.A + (size_t)cur.pm * tstep; const char* cB = (const char*)g.Bt + (size_t)cur.pn * tstep;
    S.a_ready(cur);
    if constexpr (SP2) {
        PG8_STAGE(PG8_SB(0, 0), cB, voffB); PG8_STAGE(PG8_SB(0, 1), cB + hstep, voffB); PG8_STAGE(PG8_SA(0, 0), cA, voffA); PG8_STAGE(PG8_SA(0, 1), cA + hstep, voffA);
        if (wr == 1) PG8_BAR;
        PG8_WAIT_V(2); PG8_BAR;
        PG8_STAGE(PG8_SB(1, 0), cB + kstep, voffB); PG8_STAGE(PG8_SA(1, 0), cA + kstep, voffA); PG8_STAGE(PG8_SB(1, 1), cB + hstep + kstep, voffB);
        PG8_WAIT_V(6); PG8_BAR;
    } else {
        PG8_STAGE(PG8_SB(0, 0), cB, voffB); PG8_STAGE(PG8_SA(0, 0), cA, voffA); PG8_STAGE(PG8_SB(0, 1), cB + hstep, voffB); PG8_STAGE(PG8_SA(0, 1), cA + hstep, voffA);
        if (wr == 1) PG8_BAR;
        PG8_WAIT_V(4); PG8_BAR;
        PG8_STAGE(PG8_SB(1, 0), cB + kstep, voffB); PG8_STAGE(PG8_SA(1, 0), cA + kstep, voffA); PG8_STAGE(PG8_SB(1, 1), cB + hstep + kstep, voffB);
        PG8_WAIT_V(6); PG8_BAR;
    }
    for (;;) {
        const bool has_next = S.next(ui + 1, nxt);
        const char* nA = has_next ? (const char*)g.A + (size_t)nxt.pm * tstep : cA; const char* nB = has_next ? (const char*)g.Bt + (size_t)nxt.pn * tstep : cB;
        for (int t = 0; t < nt; t += 2) {
            const bool last = (t == nt - 2);
            const char* a1 = cA + (size_t)(t + 1) * kstep;
            const char* a2 = last ? nA : cA + (size_t)(t + 2) * kstep; const char* b2 = last ? nB : cB + (size_t)(t + 2) * kstep;
            const char* a3 = a2 + kstep; const char* b3 = b2 + kstep;
            if (last && has_next) S.a_ready(nxt);
            if constexpr (SP2) {
            PG8_LDB(B0, 0, 0); PG8_LDB(B1, 0, 1); PG8_SCHED; PG8_LDA(At, 0, 0); PG8_STAGE(PG8_SA(1, 1), a1 + hstep, voffA);
            PG8_WAIT_V(8); PG8_WAIT_L(0); PG8_BAR; PG8_MMA(0, 0, At, B0); PG8_MMA(0, 1, At, B1); PG8_BAR; PG8_SCHED;
            PG8_LDA(At, 0, 1); PG8_STAGE(PG8_SB(0, 0), b2, voffB); PG8_STAGE(PG8_SB(0, 1), b2 + hstep, voffB); PG8_STAGE(PG8_SA(0, 0), a2, voffA);
            PG8_WAIT_V(8); PG8_WAIT_L(0); PG8_BAR; PG8_MMA(1, 0, At, B0); PG8_MMA(1, 1, At, B1); PG8_BAR; PG8_SCHED;
            PG8_LDB(B0, 1, 0); PG8_LDB(B1, 1, 1); PG8_SCHED; PG8_LDA(At, 1, 0); PG8_STAGE(PG8_SA(0, 1), a2 + hstep, voffA);
            PG8_WAIT_V(8); PG8_WAIT_L(0); PG8_BAR; PG8_MMA(0, 0, At, B0); PG8_MMA(0, 1, At, B1); PG8_BAR; PG8_SCHED;
            PG8_LDA(At, 1, 1); PG8_STAGE(PG8_SB(1, 0), b3, voffB); PG8_STAGE(PG8_SB(1, 1), b3 + hstep, voffB); PG8_STAGE(PG8_SA(1, 0), a3, voffA);
            PG8_WAIT_V(8); PG8_WAIT_L(0); PG8_BAR; PG8_MMA(1, 0, At, B0); PG8_MMA(1, 1, At, B1); PG8_BAR; PG8_SCHED;
            } else {
            PG8_LDB(B0, 0, 0); PG8_SCHED; PG8_LDA(At, 0, 0); PG8_STAGE(PG8_SA(1, 1), a1 + hstep, voffA);
            PG8_WAIT_L(8); PG8_BAR; PG8_WAIT_L(0); PG8_MMA(0, 0, At, B0); PG8_BAR; PG8_SCHED;
            PG8_LDB(B1, 0, 1); PG8_STAGE(PG8_SB(0, 0), b2, voffB);
            PG8_BAR; PG8_WAIT_L(0); PG8_MMA(0, 1, At, B1); PG8_BAR;
            PG8_LDA(At, 0, 1); PG8_STAGE(PG8_SA(0, 0), a2, voffA);
            PG8_BAR; PG8_WAIT_L(0); PG8_MMA(1, 0, At, B0); PG8_BAR; PG8_SCHED;
            PG8_STAGE(PG8_SB(0, 1), b2 + hstep, voffB);
            PG8_WAIT_V(6); PG8_BAR; PG8_MMA(1, 1, At, B1); PG8_BAR;
            PG8_LDB(B0, 1, 0); PG8_SCHED; PG8_LDA(At, 1, 0); PG8_STAGE(PG8_SA(0, 1), a2 + hstep, voffA);
            PG8_WAIT_L(8); PG8_BAR; PG8_WAIT_L(0); PG8_MMA(0, 0, At, B0); PG8_BAR; PG8_SCHED;
            PG8_LDB(B1, 1, 1); PG8_STAGE(PG8_SB(1, 0), b3, voffB);
            PG8_BAR; PG8_WAIT_L(0); PG8_MMA(0, 1, At, B1); PG8_BAR;
            PG8_LDA(At, 1, 1); PG8_STAGE(PG8_SA(1, 0), a3, voffA);
            PG8_BAR; PG8_WAIT_L(0); PG8_MMA(1, 0, At, B0); PG8_BAR; PG8_SCHED;
            PG8_STAGE(PG8_SB(1, 1), b3 + hstep, voffB);
            PG8_WAIT_V(6); PG8_BAR; PG8_MMA(1, 1, At, B1); PG8_BAR;
            }
        }
        if constexpr (ALIGN_EPI) { if (wr == 0) PG8_BAR; }
        if constexpr (!Epi::AFTER_DRAIN) { E(acc, cur, wr, wc, fr, fq); S.done(cur); }
        if (!has_next) break;
#pragma unroll
        for (int a = 0; a < 2; ++a)
#pragma unroll
            for (int b = 0; b < 2; ++b)
#pragma unroll
                for (int m = 0; m < 4; ++m)
#pragma unroll
                    for (int n = 0; n < 2; ++n) acc[a][b][m][n] = (f32x4){0.f, 0.f, 0.f, 0.f};
        cur = nxt; cA = nA; cB = nB; ++ui;
        if constexpr (ALIGN_EPI) { if (wr == 1) PG8_BAR; }
    }
    PG8_WAIT_V(0);
    if constexpr (!ALIGN_EPI) { if (wr == 0) PG8_BAR; }
    PG8_BAR;
    if constexpr (Epi::AFTER_DRAIN) { E.fused(acc, cur, wr, wc, fr, fq, lds, wid, lane); S.done(cur); }
#undef PG8_SA
#undef PG8_SB
#undef PG8_STAGE
#undef PG8_LDA
#undef PG8_LDB
#undef PG8_MMA
#undef PG8_WAIT_V
#undef PG8_WAIT_L
#undef PG8_BAR
#undef PG8_SCHED
}
}

#include <hip/hip_bf16.h>
#include <cmath>
namespace attn_body {
using bf16=__hip_bfloat16;
using bf16x8=__attribute__((ext_vector_type(8)))short;
using s16x4=__attribute__((ext_vector_type(4)))short;
using f32x16=__attribute__((ext_vector_type(16)))float;
using u32x4=__attribute__((ext_vector_type(4)))unsigned;
constexpr int BATCH=8,NHEAD=8,SEQ=4096,D=64,DM=3840,OPITCH=1024;
constexpr int NW=8,QBLK=32,QB=QBLK*NW,KVBLK=64,NQB=SEQ/QB;
constexpr int ATTN_PITCH=DM, ATTN_UNIT_ROWS=QB;
__device__ __forceinline__ int crow(int r,int hi){return (r&3)+8*(r>>2)+4*hi;}
#define SBAR() __builtin_amdgcn_sched_barrier(0)
__device__ __forceinline__ void cmask(f32x16&p0,f32x16&p1,int jb,int qrel,int hi){
  const float NEG=-INFINITY; int kb=64*jb+4*hi;
  #pragma unroll
  for(int r=0;r<16;++r){int kv=kb+(r&3)+8*(r>>2); if(kv>qrel)p0[r]=NEG; if(kv+32>qrel)p1[r]=NEG;}
}

constexpr int NSLOT=3, SLOTB=8192;
constexpr int LDS_K=0, LDS_V=NSLOT*SLOTB, LDS_WS=2*NSLOT*SLOTB, LDS_OST=LDS_WS+NW*64*4, LDS_CB=LDS_OST+NW*4096, LDS_BYTES=LDS_CB+SEQ*4+1024;
constexpr float C2=0.125f*1.4426950408889634f;
__device__ __forceinline__ void glds16(const void*gsrc,unsigned lds_dst){unsigned keep;
  asm volatile("s_mov_b32 %0, m0\n\ts_mov_b32 m0, %2\n\ts_nop 0\n\tglobal_load_lds_dwordx4 %1, off\n\ts_mov_b32 m0, %0":"=&s"(keep):"v"(gsrc),"s"(lds_dst):"memory");}
__device__ __forceinline__ float max3f(float a,float b,float c){float r;asm("v_max3_f32 %0, %1, %2, %3":"=v"(r):"v"(a),"v"(b),"v"(c));return r;}
__device__ __forceinline__ float max2f(float a,float b){float r;asm("v_max_f32_e32 %0, %1, %2":"=v"(r):"v"(a),"v"(b));return r;}
__device__ __forceinline__ float fadd_s(float a,float b){float r;asm("v_add_f32_e32 %0, %1, %2":"=v"(r):"v"(a),"v"(b));return r;}
__device__ __forceinline__ float fsub_s(float a,float b){float r;asm("v_sub_f32_e32 %0, %1, %2":"=v"(r):"v"(a),"v"(b));return r;}
typedef float f32x4v __attribute__((ext_vector_type(4))); typedef float f32x2_t __attribute__((ext_vector_type(2))); typedef __bf16 bf16x2_t __attribute__((ext_vector_type(2)));
__device__ __forceinline__ unsigned cvtpk_s(float lo,float hi){f32x2_t v={lo,hi};bf16x2_t b=__builtin_convertvector(v,bf16x2_t);return __builtin_bit_cast(unsigned,b);}
#define WAIT_BAR(N) asm volatile("s_waitcnt vmcnt(" #N ") lgkmcnt(0)\n\ts_barrier":::"memory")

__device__ __forceinline__ void qkt(f32x16&p0,f32x16&p1,const char*Kslot,const bf16x8*qr,int r32,int hi){
  const char*kb=Kslot+hi*1024+r32*16;
  #pragma unroll
  for(int d0=0;d0<4;++d0){
    const bf16x8 b0=*reinterpret_cast<const bf16x8*>(kb+d0*2048);
    const bf16x8 b1=*reinterpret_cast<const bf16x8*>(kb+d0*2048+512);
    p0=__builtin_amdgcn_mfma_f32_32x32x16_bf16(b0,qr[d0],p0,0,0,0);p1=__builtin_amdgcn_mfma_f32_32x32x16_bf16(b1,qr[d0],p1,0,0,0);}
}
typedef __attribute__((address_space(3))) const char* lds_cptr;
typedef short v4i16_t __attribute__((ext_vector_type(4)));
__device__ __forceinline__ void kload8(bf16x8*kf,lds_cptr kp){
  kf[0]=*(const __attribute__((address_space(3))) bf16x8*)(kp);      kf[1]=*(const __attribute__((address_space(3))) bf16x8*)(kp+512);
  kf[2]=*(const __attribute__((address_space(3))) bf16x8*)(kp+2048); kf[3]=*(const __attribute__((address_space(3))) bf16x8*)(kp+2560);
  kf[4]=*(const __attribute__((address_space(3))) bf16x8*)(kp+4096); kf[5]=*(const __attribute__((address_space(3))) bf16x8*)(kp+4608);
  kf[6]=*(const __attribute__((address_space(3))) bf16x8*)(kp+6144); kf[7]=*(const __attribute__((address_space(3))) bf16x8*)(kp+6656);
}
__device__ __forceinline__ void kload2(bf16x8*kf,lds_cptr kp,int j){ kf[2*j]=*(const __attribute__((address_space(3))) bf16x8*)(kp+j*2048); kf[2*j+1]=*(const __attribute__((address_space(3))) bf16x8*)(kp+j*2048+512); }
__device__ __forceinline__ s16x4 vtr(lds_cptr p){ return __builtin_bit_cast(s16x4,__builtin_amdgcn_ds_read_tr16_b64_v4i16((__attribute__((address_space(3))) v4i16_t*)p)); }
__device__ __forceinline__ float rowmax(const f32x16&p0,const f32x16&p1){
  float a=max3f(p0[0],p0[1],p1[0]),b=max3f(p0[2],p0[3],p1[1]);a=max3f(a,p1[2],p1[3]);
  #pragma unroll
  for(int r=4;r<16;r+=4){a=max3f(a,p0[r],p0[r+1]);b=max3f(b,p0[r+2],p0[r+3]);a=max3f(a,p1[r],p1[r+1]);b=max3f(b,p1[r+2],p1[r+3]);}
  const float m=max2f(a,b);
  auto rr=__builtin_amdgcn_permlane32_swap(__float_as_uint(m),__float_as_uint(m),false,false);
  return max2f(__uint_as_float(rr[0]),__uint_as_float(rr[1]));
}
__device__ __forceinline__ void pv(f32x16*o,int vb,bf16x8 pa0,bf16x8 pa1,bf16x8 pa2,bf16x8 pa3){
  #pragma unroll
  for(int d0=0;d0<2;++d0){s16x4 lo[4],hi[4];
    #pragma unroll
    for(int ks=0;ks<4;++ks){
      asm volatile("ds_read_b64_tr_b16 %0,%1 offset:%c2":"=&v"(lo[ks]):"v"(vb),"i"(d0*4096+ks*1024):"memory");
      asm volatile("ds_read_b64_tr_b16 %0,%1 offset:%c2":"=&v"(hi[ks]):"v"(vb),"i"(d0*4096+ks*1024+512):"memory");}
    asm volatile("s_waitcnt lgkmcnt(0)":::"memory");SBAR();
    #define PK(k) (bf16x8){lo[k][0],lo[k][1],lo[k][2],lo[k][3],hi[k][0],hi[k][1],hi[k][2],hi[k][3]}
    o[d0]=__builtin_amdgcn_mfma_f32_32x32x16_bf16(pa0,PK(0),o[d0],0,0,0);
    o[d0]=__builtin_amdgcn_mfma_f32_32x32x16_bf16(pa1,PK(1),o[d0],0,0,0);
    o[d0]=__builtin_amdgcn_mfma_f32_32x32x16_bf16(pa2,PK(2),o[d0],0,0,0);
    o[d0]=__builtin_amdgcn_mfma_f32_32x32x16_bf16(pa3,PK(3),o[d0],0,0,0);
    #undef PK
  }
}

#ifndef ATTN_STORE16
#define ATTN_STORE16(p,v) (*(u32x4*)(p)=(v))
#endif
template<int THRL> __device__ __forceinline__ void attn_unit(int b,int h,int qb,const bf16*Q,const bf16*__restrict__ K,const bf16*__restrict__ V,const bf16*Gt,const float*CBg,bf16*O,char*shm){
  int tid_=threadIdx.x; asm volatile("":"+v"(tid_)); const int tid=tid_,lane=tid&63,r32=lane&31,hi=lane>>5; const int wid=__builtin_amdgcn_readfirstlane(tid>>6);
  const long rowbase=(long)b*SEQ; const int q0=qb*QB;
  const bf16*Qw=Q+(rowbase+q0+wid*QBLK)*DM+h*D;
  const bf16*Kh=K+rowbase*DM+h*D,*Vh=V+rowbase*DM+h*D;
  const unsigned lds0=(unsigned)(uintptr_t)shm;
  float*wsf=(float*)(shm+LDS_WS)+wid*64;
  const bf16*ksrc=Kh+(long)lane*DM+wid*8;
  const bf16*vsrc=Vh+(long)(16*(wid&3)+(lane>>2))*DM+(wid>>2)*32+(lane&3)*8;
  const unsigned kdst=lds0+LDS_K+wid*1024, vdst=lds0+LDS_V+wid*1024;
  #define DMA_K(t,slot) glds16(ksrc+(long)(t)*KVBLK*DM,(unsigned)__builtin_amdgcn_readfirstlane(kdst+(slot)))
  #define DMA_V(t,slot) glds16(vsrc+(long)(t)*KVBLK*DM,(unsigned)__builtin_amdgcn_readfirstlane(vdst+(slot)))
  const int vb0=(int)(lds0+LDS_V)+((lane>>4)&1)*32+(lane&3)*8+(4*hi+((lane&15)>>2))*64;
  const char*Kbase=shm+LDS_K; bf16x8 kf[8];
  const lds_cptr shm3=(lds_cptr)shm; const lds_cptr kp0=shm3+LDS_K+hi*1024+r32*16; const lds_cptr vp0=shm3+LDS_V+((lane>>4)&1)*32+(lane&3)*8+(4*hi+((lane&15)>>2))*64;
  const int NT=(q0+QB)/KVBLK;
  { const float*cbsrc=CBg+((long)b*NHEAD+h)*SEQ; float*cbl=(float*)(shm+LDS_CB);
    #pragma unroll
    for(int i=0;i<2;++i){ const int e=(i*512+tid)*4; if(e<q0+QB){ const f32x4v v=*reinterpret_cast<const f32x4v*>(cbsrc+e); *reinterpret_cast<f32x4v*>(cbl+e)=v; } } }
  DMA_K(0,0);DMA_V(0,0);DMA_K(1,SLOTB);
  bf16x8 qr[4];
  #pragma unroll
  for(int d0=0;d0<4;++d0)qr[d0]=*reinterpret_cast<const bf16x8*>(&Qw[(long)r32*DM+d0*16+hi*8]);
  float mhat=0.f,l_reg=0.f;f32x16 o[2];o[0]=f32x16{};o[1]=f32x16{};
  const int qrel=wid*QBLK+r32;
  #define CMASK(P0,P1,t) do{int jb_=(t)-(NT-4); if(jb_>=0)cmask(P0,P1,jb_,qrel,hi);}while(0)
  bool resc=false; f32x16 pA0,pA1,pB0,pB1;
  #define START(P0,P1) do{ const float rm=rowmax(P0,P1); resc=false; \
    { const float dl=__builtin_fmaxf(rm,-16.f); mhat=fadd_s(mhat,dl); mh2=cbq+mhat; \
      _Pragma("unroll") for(int r=0;r<16;++r){P0[r]=fsub_s(P0[r],dl);P1[r]=fsub_s(P1[r],dl);} } \
    _Pragma("unroll") for(int r=0;r<16;++r)P0[r]=__builtin_amdgcn_exp2f(P0[r]); }while(0)
  #define RESC() do{ if(resc){ asm volatile("s_waitcnt lgkmcnt(0)":::"memory"); \
      _Pragma("unroll") for(int d_=0;d_<2;++d_) _Pragma("unroll") for(int r=0;r<16;++r)o[d_][r]*=wsf[crow(r,hi)]; } }while(0)
  int sl_prev=0,sl_cur=0,sl_next=SLOTB;
  #define ROT() do{sl_prev=sl_cur;sl_cur=sl_next;sl_next=(sl_next==(NSLOT-1)*SLOTB)?0:sl_next+SLOTB;}while(0)
  DMA_K(2,2*SLOTB);
  WAIT_BAR(3);
  const lds_cptr cbp=(lds_cptr)shm+LDS_CB+hi*16;
  const float cbq=*(const __attribute__((address_space(3))) float*)((lds_cptr)shm+LDS_CB+4*(q0+wid*QBLK+r32));
  float mh2=cbq;
  #define CBINIT(P0,P1,t) do{ _Pragma("unroll") for(int g_=0;g_<4;++g_){ \
      const f32x4v c0_=*(const __attribute__((address_space(3))) f32x4v*)(cbp+(t)*256+g_*32), c1_=*(const __attribute__((address_space(3))) f32x4v*)(cbp+(t)*256+g_*32+128); \
      _Pragma("unroll") for(int i_=0;i_<4;++i_){P0[4*g_+i_]=c0_[i_]-mh2;P1[4*g_+i_]=c1_[i_]-mh2;} } }while(0)
  CBINIT(pA0,pA1,0);
  qkt(pA0,pA1,Kbase,qr,r32,hi);asm volatile("s_nop 15\n\ts_nop 7":"+v"(pA0),"+v"(pA1));CMASK(pA0,pA1,0);
  START(pA0,pA1);
  _Pragma("unroll") for(int r=0;r<16;++r)pA1[r]=__builtin_amdgcn_exp2f(pA1[r]);
  CBINIT(pB0,pB1,1);
  WAIT_BAR(0);
  DMA_K(3,0);DMA_V(1,SLOTB);
  ROT();
  kload8(kf,kp0+sl_cur);
  WAIT_BAR(2);
  s16x4 vlo[8],vhi[8]; u32x4 pw0,pw1,pw2,pw3;
  #define PKW(P,B) cvtpk_s(P[B],P[B+1])
  #define PAF(k) __builtin_bit_cast(bf16x8,pw##k)
  #define VFR(i) (bf16x8){vlo[i][0],vlo[i][1],vlo[i][2],vlo[i][3],vhi[i][0],vhi[i][1],vhi[i][2],vhi[i][3]}
  #define PIN(x) asm volatile("":"+v"(x))
  #define MX3(a,b,c) __builtin_fmaxf(__builtin_fmaxf((a),(b)),(c))
  #define GAPA(MF,A0,A1,A2,A3,W0,W1,PW) do{ MF; sacc+=A0; sacc+=A1; sacc+=A2; sacc+=A3; PIN(sacc); W0; W1; PIN(PW); SBAR(); }while(0)
  #define EX(v) __builtin_amdgcn_exp2f(v)
  #define GAPB(MF,X,B,PN,CBO) do{ MF; X[B]=EX(X[B]); X[B+1]=EX(X[B+1]); X[B+2]=EX(X[B+2]); X[B+3]=EX(X[B+3]); PIN(X); \
    { const f32x4v c_=*(const __attribute__((address_space(3))) f32x4v*)(cbn_+(CBO)); PN[B]=c_[0]-mh2; PN[B+1]=c_[1]-mh2; PN[B+2]=c_[2]-mh2; PN[B+3]=c_[3]-mh2; PIN(PN); } SBAR(); }while(0)
  #define VRD(i) do{ vlo[i]=vtr(vp_+(((i)>>2)*4096+((i)&3)*1024)); vhi[i]=vtr(vp_+(((i)>>2)*4096+((i)&3)*1024+512)); }while(0)
  #define KRD(G,j) do{ if(G){ kload2(kf,kp0+sl_next,j); SBAR(); } }while(0)
  #define STEP(C0,C1,P0,P1,t,GK,GV,GL) do{ SBAR(); \
    const lds_cptr vp_=vp0+sl_prev; \
    VRD(0); SBAR(); float sacc=(P0[0]+P0[1]); \
    GAPA(C0=__builtin_amdgcn_mfma_f32_32x32x16_bf16(kf[0],qr[0],C0,0,0,0), P0[2],P0[3],P0[4],P0[5],     pw0[0]=PKW(P0,0), pw0[1]=PKW(P0,2), pw0); \
    VRD(4); SBAR(); GAPA(C1=__builtin_amdgcn_mfma_f32_32x32x16_bf16(kf[1],qr[0],C1,0,0,0), P0[6],P0[7],P0[8],P0[9],     pw0[2]=PKW(P0,4), pw0[3]=PKW(P0,6), pw0); \
    VRD(1); SBAR(); GAPA(C0=__builtin_amdgcn_mfma_f32_32x32x16_bf16(kf[2],qr[1],C0,0,0,0),   P0[10],P0[11],P0[12],P0[13], pw1[0]=PKW(P0,8), pw1[1]=PKW(P0,10), pw1); \
    VRD(5); SBAR(); GAPA(C1=__builtin_amdgcn_mfma_f32_32x32x16_bf16(kf[3],qr[1],C1,0,0,0),   P0[14],P0[15],P1[0],P1[1],   pw1[2]=PKW(P0,12),pw1[3]=PKW(P0,14), pw1); \
    VRD(2); SBAR(); GAPA(C0=__builtin_amdgcn_mfma_f32_32x32x16_bf16(kf[4],qr[2],C0,0,0,0),   P1[2],P1[3],P1[4],P1[5],     pw2[0]=PKW(P1,0), pw2[1]=PKW(P1,2), pw2); \
    VRD(6); SBAR(); GAPA(C1=__builtin_amdgcn_mfma_f32_32x32x16_bf16(kf[5],qr[2],C1,0,0,0),   P1[6],P1[7],P1[8],P1[9],     pw2[2]=PKW(P1,4), pw2[3]=PKW(P1,6), pw2); \
    VRD(3); SBAR(); GAPA(C0=__builtin_amdgcn_mfma_f32_32x32x16_bf16(kf[6],qr[3],C0,0,0,0),   P1[10],P1[11],P1[12],P1[13], pw3[0]=PKW(P1,8), pw3[1]=PKW(P1,10), pw3); \
    VRD(7); SBAR(); GAPA(C1=__builtin_amdgcn_mfma_f32_32x32x16_bf16(kf[7],qr[3],C1,0,0,0),   P1[14],P1[15],0.f,0.f,       pw3[2]=PKW(P1,12),pw3[3]=PKW(P1,14), pw3); \
    l_reg+=sacc; \
    if(GK){DMA_K((t)+3,sl_cur);} if(GV){DMA_V((t)+1,sl_next);} \
    CMASK(C0,C1,t); \
    { float a=MX3(C0[0],C0[1],C1[0]),b=MX3(C0[2],C0[3],C1[1]); a=MX3(a,C1[2],C1[3]); \
      _Pragma("unroll") for(int r=4;r<16;r+=4){a=MX3(a,C0[r],C0[r+1]);b=MX3(b,C0[r+2],C0[r+3]);a=MX3(a,C1[r],C1[r+1]);b=MX3(b,C1[r+2],C1[r+3]);} \
      float rm=__builtin_fmaxf(a,b); { auto rr=__builtin_amdgcn_permlane32_swap(__float_as_uint(rm),__float_as_uint(rm),false,false); rm=__builtin_fmaxf(__uint_as_float(rr[0]),__uint_as_float(rr[1])); } \
      resc=false; \
      if(__builtin_expect(__any(rm>(float)THRL),0)){ const float dl=__builtin_fmaxf(rm,0.f); mhat+=dl; \
        _Pragma("unroll") for(int r=0;r<16;++r){C0[r]-=dl;C1[r]-=dl;} \
        mh2=cbq+mhat; \
        const float f=__builtin_amdgcn_exp2f(-dl); l_reg*=f; if(hi==0)wsf[r32]=f; resc=true; } } \
    SBAR(); \
    const lds_cptr cbn_=cbp+((t)+1)*256;                      \
    GAPB(o[0]=__builtin_amdgcn_mfma_f32_32x32x16_bf16(PAF(0),VFR(0),o[0],0,0,0), C0,0, P0,0); \
    GAPB(o[1]=__builtin_amdgcn_mfma_f32_32x32x16_bf16(PAF(0),VFR(4),o[1],0,0,0), C0,4, P0,32); \
    KRD(GL,0); GAPB(o[0]=__builtin_amdgcn_mfma_f32_32x32x16_bf16(PAF(1),VFR(1),o[0],0,0,0), C0,8, P0,64); \
    KRD(GL,1); GAPB(o[1]=__builtin_amdgcn_mfma_f32_32x32x16_bf16(PAF(1),VFR(5),o[1],0,0,0), C0,12, P0,96); \
    KRD(GL,2); GAPB(o[0]=__builtin_amdgcn_mfma_f32_32x32x16_bf16(PAF(2),VFR(2),o[0],0,0,0), C1,0, P1,128); \
    KRD(GL,3); GAPB(o[1]=__builtin_amdgcn_mfma_f32_32x32x16_bf16(PAF(2),VFR(6),o[1],0,0,0), C1,4, P1,160); \
    GAPB(o[0]=__builtin_amdgcn_mfma_f32_32x32x16_bf16(PAF(3),VFR(3),o[0],0,0,0), C1,8, P1,192); \
    GAPB(o[1]=__builtin_amdgcn_mfma_f32_32x32x16_bf16(PAF(3),VFR(7),o[1],0,0,0), C1,12, P1,224); \
    }while(0)
  int t=1;
  #undef CMASK
  #define CMASK(P0,P1,t) do{}while(0)
  for(;t+5<NT;t+=2){
    STEP(pB0,pB1,pA0,pA1,t,true,true,true);     WAIT_BAR(2); RESC(); ROT();
    STEP(pA0,pA1,pB0,pB1,t+1,true,true,true);   WAIT_BAR(2); RESC(); ROT();
  }
  #undef CMASK
  #define CMASK(P0,P1,t) do{int jb_=(t)-(NT-4); if(jb_>=0)cmask(P0,P1,jb_,qrel,hi);}while(0)
  #define ENDW(tt) do{ if((tt)+3<NT){WAIT_BAR(2);} else if((tt)+2<NT){WAIT_BAR(1);} else {WAIT_BAR(0);} }while(0)
  for(;t+1<NT;t+=2){
    STEP(pB0,pB1,pA0,pA1,t,(t+3<NT),(t+1<NT),(t+1<NT));       ENDW(t);   RESC(); ROT();
    STEP(pA0,pA1,pB0,pB1,t+1,(t+4<NT),(t+2<NT),(t+2<NT));     ENDW(t+1); RESC(); ROT();
  }
  STEP(pB0,pB1,pA0,pA1,NT-1,false,false,false); RESC();
  { float sacc=pB0[0]+pB0[1]; _Pragma("unroll") for(int r=2;r<16;++r)sacc+=pB0[r]; _Pragma("unroll") for(int r=0;r<16;++r)sacc+=pB1[r]; l_reg+=sacc;
    pw0=(u32x4){PKW(pB0,0),PKW(pB0,2),PKW(pB0,4),PKW(pB0,6)};pw1=(u32x4){PKW(pB0,8),PKW(pB0,10),PKW(pB0,12),PKW(pB0,14)};pw2=(u32x4){PKW(pB1,0),PKW(pB1,2),PKW(pB1,4),PKW(pB1,6)};pw3=(u32x4){PKW(pB1,8),PKW(pB1,10),PKW(pB1,12),PKW(pB1,14)};
    SBAR(); pv(o,vb0+sl_cur,PAF(0),PAF(1),PAF(2),PAF(3)); }
  #undef PKW
  #undef PAF
  #undef VFR
  #undef PIN
  #undef MX3
  #undef GAPA
  #undef GAPB
  #undef EX
  #undef VRD
  #undef KRD
  #undef STEP
  #undef ENDW
  {auto rr=__builtin_amdgcn_permlane32_swap(__float_as_uint(l_reg),__float_as_uint(l_reg),false,false);l_reg=__uint_as_float(rr[0])+__uint_as_float(rr[1]);}
  if(hi==0)wsf[32+r32]=l_reg;asm volatile("s_waitcnt lgkmcnt(0)":::"memory");
  float rli[16];
  #pragma unroll
  for(int r=0;r<16;++r)rli[r]=__builtin_amdgcn_rcpf(wsf[32+crow(r,hi)]);
  bf16*Ow=O+(rowbase+q0+wid*QBLK)*OPITCH+h*D; const bf16*Gw=Gt+(rowbase+q0+wid*QBLK)*DM+h*D;
  { bf16*stg=(bf16*)(shm+LDS_OST)+wid*2048;
    #pragma unroll
    for(int r=0;r<16;++r){const int orow=crow(r,hi);
      #pragma unroll
      for(int d0=0;d0<2;++d0)stg[orow*64+d0*32+r32]=__float2bfloat16(o[d0][r]*rli[r]);}
    asm volatile("s_waitcnt lgkmcnt(0)":::"memory");
    #pragma unroll
    for(int i=0;i<4;++i){const int row=i*8+(lane>>3),ch=lane&7; const u32x4 v=*(const u32x4*)(stg+row*64+ch*8); const u32x4 gq=*(const u32x4*)(Gw+(long)row*DM+ch*8); u32x4 w_;
      #pragma unroll
      for(int k=0;k<4;++k){ const float g0=__builtin_bit_cast(float,gq[k]<<16), g1=__builtin_bit_cast(float,gq[k]&0xffff0000u), x0=__builtin_bit_cast(float,v[k]<<16), x1=__builtin_bit_cast(float,v[k]&0xffff0000u);
        w_[k]=cvtpk_s(x0*g0*__builtin_amdgcn_rcpf(1.f+__builtin_amdgcn_exp2f(-1.4426950408889634f*g0)), x1*g1*__builtin_amdgcn_rcpf(1.f+__builtin_amdgcn_exp2f(-1.4426950408889634f*g1))); }
      ATTN_STORE16(Ow+(long)row*OPITCH+ch*8,w_);} }
  asm volatile("s_waitcnt lgkmcnt(0)\n\ts_barrier":::"memory");
  #undef CBINIT
  #undef DMA_K
  #undef DMA_V
  #undef CMASK
  #undef START
  #undef RESC
  #undef ROT
}
constexpr int ATTN_LDS_BYTES=LDS_BYTES;
struct AttnTensors { const bf16* Q; const bf16* K; const bf16* V; const bf16* G; const float* CB; bf16* O; };
struct AttnUnit { int bh; int qb; };
struct QueueOrder {
  unsigned* ctr; volatile __attribute__((address_space(3))) unsigned* slot;
  __device__ __forceinline__ bool next(int,AttnUnit&u)const{
    if(threadIdx.x==0){ *slot=__hip_atomic_fetch_add(ctr,1u,__ATOMIC_RELAXED,__HIP_MEMORY_SCOPE_AGENT); }
    __syncthreads(); const unsigned t=*slot; __syncthreads();
    if(t>=(unsigned)(BATCH*NHEAD*NQB))return false; u.qb=NQB-1-(int)(t/(BATCH*NHEAD)); u.bh=(int)(t%(BATCH*NHEAD)); return true; }
  __device__ __forceinline__ void a_ready(const AttnUnit&)const{}
  __device__ __forceinline__ void done(const AttnUnit&)const{}
};
template<class Sched,int THRL=8> __device__ __forceinline__ void attn_phase(char*lds,const AttnTensors&T,const Sched&S){
  AttnUnit u;
  for(int i=0;S.next(i,u);++i){ S.a_ready(u); attn_unit<THRL>(u.bh/NHEAD,u.bh%NHEAD,u.qb,T.Q,T.K,T.V,T.G,T.CB,T.O,lds); S.done(u); }
}
#undef SBAR
#undef WAIT_BAR
}

__device__ __forceinline__ int src_col(int n) {
    if (n < 1024) { const int cp = n & 255; return (n & ~255) + 64 * ((cp >> 5) & 3) + 32 * (cp >> 7) + (cp & 31); }
    if (n < 1536) return n;
    if (n < UP) return n - UR + SR;
    if (n < UG) return -1;
    if (n < UF) return n - UG + SG;
    if (n < UF + 8) return n - UF + SF;
    return -2;
}
__device__ __forceinline__ void phase_weights(const Params& p, unsigned char* lds) {
    float (*tile)[65] = (float (*)[65])lds;
    const int tid = otid();
    constexpr int T_IN = (NU / 64) * (DM / 64), T_OUT = (DM / 64) * (DM / 64), PER_L = T_IN + T_OUT;
    for (int it = blockIdx.x; it < NL * PER_L; it += gridDim.x) {
        const int l = it / PER_L; int r = it % PER_L;
        if (r < T_IN) {
            const int nt = r / (DM / 64), kt = r % (DM / 64), n0 = nt * 64, k0 = kt * 64;
            const float* W = p.w_in + (size_t)l * DM * D_IN;
            for (int e = tid; e < 64 * 64; e += NTHREADS) {
                const int kk = e >> 6, nn = e & 63, n = n0 + nn, sc = src_col(n);
                float v = 0.f;
                if (sc >= 0) v = W[(size_t)(k0 + kk) * D_IN + sc];
                else if (sc == -1) {
                    const int g = (n - UP) >> 6, d = (n - UP) & 63;
                    const float* pw = p.pool_w + ((size_t)l * 4 + g) * 64 * 64;
                    const float* wr = W + (size_t)(k0 + kk) * D_IN + SP + g * 64;
                    float s = 0.f;
                    for (int cc = 0; cc < 64; ++cc) s += wr[cc] * pw[cc * 64 + d];
                    v = s;
                }
                tile[kk][nn] = v;
            }
            __syncthreads();
            bf16_t* WT = (bf16_t*)(p.ws + WS_WT) + (size_t)l * NU * DM;
            for (int e = tid; e < 64 * 32; e += NTHREADS) {
                const int nn = e >> 5, kp = (e & 31) * 2;
                *(unsigned*)(WT + (size_t)(n0 + nn) * DM + k0 + kp) = pk2(tile[kp][nn], tile[kp + 1][nn]);
            }
            __syncthreads();
        } else {
            r -= T_IN;
            const int nt = r / (DM / 64), kt = r % (DM / 64), n0 = nt * 64, k0 = kt * 64;
            const float* W = p.w_out + (size_t)l * DM * DM;
            for (int e = tid; e < 64 * 64; e += NTHREADS) { const int kk = e >> 6, nn = e & 63; tile[kk][nn] = W[(size_t)(k0 + kk) * DM + n0 + nn]; }
            __syncthreads();
            bf16_t* WOT = (bf16_t*)(p.ws + WS_WOT) + (size_t)l * DM * DM;
            for (int e = tid; e < 64 * 32; e += NTHREADS) {
                const int nn = e >> 5, kp = (e & 31) * 2;
                *(unsigned*)(WOT + (size_t)(n0 + nn) * DM + k0 + kp) = pk2(tile[kp][nn], tile[kp + 1][nn]);
            }
            __syncthreads();
        }
    }
}

__device__ __forceinline__ void phase_mod(const Params& p, unsigned char* lds) {
    float (*sc)[DM] = (float (*)[DM])lds;
    float (*red)[NB][64] = (float (*)[NB][64])(lds + 32768);
    const int tid = otid();
    if ((int)blockIdx.x >= NL * 48) return;
    for (int e = tid; e < NB * DM; e += NTHREADS) sc[e / DM][e % DM] = siluf_(p.c[e]);
    __syncthreads();
    float* mod = (float*)(p.ws + WS_MOD);
    const int kg = tid >> 6, cl = tid & 63;
    for (int it = blockIdx.x; it < NL * 48; it += gridDim.x) {
        const int l = it / 48, n = (it % 48) * 64 + cl;
        const float* W = p.ada_w + (size_t)l * DM * 3072 + n;
        float acc[NB];
#pragma unroll
        for (int b = 0; b < NB; ++b) acc[b] = 0.f;
#pragma unroll 8
        for (int k = kg * 128; k < kg * 128 + 128; ++k) {
            const float w = W[(size_t)k * 3072];
#pragma unroll
            for (int b = 0; b < NB; ++b) acc[b] += sc[b][k] * w;
        }
#pragma unroll
        for (int b = 0; b < NB; ++b) red[kg][b][cl] = acc[b];
        __syncthreads();
        {
            const int b = tid >> 6;
            float s = p.ada_b[l * 3072 + n];
#pragma unroll
            for (int g = 0; g < 8; ++g) s += red[g][b][cl];
            mod[((size_t)l * NB + b) * 3072 + n] = s;
        }
        __syncthreads();
    }
}

__device__ __forceinline__ void row_h_store(const f32x4 (&v)[4], float rinv, const float* npre, const float* mod_lb, bf16_t* xnrow, int lane) {
#pragma unroll
    for (int j = 0; j < 4; ++j) {
        const int c = j * 256 + lane * 4;
        const f32x4 g = *(const f32x4*)(npre + c), sh = *(const f32x4*)(mod_lb + c), scl = *(const f32x4*)(mod_lb + 1024 + c);
        f32x4 h;
#pragma unroll
        for (int i = 0; i < 4; ++i) h[i] = v[j][i] * rinv * g[i] * (1.f + scl[i]) + sh[i];
        u32x2 w; w.x = pk2(h[0], h[1]); w.y = pk2(h[2], h[3]);
        *(u32x2*)(xnrow + c) = w;
    }
}
__device__ __forceinline__ void phase_rows(const Params& p, int mode, int l) {
    const int tid = otid(), lane = tid & 63, wv = tid >> 6;
    const int gw = blockIdx.x * 8 + wv, ngw = gridDim.x * 8;
    const float* mod = (const float*)(p.ws + WS_MOD);
    bf16_t* XN = (bf16_t*)(p.ws + WS_XN);
    const bf16_t* Z = (const bf16_t*)(p.ws + WS_Z);
    for (int m = gw; m < MTOK; m += ngw) {
        const int b = m / SEQ;
        f32x4 v[4];
        if (mode == 0) {
#pragma unroll
            for (int j = 0; j < 4; ++j) v[j] = *(const f32x4*)(p.x + (size_t)m * DM + j * 256 + lane * 4);
            float s = 0.f;
#pragma unroll
            for (int j = 0; j < 4; ++j) s += v[j][0] * v[j][0] + v[j][1] * v[j][1] + v[j][2] * v[j][2] + v[j][3] * v[j][3];
            const float rinv = rsqrtf(wave_sum(s) * (1.f / DM) + 1e-6f);
            row_h_store(v, rinv, p.norm_pre, mod + ((size_t)0 * NB + b) * 3072, XN + (size_t)m * DM, lane);
        } else {
            f32x4 z[4];
#pragma unroll
            for (int j = 0; j < 4; ++j) { const u32x2 zw = *(const u32x2*)(Z + (size_t)m * DM + j * 256 + lane * 4); z[j] = (f32x4){bflo(zw.x), bfhi(zw.x), bflo(zw.y), bfhi(zw.y)}; }
            float s = 0.f;
#pragma unroll
            for (int j = 0; j < 4; ++j) s += z[j][0] * z[j][0] + z[j][1] * z[j][1] + z[j][2] * z[j][2] + z[j][3] * z[j][3];
            const float rz = rsqrtf(wave_sum(s) * (1.f / DM) + 1e-6f);
            const float* xold = (l == 0) ? p.x : p.out;
            const float* mod_lb = mod + ((size_t)l * NB + b) * 3072;
            float s2 = 0.f;
#pragma unroll
            for (int j = 0; j < 4; ++j) {
                const int c = j * 256 + lane * 4;
                const f32x4 xo = *(const f32x4*)(xold + (size_t)m * DM + c), gp = *(const f32x4*)(p.norm_post + l * DM + c), gt = *(const f32x4*)(mod_lb + 2048 + c);
#pragma unroll
                for (int i = 0; i < 4; ++i) { v[j][i] = xo[i] + gt[i] * (z[j][i] * rz * gp[i]); s2 += v[j][i] * v[j][i]; }
                *(f32x4*)(p.out + (size_t)m * DM + c) = v[j];
            }
            if (l + 1 < NL) {
                const float rinv = rsqrtf(wave_sum(s2) * (1.f / DM) + 1e-6f);
                row_h_store(v, rinv, p.norm_pre + (l + 1) * DM, mod + ((size_t)(l + 1) * NB + b) * 3072, XN + (size_t)m * DM, lane);
            }
        }
    }
}

template <int MODE>
__device__ __forceinline__ void phase_gemm_simple(unsigned char* lds, const bf16_t* A, const bf16_t* Bt, void* Cout, int M, int N, int K, const float* qg, const float* kg) {
    bf16_t (*As)[40] = (bf16_t (*)[40])lds;
    bf16_t (*Bs)[40] = (bf16_t (*)[40])(lds + 128 * 40 * 2);
    const int tid = otid(), lane = tid & 63, wv = tid >> 6;
    const int ntn = N / 64, ntm = M / 128;
    for (int it = blockIdx.x; it < ntm * ntn; it += gridDim.x) {
        const int tm = it / ntn, tn = it % ntn, m0 = tm * 128, n0 = tn * 64;
        f32x4 acc[4];
#pragma unroll
        for (int n = 0; n < 4; ++n) acc[n] = (f32x4){0.f, 0.f, 0.f, 0.f};
        for (int k0 = 0; k0 < K; k0 += 32) {
            {
                const int r = tid >> 2, ch = tid & 3;
                *(u32x4*)(&As[r][ch * 8]) = *(const u32x4*)(A + (size_t)(m0 + r) * K + k0 + ch * 8);
                if (tid < 256) *(u32x4*)(&Bs[r][ch * 8]) = *(const u32x4*)(Bt + (size_t)(n0 + r) * K + k0 + ch * 8);
            }
            __syncthreads();
            const bf16x8 a = *(const bf16x8*)(&As[wv * 16 + (lane & 15)][(lane >> 4) * 8]);
#pragma unroll
            for (int n = 0; n < 4; ++n) {
                const bf16x8 b = *(const bf16x8*)(&Bs[n * 16 + (lane & 15)][(lane >> 4) * 8]);
                acc[n] = __builtin_amdgcn_mfma_f32_16x16x32_bf16(a, b, acc[n], 0, 0, 0);
            }
            __syncthreads();
        }
        if (MODE == 0) {
            bf16_t* C = (bf16_t*)Cout;
            float scale[4] = {1.f, 1.f, 1.f, 1.f};
            float gain[4] = {1.f, 1.f, 1.f, 1.f};
            if (n0 < 1024) {
#pragma unroll
                for (int r = 0; r < 4; ++r) {
                    float s = acc[0][r] * acc[0][r] + acc[1][r] * acc[1][r] + acc[2][r] * acc[2][r] + acc[3][r] * acc[3][r];
                    s += __shfl_xor(s, 1); s += __shfl_xor(s, 2); s += __shfl_xor(s, 4); s += __shfl_xor(s, 8);
                    scale[r] = rsqrtf(s * (1.f / 64.f) + 1e-6f) * (n0 < 512 ? C2 : 1.f);
                }
#pragma unroll
                for (int n = 0; n < 4; ++n) gain[n] = (n0 < 512 ? qg : kg)[n * 16 + (lane & 15)];
            }
#pragma unroll
            for (int n = 0; n < 4; ++n)
#pragma unroll
                for (int r = 0; r < 4; ++r)
                    C[(size_t)(m0 + wv * 16 + (lane >> 4) * 4 + r) * N + n0 + n * 16 + (lane & 15)] = (bf16_t)f2bf(acc[n][r] * scale[r] * gain[n]);
        } else {
            float* C = (float*)Cout;
#pragma unroll
            for (int n = 0; n < 4; ++n)
#pragma unroll
                for (int r = 0; r < 4; ++r) C[(size_t)(m0 + wv * 16 + (lane >> 4) * 4 + r) * N + n0 + n * 16 + (lane & 15)] = acc[n][r];
        }
    }
}

__device__ __forceinline__ void phase_cum(const Params& p, int l, unsigned char* lds) {
    float (*wtot)[8] = (float (*)[8])lds;
    const int tid = otid(), lane = tid & 63, wv = tid >> 6;
    const bf16_t* U = (const bf16_t*)(p.ws + WS_U);
    float* CB = (float*)(p.ws + WS_CB);
    for (int b = blockIdx.x; b < NB; b += gridDim.x) {
        float pre[8][8];
        float run[8];
#pragma unroll
        for (int h = 0; h < 8; ++h) run[h] = 0.f;
#pragma unroll
        for (int i = 0; i < 8; ++i) {
            const u32x4 w = *(const u32x4*)(U + (size_t)(b * SEQ + tid * 8 + i) * NU + UF);
            float f[8] = {bflo(w.x), bfhi(w.x), bflo(w.y), bfhi(w.y), bflo(w.z), bfhi(w.z), bflo(w.w), bfhi(w.w)};
#pragma unroll
            for (int h = 0; h < 8; ++h) {
                const float xx = f[h] + p.f_bias[l * 8 + h];
                const float ls = fminf(xx, 0.f) - __logf(1.f + __expf(-fabsf(xx)));
                run[h] += -ls * LOG2E;
                pre[i][h] = run[h];
            }
        }
        float exc[8];
#pragma unroll
        for (int h = 0; h < 8; ++h) {
            float v = run[h];
#pragma unroll
            for (int o = 1; o < 64; o <<= 1) { const float t = __shfl_up(v, o); if (lane >= o) v += t; }
            if (lane == 63) wtot[wv][h] = v;
            exc[h] = v - run[h];
        }
        __syncthreads();
#pragma unroll
        for (int h = 0; h < 8; ++h) { float base = 0.f; for (int w2 = 0; w2 < wv; ++w2) base += wtot[w2][h]; exc[h] += base; }
#pragma unroll
        for (int h = 0; h < 8; ++h)
#pragma unroll
            for (int i = 0; i < 8; ++i) CB[((size_t)b * 8 + h) * SEQ + tid * 8 + i] = exc[h] + pre[i][h];
        __syncthreads();
    }
}

typedef _Float16 h8 __attribute__((ext_vector_type(8)));
typedef _Float16 h4 __attribute__((ext_vector_type(4)));
typedef float f32x2 __attribute__((ext_vector_type(2)));
template <int CTRL> __device__ __forceinline__ float dpp_add(float x) {
    const int y = __builtin_amdgcn_update_dpp(0, __builtin_bit_cast(int, x), CTRL, 0xF, 0xF, true);
    return x + __builtin_bit_cast(float, y);
}
__device__ __forceinline__ float row16_sum(float x) {
    x = dpp_add<0xB1>(x); x = dpp_add<0x4E>(x); x = dpp_add<0x141>(x); x = dpp_add<0x140>(x); return x;
}
__device__ __forceinline__ float wave_sum_fast(float x) {
    x = row16_sum(x);
    { const unsigned xi = __builtin_bit_cast(unsigned, x); auto rr = __builtin_amdgcn_permlane16_swap(xi, xi, false, false); const unsigned r0 = rr[0], r1 = rr[1]; x = __builtin_bit_cast(float, r0) + __builtin_bit_cast(float, r1); }
    { const unsigned xi = __builtin_bit_cast(unsigned, x); auto rr = __builtin_amdgcn_permlane32_swap(xi, xi, false, false); const unsigned r0 = rr[0], r1 = rr[1]; x = __builtin_bit_cast(float, r0) + __builtin_bit_cast(float, r1); }
    return x;
}
__device__ __forceinline__ f32x4 mma_nt16(f32x4 acc, const LAS unsigned char* A, int pa, const LAS unsigned char* Bt, int pb, int K, int lane) {
    const LAS unsigned char* ap = A + (lane & 15) * pa + (lane >> 4) * 16;
    const LAS unsigned char* bp = Bt + (lane & 15) * pb + (lane >> 4) * 16;
#pragma unroll
    for (int k = 0; k < K; k += 32) {
        const bf16x8 a = *(const LAS bf16x8*)(ap + 2 * k), b = *(const LAS bf16x8*)(bp + 2 * k);
        acc = __builtin_amdgcn_mfma_f32_16x16x32_bf16(a, b, acc, 0, 0, 0);
    }
    return acc;
}
constexpr int CK_W2T = 0, CK_A2T = 9216, CK_XW = 18432, CK_XA = 23040, CK_SWF = 27648, CK_SAF = 35968, CK_TOT = 44288, CK_EGL = 46336;
constexpr int CK_KT = 46592, CK_RT = 51200, CK_BH = 55808, CK_KH = 60416, CK_RHS = 65024, CK_VT = 81920, CK_BBT = 87040, CK_KBT = 92160, CK_LF = 97280;
constexpr int CK_AAK = 101888, CK_AQB = 104448, CK_AQK = 107008, CK_W1T = 109568, CK_W2N = 114688, CK_OUT = 119808;
constexpr int P72 = 144, P40 = 80, PSF = 65 * 4, PRHS = 132 * 4, PLF = 36 * 4;
__device__ __forceinline__ float fsigmoid(float x) { return __builtin_amdgcn_rcpf(1.f + __expf(-x)); }
__device__ __forceinline__ float ftanh(float x) { return 1.f - 2.f * __builtin_amdgcn_rcpf(1.f + __expf(2.f * x)); }
typedef float f32x2c __attribute__((ext_vector_type(2))); typedef __bf16 bf16x2c __attribute__((ext_vector_type(2)));
__device__ __forceinline__ unsigned cvtpk(float lo, float hi) { const f32x2c v = {lo, hi}; const bf16x2c b = __builtin_convertvector(v, bf16x2c); return __builtin_bit_cast(unsigned, b); }
__device__ __forceinline__ bf16_t cvt1(float x) { return (bf16_t)(cvtpk(x, x) & 0xffffu); }
__device__ __forceinline__ void phase_rwkv_chunk(const Params& p, int l, unsigned char* lds_) {
    LAS unsigned char* lds = (LAS unsigned char*)lds_;
    const int tid = otid(), lane = tid & 63, wv = __builtin_amdgcn_readfirstlane(tid >> 6);
    const int h = (int)blockIdx.x & 3, c = h * 64 + lane;
    const bf16_t* U = (const bf16_t*)(p.ws + WS_U);
    float* BON = (float*)(p.ws + WS_BON);
    unsigned char* CHK = p.ws + WS_CHK;
    for (int e = tid; e < 2 * 64 * 64; e += NTHREADS) {
        const int which = e >> 12, k = (e >> 6) & 63, cc = e & 63;
        const float v = (which ? p.a2 : p.w2)[((size_t)l * 64 + k) * 256 + h * 64 + cc];
        *(LAS bf16_t*)(lds + (which ? CK_A2T : CK_W2T) + cc * P72 + k * 2) = cvt1(v);
    }
    const float mur = p.mu[l * 896 + c], muk = p.mu[l * 896 + 256 + c], muv = p.mu[l * 896 + 512 + c], muw = p.mu[l * 896 + 768 + lane], mua = p.mu[l * 896 + 832 + lane];
    const float w0c = p.w0[l * 256 + c], a0c = p.a0[l * 256 + c], kkc = p.k_k[l * 256 + c], kac = p.k_a[l * 256 + c], rkc = p.r_k[l * 256 + c];
    const int fr = lane & 15, fq = lane >> 4;
    unsigned short xr[5], xk[5], xv[5], xw_[5], xa_[5];
#define CK_LOAD(qq) do { const int b_ = (qq) / NCHK, ch_ = (qq) % NCHK; const bf16_t* ub = U + ((size_t)b_ * SEQ + ch_ * 32 + 4 * wv) * NU + UR; const bool first_ = (ch_ == 0 && wv == 0); \
        _Pragma("unroll") for (int u = 0; u < 5; ++u) { const bf16_t* q_ = ub + (ptrdiff_t)(u - 1 + ((u == 0 && first_) ? 1 : 0)) * NU; \
            xr[u] = q_[c]; xk[u] = q_[256 + c]; xv[u] = q_[512 + c]; xw_[u] = q_[768 + lane]; xa_[u] = q_[832 + lane]; } } while (0)
    if (((int)blockIdx.x >> 2) < NB * NCHK) CK_LOAD((int)blockIdx.x >> 2);
    for (int q = (int)blockIdx.x >> 2; q < NB * NCHK; q += (int)gridDim.x >> 2) {
        const int b = q / NCHK, ch = q % NCHK;
        int lz_ = 0; asm volatile("" : "+v"(lz_)); LAS unsigned char* L_ = lds + lz_;
        const size_t m0 = (size_t)b * SEQ + ch * 32;
        float rl[4], kl[4], vl[4];
        {
            const bool first = (ch == 0 && wv == 0);
#pragma unroll
            for (int u = 0; u < 4; ++u) {
                const float pz = (u == 0 && first) ? 0.f : 1.f;
                const float rc = bf2f(xr[u + 1]), kc = bf2f(xk[u + 1]), vc = bf2f(xv[u + 1]), wc = bf2f(xw_[u + 1]), ac = bf2f(xa_[u + 1]);
                rl[u] = rc + (bf2f(xr[u]) * pz - rc) * mur; kl[u] = kc + (bf2f(xk[u]) * pz - kc) * muk; vl[u] = vc + (bf2f(xv[u]) * pz - vc) * muv;
                const float wl = wc + (bf2f(xw_[u]) * pz - wc) * muw, al = ac + (bf2f(xa_[u]) * pz - ac) * mua;
                const int t = 4 * wv + u;
                *(LAS bf16_t*)(L_ + CK_XW + t * P72 + lane * 2) = cvt1(ftanh(wl));
                *(LAS bf16_t*)(L_ + CK_XA + t * P72 + lane * 2) = cvt1(al);
            }
            const int qn = q + ((int)gridDim.x >> 2);
            if (qn < NB * NCHK) CK_LOAD(qn);
        }
        __syncthreads();
        {
            const int mi = wv >> 2, tr = (wv >> 1) & 1;
#pragma unroll
            for (int i = 0; i < 2; ++i) {
                const int tc = 2 * (wv & 1) + i;
                f32x4 acc = {0.f, 0.f, 0.f, 0.f};
                acc = mma_nt16(acc, L_ + (mi ? CK_XA : CK_XW) + 16 * tr * P72, P72, L_ + (mi ? CK_A2T : CK_W2T) + 16 * tc * P72, P72, 64, lane);
#pragma unroll
                for (int r = 0; r < 4; ++r) *(LAS float*)(L_ + (mi ? CK_SAF : CK_SWF) + (16 * tr + 4 * fq + r) * PSF + (16 * tc + fr) * 4) = acc[r];
            }
        }
        __syncthreads();
        float lw[4], kkv[4], ktv[4], bbv[4], gl[4];
        {
            float run = 0.f;
#pragma unroll
            for (int u = 0; u < 4; ++u) {
                const int t = 4 * wv + u;
                const float sw = *(const LAS float*)(L_ + CK_SWF + t * PSF + lane * 4) + w0c, sa = *(const LAS float*)(L_ + CK_SAF + t * PSF + lane * 4) + a0c;
                lw[u] = -DECAY_SCALE * fsigmoid(sw);
                const float a = fsigmoid(sa);
                const float kx = kl[u] * kkc;
                kkv[u] = kx * __builtin_amdgcn_rsqf(fmaxf(wave_sum_fast(kx * kx), 1e-24f));
                ktv[u] = kl[u] * (1.f + (a - 1.f) * kac); bbv[u] = kkv[u] * a;
                const float bs = wave_sum_fast(rl[u] * ktv[u] * rkc);
                if (lane == 0) BON[(m0 + t) * 4 + h] = bs;
                run += lw[u]; gl[u] = run;
            }
            *(LAS float*)(L_ + CK_TOT + (wv * 64 + lane) * 4) = run;
        }
        __syncthreads();
        {
            float off = 0.f, tot = 0.f;
#pragma unroll
            for (int g = 0; g < 8; ++g) { const float x = *(const LAS float*)(L_ + CK_TOT + (g * 64 + lane) * 4); tot += x; off += (g < wv) ? x : 0.f; }
            const float etot = __expf(tot);
            if (wv == 0) *(LAS float*)(L_ + CK_EGL + lane * 4) = etot;
            float bbe[4], kte[4];
#pragma unroll
            for (int u = 0; u < 4; ++u) {
                const int t = 4 * wv + u;
                const float G = off + gl[u];
                const float e1 = __expf(G - lw[u]), e2 = __expf(G), inv = __builtin_amdgcn_rcpf(e2), el = etot * inv;
                const float ktl = kkv[u] * e1;
                *(LAS bf16_t*)(L_ + CK_KT + t * P72 + lane * 2) = cvt1(ktl);
                *(LAS float*)(L_ + CK_RHS + t * PRHS + lane * 4) = ktl;
                *(LAS bf16_t*)(L_ + CK_RT + t * P72 + lane * 2) = cvt1(rl[u] * e2);
                *(LAS bf16_t*)(L_ + CK_BH + t * P72 + lane * 2) = cvt1(bbv[u] * inv);
                *(LAS bf16_t*)(L_ + CK_KH + t * P72 + lane * 2) = cvt1(ktv[u] * inv);
                bbe[u] = bbv[u] * el; kte[u] = ktv[u] * el;
            }
            *(LAS u32x2*)(L_ + CK_VT + lane * P40 + wv * 8) = (u32x2){cvtpk(vl[0], vl[1]), cvtpk(vl[2], vl[3])};
            *(LAS u32x2*)(L_ + CK_BBT + lane * P40 + wv * 8) = (u32x2){cvtpk(bbe[0], bbe[1]), cvtpk(bbe[2], bbe[3])};
            *(LAS u32x2*)(L_ + CK_KBT + lane * P40 + wv * 8) = (u32x2){cvtpk(kte[0], kte[1]), cvtpk(kte[2], kte[3])};
        }
        __syncthreads();
        {
            const int mi = wv >> 1, tr = wv & 1;
            const LAS unsigned char* A = L_ + ((mi < 2) ? CK_KT : CK_RT) + 16 * tr * P72;
            const LAS unsigned char* Bm = L_ + ((mi & 1) ? CK_KH : CK_BH);
#pragma unroll
            for (int tc = 0; tc < 2; ++tc) {
                f32x4 acc = {0.f, 0.f, 0.f, 0.f};
                acc = mma_nt16(acc, A, P72, Bm + 16 * tc * P72, P72, 64, lane);
#pragma unroll
                for (int r = 0; r < 4; ++r) {
                    const int t = 16 * tr + 4 * fq + r, s_ = 16 * tc + fr;
                    const float x = (mi < 2 ? (s_ < t) : (s_ <= t)) ? acc[r] : 0.f;
                    if (mi == 0) *(LAS float*)(L_ + CK_LF + s_ * PLF + (((t & 3) << 3) + (t >> 2)) * 4) = x;
                    else *(LAS bf16_t*)(L_ + (mi == 1 ? CK_AAK : (mi == 2 ? CK_AQB : CK_AQK)) + t * P40 + s_ * 2) = cvt1(x);
                }
            }
        }
        __syncthreads();
        {
            const int tr = wv >> 2, ic = wv & 3;
            f32x4 acc = {0.f, 0.f, 0.f, 0.f};
            acc = mma_nt16(acc, L_ + CK_AAK + 16 * tr * P40, P40, L_ + CK_VT + 16 * ic * P40, P40, 32, lane);
#pragma unroll
            for (int r = 0; r < 4; ++r) *(LAS float*)(L_ + CK_RHS + (16 * tr + 4 * fq + r) * PRHS + (64 + 16 * ic + fr) * 4) = acc[r];
        }
        __syncthreads();
        {
            const int col = tid >> 2, pq = tid & 3;
            float acc[8];
#pragma unroll
            for (int i = 0; i < 8; ++i) acc[i] = *(const LAS float*)(L_ + CK_RHS + (4 * i + pq) * PRHS + col * 4);
            const LAS unsigned char* lp = L_ + CK_LF + pq * 32;
#pragma unroll
            for (int s_ = 0; s_ < 31; ++s_) {
                const f32x4 l0 = *(const LAS f32x4*)(lp + s_ * PLF), l1 = *(const LAS f32x4*)(lp + s_ * PLF + 16);
                const int xi_ = __builtin_bit_cast(int, acc[s_ >> 2]); int src;
                switch (s_ & 3) { case 0: src = __builtin_amdgcn_update_dpp(0, xi_, 0x00, 0xF, 0xF, true); break; case 1: src = __builtin_amdgcn_update_dpp(0, xi_, 0x55, 0xF, 0xF, true); break;
                                  case 2: src = __builtin_amdgcn_update_dpp(0, xi_, 0xAA, 0xF, 0xF, true); break; default: src = __builtin_amdgcn_update_dpp(0, xi_, 0xFF, 0xF, 0xF, true); break; }
                const float ws = __builtin_bit_cast(float, src);
#pragma unroll
                for (int i = 0; i < 4; ++i) { acc[i] -= l0[i] * ws; acc[4 + i] -= l1[i] * ws; }
                if ((s_ & 7) == 7) asm volatile("" ::: "memory");
            }
            LAS unsigned char* dst = L_ + (col < 64 ? CK_W1T : CK_W2N) + (col & 63) * P40;
#pragma unroll
            for (int i = 0; i < 8; ++i) *(LAS bf16_t*)(dst + (4 * i + pq) * 2) = cvt1(-acc[i]);
        }
        __syncthreads();
        {
            {
                const int tr = wv >> 2, cc = wv & 3;
                f32x4 acc;
#pragma unroll
                for (int r = 0; r < 4; ++r) acc[r] = bf2f(*(const LAS bf16_t*)(L_ + CK_RT + (16 * tr + 4 * fq + r) * P72 + (16 * cc + fr) * 2));
                acc = mma_nt16(acc, L_ + CK_AQB + 16 * tr * P40, P40, L_ + CK_W1T + 16 * cc * P40, P40, 32, lane);
#pragma unroll
                for (int r = 0; r < 4; ++r) *(LAS bf16_t*)(L_ + CK_OUT + (16 * tr + 4 * fq + r) * 128 + (16 * cc + fr) * 2) = cvt1(acc[r]);
                f32x4 ac2 = {0.f, 0.f, 0.f, 0.f};
                ac2 = mma_nt16(ac2, L_ + CK_AQK + 16 * tr * P40, P40, L_ + CK_VT + 16 * cc * P40, P40, 32, lane);
                ac2 = mma_nt16(ac2, L_ + CK_AQB + 16 * tr * P40, P40, L_ + CK_W2N + 16 * cc * P40, P40, 32, lane);
#pragma unroll
                for (int r = 0; r < 4; ++r) *(LAS bf16_t*)(L_ + CK_OUT + 4096 + (16 * tr + 4 * fq + r) * 128 + (16 * cc + fr) * 2) = cvt1(ac2[r]);
            }
#pragma unroll
            for (int i = 0; i < 2; ++i) {
                const int tl = 2 * wv + i, rr = tl >> 2, cc = tl & 3;
                f32x4 acc = {0.f, 0.f, 0.f, 0.f};
                acc = mma_nt16(acc, L_ + CK_BBT + 16 * rr * P40, P40, L_ + CK_W1T + 16 * cc * P40, P40, 32, lane);
#pragma unroll
                for (int r = 0; r < 4; ++r) { const int jp = 16 * rr + 4 * fq + r, j = 16 * cc + fr;
                    const float x = acc[r] + ((jp == j) ? *(const LAS float*)(L_ + CK_EGL + j * 4) : 0.f);
                    *(LAS bf16_t*)(L_ + CK_OUT + 8192 + jp * 128 + j * 2) = cvt1(x); }
                f32x4 ac2 = {0.f, 0.f, 0.f, 0.f};
                ac2 = mma_nt16(ac2, L_ + CK_VT + 16 * rr * P40, P40, L_ + CK_KBT + 16 * cc * P40, P40, 32, lane);
                ac2 = mma_nt16(ac2, L_ + CK_W2N + 16 * rr * P40, P40, L_ + CK_BBT + 16 * cc * P40, P40, 32, lane);
#pragma unroll
                for (int r = 0; r < 4; ++r) *(LAS bf16_t*)(L_ + CK_OUT + 16384 + (16 * rr + 4 * fq + r) * 128 + (16 * cc + fr) * 2) = cvt1(ac2[r]);
            }
        }
        __syncthreads();
        {
            unsigned char* dst = CHK + ((size_t)(b * 4 + h) * NCHK + ch) * CHK_B;
#pragma unroll
            for (int i = 0; i < 3; ++i) *(u32x4*)(dst + (i * NTHREADS + tid) * 16) = *(const LAS u32x4*)(L_ + CK_OUT + (i * NTHREADS + tid) * 16);
        }
        __syncthreads();
    }
}

#undef CK_LOAD
__device__ __forceinline__ void glds16g(const void* gsrc, unsigned lds_dst) { unsigned keep;
    asm volatile("s_mov_b32 %0, m0\n\ts_mov_b32 m0, %2\n\ts_nop 0\n\tglobal_load_lds_dwordx4 %1, off\n\ts_mov_b32 m0, %0" : "=&s"(keep) : "v"(gsrc), "s"(lds_dst) : "memory"); }
constexpr int CN_NBUF = 5, CN_RING = 0, CN_SB = CN_NBUF * CHK_B;
__device__ __forceinline__ void phase_rwkv_chain(const Params& p, unsigned char* lds_, int bh) {
    LAS unsigned char* lds = (LAS unsigned char*)lds_;
    const int tid = otid(), lane = tid & 63, wv = __builtin_amdgcn_readfirstlane(tid >> 6);
    const int fr = lane & 15, fq = lane >> 4, b = bh >> 2, h = bh & 3;
    const unsigned char* rec = p.ws + WS_CHK + (size_t)bh * NCHK * CHK_B;
    float* O32 = (float*)(p.ws + WS_O32);
    const unsigned lds0 = (unsigned)(size_t)lds;
#define CN_DMA(cc) do { const unsigned char* g = rec + (size_t)(cc) * CHK_B + tid * 16; const unsigned d = (unsigned)__builtin_amdgcn_readfirstlane((int)(lds0 + CN_RING + ((cc) % CN_NBUF) * CHK_B + wv * 1024)); \
        glds16g(g, d); glds16g(g + 8192, d + 8192); glds16g(g + 16384, d + 16384); } while (0)
    for (int e = tid; e < 2 * 64 * 72 / 2; e += NTHREADS) *(LAS unsigned*)(lds + CN_SB + e * 4) = 0u;
    CN_DMA(0); CN_DMA(1); CN_DMA(2); CN_DMA(3);
    asm volatile("s_waitcnt vmcnt(0) lgkmcnt(0)\n\ts_barrier" ::: "memory");
#pragma unroll 1
    for (int cc = 0; cc < NCHK; ++cc) {
        if (cc + 4 < NCHK) CN_DMA(cc + 4);
        int lz_ = 0; asm volatile("" : "+v"(lz_)); LAS unsigned char* L_ = lds + lz_;
        const LAS unsigned char* R = L_ + CN_RING + (cc % CN_NBUF) * CHK_B;
        const LAS unsigned char* Sc = L_ + CN_SB + (cc & 1) * (64 * P72);
        LAS unsigned char* Sn = L_ + CN_SB + ((cc + 1) & 1) * (64 * P72);
        {
            const int tr = wv >> 2, ic = wv & 3;
            f32x4 acc;
#pragma unroll
            for (int r = 0; r < 4; ++r) acc[r] = bf2f(*(const LAS bf16_t*)(R + 4096 + (16 * tr + 4 * fq + r) * 128 + (16 * ic + fr) * 2));
            acc = mma_nt16(acc, R + 16 * tr * 128, 128, Sc + 16 * ic * P72, P72, 64, lane);
            float* op = O32 + ((size_t)b * SEQ + cc * 32 + 16 * tr + 4 * fq) * 256 + h * 64 + 16 * ic + fr;
#pragma unroll
            for (int r = 0; r < 4; ++r) op[(size_t)r * 256] = acc[r];
        }
#pragma unroll
        for (int i = 0; i < 2; ++i) {
            const int tl = 2 * wv + i, ir = tl >> 2, jc = tl & 3;
            f32x4 acc;
#pragma unroll
            for (int r = 0; r < 4; ++r) acc[r] = bf2f(*(const LAS bf16_t*)(R + 16384 + (16 * ir + 4 * fq + r) * 128 + (16 * jc + fr) * 2));
            acc = mma_nt16(acc, Sc + 16 * ir * P72, P72, R + 8192 + 16 * jc * 128, 128, 64, lane);
#pragma unroll
            for (int r = 0; r < 4; ++r) *(LAS bf16_t*)(Sn + (16 * ir + 4 * fq + r) * P72 + (16 * jc + fr) * 2) = (bf16_t)f2bf(acc[r]);
        }
        if (cc + 4 < NCHK) asm volatile("s_waitcnt vmcnt(9) lgkmcnt(0)\n\ts_barrier" ::: "memory");
        else asm volatile("s_waitcnt vmcnt(0) lgkmcnt(0)\n\ts_barrier" ::: "memory");
    }
#undef CN_DMA
}

__device__ __forceinline__ void phase_rwkv_fin(const Params& p, int l) {
    const int tid = otid(), lane = tid & 63, wv = tid >> 6;
    const bf16_t* U = (const bf16_t*)(p.ws + WS_U);
    const float* O32 = (const float*)(p.ws + WS_O32); const float* BON = (const float*)(p.ws + WS_BON);
    bf16_t* Y = (bf16_t*)(p.ws + WS_Y);
    const int ngw = gridDim.x * 8;
    for (int m2 = blockIdx.x * 8 + wv; m2 < MTOK / 2; m2 += ngw) {
        float o[8], vc[8], vp[8], g[8], bn[8];
#pragma unroll
        for (int k = 0; k < 8; ++k) {
            const int m = 2 * m2 + (k >> 2), h = k & 3, c = h * 64 + lane;
            const bool has_prev = (m % SEQ) != 0;
            o[k] = O32[(size_t)m * 256 + c];
            vc[k] = bf2f(U[(size_t)m * NU + UR + 512 + c]);
            vp[k] = has_prev ? bf2f(U[(size_t)(m - 1) * NU + UR + 512 + c]) : 0.f;
            g[k] = bf2f(U[(size_t)m * NU + UG + 512 + c]);
            bn[k] = BON[(size_t)m * 4 + h];
        }
#pragma unroll
        for (int k = 0; k < 8; ++k) {
            const int m = 2 * m2 + (k >> 2), h = k & 3, c = h * 64 + lane;
            const float mean = wave_sum_fast(o[k]) * (1.f / 64.f);
            const float dv = o[k] - mean;
            const float var = wave_sum_fast(dv * dv) * (1.f / 64.f);
            const float v = vc[k] + (vp[k] - vc[k]) * p.mu[l * 896 + 512 + c];
            const float on = dv * rsqrtf(var + 64e-5f) * p.ln_g[l * 256 + c] + p.ln_b[l * 256 + c] + bn[k] * v;
            Y[(size_t)m * DM + 512 + c] = (bf16_t)f2bf(on * g[k] * __builtin_amdgcn_rcpf(1.f + __expf(-g[k])));
        }
    }
}

template <int W> __device__ __forceinline__ void pool_item(const bf16_t* up, bf16_t* yp, int t0, float scl) {
    unsigned short xc[16], xp[W - 1], gg[16];
#pragma unroll
    for (int i = 0; i < 16; ++i) { xc[i] = up[(size_t)i * NU]; gg[i] = up[(size_t)i * NU + (UG + 768 - UP)]; }
#pragma unroll
    for (int d = 1; d < W; ++d) xp[d - 1] = (t0 - d >= 0) ? up[-(ptrdiff_t)d * NU] : (unsigned short)0;
    float s = 0.f;
#pragma unroll
    for (int d = 1; d < W; ++d) s += bf2f(xp[d - 1]);
#pragma unroll
    for (int i = 0; i < 16; ++i) {
        const int t = t0 + i;
        const float cur = bf2f(xc[i]);
        s += cur;
        const int cnt = (t + 1 < W) ? t + 1 : W;
        const float yv = (s * __builtin_amdgcn_rcpf((float)cnt) - cur) * scl;
        const float gv = bf2f(gg[i]);
        yp[(size_t)i * DM] = (bf16_t)f2bf(yv * gv * __builtin_amdgcn_rcpf(1.f + __expf(-gv)));
        const int k = i - W + 1;
        s -= (k >= 0) ? bf2f(xc[k >= 0 ? k : 0]) : bf2f(xp[k < 0 ? -k - 1 : 0]);
    }
}
__device__ __forceinline__ void phase_pool(const Params& p, int l) {
    const bf16_t* U = (const bf16_t*)(p.ws + WS_U);
    bf16_t* Y = (bf16_t*)(p.ws + WS_Y);
    const int tid = otid(), c = tid & 255, sub = tid >> 8, g = __builtin_amdgcn_readfirstlane(c >> 6);
    const float scl = p.pool_scale[l * 256 + c];
    for (int it = blockIdx.x * 2 + sub; it < MTOK / 16; it += gridDim.x * 2) {
        const int m0 = it * 16, t0 = m0 % SEQ;
        const bf16_t* up = U + (size_t)m0 * NU + UP + c;
        bf16_t* yp = Y + (size_t)m0 * DM + 768 + c;
        if (g == 0) pool_item<2>(up, yp, t0, scl); else if (g == 1) pool_item<4>(up, yp, t0, scl); else if (g == 2) pool_item<8>(up, yp, t0, scl); else pool_item<16>(up, yp, t0, scl);
    }
}

__global__ void __launch_bounds__(NTHREADS, 2) mega_fwd(Params p) {
    extern __shared__ __attribute__((aligned(16))) unsigned char lds[];
    volatile LAS unsigned* MISC = (volatile LAS unsigned*)((LAS unsigned char*)lds + MISC_OFF);
    if (threadIdx.x < 32) MISC[threadIdx.x] = 0u;
    __syncthreads();
    XcdBarrier bar = xcd_barrier_post((unsigned*)(p.ws + WS_CTL) + CW_BAR, MISC + 8);
#define GRID_BAR() do { XcdBarrier b_ = bar; unsigned* bp_ = (unsigned*)(p.ws + WS_CTL) + CW_BAR; asm volatile("" : "+s"(bp_)); b_.bar = bp_; xcd_barrier(b_); } while (0)
    bf16_t* XN = (bf16_t*)(p.ws + WS_XN); bf16_t* Y = (bf16_t*)(p.ws + WS_Y); bf16_t* U = (bf16_t*)(p.ws + WS_U); bf16_t* Z = (bf16_t*)(p.ws + WS_Z);

    phase_weights(p, lds);
    phase_mod(p, lds);
    GRID_BAR();
    phase_rows(p, 0, 0);
    GRID_BAR();
#pragma unroll 1
    for (int l = 0; l < NL; ++l) {
        const bf16_t* WT = (const bf16_t*)(p.ws + WS_WT) + (size_t)l * NU * DM;
        const bf16_t* WOT = (const bf16_t*)(p.ws + WS_WOT) + (size_t)l * DM * DM;
        {
            pg8::Gemm g{XN, WT, MTOK, NU, DM}; pg8::StaticOrder S; S.init(MTOK, NU, (int)gridDim.x, (int)blockIdx.x);
            pg8::EpiU E{U, p.q_gain + l * 64, p.k_gain + l * 64, NU};
            pg8::gemm_phase<pg8::EpiU, pg8::StaticOrder, true, true>((LAS unsigned char*)lds, g, S, E);
        }
        GRID_BAR();
        phase_cum(p, l, lds);
        phase_rwkv_chunk(p, l, lds);
        phase_pool(p, l);
        GRID_BAR();
        if (blockIdx.x < NB * 4) phase_rwkv_chain(p, lds, (int)blockIdx.x);
        {
            const attn_body::AttnTensors AT{(const attn_body::bf16*)(U + UQ), (const attn_body::bf16*)(U + UK), (const attn_body::bf16*)(U + UV), (const attn_body::bf16*)(U + UG),
                                            (const float*)(p.ws + WS_CB), (attn_body::bf16*)Y};
            const attn_body::QueueOrder S{(unsigned*)(p.ws + WS_CTL) + CW_ATTQ + l * 64, MISC + 16};
            attn_body::attn_phase<attn_body::QueueOrder>((char*)lds, AT, S);
        }
        GRID_BAR();
        phase_rwkv_fin(p, l);
        GRID_BAR();
        {
            pg8::Gemm g{Y, WOT, MTOK, DM, DM}; pg8::StaticOrder S; S.init(MTOK, DM, (int)gridDim.x, (int)blockIdx.x);
            pg8::EpiB16 E{Z, DM};
            pg8::gemm_phase<pg8::EpiB16, pg8::StaticOrder, true, true>((LAS unsigned char*)lds, g, S, E);
        }
        GRID_BAR();
        phase_rows(p, 1, l);
        if (l + 1 < NL) GRID_BAR();
    }
}

extern "C" void kernel_launch(void* const* d_in, const int* in_sizes, int n_in, void* d_out, int out_size, void* d_ws, size_t ws_size, hipStream_t stream) {
    static int grid = 0;
    if (grid == 0) {
        if (n_in != 23 || ws_size < WS_END) { fprintf(stderr, "kernel_launch: unexpected n_in %d / ws_size %zu\n", n_in, ws_size); grid = -1; return; }
        int dev = 0, cus = 0, per_cu = 0;
        if (hipGetDevice(&dev) != hipSuccess || hipDeviceGetAttribute(&cus, hipDeviceAttributeMultiprocessorCount, dev) != hipSuccess) { grid = -1; return; }
        if (hipFuncSetAttribute((const void*)mega_fwd, hipFuncAttributeMaxDynamicSharedMemorySize, LDS_BYTES) != hipSuccess) { fprintf(stderr, "kernel_launch: hipFuncSetAttribute failed\n"); grid = -1; return; }
        if (hipOccupancyMaxActiveBlocksPerMultiprocessor(&per_cu, (const void*)mega_fwd, NTHREADS, LDS_BYTES) != hipSuccess || per_cu < 1) { fprintf(stderr, "kernel_launch: occupancy query failed (%d)\n", per_cu); grid = -1; return; }
        grid = cus;
        if (grid <= NB * 8) { fprintf(stderr, "kernel_launch: grid %d too small\n", grid); grid = -1; return; }
    }
    if (grid < 0) return;
    (void)hipMemsetAsync((char*)d_ws + WS_CTL, 0, CTL_ZERO_BYTES, stream);
    Params p{};
    const float** f = (const float**)&p;
    for (int i = 0; i < 23; ++i) f[i] = (const float*)d_in[i];
    p.out = (float*)d_out; p.ws = (unsigned char*)d_ws;
    void* args[] = {&p};
    hipError_t e = hipLaunchCooperativeKernel((const void*)mega_fwd, dim3(grid), dim3(NTHREADS), args, LDS_BYTES, stream);
    if (e != hipSuccess) fprintf(stderr, "cooperative launch failed: %s (grid %d)\n", hipGetErrorString(e), grid);
}
```

```cpp
#include <hip/hip_runtime.h>
#include <hip/hip_bf16.h>
#include <cstdio>
#include <cstdint>

constexpr int NB = 8, SEQ = 4096, DM = 1024, MTOK = NB * SEQ, NL = 2;
constexpr int D_IN = 3720, NU = 3840;
constexpr int UQ = 0, UK = 512, UV = 1024, UR = 1536  , UP = 2432  , UG = 2688  , UF = 3712  ;
constexpr int SQ = 0, SF = 1536, SR = 1544, SP = 2440, SG = 2696;
constexpr float C2 = 0.125f * 1.4426950408889634f;
constexpr float LOG2E = 1.4426950408889634f;
constexpr float DECAY_SCALE = 0.6065306597126334f;

typedef unsigned short bf16_t;
typedef short bf16x8 __attribute__((ext_vector_type(8)));
typedef float f32x4 __attribute__((ext_vector_type(4)));
typedef unsigned u32x4 __attribute__((ext_vector_type(4)));
typedef unsigned u32x2 __attribute__((ext_vector_type(2)));

__device__ __forceinline__ unsigned f2bf(float f) { unsigned u = __builtin_bit_cast(unsigned, f); return (u + 0x7fffu + ((u >> 16) & 1u)) >> 16; }
__device__ __forceinline__ unsigned pk2(float lo, float hi) { return f2bf(lo) | (f2bf(hi) << 16); }
__device__ __forceinline__ float bf2f(unsigned short b) { return __builtin_bit_cast(float, (unsigned)b << 16); }
__device__ __forceinline__ float bflo(unsigned w) { return __builtin_bit_cast(float, w << 16); }
__device__ __forceinline__ float bfhi(unsigned w) { return __builtin_bit_cast(float, w & 0xffff0000u); }
__device__ __forceinline__ float sigmoidf_(float x) { return 1.f / (1.f + __expf(-x)); }
__device__ __forceinline__ float siluf_(float x) { return x / (1.f + __expf(-x)); }
__device__ __forceinline__ float wave_sum(float v) {
#pragma unroll
    for (int o = 1; o < 64; o <<= 1) v += __shfl_xor(v, o);
    return v;
}

__device__ __forceinline__ int otid() { int t = threadIdx.x; asm volatile("" : "+v"(t)); return t; }

constexpr size_t MiB = 1u << 20;
constexpr size_t WS_CTL = 0;
constexpr size_t WS_MOD = 1 * MiB;
constexpr size_t WS_WT = 2 * MiB;
constexpr size_t WS_WOT = 18 * MiB;
constexpr size_t WS_TS = 512 * 1024;
constexpr size_t WS_CB = 22 * MiB;
constexpr size_t WS_XN = 24 * MiB;
constexpr size_t WS_O32 = 24 * MiB;
constexpr size_t WS_BON = 23 * MiB;
constexpr size_t WS_PA = 56 * MiB;
constexpr size_t WS_Y = 88 * MiB;
constexpr size_t WS_U = 152 * MiB;
constexpr size_t WS_Z = 152 * MiB;
constexpr size_t WS_CHK = 392 * MiB;
constexpr int CHK_B = 24576;
constexpr int NCHK = SEQ / 32;
constexpr size_t WS_END = 488 * MiB;
constexpr size_t CTL_ZERO_BYTES = 65536;
constexpr int CW_ATTQ = 8192;
constexpr int CW_BAR = 1024;

struct Params {
    const float *x, *c, *ada_w, *ada_b, *norm_pre, *norm_post, *w_in, *q_gain, *k_gain, *f_bias, *mu, *w0, *w2, *a0, *a2, *k_k, *k_a, *r_k, *ln_g, *ln_b,
        *pool_w, *pool_scale, *w_out;
    float* out;
    unsigned char* ws;
};


#define LAS __attribute__((address_space(3)))
constexpr int NTHREADS = 512;
constexpr int LDS_BYTES = 147456;
constexpr int MISC_OFF = LDS_BYTES - 128;

#define XB_TMO      128
#define XB_XCNT(j)  (256  + 64 * (j))
#define XB_XSUB(j)  (1280 + 64 * (j))
#define XB_XGEN(j)  (2304 + 64 * (j))
#define XB_TOP      3328
#define XB_TOPGEN   3392
#define XCD_BAR_WORDS 3456
#define XB_SPIN_CAP (1u << 18)
__device__ __forceinline__ unsigned xb_ld(unsigned* p)              { return __hip_atomic_load(p, __ATOMIC_RELAXED, __HIP_MEMORY_SCOPE_AGENT); }
__device__ __forceinline__ unsigned xb_add(unsigned* p, unsigned v) { return __hip_atomic_fetch_add(p, v, __ATOMIC_RELAXED, __HIP_MEMORY_SCOPE_AGENT); }
__device__ __forceinline__ unsigned xb_xcc_id() { return (unsigned)__builtin_amdgcn_s_getreg((3 << 11) | 20) & 0xFu; }
#define XB_SPIN(cond, bar) do { unsigned _sp = 0; while (cond) { __builtin_amdgcn_s_sleep(1); \
    if ((++_sp & 255u) == 0u) { if (xb_ld(&(bar)[XB_TMO])) break; if (_sp > XB_SPIN_CAP) { atomicAdd(&(bar)[XB_TMO], 1u); break; } } } } while (0)
struct XcdBarrier { unsigned* bar; unsigned x; volatile LAS unsigned* st; };
__device__ __forceinline__ XcdBarrier xcd_barrier_post(unsigned* bar, volatile LAS unsigned* st) {
    XcdBarrier b; b.bar = bar; b.x = xb_xcc_id(); b.st = st;
    if (threadIdx.x == 0) (void)xb_add(&bar[XB_XCNT(b.x)], 1u);
    return b;
}
__device__ __forceinline__ void xcd_barrier_complete(unsigned* bar, unsigned x, unsigned& nloc, unsigned& nx) {
    const unsigned G = gridDim.x * gridDim.y * gridDim.z;
    unsigned sum, cnt, mine, sp = 0u;
    for (;;) {
        sum = 0u; cnt = 0u; mine = 0u;
#pragma unroll
        for (unsigned j = 0; j < 16; ++j) { const unsigned c = xb_ld(&bar[XB_XCNT(j)]); sum += c; cnt += (c > 0u) ? 1u : 0u; mine = (j == x) ? c : mine; }
        if (sum == G) break;
        __builtin_amdgcn_s_sleep(1);
        if ((++sp & 255u) == 0u) { if (xb_ld(&bar[XB_TMO])) break; if (sp > XB_SPIN_CAP) { atomicAdd(&bar[XB_TMO], 1u); break; } }
    }
    nloc = mine > 0u ? mine : 1u; nx = cnt > 0u ? cnt : 1u;
}
__device__ __forceinline__ void xcd_barrier(const XcdBarrier& b) {
    asm volatile("s_waitcnt vmcnt(0)" ::: "memory");
    __syncthreads();
    if (threadIdx.x == 0) {
        unsigned* bar = b.bar;
        __builtin_amdgcn_s_waitcnt(0);
        unsigned nloc = b.st[0], nx = b.st[1];
        if (nloc == 0u) { xcd_barrier_complete(bar, b.x, nloc, nx); b.st[0] = nloc; b.st[1] = nx; }
        const unsigned old = xb_add(&bar[XB_XSUB(b.x)], 1u);
        const unsigned gen = old / nloc;
        if (old + 1u == (gen + 1u) * nloc) {
            __builtin_amdgcn_fence(__ATOMIC_RELEASE, "agent");
            asm volatile("s_waitcnt vmcnt(0)" ::: "memory");
            const unsigned og = xb_add(&bar[XB_TOP], 1u);
            const unsigned tg = og / nx;
            if (og + 1u == (tg + 1u) * nx) xb_add(&bar[XB_TOPGEN], 1u);
            else XB_SPIN(xb_ld(&bar[XB_TOPGEN]) == tg, bar);
            __builtin_amdgcn_fence(__ATOMIC_ACQUIRE, "agent");
            xb_add(&bar[XB_XGEN(b.x)], 1u);
            asm volatile("s_waitcnt vmcnt(0)" ::: "memory");
        } else {
            XB_SPIN(xb_ld(&bar[XB_XGEN(b.x)]) == gen, bar);
            __builtin_amdgcn_fence(__ATOMIC_ACQUIRE, "agent");
            asm volatile("s_waitcnt vmcnt(0)" ::: "memory");
        }
    }
    __syncthreads();
}


namespace pg8 {
#define PG8_LAS __attribute__((address_space(3)))
typedef unsigned short bf16_t;
typedef short bf16x8 __attribute__((ext_vector_type(8)));
typedef float f32x4 __attribute__((ext_vector_type(4)));
typedef unsigned u32x4 __attribute__((ext_vector_type(4)));
constexpr int BM = 256, BK = 64, HALF = 128, HTB = HALF * BK * 2  , STAGE_BYTES = 8 * HTB, NXCD = 8, WGM = 8;

__host__ __device__ __forceinline__ int lds_byte(int r, int c) { const int st = (r >> 4) * 2 + (c >> 5), rr = r & 15, cc = c & 31, ob = rr * 64 + cc * 2; return st * 1024 + (ob ^ (((ob >> 9) & 1) << 5)); }
__host__ __device__ __forceinline__ void stage_rc(int b, int& R, int& C) { const int st = b / 1024, sb = b % 1024, swz = sb ^ (((sb >> 9) & 1) << 5); R = (st >> 1) * 16 + swz / 64; C = (st & 1) * 32 + (swz % 64) / 2; }
__host__ __device__ __forceinline__ int perm32(int rho) { const int n = rho >> 4, i = rho & 15; return 8 * (i >> 2) + 4 * n + (i & 3); }

struct Unit { int pm, pn; };
struct Gemm { const bf16_t* A; const bf16_t* Bt; int M, N, K; };

struct StaticOrder {
    int nM, nN, nwg, G, c;
    __host__ __device__ void init(int M, int N, int G_, int c_) { nM = M / BM; nN = N / BM; nwg = nM * nN; G = G_; c = c_; }
    __host__ __device__ bool next(int i, Unit& u) const {
        const long L = (long)i * G + c; if (L >= nwg) return false;
        int wgid = (int)L; { const int q = nwg / NXCD, r = nwg % NXCD, xcd = wgid % NXCD, off = wgid / NXCD; wgid = (xcd < r ? xcd * (q + 1) : r * (q + 1) + (xcd - r) * q) + off; }
        const int nig = WGM * nN, gid = wgid / nig, fm = gid * WGM, gsz = (nM - fm) < WGM ? (nM - fm) : WGM;
        u.pm = fm + ((wgid % nig) % gsz); u.pn = (wgid % nig) / gsz; return true;
    }
    __device__ __forceinline__ void a_ready(const Unit&) const {}
    __device__ __forceinline__ void done(const Unit&) const {}
};

__device__ __forceinline__ unsigned cvt_pk_bf16(float lo, float hi) { unsigned r; asm volatile("v_cvt_pk_bf16_f32 %0, %1, %2" : "=v"(r) : "v"(lo), "v"(hi)); return r; }

struct EpiU {
    static constexpr bool PERM = true, AFTER_DRAIN = false;
    bf16_t* U; const float* qg; const float* kg; int ldc;
    __device__ __forceinline__ void operator()(const f32x4 (&acc)[2][2][4][2], const Unit& u, int wr, int wc, int fr, int fq) const {
        const int row0 = u.pm * BM + wr * 64 + fr;
        if (u.pn < 4) {
            const float* gp = (u.pn < 2 ? qg : kg) + 8 * fq; const float mult = u.pn < 2 ? (0.125f * 1.4426950408889634f) : 1.f;
            f32x4 gv[2][2];
#pragma unroll
            for (int bj = 0; bj < 2; ++bj)
#pragma unroll
                for (int n = 0; n < 2; ++n) gv[bj][n] = *(const f32x4*)(gp + 32 * bj + 4 * n);
            const int col0 = u.pn * BM + 64 * wc + 8 * fq;
#pragma unroll
            for (int ai = 0; ai < 2; ++ai)
#pragma unroll
                for (int m = 0; m < 4; ++m) {
                    float s = 0.f;
#pragma unroll
                    for (int bj = 0; bj < 2; ++bj)
#pragma unroll
                        for (int n = 0; n < 2; ++n) { const f32x4 x = acc[ai][bj][m][n]; s += (x[0] * x[0] + x[1] * x[1]) + (x[2] * x[2] + x[3] * x[3]); }
                    s += __shfl_xor(s, 16); s += __shfl_xor(s, 32);
                    const float sc = rsqrtf(s * (1.f / 64.f) + 1e-6f) * mult;
                    bf16_t* rowp = U + (size_t)(row0 + ai * HALF + m * 16) * ldc + col0;
#pragma unroll
                    for (int bj = 0; bj < 2; ++bj) { const f32x4 v0 = acc[ai][bj][m][0] * sc * gv[bj][0], v1 = acc[ai][bj][m][1] * sc * gv[bj][1];
                        u32x4 w; w.x = cvt_pk_bf16(v0[0], v0[1]); w.y = cvt_pk_bf16(v0[2], v0[3]); w.z = cvt_pk_bf16(v1[0], v1[1]); w.w = cvt_pk_bf16(v1[2], v1[3]);
                        *(u32x4*)(rowp + bj * 32) = w; }
                }
        } else {
            const int col0 = u.pn * BM + wc * 32 + 8 * fq;
#pragma unroll
            for (int ai = 0; ai < 2; ++ai)
#pragma unroll
                for (int m = 0; m < 4; ++m) { bf16_t* rowp = U + (size_t)(row0 + ai * HALF + m * 16) * ldc + col0;
#pragma unroll
                    for (int bj = 0; bj < 2; ++bj) { const f32x4 v0 = acc[ai][bj][m][0], v1 = acc[ai][bj][m][1];
                        u32x4 w; w.x = cvt_pk_bf16(v0[0], v0[1]); w.y = cvt_pk_bf16(v0[2], v0[3]); w.z = cvt_pk_bf16(v1[0], v1[1]); w.w = cvt_pk_bf16(v1[2], v1[3]);
                        *(u32x4*)(rowp + bj * HALF) = w; } }
        }
    }
};
struct EpiB16 {
    static constexpr bool PERM = true, AFTER_DRAIN = false;
    bf16_t* C; int ldc;
    __device__ __forceinline__ void operator()(const f32x4 (&acc)[2][2][4][2], const Unit& u, int wr, int wc, int fr, int fq) const {
        const int row0 = u.pm * BM + wr * 64 + fr, col0 = u.pn * BM + wc * 32 + 8 * fq;
#pragma unroll
        for (int ai = 0; ai < 2; ++ai)
#pragma unroll
            for (int m = 0; m < 4; ++m) { bf16_t* rowp = C + (size_t)(row0 + ai * HALF + m * 16) * ldc + col0;
#pragma unroll
                for (int bj = 0; bj < 2; ++bj) { const f32x4 v0 = acc[ai][bj][m][0], v1 = acc[ai][bj][m][1];
                    u32x4 w; w.x = cvt_pk_bf16(v0[0], v0[1]); w.y = cvt_pk_bf16(v0[2], v0[3]); w.z = cvt_pk_bf16(v1[0], v1[1]); w.w = cvt_pk_bf16(v1[2], v1[3]);
                    *(u32x4*)(rowp + bj * HALF) = w; } }
    }
};
struct EpiF32 {
    static constexpr bool PERM = false, AFTER_DRAIN = false;
    float* C; int ldc;
    __device__ __forceinline__ void operator()(const f32x4 (&acc)[2][2][4][2], const Unit& u, int wr, int wc, int fr, int fq) const {
        const int row0 = u.pm * BM + wr * 64 + fr, col0 = u.pn * BM + wc * 32 + 4 * fq;
#pragma unroll
        for (int ai = 0; ai < 2; ++ai)
#pragma unroll
            for (int m = 0; m < 4; ++m) { float* rowp = C + (size_t)(row0 + ai * HALF + m * 16) * ldc + col0;
#pragma unroll
                for (int bj = 0; bj < 2; ++bj)
#pragma unroll
                    for (int n = 0; n < 2; ++n) *(f32x4*)(rowp + bj * HALF + n * 16) = acc[ai][bj][m][n]; }
    }
};

template <class Epi, class Sched, bool ALIGN_EPI = false, bool SP2 = false>
__device__ __forceinline__ void gemm_phase(PG8_LAS unsigned char* lds, const Gemm g, const Sched& S, const Epi& E) {
    int tid_ = threadIdx.x; asm volatile("" : "+v"(tid_));
    const int tid = tid_, wid = __builtin_amdgcn_readfirstlane(tid >> 6), lane = tid & 63, wr = wid >> 2, wc = wid & 3, fr = lane & 15, fq = lane >> 4;
    const int K = g.K, nt = K / BK;
    unsigned voffA[2], voffB[2];
#pragma unroll
    for (int i = 0; i < 2; ++i) { int R, C; stage_rc(tid * 16 + i * 8192, R, C); const int Rb = Epi::PERM ? ((R & ~31) + perm32(R & 31)) : R;
        voffA[i] = (unsigned)(R * K + C) * 2u; voffB[i] = (unsigned)(Rb * K + C) * 2u; }
    const size_t kstep = (size_t)(BK * 2);
    const size_t hstep = (size_t)HALF * K * 2;
    const size_t tstep = 2 * hstep;
    const unsigned ldsw = (unsigned)wid * 1024u;
    const int aoff = lds_byte(wr * 64 + fr, fq * 8), boff = lds_byte(wc * 32 + fr, fq * 8);
#define PG8_SA(b, h) (((b) * 2 + (h)) * HTB)
#define PG8_SB(b, h) ((4 + (b) * 2 + (h)) * HTB)
#define PG8_STAGE(bufoff, gbase, voff) do { _Pragma("unroll") for (int _i = 0; _i < 2; ++_i) \
        __builtin_amdgcn_global_load_lds((const unsigned*)((const char*)(gbase) + (voff)[_i]), (PG8_LAS unsigned*)(lds + (bufoff) + ldsw + _i * 8192), 16, 0, 0); } while (0)
#define PG8_LDA(dst, b, h) do { _Pragma("unroll") for (int m = 0; m < 4; ++m) _Pragma("unroll") for (int k = 0; k < 2; ++k) dst[m][k] = *(const PG8_LAS bf16x8*)(lds + PG8_SA(b, h) + aoff + m * 2048 + k * 1024); } while (0)
#define PG8_LDB(dst, b, h) do { _Pragma("unroll") for (int n = 0; n < 2; ++n) _Pragma("unroll") for (int k = 0; k < 2; ++k) dst[n][k] = *(const PG8_LAS bf16x8*)(lds + PG8_SB(b, h) + boff + n * 2048 + k * 1024); } while (0)
#define PG8_MMA(ai, bj, At, Bt) do { __builtin_amdgcn_s_setprio(1); _Pragma("unroll") for (int m = 0; m < 4; ++m) _Pragma("unroll") for (int n = 0; n < 2; ++n) _Pragma("unroll") for (int k = 0; k < 2; ++k) \
        acc[ai][bj][m][n] = __builtin_amdgcn_mfma_f32_16x16x32_bf16(Bt[n][k], At[m][k], acc[ai][bj][m][n], 0, 0, 0); __builtin_amdgcn_s_setprio(0); } while (0)
#define PG8_WAIT_V(n) asm volatile("s_waitcnt vmcnt(" #n ")" ::: "memory")
#define PG8_WAIT_L(n) asm volatile("s_waitcnt lgkmcnt(" #n ")" ::: "memory")
#define PG8_BAR __builtin_amdgcn_s_barrier()
#define PG8_SCHED __builtin_amdgcn_sched_barrier(0)
    Unit cur, nxt; int ui = 0;
    if (!S.next(0, cur)) return;
    f32x4 acc[2][2][4][2];
#pragma unroll
    for (int a = 0; a < 2; ++a)
#pragma unroll
        for (int b = 0; b < 2; ++b)
#pragma unroll
            for (int m = 0; m < 4; ++m)
#pragma unroll
                for (int n = 0; n < 2; ++n) acc[a][b][m][n] = (f32x4){0.f, 0.f, 0.f, 0.f};
    bf16x8 At[4][2], B0[2][2], B1[2][2];
    const char* cA = (const char*)g.A + (size_t)cur.pm * tstep; const char* cB = (const char*)g.Bt + (size_t)cur.pn * tstep;
    S.a_ready(cur);
    if constexpr (SP2) {
        PG8_STAGE(PG8_SB(0, 0), cB, voffB); PG8_STAGE(PG8_SB(0, 1), cB + hstep, voffB); PG8_STAGE(PG8_SA(0, 0), cA, voffA); PG8_STAGE(PG8_SA(0, 1), cA + hstep, voffA);
        if (wr == 1) PG8_BAR;
        PG8_WAIT_V(2); PG8_BAR;
        PG8_STAGE(PG8_SB(1, 0), cB + kstep, voffB); PG8_STAGE(PG8_SA(1, 0), cA + kstep, voffA); PG8_STAGE(PG8_SB(1, 1), cB + hstep + kstep, voffB);
        PG8_WAIT_V(6); PG8_BAR;
    } else {
        PG8_STAGE(PG8_SB(0, 0), cB, voffB); PG8_STAGE(PG8_SA(0, 0), cA, voffA); PG8_STAGE(PG8_SB(0, 1), cB + hstep, voffB); PG8_STAGE(PG8_SA(0, 1), cA + hstep, voffA);
        if (wr == 1) PG8_BAR;
        PG8_WAIT_V(4); PG8_BAR;
        PG8_STAGE(PG8_SB(1, 0), cB + kstep, voffB); PG8_STAGE(PG8_SA(1, 0), cA + kstep, voffA); PG8_STAGE(PG8_SB(1, 1), cB + hstep + kstep, voffB);
        PG8_WAIT_V(6); PG8_BAR;
    }
    for (;;) {
        const bool has_next = S.next(ui + 1, nxt);
        const char* nA = has_next ? (const char*)g.A + (size_t)nxt.pm * tstep : cA; const char* nB = has_next ? (const char*)g.Bt + (size_t)nxt.pn * tstep : cB;
        for (int t = 0; t < nt; t += 2) {
            const bool last = (t == nt - 2);
            const char* a1 = cA + (size_t)(t + 1) * kstep;
            const char* a2 = last ? nA : cA + (size_t)(t + 2) * kstep; const char* b2 = last ? nB : cB + (size_t)(t + 2) * kstep;
            const char* a3 = a2 + kstep; const char* b3 = b2 + kstep;
            if (last && has_next) S.a_ready(nxt);
            if constexpr (SP2) {
            PG8_LDB(B0, 0, 0); PG8_LDB(B1, 0, 1); PG8_SCHED; PG8_LDA(At, 0, 0); PG8_STAGE(PG8_SA(1, 1), a1 + hstep, voffA);
            PG8_WAIT_V(8); PG8_WAIT_L(0); PG8_BAR; PG8_MMA(0, 0, At, B0); PG8_MMA(0, 1, At, B1); PG8_BAR; PG8_SCHED;
            PG8_LDA(At, 0, 1); PG8_STAGE(PG8_SB(0, 0), b2, voffB); PG8_STAGE(PG8_SB(0, 1), b2 + hstep, voffB); PG8_STAGE(PG8_SA(0, 0), a2, voffA);
            PG8_WAIT_V(8); PG8_WAIT_L(0); PG8_BAR; PG8_MMA(1, 0, At, B0); PG8_MMA(1, 1, At, B1); PG8_BAR; PG8_SCHED;
            PG8_LDB(B0, 1, 0); PG8_LDB(B1, 1, 1); PG8_SCHED; PG8_LDA(At, 1, 0); PG8_STAGE(PG8_SA(0, 1), a2 + hstep, voffA);
            PG8_WAIT_V(8); PG8_WAIT_L(0); PG8_BAR; PG8_MMA(0, 0, At, B0); PG8_MMA(0, 1, At, B1); PG8_BAR; PG8_SCHED;
            PG8_LDA(At, 1, 1); PG8_STAGE(PG8_SB(1, 0), b3, voffB); PG8_STAGE(PG8_SB(1, 1), b3 + hstep, voffB); PG8_STAGE(PG8_SA(1, 0), a3, voffA);
            PG8_WAIT_V(8); PG8_WAIT_L(0); PG8_BAR; PG8_MMA(1, 0, At, B0); PG8_MMA(1, 1, At, B1); PG8_BAR; PG8_SCHED;
            } else {
            PG8_LDB(B0, 0, 0); PG8_SCHED; PG8_LDA(At, 0, 0); PG8_STAGE(PG8_SA(1, 1), a1 + hstep, voffA);
            PG8_WAIT_L(8); PG8_BAR; PG8_WAIT_L(0); PG8_MMA(0, 0, At, B0); PG8_BAR; PG8_SCHED;
            PG8_LDB(B1, 0, 1); PG8_STAGE(PG8_SB(0, 0), b2, voffB);
            PG8_BAR; PG8_WAIT_L(0); PG8_MMA(0, 1, At, B1); PG8_BAR;
            PG8_LDA(At, 0, 1); PG8_STAGE(PG8_SA(0, 0), a2, voffA);
            PG8_BAR; PG8_WAIT_L(0); PG8_MMA(1, 0, At, B0); PG8_BAR; PG8_SCHED;
            PG8_STAGE(PG8_SB(0, 1), b2 + hstep, voffB);
            PG8_WAIT_V(6); PG8_BAR; PG8_MMA(1, 1, At, B1); PG8_BAR;
            PG8_LDB(B0, 1, 0); PG8_SCHED; PG8_LDA(At, 1, 0); PG8_STAGE(PG8_SA(0, 1), a2 + hstep, voffA);
            PG8_WAIT_L(8); PG8_BAR; PG8_WAIT_L(0); PG8_MMA(0, 0, At, B0); PG8_BAR; PG8_SCHED;
            PG8_LDB(B1, 1, 1); PG8_STAGE(PG8_SB(1, 0), b3, voffB);
            PG8_BAR; PG8_WAIT_L(0); PG8_MMA(0, 1, At, B1); PG8_BAR;
            PG8_LDA(At, 1, 1); PG8_STAGE(PG8_SA(1, 0), a3, voffA);
            PG8_BAR; PG8_WAIT_L(0); PG8_MMA(1, 0, At, B0); PG8_BAR; PG8_SCHED;
            PG8_STAGE(PG8_SB(1, 1), b3 + hstep, voffB);
            PG8_WAIT_V(6); PG8_BAR; PG8_MMA(1, 1, At, B1); PG8_BAR;
            }
        }
        if constexpr (ALIGN_EPI) { if (wr == 0) PG8_BAR; }
        if constexpr (!Epi::AFTER_DRAIN) { E(acc, cur, wr, wc, fr, fq); S.done(cur); }
        if (!has_next) break;
#pragma unroll
        for (int a = 0; a < 2; ++a)
#pragma unroll
            for (int b = 0; b < 2; ++b)
#pragma unroll
                for (int m = 0; m < 4; ++m)
#pragma unroll
                    for (int n = 0; n < 2; ++n) acc[a][b][m][n] = (f32x4){0.f, 0.f, 0.f, 0.f};
        cur = nxt; cA = nA; cB = nB; ++ui;
        if constexpr (ALIGN_EPI) { if (wr == 1) PG8_BAR; }
    }
    PG8_WAIT_V(0);
    if constexpr (!ALIGN_EPI) { if (wr == 0) PG8_BAR; }
    PG8_BAR;
    if constexpr (Epi::AFTER_DRAIN) { E.fused(acc, cur, wr, wc, fr, fq, lds, wid, lane); S.done(cur); }
#undef PG8_SA
#undef PG8_SB
#undef PG8_STAGE
#undef PG8_LDA
#undef PG8_LDB
#undef PG8_MMA
#undef PG8_WAIT_V
#undef PG8_WAIT_L
#undef PG8_BAR
#undef PG8_SCHED
}
}

#include <hip/hip_bf16.h>
#include <cmath>
namespace attn_body {
using bf16=__hip_bfloat16;
using bf16x8=__attribute__((ext_vector_type(8)))short;
using s16x4=__attribute__((ext_vector_type(4)))short;
using f32x16=__attribute__((ext_vector_type(16)))float;
using u32x4=__attribute__((ext_vector_type(4)))unsigned;
constexpr int BATCH=8,NHEAD=8,SEQ=4096,D=64,DM=3840,OPITCH=1024;
constexpr int NW=8,QBLK=32,QB=QBLK*NW,KVBLK=64,NQB=SEQ/QB;
constexpr int ATTN_PITCH=DM, ATTN_UNIT_ROWS=QB;
__device__ __forceinline__ int crow(int r,int hi){return (r&3)+8*(r>>2)+4*hi;}
#define SBAR() __builtin_amdgcn_sched_barrier(0)
__device__ __forceinline__ void cmask(f32x16&p0,f32x16&p1,int jb,int qrel,int hi){
  const float NEG=-INFINITY; int kb=64*jb+4*hi;
  #pragma unroll
  for(int r=0;r<16;++r){int kv=kb+(r&3)+8*(r>>2); if(kv>qrel)p0[r]=NEG; if(kv+32>qrel)p1[r]=NEG;}
}

constexpr int NSLOT=3, SLOTB=8192;
constexpr int LDS_K=0, LDS_V=NSLOT*SLOTB, LDS_WS=2*NSLOT*SLOTB, LDS_OST=LDS_WS+NW*64*4, LDS_CB=LDS_OST+NW*4096, LDS_BYTES=LDS_CB+SEQ*4+1024;
constexpr float C2=0.125f*1.4426950408889634f;
__device__ __forceinline__ void glds16(const void*gsrc,unsigned lds_dst){unsigned keep;
  asm volatile("s_mov_b32 %0, m0\n\ts_mov_b32 m0, %2\n\ts_nop 0\n\tglobal_load_lds_dwordx4 %1, off\n\ts_mov_b32 m0, %0":"=&s"(keep):"v"(gsrc),"s"(lds_dst):"memory");}
__device__ __forceinline__ float max3f(float a,float b,float c){float r;asm("v_max3_f32 %0, %1, %2, %3":"=v"(r):"v"(a),"v"(b),"v"(c));return r;}
__device__ __forceinline__ float max2f(float a,float b){float r;asm("v_max_f32_e32 %0, %1, %2":"=v"(r):"v"(a),"v"(b));return r;}
__device__ __forceinline__ float fadd_s(float a,float b){float r;asm("v_add_f32_e32 %0, %1, %2":"=v"(r):"v"(a),"v"(b));return r;}
__device__ __forceinline__ float fsub_s(float a,float b){float r;asm("v_sub_f32_e32 %0, %1, %2":"=v"(r):"v"(a),"v"(b));return r;}
typedef float f32x4v __attribute__((ext_vector_type(4))); typedef float f32x2_t __attribute__((ext_vector_type(2))); typedef __bf16 bf16x2_t __attribute__((ext_vector_type(2)));
__device__ __forceinline__ unsigned cvtpk_s(float lo,float hi){f32x2_t v={lo,hi};bf16x2_t b=__builtin_convertvector(v,bf16x2_t);return __builtin_bit_cast(unsigned,b);}
#define WAIT_BAR(N) asm volatile("s_waitcnt vmcnt(" #N ") lgkmcnt(0)\n\ts_barrier":::"memory")

__device__ __forceinline__ void qkt(f32x16&p0,f32x16&p1,const char*Kslot,const bf16x8*qr,int r32,int hi){
  const char*kb=Kslot+hi*1024+r32*16;
  #pragma unroll
  for(int d0=0;d0<4;++d0){
    const bf16x8 b0=*reinterpret_cast<const bf16x8*>(kb+d0*2048);
    const bf16x8 b1=*reinterpret_cast<const bf16x8*>(kb+d0*2048+512);
    p0=__builtin_amdgcn_mfma_f32_32x32x16_bf16(b0,qr[d0],p0,0,0,0);p1=__builtin_amdgcn_mfma_f32_32x32x16_bf16(b1,qr[d0],p1,0,0,0);}
}
typedef __attribute__((address_space(3))) const char* lds_cptr;
typedef short v4i16_t __attribute__((ext_vector_type(4)));
__device__ __forceinline__ void kload8(bf16x8*kf,lds_cptr kp){
  kf[0]=*(const __attribute__((address_space(3))) bf16x8*)(kp);      kf[1]=*(const __attribute__((address_space(3))) bf16x8*)(kp+512);
  kf[2]=*(const __attribute__((address_space(3))) bf16x8*)(kp+2048); kf[3]=*(const __attribute__((address_space(3))) bf16x8*)(kp+2560);
  kf[4]=*(const __attribute__((address_space(3))) bf16x8*)(kp+4096); kf[5]=*(const __attribute__((address_space(3))) bf16x8*)(kp+4608);
  kf[6]=*(const __attribute__((address_space(3))) bf16x8*)(kp+6144); kf[7]=*(const __attribute__((address_space(3))) bf16x8*)(kp+6656);
}
__device__ __forceinline__ void kload2(bf16x8*kf,lds_cptr kp,int j){ kf[2*j]=*(const __attribute__((address_space(3))) bf16x8*)(kp+j*2048); kf[2*j+1]=*(const __attribute__((address_space(3))) bf16x8*)(kp+j*2048+512); }
__device__ __forceinline__ s16x4 vtr(lds_cptr p){ return __builtin_bit_cast(s16x4,__builtin_amdgcn_ds_read_tr16_b64_v4i16((__attribute__((address_space(3))) v4i16_t*)p)); }
__device__ __forceinline__ float rowmax(const f32x16&p0,const f32x16&p1){
  float a=max3f(p0[0],p0[1],p1[0]),b=max3f(p0[2],p0[3],p1[1]);a=max3f(a,p1[2],p1[3]);
  #pragma unroll
  for(int r=4;r<16;r+=4){a=max3f(a,p0[r],p0[r+1]);b=max3f(b,p0[r+2],p0[r+3]);a=max3f(a,p1[r],p1[r+1]);b=max3f(b,p1[r+2],p1[r+3]);}
  const float m=max2f(a,b);
  auto rr=__builtin_amdgcn_permlane32_swap(__float_as_uint(m),__float_as_uint(m),false,false);
  return max2f(__uint_as_float(rr[0]),__uint_as_float(rr[1]));
}
__device__ __forceinline__ void pv(f32x16*o,int vb,bf16x8 pa0,bf16x8 pa1,bf16x8 pa2,bf16x8 pa3){
  #pragma unroll
  for(int d0=0;d0<2;++d0){s16x4 lo[4],hi[4];
    #pragma unroll
    for(int ks=0;ks<4;++ks){
      asm volatile("ds_read_b64_tr_b16 %0,%1 offset:%c2":"=&v"(lo[ks]):"v"(vb),"i"(d0*4096+ks*1024):"memory");
      asm volatile("ds_read_b64_tr_b16 %0,%1 offset:%c2":"=&v"(hi[ks]):"v"(vb),"i"(d0*4096+ks*1024+512):"memory");}
    asm volatile("s_waitcnt lgkmcnt(0)":::"memory");SBAR();
    #define PK(k) (bf16x8){lo[k][0],lo[k][1],lo[k][2],lo[k][3],hi[k][0],hi[k][1],hi[k][2],hi[k][3]}
    o[d0]=__builtin_amdgcn_mfma_f32_32x32x16_bf16(pa0,PK(0),o[d0],0,0,0);
    o[d0]=__builtin_amdgcn_mfma_f32_32x32x16_bf16(pa1,PK(1),o[d0],0,0,0);
    o[d0]=__builtin_amdgcn_mfma_f32_32x32x16_bf16(pa2,PK(2),o[d0],0,0,0);
    o[d0]=__builtin_amdgcn_mfma_f32_32x32x16_bf16(pa3,PK(3),o[d0],0,0,0);
    #undef PK
  }
}

#ifndef ATTN_STORE16
#define ATTN_STORE16(p,v) (*(u32x4*)(p)=(v))
#endif
template<int THRL> __device__ __forceinline__ void attn_unit(int b,int h,int qb,const bf16*Q,const bf16*__restrict__ K,const bf16*__restrict__ V,const bf16*Gt,const float*CBg,const int*TSg,bf16*O,char*shm){
  int tid_=threadIdx.x; asm volatile("":"+v"(tid_)); const int tid=tid_,lane=tid&63,r32=lane&31,hi=lane>>5; const int wid=__builtin_amdgcn_readfirstlane(tid>>6);
  const long rowbase=(long)b*SEQ; const int q0=qb*QB;
  const bf16*Qw=Q+(rowbase+q0+wid*QBLK)*DM+h*D;
  const int ts=__builtin_amdgcn_readfirstlane(TSg[(b*NHEAD+h)*NQB+qb]);
  const bf16*Kh=K+(rowbase+(long)ts*KVBLK)*DM+h*D,*Vh=V+(rowbase+(long)ts*KVBLK)*DM+h*D;
  const unsigned lds0=(unsigned)(uintptr_t)shm;
  float*wsf=(float*)(shm+LDS_WS)+wid*64;
  const bf16*ksrc=Kh+(long)lane*DM+wid*8;
  const bf16*vsrc=Vh+(long)(16*(wid&3)+(lane>>2))*DM+(wid>>2)*32+(lane&3)*8;
  const unsigned kdst=lds0+LDS_K+wid*1024, vdst=lds0+LDS_V+wid*1024;
  #define DMA_K(t,slot) glds16(ksrc+(long)(t)*KVBLK*DM,(unsigned)__builtin_amdgcn_readfirstlane(kdst+(slot)))
  #define DMA_V(t,slot) glds16(vsrc+(long)(t)*KVBLK*DM,(unsigned)__builtin_amdgcn_readfirstlane(vdst+(slot)))
  const int vb0=(int)(lds0+LDS_V)+((lane>>4)&1)*32+(lane&3)*8+(4*hi+((lane&15)>>2))*64;
  const char*Kbase=shm+LDS_K; bf16x8 kf[8];
  const lds_cptr shm3=(lds_cptr)shm; const lds_cptr kp0=shm3+LDS_K+hi*1024+r32*16; const lds_cptr vp0=shm3+LDS_V+((lane>>4)&1)*32+(lane&3)*8+(4*hi+((lane&15)>>2))*64;
  const int NT=(q0+QB)/KVBLK-ts;
  { const float*cbsrc=CBg+((long)b*NHEAD+h)*SEQ; float*cbl=(float*)(shm+LDS_CB);
    #pragma unroll
    for(int i=0;i<2;++i){ const int e=(i*512+tid)*4; if(e<q0+QB){ const f32x4v v=*reinterpret_cast<const f32x4v*>(cbsrc+e); *reinterpret_cast<f32x4v*>(cbl+e)=v; } } }
  DMA_K(0,0);DMA_V(0,0);DMA_K(1,SLOTB);
  bf16x8 qr[4];
  #pragma unroll
  for(int d0=0;d0<4;++d0)qr[d0]=*reinterpret_cast<const bf16x8*>(&Qw[(long)r32*DM+d0*16+hi*8]);
  float mhat=0.f,l_reg=0.f;f32x16 o[2];o[0]=f32x16{};o[1]=f32x16{};
  const int qrel=wid*QBLK+r32;
  #define CMASK(P0,P1,t) do{int jb_=(t)-(NT-4); if(jb_>=0)cmask(P0,P1,jb_,qrel,hi);}while(0)
  bool resc=false; f32x16 pA0,pA1,pB0,pB1;
  #define START(P0,P1) do{ const float rm=rowmax(P0,P1); resc=false; \
    { const float dl=__builtin_fmaxf(rm,-16.f); mhat=fadd_s(mhat,dl); mh2=cbq+mhat; \
      _Pragma("unroll") for(int r=0;r<16;++r){P0[r]=fsub_s(P0[r],dl);P1[r]=fsub_s(P1[r],dl);} } \
    _Pragma("unroll") for(int r=0;r<16;++r)P0[r]=__builtin_amdgcn_exp2f(P0[r]); }while(0)
  #define RESC() do{ if(resc){ asm volatile("s_waitcnt lgkmcnt(0)":::"memory"); \
      _Pragma("unroll") for(int d_=0;d_<2;++d_) _Pragma("unroll") for(int r=0;r<16;++r)o[d_][r]*=wsf[crow(r,hi)]; } }while(0)
  int sl_prev=0,sl_cur=0,sl_next=SLOTB;
  #define ROT() do{sl_prev=sl_cur;sl_cur=sl_next;sl_next=(sl_next==(NSLOT-1)*SLOTB)?0:sl_next+SLOTB;}while(0)
  DMA_K(2,2*SLOTB);
  WAIT_BAR(3);
  const lds_cptr cbp=(lds_cptr)shm+LDS_CB+hi*16+ts*256;
  const float cbq=*(const __attribute__((address_space(3))) float*)((lds_cptr)shm+LDS_CB+4*(q0+wid*QBLK+r32));
  float mh2=cbq;
  #define CBINIT(P0,P1,t) do{ _Pragma("unroll") for(int g_=0;g_<4;++g_){ \
      const f32x4v c0_=*(const __attribute__((address_space(3))) f32x4v*)(cbp+(t)*256+g_*32), c1_=*(const __attribute__((address_space(3))) f32x4v*)(cbp+(t)*256+g_*32+128); \
      _Pragma("unroll") for(int i_=0;i_<4;++i_){P0[4*g_+i_]=c0_[i_]-mh2;P1[4*g_+i_]=c1_[i_]-mh2;} } }while(0)
  CBINIT(pA0,pA1,0);
  qkt(pA0,pA1,Kbase,qr,r32,hi);asm volatile("s_nop 15\n\ts_nop 7":"+v"(pA0),"+v"(pA1));CMASK(pA0,pA1,0);
  START(pA0,pA1);
  _Pragma("unroll") for(int r=0;r<16;++r)pA1[r]=__builtin_amdgcn_exp2f(pA1[r]);
  CBINIT(pB0,pB1,1);
  WAIT_BAR(0);
  DMA_K(3,0);DMA_V(1,SLOTB);
  ROT();
  kload8(kf,kp0+sl_cur);
  WAIT_BAR(2);
  s16x4 vlo[8],vhi[8]; u32x4 pw0,pw1,pw2,pw3;
  #define PKW(P,B) cvtpk_s(P[B],P[B+1])
  #define PAF(k) __builtin_bit_cast(bf16x8,pw##k)
  #define VFR(i) (bf16x8){vlo[i][0],vlo[i][1],vlo[i][2],vlo[i][3],vhi[i][0],vhi[i][1],vhi[i][2],vhi[i][3]}
  #define PIN(x) asm volatile("":"+v"(x))
  #define MX3(a,b,c) __builtin_fmaxf(__builtin_fmaxf((a),(b)),(c))
  #define GAPA(MF,A0,A1,A2,A3,W0,W1,PW) do{ MF; sacc+=A0; sacc+=A1; sacc+=A2; sacc+=A3; PIN(sacc); W0; W1; PIN(PW); SBAR(); }while(0)
  #define EX(v) __builtin_amdgcn_exp2f(v)
  #define GAPB(MF,X,B,PN,CBO) do{ MF; X[B]=EX(X[B]); X[B+1]=EX(X[B+1]); X[B+2]=EX(X[B+2]); X[B+3]=EX(X[B+3]); PIN(X); \
    { const f32x4v c_=*(const __attribute__((address_space(3))) f32x4v*)(cbn_+(CBO)); PN[B]=c_[0]-mh2; PN[B+1]=c_[1]-mh2; PN[B+2]=c_[2]-mh2; PN[B+3]=c_[3]-mh2; PIN(PN); } SBAR(); }while(0)
  #define VRD(i) do{ vlo[i]=vtr(vp_+(((i)>>2)*4096+((i)&3)*1024)); vhi[i]=vtr(vp_+(((i)>>2)*4096+((i)&3)*1024+512)); }while(0)
  #define KRD(G,j) do{ if(G){ kload2(kf,kp0+sl_next,j); SBAR(); } }while(0)
  #define STEP(C0,C1,P0,P1,t,GK,GV,GL) do{ SBAR(); \
    const lds_cptr vp_=vp0+sl_prev; \
    VRD(0); SBAR(); float sacc=(P0[0]+P0[1]); \
    GAPA(C0=__builtin_amdgcn_mfma_f32_32x32x16_bf16(kf[0],qr[0],C0,0,0,0), P0[2],P0[3],P0[4],P0[5],     pw0[0]=PKW(P0,0), pw0[1]=PKW(P0,2), pw0); \
    VRD(4); SBAR(); GAPA(C1=__builtin_amdgcn_mfma_f32_32x32x16_bf16(kf[1],qr[0],C1,0,0,0), P0[6],P0[7],P0[8],P0[9],     pw0[2]=PKW(P0,4), pw0[3]=PKW(P0,6), pw0); \
    VRD(1); SBAR(); GAPA(C0=__builtin_amdgcn_mfma_f32_32x32x16_bf16(kf[2],qr[1],C0,0,0,0),   P0[10],P0[11],P0[12],P0[13], pw1[0]=PKW(P0,8), pw1[1]=PKW(P0,10), pw1); \
    VRD(5); SBAR(); GAPA(C1=__builtin_amdgcn_mfma_f32_32x32x16_bf16(kf[3],qr[1],C1,0,0,0),   P0[14],P0[15],P1[0],P1[1],   pw1[2]=PKW(P0,12),pw1[3]=PKW(P0,14), pw1); \
    VRD(2); SBAR(); GAPA(C0=__builtin_amdgcn_mfma_f32_32x32x16_bf16(kf[4],qr[2],C0,0,0,0),   P1[2],P1[3],P1[4],P1[5],     pw2[0]=PKW(P1,0), pw2[1]=PKW(P1,2), pw2); \
    VRD(6); SBAR(); GAPA(C1=__builtin_amdgcn_mfma_f32_32x32x16_bf16(kf[5],qr[2],C1,0,0,0),   P1[6],P1[7],P1[8],P1[9],     pw2[2]=PKW(P1,4), pw2[3]=PKW(P1,6), pw2); \
    VRD(3); SBAR(); GAPA(C0=__builtin_amdgcn_mfma_f32_32x32x16_bf16(kf[6],qr[3],C0,0,0,0),   P1[10],P1[11],P1[12],P1[13], pw3[0]=PKW(P1,8), pw3[1]=PKW(P1,10), pw3); \
    VRD(7); SBAR(); GAPA(C1=__builtin_amdgcn_mfma_f32_32x32x16_bf16(kf[7],qr[3],C1,0,0,0),   P1[14],P1[15],0.f,0.f,       pw3[2]=PKW(P1,12),pw3[3]=PKW(P1,14), pw3); \
    l_reg+=sacc; \
    if(GK){DMA_K((t)+3,sl_cur);} if(GV){DMA_V((t)+1,sl_next);} \
    CMASK(C0,C1,t); \
    { float a=MX3(C0[0],C0[1],C1[0]),b=MX3(C0[2],C0[3],C1[1]); a=MX3(a,C1[2],C1[3]); \
      _Pragma("unroll") for(int r=4;r<16;r+=4){a=MX3(a,C0[r],C0[r+1]);b=MX3(b,C0[r+2],C0[r+3]);a=MX3(a,C1[r],C1[r+1]);b=MX3(b,C1[r+2],C1[r+3]);} \
      float rm=__builtin_fmaxf(a,b); { auto rr=__builtin_amdgcn_permlane32_swap(__float_as_uint(rm),__float_as_uint(rm),false,false); rm=__builtin_fmaxf(__uint_as_float(rr[0]),__uint_as_float(rr[1])); } \
      resc=false; \
      if(__builtin_expect(__any(rm>(float)THRL),0)){ const float dl=__builtin_fmaxf(rm,0.f); mhat+=dl; \
        _Pragma("unroll") for(int r=0;r<16;++r){C0[r]-=dl;C1[r]-=dl;} \
        mh2=cbq+mhat; \
        const float f=__builtin_amdgcn_exp2f(-dl); l_reg*=f; if(hi==0)wsf[r32]=f; resc=true; } } \
    SBAR(); \
    const lds_cptr cbn_=cbp+((t)+1)*256;                      \
    GAPB(o[0]=__builtin_amdgcn_mfma_f32_32x32x16_bf16(PAF(0),VFR(0),o[0],0,0,0), C0,0, P0,0); \
    GAPB(o[1]=__builtin_amdgcn_mfma_f32_32x32x16_bf16(PAF(0),VFR(4),o[1],0,0,0), C0,4, P0,32); \
    KRD(GL,0); GAPB(o[0]=__builtin_amdgcn_mfma_f32_32x32x16_bf16(PAF(1),VFR(1),o[0],0,0,0), C0,8, P0,64); \
    KRD(GL,1); GAPB(o[1]=__builtin_amdgcn_mfma_f32_32x32x16_bf16(PAF(1),VFR(5),o[1],0,0,0), C0,12, P0,96); \
    KRD(GL,2); GAPB(o[0]=__builtin_amdgcn_mfma_f32_32x32x16_bf16(PAF(2),VFR(2),o[0],0,0,0), C1,0, P1,128); \
    KRD(GL,3); GAPB(o[1]=__builtin_amdgcn_mfma_f32_32x32x16_bf16(PAF(2),VFR(6),o[1],0,0,0), C1,4, P1,160); \
    GAPB(o[0]=__builtin_amdgcn_mfma_f32_32x32x16_bf16(PAF(3),VFR(3),o[0],0,0,0), C1,8, P1,192); \
    GAPB(o[1]=__builtin_amdgcn_mfma_f32_32x32x16_bf16(PAF(3),VFR(7),o[1],0,0,0), C1,12, P1,224); \
    }while(0)
  int t=1;
  #undef CMASK
  #define CMASK(P0,P1,t) do{}while(0)
  for(;t+5<NT;t+=2){
    STEP(pB0,pB1,pA0,pA1,t,true,true,true);     WAIT_BAR(2); RESC(); ROT();
    STEP(pA0,pA1,pB0,pB1,t+1,true,true,true);   WAIT_BAR(2); RESC(); ROT();
  }
  #undef CMASK
  #define CMASK(P0,P1,t) do{int jb_=(t)-(NT-4); if(jb_>=0)cmask(P0,P1,jb_,qrel,hi);}while(0)
  #define ENDW(tt) do{ if((tt)+3<NT){WAIT_BAR(2);} else if((tt)+2<NT){WAIT_BAR(1);} else {WAIT_BAR(0);} }while(0)
  for(;t+1<NT;t+=2){
    STEP(pB0,pB1,pA0,pA1,t,(t+3<NT),(t+1<NT),(t+1<NT));       ENDW(t);   RESC(); ROT();
    STEP(pA0,pA1,pB0,pB1,t+1,(t+4<NT),(t+2<NT),(t+2<NT));     ENDW(t+1); RESC(); ROT();
  }
  STEP(pB0,pB1,pA0,pA1,NT-1,false,false,false); RESC();
  { float sacc=pB0[0]+pB0[1]; _Pragma("unroll") for(int r=2;r<16;++r)sacc+=pB0[r]; _Pragma("unroll") for(int r=0;r<16;++r)sacc+=pB1[r]; l_reg+=sacc;
    pw0=(u32x4){PKW(pB0,0),PKW(pB0,2),PKW(pB0,4),PKW(pB0,6)};pw1=(u32x4){PKW(pB0,8),PKW(pB0,10),PKW(pB0,12),PKW(pB0,14)};pw2=(u32x4){PKW(pB1,0),PKW(pB1,2),PKW(pB1,4),PKW(pB1,6)};pw3=(u32x4){PKW(pB1,8),PKW(pB1,10),PKW(pB1,12),PKW(pB1,14)};
    SBAR(); pv(o,vb0+sl_cur,PAF(0),PAF(1),PAF(2),PAF(3)); }
  #undef PKW
  #undef PAF
  #undef VFR
  #undef PIN
  #undef MX3
  #undef GAPA
  #undef GAPB
  #undef EX
  #undef VRD
  #undef KRD
  #undef STEP
  #undef ENDW
  {auto rr=__builtin_amdgcn_permlane32_swap(__float_as_uint(l_reg),__float_as_uint(l_reg),false,false);l_reg=__uint_as_float(rr[0])+__uint_as_float(rr[1]);}
  if(hi==0)wsf[32+r32]=l_reg;asm volatile("s_waitcnt lgkmcnt(0)":::"memory");
  float rli[16];
  #pragma unroll
  for(int r=0;r<16;++r)rli[r]=__builtin_amdgcn_rcpf(wsf[32+crow(r,hi)]);
  bf16*Ow=O+(rowbase+q0+wid*QBLK)*OPITCH+h*D; const bf16*Gw=Gt+(rowbase+q0+wid*QBLK)*DM+h*D;
  { bf16*stg=(bf16*)(shm+LDS_OST)+wid*2048;
    #pragma unroll
    for(int r=0;r<16;++r){const int orow=crow(r,hi);
      #pragma unroll
      for(int d0=0;d0<2;++d0)stg[orow*64+d0*32+r32]=__float2bfloat16(o[d0][r]*rli[r]);}
    asm volatile("s_waitcnt lgkmcnt(0)":::"memory");
    #pragma unroll
    for(int i=0;i<4;++i){const int row=i*8+(lane>>3),ch=lane&7; const u32x4 v=*(const u32x4*)(stg+row*64+ch*8); const u32x4 gq=*(const u32x4*)(Gw+(long)row*DM+ch*8); u32x4 w_;
      #pragma unroll
      for(int k=0;k<4;++k){ const float g0=__builtin_bit_cast(float,gq[k]<<16), g1=__builtin_bit_cast(float,gq[k]&0xffff0000u), x0=__builtin_bit_cast(float,v[k]<<16), x1=__builtin_bit_cast(float,v[k]&0xffff0000u);
        w_[k]=cvtpk_s(x0*g0*__builtin_amdgcn_rcpf(1.f+__builtin_amdgcn_exp2f(-1.4426950408889634f*g0)), x1*g1*__builtin_amdgcn_rcpf(1.f+__builtin_amdgcn_exp2f(-1.4426950408889634f*g1))); }
      ATTN_STORE16(Ow+(long)row*OPITCH+ch*8,w_);} }
  asm volatile("s_waitcnt lgkmcnt(0)\n\ts_barrier":::"memory");
  #undef CBINIT
  #undef DMA_K
  #undef DMA_V
  #undef CMASK
  #undef START
  #undef RESC
  #undef ROT
}
constexpr int ATTN_LDS_BYTES=LDS_BYTES;
struct AttnTensors { const bf16* Q; const bf16* K; const bf16* V; const bf16* G; const float* CB; const int* TS; bf16* O; };
struct AttnUnit { int bh; int qb; };
struct QueueOrder {
  unsigned* ctr; volatile __attribute__((address_space(3))) unsigned* slot;
  __device__ __forceinline__ bool next(int,AttnUnit&u)const{
    if(threadIdx.x==0){ *slot=__hip_atomic_fetch_add(ctr,1u,__ATOMIC_RELAXED,__HIP_MEMORY_SCOPE_AGENT); }
    __syncthreads(); const unsigned t=*slot; __syncthreads();
    if(t>=(unsigned)(BATCH*NHEAD*NQB))return false; u.qb=NQB-1-(int)(t/(BATCH*NHEAD)); u.bh=(int)(t%(BATCH*NHEAD)); return true; }
  __device__ __forceinline__ void a_ready(const AttnUnit&)const{}
  __device__ __forceinline__ void done(const AttnUnit&)const{}
};
template<class Sched,int THRL=8> __device__ __forceinline__ void attn_phase(char*lds,const AttnTensors&T,const Sched&S){
  AttnUnit u;
  for(int i=0;S.next(i,u);++i){ S.a_ready(u); attn_unit<THRL>(u.bh/NHEAD,u.bh%NHEAD,u.qb,T.Q,T.K,T.V,T.G,T.CB,T.TS,T.O,lds); S.done(u); }
}
#undef SBAR
#undef WAIT_BAR
}

__device__ __forceinline__ int src_col(int n) {
    if (n < 1024) { const int cp = n & 255; return (n & ~255) + 64 * ((cp >> 5) & 3) + 32 * (cp >> 7) + (cp & 31); }
    if (n < 1536) return n;
    if (n < UP) return n - UR + SR;
    if (n < UG) return -1;
    if (n < UF) return n - UG + SG;
    if (n < UF + 8) return n - UF + SF;
    return -2;
}
__device__ __forceinline__ void phase_weights(const Params& p, unsigned char* lds) {
    float (*tile)[65] = (float (*)[65])lds;
    const int tid = otid();
    constexpr int T_IN = (NU / 64) * (DM / 64), T_OUT = (DM / 64) * (DM / 64), PER_L = T_IN + T_OUT;
    for (int it = blockIdx.x; it < NL * PER_L; it += gridDim.x) {
        const int l = it / PER_L; int r = it % PER_L;
        if (r < T_IN) {
            const int nt = r / (DM / 64), kt = r % (DM / 64), n0 = nt * 64, k0 = kt * 64;
            const float* W = p.w_in + (size_t)l * DM * D_IN;
            for (int e = tid; e < 64 * 64; e += NTHREADS) {
                const int kk = e >> 6, nn = e & 63, n = n0 + nn, sc = src_col(n);
                float v = 0.f;
                if (sc >= 0) v = W[(size_t)(k0 + kk) * D_IN + sc];
                else if (sc == -1) {
                    const int g = (n - UP) >> 6, d = (n - UP) & 63;
                    const float* pw = p.pool_w + ((size_t)l * 4 + g) * 64 * 64;
                    const float* wr = W + (size_t)(k0 + kk) * D_IN + SP + g * 64;
                    float s = 0.f;
                    for (int cc = 0; cc < 64; ++cc) s += wr[cc] * pw[cc * 64 + d];
                    v = s;
                }
                tile[kk][nn] = v;
            }
            __syncthreads();
            bf16_t* WT = (bf16_t*)(p.ws + WS_WT) + (size_t)l * NU * DM;
            for (int e = tid; e < 64 * 32; e += NTHREADS) {
                const int nn = e >> 5, kp = (e & 31) * 2;
                *(unsigned*)(WT + (size_t)(n0 + nn) * DM + k0 + kp) = pk2(tile[kp][nn], tile[kp + 1][nn]);
            }
            __syncthreads();
        } else {
            r -= T_IN;
            const int nt = r / (DM / 64), kt = r % (DM / 64), n0 = nt * 64, k0 = kt * 64;
            const float* W = p.w_out + (size_t)l * DM * DM;
            for (int e = tid; e < 64 * 64; e += NTHREADS) { const int kk = e >> 6, nn = e & 63; tile[kk][nn] = W[(size_t)(k0 + kk) * DM + n0 + nn]; }
            __syncthreads();
            bf16_t* WOT = (bf16_t*)(p.ws + WS_WOT) + (size_t)l * DM * DM;
            for (int e = tid; e < 64 * 32; e += NTHREADS) {
                const int nn = e >> 5, kp = (e & 31) * 2;
                *(unsigned*)(WOT + (size_t)(n0 + nn) * DM + k0 + kp) = pk2(tile[kp][nn], tile[kp + 1][nn]);
            }
            __syncthreads();
        }
    }
}

__device__ __forceinline__ void phase_mod(const Params& p, unsigned char* lds) {
    float (*sc)[DM] = (float (*)[DM])lds;
    float (*red)[NB][64] = (float (*)[NB][64])(lds + 32768);
    const int tid = otid();
    if ((int)blockIdx.x >= NL * 48) return;
    for (int e = tid; e < NB * DM; e += NTHREADS) sc[e / DM][e % DM] = siluf_(p.c[e]);
    __syncthreads();
    float* mod = (float*)(p.ws + WS_MOD);
    const int kg = tid >> 6, cl = tid & 63;
    for (int it = blockIdx.x; it < NL * 48; it += gridDim.x) {
        const int l = it / 48, n = (it % 48) * 64 + cl;
        const float* W = p.ada_w + (size_t)l * DM * 3072 + n;
        float acc[NB];
#pragma unroll
        for (int b = 0; b < NB; ++b) acc[b] = 0.f;
#pragma unroll 8
        for (int k = kg * 128; k < kg * 128 + 128; ++k) {
            const float w = W[(size_t)k * 3072];
#pragma unroll
            for (int b = 0; b < NB; ++b) acc[b] += sc[b][k] * w;
        }
#pragma unroll
        for (int b = 0; b < NB; ++b) red[kg][b][cl] = acc[b];
        __syncthreads();
        {
            const int b = tid >> 6;
            float s = p.ada_b[l * 3072 + n];
#pragma unroll
            for (int g = 0; g < 8; ++g) s += red[g][b][cl];
            mod[((size_t)l * NB + b) * 3072 + n] = s;
        }
        __syncthreads();
    }
}

__device__ __forceinline__ void row_h_store(const f32x4 (&v)[4], float rinv, const float* npre, const float* mod_lb, bf16_t* xnrow, int lane) {
#pragma unroll
    for (int j = 0; j < 4; ++j) {
        const int c = j * 256 + lane * 4;
        const f32x4 g = *(const f32x4*)(npre + c), sh = *(const f32x4*)(mod_lb + c), scl = *(const f32x4*)(mod_lb + 1024 + c);
        f32x4 h;
#pragma unroll
        for (int i = 0; i < 4; ++i) h[i] = v[j][i] * rinv * g[i] * (1.f + scl[i]) + sh[i];
        u32x2 w; w.x = pk2(h[0], h[1]); w.y = pk2(h[2], h[3]);
        *(u32x2*)(xnrow + c) = w;
    }
}
__device__ __forceinline__ void phase_rows(const Params& p, int mode, int l) {
    const int tid = otid(), lane = tid & 63, wv = tid >> 6;
    const int gw = blockIdx.x * 8 + wv, ngw = gridDim.x * 8;
    const float* mod = (const float*)(p.ws + WS_MOD);
    bf16_t* XN = (bf16_t*)(p.ws + WS_XN);
    const bf16_t* Z = (const bf16_t*)(p.ws + WS_Z);
    for (int m = gw; m < MTOK; m += ngw) {
        const int b = m / SEQ;
        f32x4 v[4];
        if (mode == 0) {
#pragma unroll
            for (int j = 0; j < 4; ++j) v[j] = *(const f32x4*)(p.x + (size_t)m * DM + j * 256 + lane * 4);
            float s = 0.f;
#pragma unroll
            for (int j = 0; j < 4; ++j) s += v[j][0] * v[j][0] + v[j][1] * v[j][1] + v[j][2] * v[j][2] + v[j][3] * v[j][3];
            const float rinv = rsqrtf(wave_sum(s) * (1.f / DM) + 1e-6f);
            row_h_store(v, rinv, p.norm_pre, mod + ((size_t)0 * NB + b) * 3072, XN + (size_t)m * DM, lane);
        } else {
            f32x4 z[4];
#pragma unroll
            for (int j = 0; j < 4; ++j) { const u32x2 zw = *(const u32x2*)(Z + (size_t)m * DM + j * 256 + lane * 4); z[j] = (f32x4){bflo(zw.x), bfhi(zw.x), bflo(zw.y), bfhi(zw.y)}; }
            float s = 0.f;
#pragma unroll
            for (int j = 0; j < 4; ++j) s += z[j][0] * z[j][0] + z[j][1] * z[j][1] + z[j][2] * z[j][2] + z[j][3] * z[j][3];
            const float rz = rsqrtf(wave_sum(s) * (1.f / DM) + 1e-6f);
            const float* xold = (l == 0) ? p.x : p.out;
            const float* mod_lb = mod + ((size_t)l * NB + b) * 3072;
            float s2 = 0.f;
#pragma unroll
            for (int j = 0; j < 4; ++j) {
                const int c = j * 256 + lane * 4;
                const f32x4 xo = *(const f32x4*)(xold + (size_t)m * DM + c), gp = *(const f32x4*)(p.norm_post + l * DM + c), gt = *(const f32x4*)(mod_lb + 2048 + c);
#pragma unroll
                for (int i = 0; i < 4; ++i) { v[j][i] = xo[i] + gt[i] * (z[j][i] * rz * gp[i]); s2 += v[j][i] * v[j][i]; }
                *(f32x4*)(p.out + (size_t)m * DM + c) = v[j];
            }
            if (l + 1 < NL) {
                const float rinv = rsqrtf(wave_sum(s2) * (1.f / DM) + 1e-6f);
                row_h_store(v, rinv, p.norm_pre + (l + 1) * DM, mod + ((size_t)(l + 1) * NB + b) * 3072, XN + (size_t)m * DM, lane);
            }
        }
    }
}

template <int MODE>
__device__ __forceinline__ void phase_gemm_simple(unsigned char* lds, const bf16_t* A, const bf16_t* Bt, void* Cout, int M, int N, int K, const float* qg, const float* kg) {
    bf16_t (*As)[40] = (bf16_t (*)[40])lds;
    bf16_t (*Bs)[40] = (bf16_t (*)[40])(lds + 128 * 40 * 2);
    const int tid = otid(), lane = tid & 63, wv = tid >> 6;
    const int ntn = N / 64, ntm = M / 128;
    for (int it = blockIdx.x; it < ntm * ntn; it += gridDim.x) {
        const int tm = it / ntn, tn = it % ntn, m0 = tm * 128, n0 = tn * 64;
        f32x4 acc[4];
#pragma unroll
        for (int n = 0; n < 4; ++n) acc[n] = (f32x4){0.f, 0.f, 0.f, 0.f};
        for (int k0 = 0; k0 < K; k0 += 32) {
            {
                const int r = tid >> 2, ch = tid & 3;
                *(u32x4*)(&As[r][ch * 8]) = *(const u32x4*)(A + (size_t)(m0 + r) * K + k0 + ch * 8);
                if (tid < 256) *(u32x4*)(&Bs[r][ch * 8]) = *(const u32x4*)(Bt + (size_t)(n0 + r) * K + k0 + ch * 8);
            }
            __syncthreads();
            const bf16x8 a = *(const bf16x8*)(&As[wv * 16 + (lane & 15)][(lane >> 4) * 8]);
#pragma unroll
            for (int n = 0; n < 4; ++n) {
                const bf16x8 b = *(const bf16x8*)(&Bs[n * 16 + (lane & 15)][(lane >> 4) * 8]);
                acc[n] = __builtin_amdgcn_mfma_f32_16x16x32_bf16(a, b, acc[n], 0, 0, 0);
            }
            __syncthreads();
        }
        if (MODE == 0) {
            bf16_t* C = (bf16_t*)Cout;
            float scale[4] = {1.f, 1.f, 1.f, 1.f};
            float gain[4] = {1.f, 1.f, 1.f, 1.f};
            if (n0 < 1024) {
#pragma unroll
                for (int r = 0; r < 4; ++r) {
                    float s = acc[0][r] * acc[0][r] + acc[1][r] * acc[1][r] + acc[2][r] * acc[2][r] + acc[3][r] * acc[3][r];
                    s += __shfl_xor(s, 1); s += __shfl_xor(s, 2); s += __shfl_xor(s, 4); s += __shfl_xor(s, 8);
                    scale[r] = rsqrtf(s * (1.f / 64.f) + 1e-6f) * (n0 < 512 ? C2 : 1.f);
                }
#pragma unroll
                for (int n = 0; n < 4; ++n) gain[n] = (n0 < 512 ? qg : kg)[n * 16 + (lane & 15)];
            }
#pragma unroll
            for (int n = 0; n < 4; ++n)
#pragma unroll
                for (int r = 0; r < 4; ++r)
                    C[(size_t)(m0 + wv * 16 + (lane >> 4) * 4 + r) * N + n0 + n * 16 + (lane & 15)] = (bf16_t)f2bf(acc[n][r] * scale[r] * gain[n]);
        } else {
            float* C = (float*)Cout;
#pragma unroll
            for (int n = 0; n < 4; ++n)
#pragma unroll
                for (int r = 0; r < 4; ++r) C[(size_t)(m0 + wv * 16 + (lane >> 4) * 4 + r) * N + n0 + n * 16 + (lane & 15)] = acc[n][r];
        }
    }
}

__device__ __forceinline__ void phase_cum(const Params& p, int l, unsigned char* lds) {
    float (*wtot)[8] = (float (*)[8])lds;
    const int tid = otid(), lane = tid & 63, wv = tid >> 6;
    const bf16_t* U = (const bf16_t*)(p.ws + WS_U);
    float* CB = (float*)(p.ws + WS_CB);
    for (int b = blockIdx.x; b < NB; b += gridDim.x) {
        float pre[8][8];
        float run[8];
#pragma unroll
        for (int h = 0; h < 8; ++h) run[h] = 0.f;
#pragma unroll
        for (int i = 0; i < 8; ++i) {
            const u32x4 w = *(const u32x4*)(U + (size_t)(b * SEQ + tid * 8 + i) * NU + UF);
            float f[8] = {bflo(w.x), bfhi(w.x), bflo(w.y), bfhi(w.y), bflo(w.z), bfhi(w.z), bflo(w.w), bfhi(w.w)};
#pragma unroll
            for (int h = 0; h < 8; ++h) {
                const float xx = f[h] + p.f_bias[l * 8 + h];
                const float ls = fminf(xx, 0.f) - __logf(1.f + __expf(-fabsf(xx)));
                run[h] += -ls * LOG2E;
                pre[i][h] = run[h];
            }
        }
        float exc[8];
#pragma unroll
        for (int h = 0; h < 8; ++h) {
            float v = run[h];
#pragma unroll
            for (int o = 1; o < 64; o <<= 1) { const float t = __shfl_up(v, o); if (lane >= o) v += t; }
            if (lane == 63) wtot[wv][h] = v;
            exc[h] = v - run[h];
        }
        __syncthreads();
#pragma unroll
        for (int h = 0; h < 8; ++h) { float base = 0.f; for (int w2 = 0; w2 < wv; ++w2) base += wtot[w2][h]; exc[h] += base; }
#pragma unroll
        for (int h = 0; h < 8; ++h)
#pragma unroll
            for (int i = 0; i < 8; ++i) CB[((size_t)b * 8 + h) * SEQ + tid * 8 + i] = exc[h] + pre[i][h];
        float* cbe = (float*)(lds + 256);
        float* cbq0 = cbe + 512;
#pragma unroll
        for (int h = 0; h < 8; ++h) { if ((tid & 7) == 7) cbe[h * 64 + (tid >> 3)] = exc[h] + pre[7][h]; if ((tid & 31) == 0) cbq0[h * 16 + (tid >> 5)] = exc[h] + pre[0][h]; }
        __syncthreads();
        {
            float gq = fabsf(p.q_gain[l * 64 + lane]), gk = fabsf(p.k_gain[l * 64 + lane]);
#pragma unroll
            for (int o = 1; o < 64; o <<= 1) { gq = fmaxf(gq, __shfl_xor(gq, o)); gk = fmaxf(gk, __shfl_xor(gk, o)); }
            const float dskip = 2.f * 1.02f * (64.f * C2) * gq * gk + 52.f;
            int* TS = (int*)(p.ws + WS_TS);
            for (int it = wv; it < 8 * 16; it += 8) {
                const int h = it >> 4, qb = it & 15, nt = 4 * qb + 4;
                const bool pr = (lane < nt) && (cbe[h * 64 + lane] < cbq0[h * 16 + qb] - dskip);
                int ts = __popcll(__ballot(pr));
                ts &= ~1; ts = ts < nt - 4 ? ts : nt - 4;
                if (lane == 0) TS[(b * 8 + h) * 16 + qb] = ts;
            }
        }
        __syncthreads();
    }
}

typedef _Float16 h8 __attribute__((ext_vector_type(8)));
typedef _Float16 h4 __attribute__((ext_vector_type(4)));
typedef float f32x2 __attribute__((ext_vector_type(2)));
template <int CTRL> __device__ __forceinline__ float dpp_add(float x) {
    const int y = __builtin_amdgcn_update_dpp(0, __builtin_bit_cast(int, x), CTRL, 0xF, 0xF, true);
    return x + __builtin_bit_cast(float, y);
}
__device__ __forceinline__ float row16_sum(float x) {
    x = dpp_add<0xB1>(x); x = dpp_add<0x4E>(x); x = dpp_add<0x141>(x); x = dpp_add<0x140>(x); return x;
}
__device__ __forceinline__ float wave_sum_fast(float x) {
    x = row16_sum(x);
    { const unsigned xi = __builtin_bit_cast(unsigned, x); auto rr = __builtin_amdgcn_permlane16_swap(xi, xi, false, false); const unsigned r0 = rr[0], r1 = rr[1]; x = __builtin_bit_cast(float, r0) + __builtin_bit_cast(float, r1); }
    { const unsigned xi = __builtin_bit_cast(unsigned, x); auto rr = __builtin_amdgcn_permlane32_swap(xi, xi, false, false); const unsigned r0 = rr[0], r1 = rr[1]; x = __builtin_bit_cast(float, r0) + __builtin_bit_cast(float, r1); }
    return x;
}
__device__ __forceinline__ f32x4 mma_nt16(f32x4 acc, const LAS unsigned char* A, int pa, const LAS unsigned char* Bt, int pb, int K, int lane) {
    const LAS unsigned char* ap = A + (lane & 15) * pa + (lane >> 4) * 16;
    const LAS unsigned char* bp = Bt + (lane & 15) * pb + (lane >> 4) * 16;
#pragma unroll
    for (int k = 0; k < K; k += 32) {
        const bf16x8 a = *(const LAS bf16x8*)(ap + 2 * k), b = *(const LAS bf16x8*)(bp + 2 * k);
        acc = __builtin_amdgcn_mfma_f32_16x16x32_bf16(a, b, acc, 0, 0, 0);
    }
    return acc;
}
constexpr int CK_W2T = 0, CK_A2T = 9216, CK_XW = 18432, CK_XA = 23040, CK_SWF = 27648, CK_SAF = 35968, CK_TOT = 44288, CK_EGL = 46336;
constexpr int CK_KT = 46592, CK_RT = 51200, CK_BH = 55808, CK_KH = 60416, CK_RHS = 65024, CK_VT = 81920, CK_BBT = 87040, CK_KBT = 92160, CK_LF = 97280;
constexpr int CK_AAK = 101888, CK_AQB = 104448, CK_AQK = 107008, CK_W1T = 109568, CK_W2N = 114688, CK_OUT = 119808;
constexpr int P72 = 144, P40 = 80, PSF = 65 * 4, PRHS = 132 * 4, PLF = 36 * 4;
__device__ __forceinline__ float fsigmoid(float x) { return __builtin_amdgcn_rcpf(1.f + __expf(-x)); }
__device__ __forceinline__ float ftanh(float x) { return 1.f - 2.f * __builtin_amdgcn_rcpf(1.f + __expf(2.f * x)); }
typedef float f32x2c __attribute__((ext_vector_type(2))); typedef __bf16 bf16x2c __attribute__((ext_vector_type(2)));
__device__ __forceinline__ unsigned cvtpk(float lo, float hi) { const f32x2c v = {lo, hi}; const bf16x2c b = __builtin_convertvector(v, bf16x2c); return __builtin_bit_cast(unsigned, b); }
__device__ __forceinline__ bf16_t cvt1(float x) { return (bf16_t)(cvtpk(x, x) & 0xffffu); }
__device__ __forceinline__ void phase_rwkv_chunk(const Params& p, int l, unsigned char* lds_) {
    LAS unsigned char* lds = (LAS unsigned char*)lds_;
    const int tid = otid(), lane = tid & 63, wv = __builtin_amdgcn_readfirstlane(tid >> 6);
    const int h = (int)blockIdx.x & 3, c = h * 64 + lane;
    const bf16_t* U = (const bf16_t*)(p.ws + WS_U);
    float* BON = (float*)(p.ws + WS_BON);
    unsigned char* CHK = p.ws + WS_CHK;
    for (int e = tid; e < 2 * 64 * 64; e += NTHREADS) {
        const int which = e >> 12, k = (e >> 6) & 63, cc = e & 63;
        const float v = (which ? p.a2 : p.w2)[((size_t)l * 64 + k) * 256 + h * 64 + cc];
        *(LAS bf16_t*)(lds + (which ? CK_A2T : CK_W2T) + cc * P72 + k * 2) = cvt1(v);
    }
    const float mur = p.mu[l * 896 + c], muk = p.mu[l * 896 + 256 + c], muv = p.mu[l * 896 + 512 + c], muw = p.mu[l * 896 + 768 + lane], mua = p.mu[l * 896 + 832 + lane];
    const float w0c = p.w0[l * 256 + c], a0c = p.a0[l * 256 + c], kkc = p.k_k[l * 256 + c], kac = p.k_a[l * 256 + c], rkc = p.r_k[l * 256 + c];
    const int fr = lane & 15, fq = lane >> 4;
    unsigned short xr[5], xk[5], xv[5], xw_[5], xa_[5];
#define CK_LOAD(qq) do { const int b_ = (qq) / NCHK, ch_ = (qq) % NCHK; const bf16_t* ub = U + ((size_t)b_ * SEQ + ch_ * 32 + 4 * wv) * NU + UR; const bool first_ = (ch_ == 0 && wv == 0); \
        _Pragma("unroll") for (int u = 0; u < 5; ++u) { const bf16_t* q_ = ub + (ptrdiff_t)(u - 1 + ((u == 0 && first_) ? 1 : 0)) * NU; \
            xr[u] = q_[c]; xk[u] = q_[256 + c]; xv[u] = q_[512 + c]; xw_[u] = q_[768 + lane]; xa_[u] = q_[832 + lane]; } } while (0)
    if (((int)blockIdx.x >> 2) < NB * NCHK) CK_LOAD((int)blockIdx.x >> 2);
    for (int q = (int)blockIdx.x >> 2; q < NB * NCHK; q += (int)gridDim.x >> 2) {
        const int b = q / NCHK, ch = q % NCHK;
        int lz_ = 0; asm volatile("" : "+v"(lz_)); LAS unsigned char* L_ = lds + lz_;
        const size_t m0 = (size_t)b * SEQ + ch * 32;
        float rl[4], kl[4], vl[4];
        {
            const bool first = (ch == 0 && wv == 0);
#pragma unroll
            for (int u = 0; u < 4; ++u) {
                const float pz = (u == 0 && first) ? 0.f : 1.f;
                const float rc = bf2f(xr[u + 1]), kc = bf2f(xk[u + 1]), vc = bf2f(xv[u + 1]), wc = bf2f(xw_[u + 1]), ac = bf2f(xa_[u + 1]);
                rl[u] = rc + (bf2f(xr[u]) * pz - rc) * mur; kl[u] = kc + (bf2f(xk[u]) * pz - kc) * muk; vl[u] = vc + (bf2f(xv[u]) * pz - vc) * muv;
                const float wl = wc + (bf2f(xw_[u]) * pz - wc) * muw, al = ac + (bf2f(xa_[u]) * pz - ac) * mua;
                const int t = 4 * wv + u;
                *(LAS bf16_t*)(L_ + CK_XW + t * P72 + lane * 2) = cvt1(ftanh(wl));
                *(LAS bf16_t*)(L_ + CK_XA + t * P72 + lane * 2) = cvt1(al);
            }
            const int qn = q + ((int)gridDim.x >> 2);
            if (qn < NB * NCHK) CK_LOAD(qn);
        }
        __syncthreads();
        {
            const int mi = wv >> 2, tr = (wv >> 1) & 1;
#pragma unroll
            for (int i = 0; i < 2; ++i) {
                const int tc = 2 * (wv & 1) + i;
                f32x4 acc = {0.f, 0.f, 0.f, 0.f};
                acc = mma_nt16(acc, L_ + (mi ? CK_XA : CK_XW) + 16 * tr * P72, P72, L_ + (mi ? CK_A2T : CK_W2T) + 16 * tc * P72, P72, 64, lane);
#pragma unroll
                for (int r = 0; r < 4; ++r) *(LAS float*)(L_ + (mi ? CK_SAF : CK_SWF) + (16 * tr + 4 * fq + r) * PSF + (16 * tc + fr) * 4) = acc[r];
            }
        }
        __syncthreads();
        float lw[4], kkv[4], ktv[4], bbv[4], gl[4];
        {
            float run = 0.f;
#pragma unroll
            for (int u = 0; u < 4; ++u) {
                const int t = 4 * wv + u;
                const float sw = *(const LAS float*)(L_ + CK_SWF + t * PSF + lane * 4) + w0c, sa = *(const LAS float*)(L_ + CK_SAF + t * PSF + lane * 4) + a0c;
                lw[u] = -DECAY_SCALE * fsigmoid(sw);
                const float a = fsigmoid(sa);
                const float kx = kl[u] * kkc;
                kkv[u] = kx * __builtin_amdgcn_rsqf(fmaxf(wave_sum_fast(kx * kx), 1e-24f));
                ktv[u] = kl[u] * (1.f + (a - 1.f) * kac); bbv[u] = kkv[u] * a;
                const float bs = wave_sum_fast(rl[u] * ktv[u] * rkc);
                if (lane == 0) BON[(m0 + t) * 4 + h] = bs;
                run += lw[u]; gl[u] = run;
            }
            *(LAS float*)(L_ + CK_TOT + (wv * 64 + lane) * 4) = run;
        }
        __syncthreads();
        {
            float off = 0.f, tot = 0.f;
#pragma unroll
            for (int g = 0; g < 8; ++g) { const float x = *(const LAS float*)(L_ + CK_TOT + (g * 64 + lane) * 4); tot += x; off += (g < wv) ? x : 0.f; }
            const float etot = __expf(tot);
            if (wv == 0) *(LAS float*)(L_ + CK_EGL + lane * 4) = etot;
            float bbe[4], kte[4];
#pragma unroll
            for (int u = 0; u < 4; ++u) {
                const int t = 4 * wv + u;
                const float G = off + gl[u];
                const float e1 = __expf(G - lw[u]), e2 = __expf(G), inv = __builtin_amdgcn_rcpf(e2), el = etot * inv;
                const float ktl = kkv[u] * e1;
                *(LAS bf16_t*)(L_ + CK_KT + t * P72 + lane * 2) = cvt1(ktl);
                *(LAS float*)(L_ + CK_RHS + t * PRHS + lane * 4) = ktl;
                *(LAS bf16_t*)(L_ + CK_RT + t * P72 + lane * 2) = cvt1(rl[u] * e2);
                *(LAS bf16_t*)(L_ + CK_BH + t * P72 + lane * 2) = cvt1(bbv[u] * inv);
                *(LAS bf16_t*)(L_ + CK_KH + t * P72 + lane * 2) = cvt1(ktv[u] * inv);
                bbe[u] = bbv[u] * el; kte[u] = ktv[u] * el;
            }
            *(LAS u32x2*)(L_ + CK_VT + lane * P40 + wv * 8) = (u32x2){cvtpk(vl[0], vl[1]), cvtpk(vl[2], vl[3])};
            *(LAS u32x2*)(L_ + CK_BBT + lane * P40 + wv * 8) = (u32x2){cvtpk(bbe[0], bbe[1]), cvtpk(bbe[2], bbe[3])};
            *(LAS u32x2*)(L_ + CK_KBT + lane * P40 + wv * 8) = (u32x2){cvtpk(kte[0], kte[1]), cvtpk(kte[2], kte[3])};
        }
        __syncthreads();
        {
            const int mi = wv >> 1, tr = wv & 1;
            const LAS unsigned char* A = L_ + ((mi < 2) ? CK_KT : CK_RT) + 16 * tr * P72;
            const LAS unsigned char* Bm = L_ + ((mi & 1) ? CK_KH : CK_BH);
#pragma unroll
            for (int tc = 0; tc < 2; ++tc) {
                f32x4 acc = {0.f, 0.f, 0.f, 0.f};
                acc = mma_nt16(acc, A, P72, Bm + 16 * tc * P72, P72, 64, lane);
#pragma unroll
                for (int r = 0; r < 4; ++r) {
                    const int t = 16 * tr + 4 * fq + r, s_ = 16 * tc + fr;
                    const float x = (mi < 2 ? (s_ < t) : (s_ <= t)) ? acc[r] : 0.f;
                    if (mi == 0) *(LAS float*)(L_ + CK_LF + s_ * PLF + (((t & 3) << 3) + (t >> 2)) * 4) = x;
                    else *(LAS bf16_t*)(L_ + (mi == 1 ? CK_AAK : (mi == 2 ? CK_AQB : CK_AQK)) + t * P40 + s_ * 2) = cvt1(x);
                }
            }
        }
        __syncthreads();
        {
            const int tr = wv >> 2, ic = wv & 3;
            f32x4 acc = {0.f, 0.f, 0.f, 0.f};
            acc = mma_nt16(acc, L_ + CK_AAK + 16 * tr * P40, P40, L_ + CK_VT + 16 * ic * P40, P40, 32, lane);
#pragma unroll
            for (int r = 0; r < 4; ++r) *(LAS float*)(L_ + CK_RHS + (16 * tr + 4 * fq + r) * PRHS + (64 + 16 * ic + fr) * 4) = acc[r];
        }
        __syncthreads();
        {
            const int col = tid >> 2, pq = tid & 3;
            float acc[8];
#pragma unroll
            for (int i = 0; i < 8; ++i) acc[i] = *(const LAS float*)(L_ + CK_RHS + (4 * i + pq) * PRHS + col * 4);
            const LAS unsigned char* lp = L_ + CK_LF + pq * 32;
#pragma unroll
            for (int s_ = 0; s_ < 31; ++s_) {
                const f32x4 l0 = *(const LAS f32x4*)(lp + s_ * PLF), l1 = *(const LAS f32x4*)(lp + s_ * PLF + 16);
                const int xi_ = __builtin_bit_cast(int, acc[s_ >> 2]); int src;
                switch (s_ & 3) { case 0: src = __builtin_amdgcn_update_dpp(0, xi_, 0x00, 0xF, 0xF, true); break; case 1: src = __builtin_amdgcn_update_dpp(0, xi_, 0x55, 0xF, 0xF, true); break;
                                  case 2: src = __builtin_amdgcn_update_dpp(0, xi_, 0xAA, 0xF, 0xF, true); break; default: src = __builtin_amdgcn_update_dpp(0, xi_, 0xFF, 0xF, 0xF, true); break; }
                const float ws = __builtin_bit_cast(float, src);
#pragma unroll
                for (int i = 0; i < 4; ++i) { acc[i] -= l0[i] * ws; acc[4 + i] -= l1[i] * ws; }
                if ((s_ & 7) == 7) asm volatile("" ::: "memory");
            }
            LAS unsigned char* dst = L_ + (col < 64 ? CK_W1T : CK_W2N) + (col & 63) * P40;
#pragma unroll
            for (int i = 0; i < 8; ++i) *(LAS bf16_t*)(dst + (4 * i + pq) * 2) = cvt1(-acc[i]);
        }
        __syncthreads();
        {
            {
                const int tr = wv >> 2, cc = wv & 3;
                f32x4 acc;
#pragma unroll
                for (int r = 0; r < 4; ++r) acc[r] = bf2f(*(const LAS bf16_t*)(L_ + CK_RT + (16 * tr + 4 * fq + r) * P72 + (16 * cc + fr) * 2));
                acc = mma_nt16(acc, L_ + CK_AQB + 16 * tr * P40, P40, L_ + CK_W1T + 16 * cc * P40, P40, 32, lane);
#pragma unroll
                for (int r = 0; r < 4; ++r) *(LAS bf16_t*)(L_ + CK_OUT + (16 * tr + 4 * fq + r) * 128 + (16 * cc + fr) * 2) = cvt1(acc[r]);
                f32x4 ac2 = {0.f, 0.f, 0.f, 0.f};
                ac2 = mma_nt16(ac2, L_ + CK_AQK + 16 * tr * P40, P40, L_ + CK_VT + 16 * cc * P40, P40, 32, lane);
                ac2 = mma_nt16(ac2, L_ + CK_AQB + 16 * tr * P40, P40, L_ + CK_W2N + 16 * cc * P40, P40, 32, lane);
#pragma unroll
                for (int r = 0; r < 4; ++r) *(LAS bf16_t*)(L_ + CK_OUT + 4096 + (16 * tr + 4 * fq + r) * 128 + (16 * cc + fr) * 2) = cvt1(ac2[r]);
            }
#pragma unroll
            for (int i = 0; i < 2; ++i) {
                const int tl = 2 * wv + i, rr = tl >> 2, cc = tl & 3;
                f32x4 acc = {0.f, 0.f, 0.f, 0.f};
                acc = mma_nt16(acc, L_ + CK_BBT + 16 * rr * P40, P40, L_ + CK_W1T + 16 * cc * P40, P40, 32, lane);
#pragma unroll
                for (int r = 0; r < 4; ++r) { const int jp = 16 * rr + 4 * fq + r, j = 16 * cc + fr;
                    const float x = acc[r] + ((jp == j) ? *(const LAS float*)(L_ + CK_EGL + j * 4) : 0.f);
                    *(LAS bf16_t*)(L_ + CK_OUT + 8192 + jp * 128 + j * 2) = cvt1(x); }
                f32x4 ac2 = {0.f, 0.f, 0.f, 0.f};
                ac2 = mma_nt16(ac2, L_ + CK_VT + 16 * rr * P40, P40, L_ + CK_KBT + 16 * cc * P40, P40, 32, lane);
                ac2 = mma_nt16(ac2, L_ + CK_W2N + 16 * rr * P40, P40, L_ + CK_BBT + 16 * cc * P40, P40, 32, lane);
#pragma unroll
                for (int r = 0; r < 4; ++r) *(LAS bf16_t*)(L_ + CK_OUT + 16384 + (16 * rr + 4 * fq + r) * 128 + (16 * cc + fr) * 2) = cvt1(ac2[r]);
            }
        }
        __syncthreads();
        {
            unsigned char* dst = CHK + ((size_t)(b * 4 + h) * NCHK + ch) * CHK_B;
#pragma unroll
            for (int i = 0; i < 3; ++i) *(u32x4*)(dst + (i * NTHREADS + tid) * 16) = *(const LAS u32x4*)(L_ + CK_OUT + (i * NTHREADS + tid) * 16);
        }
        __syncthreads();
    }
}

#undef CK_LOAD
__device__ __forceinline__ void glds16g(const void* gsrc, unsigned lds_dst) { unsigned keep;
    asm volatile("s_mov_b32 %0, m0\n\ts_mov_b32 m0, %2\n\ts_nop 0\n\tglobal_load_lds_dwordx4 %1, off\n\ts_mov_b32 m0, %0" : "=&s"(keep) : "v"(gsrc), "s"(lds_dst) : "memory"); }
constexpr int CN_NBUF = 5, CN_RING = 0, CN_SB = CN_NBUF * CHK_B;
__device__ __forceinline__ void phase_rwkv_chain(const Params& p, unsigned char* lds_, int bh) {
    LAS unsigned char* lds = (LAS unsigned char*)lds_;
    const int tid = otid(), lane = tid & 63, wv = __builtin_amdgcn_readfirstlane(tid >> 6);
    const int fr = lane & 15, fq = lane >> 4, b = bh >> 2, h = bh & 3;
    const unsigned char* rec = p.ws + WS_CHK + (size_t)bh * NCHK * CHK_B;
    float* O32 = (float*)(p.ws + WS_O32);
    const unsigned lds0 = (unsigned)(size_t)lds;
#define CN_DMA(cc) do { const unsigned char* g = rec + (size_t)(cc) * CHK_B + tid * 16; const unsigned d = (unsigned)__builtin_amdgcn_readfirstlane((int)(lds0 + CN_RING + ((cc) % CN_NBUF) * CHK_B + wv * 1024)); \
        glds16g(g, d); glds16g(g + 8192, d + 8192); glds16g(g + 16384, d + 16384); } while (0)
    for (int e = tid; e < 2 * 64 * 72 / 2; e += NTHREADS) *(LAS unsigned*)(lds + CN_SB + e * 4) = 0u;
    CN_DMA(0); CN_DMA(1); CN_DMA(2); CN_DMA(3);
    asm volatile("s_waitcnt vmcnt(0) lgkmcnt(0)\n\ts_barrier" ::: "memory");
#pragma unroll 1
    for (int cc = 0; cc < NCHK; ++cc) {
        if (cc + 4 < NCHK) CN_DMA(cc + 4);
        int lz_ = 0; asm volatile("" : "+v"(lz_)); LAS unsigned char* L_ = lds + lz_;
        const LAS unsigned char* R = L_ + CN_RING + (cc % CN_NBUF) * CHK_B;
        const LAS unsigned char* Sc = L_ + CN_SB + (cc & 1) * (64 * P72);
        LAS unsigned char* Sn = L_ + CN_SB + ((cc + 1) & 1) * (64 * P72);
        {
            const int tr = wv >> 2, ic = wv & 3;
            f32x4 acc;
#pragma unroll
            for (int r = 0; r < 4; ++r) acc[r] = bf2f(*(const LAS bf16_t*)(R + 4096 + (16 * tr + 4 * fq + r) * 128 + (16 * ic + fr) * 2));
            acc = mma_nt16(acc, R + 16 * tr * 128, 128, Sc + 16 * ic * P72, P72, 64, lane);
            float* op = O32 + ((size_t)b * SEQ + cc * 32 + 16 * tr + 4 * fq) * 256 + h * 64 + 16 * ic + fr;
#pragma unroll
            for (int r = 0; r < 4; ++r) op[(size_t)r * 256] = acc[r];
        }
#pragma unroll
        for (int i = 0; i < 2; ++i) {
            const int tl = 2 * wv + i, ir = tl >> 2, jc = tl & 3;
            f32x4 acc;
#pragma unroll
            for (int r = 0; r < 4; ++r) acc[r] = bf2f(*(const LAS bf16_t*)(R + 16384 + (16 * ir + 4 * fq + r) * 128 + (16 * jc + fr) * 2));
            acc = mma_nt16(acc, Sc + 16 * ir * P72, P72, R + 8192 + 16 * jc * 128, 128, 64, lane);
#pragma unroll
            for (int r = 0; r < 4; ++r) *(LAS bf16_t*)(Sn + (16 * ir + 4 * fq + r) * P72 + (16 * jc + fr) * 2) = (bf16_t)f2bf(acc[r]);
        }
        if (cc + 4 < NCHK) asm volatile("s_waitcnt vmcnt(9) lgkmcnt(0)\n\ts_barrier" ::: "memory");
        else asm volatile("s_waitcnt vmcnt(0) lgkmcnt(0)\n\ts_barrier" ::: "memory");
    }
#undef CN_DMA
}

__device__ __forceinline__ void phase_rwkv_fin(const Params& p, int l) {
    const int tid = otid(), lane = tid & 63, wv = tid >> 6;
    const bf16_t* U = (const bf16_t*)(p.ws + WS_U);
    const float* O32 = (const float*)(p.ws + WS_O32); const float* BON = (const float*)(p.ws + WS_BON);
    bf16_t* Y = (bf16_t*)(p.ws + WS_Y);
    const int ngw = gridDim.x * 8;
    for (int m2 = blockIdx.x * 8 + wv; m2 < MTOK / 2; m2 += ngw) {
        float o[8], vc[8], vp[8], g[8], bn[8];
#pragma unroll
        for (int k = 0; k < 8; ++k) {
            const int m = 2 * m2 + (k >> 2), h = k & 3, c = h * 64 + lane;
            const bool has_prev = (m % SEQ) != 0;
            o[k] = O32[(size_t)m * 256 + c];
            vc[k] = bf2f(U[(size_t)m * NU + UR + 512 + c]);
            vp[k] = has_prev ? bf2f(U[(size_t)(m - 1) * NU + UR + 512 + c]) : 0.f;
            g[k] = bf2f(U[(size_t)m * NU + UG + 512 + c]);
            bn[k] = BON[(size_t)m * 4 + h];
        }
#pragma unroll
        for (int k = 0; k < 8; ++k) {
            const int m = 2 * m2 + (k >> 2), h = k & 3, c = h * 64 + lane;
            const float mean = wave_sum_fast(o[k]) * (1.f / 64.f);
            const float dv = o[k] - mean;
            const float var = wave_sum_fast(dv * dv) * (1.f / 64.f);
            const float v = vc[k] + (vp[k] - vc[k]) * p.mu[l * 896 + 512 + c];
            const float on = dv * rsqrtf(var + 64e-5f) * p.ln_g[l * 256 + c] + p.ln_b[l * 256 + c] + bn[k] * v;
            Y[(size_t)m * DM + 512 + c] = (bf16_t)f2bf(on * g[k] * __builtin_amdgcn_rcpf(1.f + __expf(-g[k])));
        }
    }
}

template <int W> __device__ __forceinline__ void pool_item(const bf16_t* up, bf16_t* yp, int t0, float scl) {
    unsigned short xc[16], xp[W - 1], gg[16];
#pragma unroll
    for (int i = 0; i < 16; ++i) { xc[i] = up[(size_t)i * NU]; gg[i] = up[(size_t)i * NU + (UG + 768 - UP)]; }
#pragma unroll
    for (int d = 1; d < W; ++d) xp[d - 1] = (t0 - d >= 0) ? up[-(ptrdiff_t)d * NU] : (unsigned short)0;
    float s = 0.f;
#pragma unroll
    for (int d = 1; d < W; ++d) s += bf2f(xp[d - 1]);
#pragma unroll
    for (int i = 0; i < 16; ++i) {
        const int t = t0 + i;
        const float cur = bf2f(xc[i]);
        s += cur;
        const int cnt = (t + 1 < W) ? t + 1 : W;
        const float yv = (s * __builtin_amdgcn_rcpf((float)cnt) - cur) * scl;
        const float gv = bf2f(gg[i]);
        yp[(size_t)i * DM] = (bf16_t)f2bf(yv * gv * __builtin_amdgcn_rcpf(1.f + __expf(-gv)));
        const int k = i - W + 1;
        s -= (k >= 0) ? bf2f(xc[k >= 0 ? k : 0]) : bf2f(xp[k < 0 ? -k - 1 : 0]);
    }
}
__device__ __forceinline__ void phase_pool(const Params& p, int l) {
    const bf16_t* U = (const bf16_t*)(p.ws + WS_U);
    bf16_t* Y = (bf16_t*)(p.ws + WS_Y);
    const int tid = otid(), c = tid & 255, sub = tid >> 8, g = __builtin_amdgcn_readfirstlane(c >> 6);
    const float scl = p.pool_scale[l * 256 + c];
    for (int it = blockIdx.x * 2 + sub; it < MTOK / 16; it += gridDim.x * 2) {
        const int m0 = it * 16, t0 = m0 % SEQ;
        const bf16_t* up = U + (size_t)m0 * NU + UP + c;
        bf16_t* yp = Y + (size_t)m0 * DM + 768 + c;
        if (g == 0) pool_item<2>(up, yp, t0, scl); else if (g == 1) pool_item<4>(up, yp, t0, scl); else if (g == 2) pool_item<8>(up, yp, t0, scl); else pool_item<16>(up, yp, t0, scl);
    }
}

__global__ void __launch_bounds__(NTHREADS, 2) mega_fwd(Params p) {
    extern __shared__ __attribute__((aligned(16))) unsigned char lds[];
    volatile LAS unsigned* MISC = (volatile LAS unsigned*)((LAS unsigned char*)lds + MISC_OFF);
    if (threadIdx.x < 32) MISC[threadIdx.x] = 0u;
    __syncthreads();
    XcdBarrier bar = xcd_barrier_post((unsigned*)(p.ws + WS_CTL) + CW_BAR, MISC + 8);
#define GRID_BAR() do { XcdBarrier b_ = bar; unsigned* bp_ = (unsigned*)(p.ws + WS_CTL) + CW_BAR; asm volatile("" : "+s"(bp_)); b_.bar = bp_; xcd_barrier(b_); } while (0)
    bf16_t* XN = (bf16_t*)(p.ws + WS_XN); bf16_t* Y = (bf16_t*)(p.ws + WS_Y); bf16_t* U = (bf16_t*)(p.ws + WS_U); bf16_t* Z = (bf16_t*)(p.ws + WS_Z);

    phase_weights(p, lds);
    phase_mod(p, lds);
    GRID_BAR();
    phase_rows(p, 0, 0);
    GRID_BAR();
#pragma unroll 1
    for (int l = 0; l < NL; ++l) {
        const bf16_t* WT = (const bf16_t*)(p.ws + WS_WT) + (size_t)l * NU * DM;
        const bf16_t* WOT = (const bf16_t*)(p.ws + WS_WOT) + (size_t)l * DM * DM;
        {
            pg8::Gemm g{XN, WT, MTOK, NU, DM}; pg8::StaticOrder S; S.init(MTOK, NU, (int)gridDim.x, (int)blockIdx.x);
            pg8::EpiU E{U, p.q_gain + l * 64, p.k_gain + l * 64, NU};
            pg8::gemm_phase<pg8::EpiU, pg8::StaticOrder, true, true>((LAS unsigned char*)lds, g, S, E);
        }
        GRID_BAR();
        phase_cum(p, l, lds);
        phase_rwkv_chunk(p, l, lds);
        phase_pool(p, l);
        GRID_BAR();
        if (blockIdx.x < NB * 4) phase_rwkv_chain(p, lds, (int)blockIdx.x);
        {
            const attn_body::AttnTensors AT{(const attn_body::bf16*)(U + UQ), (const attn_body::bf16*)(U + UK), (const attn_body::bf16*)(U + UV), (const attn_body::bf16*)(U + UG),
                                            (const float*)(p.ws + WS_CB), (const int*)(p.ws + WS_TS), (attn_body::bf16*)Y};
            const attn_body::QueueOrder S{(unsigned*)(p.ws + WS_CTL) + CW_ATTQ + l * 64, MISC + 16};
            attn_body::attn_phase<attn_body::QueueOrder>((char*)lds, AT, S);
        }
        GRID_BAR();
        phase_rwkv_fin(p, l);
        GRID_BAR();
        {
            pg8::Gemm g{Y, WOT, MTOK, DM, DM}; pg8::StaticOrder S; S.init(MTOK, DM, (int)gridDim.x, (int)blockIdx.x);
            pg8::EpiB16 E{Z, DM};
            pg8::gemm_phase<pg8::EpiB16, pg8::StaticOrder, true, true>((LAS unsigned char*)lds, g, S, E);
        }
        GRID_BAR();
        phase_rows(p, 1, l);
        if (l + 1 < NL) GRID_BAR();
    }
}

extern "C" void kernel_launch(void* const* d_in, const int* in_sizes, int n_in, void* d_out, int out_size, void* d_ws, size_t ws_size, hipStream_t stream) {
    static int grid = 0;
    if (grid == 0) {
        if (n_in != 23 || ws_size < WS_END) { fprintf(stderr, "kernel_launch: unexpected n_in %d / ws_size %zu\n", n_in, ws_size); grid = -1; return; }
        int dev = 0, cus = 0, per_cu = 0;
        if (hipGetDevice(&dev) != hipSuccess || hipDeviceGetAttribute(&cus, hipDeviceAttributeMultiprocessorCount, dev) != hipSuccess) { grid = -1; return; }
        if (hipFuncSetAttribute((const void*)mega_fwd, hipFuncAttributeMaxDynamicSharedMemorySize, LDS_BYTES) != hipSuccess) { fprintf(stderr, "kernel_launch: hipFuncSetAttribute failed\n"); grid = -1; return; }
        if (hipOccupancyMaxActiveBlocksPerMultiprocessor(&per_cu, (const void*)mega_fwd, NTHREADS, LDS_BYTES) != hipSuccess || per_cu < 1) { fprintf(stderr, "kernel_launch: occupancy query failed (%d)\n", per_cu); grid = -1; return; }
        grid = cus;
        if (grid <= NB * 8) { fprintf(stderr, "kernel_launch: grid %d too small\n", grid); grid = -1; return; }
    }
    if (grid < 0) return;
    (void)hipMemsetAsync((char*)d_ws + WS_CTL, 0, CTL_ZERO_BYTES, stream);
    Params p{};
    const float** f = (const float**)&p;
    for (int i = 0; i < 23; ++i) f[i] = (const float*)d_in[i];
    p.out = (float*)d_out; p.ws = (unsigned char*)d_ws;
    void* args[] = {&p};
    hipError_t e = hipLaunchCooperativeKernel((const void*)mega_fwd, dim3(grid), dim3(NTHREADS), args, LDS_BYTES, stream);
    if (e != hipSuccess) fprintf(stderr, "cooperative launch failed: %s (grid %d)\n", hipGetErrorString(e), grid);
}
```

```cpp
#include <hip/hip_runtime.h>
#include <hip/hip_bf16.h>
#include <cstdio>
#include <cstdint>

constexpr int NB = 8, SEQ = 4096, DM = 1024, MTOK = NB * SEQ, NL = 2;
constexpr int D_IN = 3720, NU = 3840;
constexpr int UQ = 0, UK = 512, UV = 1024, UR = 1536  , UP = 2432  , UG = 2688  , UF = 3712  ;
constexpr int SQ = 0, SF = 1536, SR = 1544, SP = 2440, SG = 2696;
constexpr float C2 = 0.125f * 1.4426950408889634f;
constexpr float LOG2E = 1.4426950408889634f;
constexpr float DECAY_SCALE = 0.6065306597126334f;

typedef unsigned short bf16_t;
typedef short bf16x8 __attribute__((ext_vector_type(8)));
typedef float f32x4 __attribute__((ext_vector_type(4)));
typedef unsigned u32x4 __attribute__((ext_vector_type(4)));
typedef unsigned u32x2 __attribute__((ext_vector_type(2)));

__device__ __forceinline__ unsigned f2bf(float f) { unsigned u = __builtin_bit_cast(unsigned, f); return (u + 0x7fffu + ((u >> 16) & 1u)) >> 16; }
__device__ __forceinline__ unsigned pk2(float lo, float hi) { return f2bf(lo) | (f2bf(hi) << 16); }
__device__ __forceinline__ float bf2f(unsigned short b) { return __builtin_bit_cast(float, (unsigned)b << 16); }
__device__ __forceinline__ float bflo(unsigned w) { return __builtin_bit_cast(float, w << 16); }
__device__ __forceinline__ float bfhi(unsigned w) { return __builtin_bit_cast(float, w & 0xffff0000u); }
__device__ __forceinline__ float sigmoidf_(float x) { return 1.f / (1.f + __expf(-x)); }
__device__ __forceinline__ float siluf_(float x) { return x / (1.f + __expf(-x)); }
__device__ __forceinline__ float wave_sum(float v) {
#pragma unroll
    for (int o = 1; o < 64; o <<= 1) v += __shfl_xor(v, o);
    return v;
}

__device__ __forceinline__ int otid() { int t = threadIdx.x; asm volatile("" : "+v"(t)); return t; }

constexpr size_t MiB = 1u << 20;
constexpr size_t WS_CTL = 0;
constexpr size_t WS_MOD = 1 * MiB;
constexpr size_t WS_WT = 2 * MiB;
constexpr size_t WS_WOT = 18 * MiB;
constexpr size_t WS_TS = 512 * 1024;
constexpr size_t WS_CB = 22 * MiB;
constexpr size_t WS_XN = 24 * MiB;
constexpr size_t WS_O32 = 24 * MiB;
constexpr size_t WS_BON = 23 * MiB;
constexpr size_t WS_PA = 56 * MiB;
constexpr size_t WS_Y = 88 * MiB;
constexpr size_t WS_U = 152 * MiB;
constexpr size_t WS_Z = 152 * MiB;
constexpr size_t WS_CHK = 392 * MiB;
constexpr int CHK_B = 24576;
constexpr int NCHK = SEQ / 32;
constexpr size_t WS_END = 488 * MiB;
constexpr size_t CTL_ZERO_BYTES = 65536;
constexpr int CW_ATTQ = 8192;
constexpr int CW_BAR = 1024;

struct Params {
    const float *x, *c, *ada_w, *ada_b, *norm_pre, *norm_post, *w_in, *q_gain, *k_gain, *f_bias, *mu, *w0, *w2, *a0, *a2, *k_k, *k_a, *r_k, *ln_g, *ln_b,
        *pool_w, *pool_scale, *w_out;
    float* out;
    unsigned char* ws;
};


#define LAS __attribute__((address_space(3)))
constexpr int NTHREADS = 512;
constexpr int LDS_BYTES = 147456;
constexpr int MISC_OFF = LDS_BYTES - 128;

#define XB_TMO      128
#define XB_XCNT(j)  (256  + 64 * (j))
#define XB_XSUB(j)  (1280 + 64 * (j))
#define XB_XGEN(j)  (2304 + 64 * (j))
#define XB_TOP      3328
#define XB_TOPGEN   3392
#define XCD_BAR_WORDS 3456
#define XB_SPIN_CAP (1u << 18)
__device__ __forceinline__ unsigned xb_ld(unsigned* p)              { return __hip_atomic_load(p, __ATOMIC_RELAXED, __HIP_MEMORY_SCOPE_AGENT); }
__device__ __forceinline__ unsigned xb_add(unsigned* p, unsigned v) { return __hip_atomic_fetch_add(p, v, __ATOMIC_RELAXED, __HIP_MEMORY_SCOPE_AGENT); }
__device__ __forceinline__ unsigned xb_xcc_id() { return (unsigned)__builtin_amdgcn_s_getreg((3 << 11) | 20) & 0xFu; }
#define XB_SPIN(cond, bar) do { unsigned _sp = 0; while (cond) { __builtin_amdgcn_s_sleep(1); \
    if ((++_sp & 255u) == 0u) { if (xb_ld(&(bar)[XB_TMO])) break; if (_sp > XB_SPIN_CAP) { atomicAdd(&(bar)[XB_TMO], 1u); break; } } } } while (0)
struct XcdBarrier { unsigned* bar; unsigned x; volatile LAS unsigned* st; };
__device__ __forceinline__ XcdBarrier xcd_barrier_post(unsigned* bar, volatile LAS unsigned* st) {
    XcdBarrier b; b.bar = bar; b.x = xb_xcc_id(); b.st = st;
    if (threadIdx.x == 0) (void)xb_add(&bar[XB_XCNT(b.x)], 1u);
    return b;
}
__device__ __forceinline__ void xcd_barrier_complete(unsigned* bar, unsigned x, unsigned& nloc, unsigned& nx) {
    const unsigned G = gridDim.x * gridDim.y * gridDim.z;
    unsigned sum, cnt, mine, sp = 0u;
    for (;;) {
        sum = 0u; cnt = 0u; mine = 0u;
#pragma unroll
        for (unsigned j = 0; j < 16; ++j) { const unsigned c = xb_ld(&bar[XB_XCNT(j)]); sum += c; cnt += (c > 0u) ? 1u : 0u; mine = (j == x) ? c : mine; }
        if (sum == G) break;
        __builtin_amdgcn_s_sleep(1);
        if ((++sp & 255u) == 0u) { if (xb_ld(&bar[XB_TMO])) break; if (sp > XB_SPIN_CAP) { atomicAdd(&bar[XB_TMO], 1u); break; } }
    }
    nloc = mine > 0u ? mine : 1u; nx = cnt > 0u ? cnt : 1u;
}
__device__ __forceinline__ void xcd_barrier(const XcdBarrier& b) {
    asm volatile("s_waitcnt vmcnt(0)" ::: "memory");
    __syncthreads();
    if (threadIdx.x == 0) {
        unsigned* bar = b.bar;
        __builtin_amdgcn_s_waitcnt(0);
        unsigned nloc = b.st[0], nx = b.st[1];
        if (nloc == 0u) { xcd_barrier_complete(bar, b.x, nloc, nx); b.st[0] = nloc; b.st[1] = nx; }
        const unsigned old = xb_add(&bar[XB_XSUB(b.x)], 1u);
        const unsigned gen = old / nloc;
        if (old + 1u == (gen + 1u) * nloc) {
            __builtin_amdgcn_fence(__ATOMIC_RELEASE, "agent");
            asm volatile("s_waitcnt vmcnt(0)" ::: "memory");
            const unsigned og = xb_add(&bar[XB_TOP], 1u);
            const unsigned tg = og / nx;
            if (og + 1u == (tg + 1u) * nx) xb_add(&bar[XB_TOPGEN], 1u);
            else XB_SPIN(xb_ld(&bar[XB_TOPGEN]) == tg, bar);
            __builtin_amdgcn_fence(__ATOMIC_ACQUIRE, "agent");
            xb_add(&bar[XB_XGEN(b.x)], 1u);
            asm volatile("s_waitcnt vmcnt(0)" ::: "memory");
        } else {
            XB_SPIN(xb_ld(&bar[XB_XGEN(b.x)]) == gen, bar);
            __builtin_amdgcn_fence(__ATOMIC_ACQUIRE, "agent");
            asm volatile("s_waitcnt vmcnt(0)" ::: "memory");
        }
    }
    __syncthreads();
}


namespace pg8 {
#define PG8_LAS __attribute__((address_space(3)))
typedef unsigned short bf16_t;
typedef short bf16x8 __attribute__((ext_vector_type(8)));
typedef float f32x4 __attribute__((ext_vector_type(4)));
typedef unsigned u32x4 __attribute__((ext_vector_type(4)));
constexpr int BM = 256, BK = 64, HALF = 128, HTB = HALF * BK * 2  , STAGE_BYTES = 8 * HTB, NXCD = 8, WGM = 8;

__host__ __device__ __forceinline__ int lds_byte(int r, int c) { const int st = (r >> 4) * 2 + (c >> 5), rr = r & 15, cc = c & 31, ob = rr * 64 + cc * 2; return st * 1024 + (ob ^ (((ob >> 9) & 1) << 5)); }
__host__ __device__ __forceinline__ void stage_rc(int b, int& R, int& C) { const int st = b / 1024, sb = b % 1024, swz = sb ^ (((sb >> 9) & 1) << 5); R = (st >> 1) * 16 + swz / 64; C = (st & 1) * 32 + (swz % 64) / 2; }
__host__ __device__ __forceinline__ int perm32(int rho) { const int n = rho >> 4, i = rho & 15; return 8 * (i >> 2) + 4 * n + (i & 3); }

struct Unit { int pm, pn; };
struct Gemm { const bf16_t* A; const bf16_t* Bt; int M, N, K; };

struct StaticOrder {
    int nM, nN, nwg, G, c;
    __host__ __device__ void init(int M, int N, int G_, int c_) { nM = M / BM; nN = N / BM; nwg = nM * nN; G = G_; c = c_; }
    __host__ __device__ bool next(int i, Unit& u) const {
        const long L = (long)i * G + c; if (L >= nwg) return false;
        int wgid = (int)L; { const int q = nwg / NXCD, r = nwg % NXCD, xcd = wgid % NXCD, off = wgid / NXCD; wgid = (xcd < r ? xcd * (q + 1) : r * (q + 1) + (xcd - r) * q) + off; }
        const int nig = WGM * nN, gid = wgid / nig, fm = gid * WGM, gsz = (nM - fm) < WGM ? (nM - fm) : WGM;
        u.pm = fm + ((wgid % nig) % gsz); u.pn = (wgid % nig) / gsz; return true;
    }
    __device__ __forceinline__ void a_ready(const Unit&) const {}
    __device__ __forceinline__ void done(const Unit&) const {}
};

__device__ __forceinline__ unsigned cvt_pk_bf16(float lo, float hi) { unsigned r; asm volatile("v_cvt_pk_bf16_f32 %0, %1, %2" : "=v"(r) : "v"(lo), "v"(hi)); return r; }

struct EpiU {
    static constexpr bool PERM = true, AFTER_DRAIN = false;
    bf16_t* U; const float* qg; const float* kg; int ldc;
    __device__ __forceinline__ void operator()(const f32x4 (&acc)[2][2][4][2], const Unit& u, int wr, int wc, int fr, int fq) const {
        const int row0 = u.pm * BM + wr * 64 + fr;
        if (u.pn < 4) {
            const float* gp = (u.pn < 2 ? qg : kg) + 8 * fq; const float mult = u.pn < 2 ? (0.125f * 1.4426950408889634f) : 1.f;
            f32x4 gv[2][2];
#pragma unroll
            for (int bj = 0; bj < 2; ++bj)
#pragma unroll
                for (int n = 0; n < 2; ++n) gv[bj][n] = *(const f32x4*)(gp + 32 * bj + 4 * n);
            const int col0 = u.pn * BM + 64 * wc + 8 * fq;
#pragma unroll
            for (int ai = 0; ai < 2; ++ai)
#pragma unroll
                for (int m = 0; m < 4; ++m) {
                    float s = 0.f;
#pragma unroll
                    for (int bj = 0; bj < 2; ++bj)
#pragma unroll
                        for (int n = 0; n < 2; ++n) { const f32x4 x = acc[ai][bj][m][n]; s += (x[0] * x[0] + x[1] * x[1]) + (x[2] * x[2] + x[3] * x[3]); }
                    s += __shfl_xor(s, 16); s += __shfl_xor(s, 32);
                    const float sc = rsqrtf(s * (1.f / 64.f) + 1e-6f) * mult;
                    bf16_t* rowp = U + (size_t)(row0 + ai * HALF + m * 16) * ldc + col0;
#pragma unroll
                    for (int bj = 0; bj < 2; ++bj) { const f32x4 v0 = acc[ai][bj][m][0] * sc * gv[bj][0], v1 = acc[ai][bj][m][1] * sc * gv[bj][1];
                        u32x4 w; w.x = cvt_pk_bf16(v0[0], v0[1]); w.y = cvt_pk_bf16(v0[2], v0[3]); w.z = cvt_pk_bf16(v1[0], v1[1]); w.w = cvt_pk_bf16(v1[2], v1[3]);
                        *(u32x4*)(rowp + bj * 32) = w; }
                }
        } else {
            const int col0 = u.pn * BM + wc * 32 + 8 * fq;
#pragma unroll
            for (int ai = 0; ai < 2; ++ai)
#pragma unroll
                for (int m = 0; m < 4; ++m) { bf16_t* rowp = U + (size_t)(row0 + ai * HALF + m * 16) * ldc + col0;
#pragma unroll
                    for (int bj = 0; bj < 2; ++bj) { const f32x4 v0 = acc[ai][bj][m][0], v1 = acc[ai][bj][m][1];
                        u32x4 w; w.x = cvt_pk_bf16(v0[0], v0[1]); w.y = cvt_pk_bf16(v0[2], v0[3]); w.z = cvt_pk_bf16(v1[0], v1[1]); w.w = cvt_pk_bf16(v1[2], v1[3]);
                        *(u32x4*)(rowp + bj * HALF) = w; } }
        }
    }
};
struct EpiB16 {
    static constexpr bool PERM = true, AFTER_DRAIN = false;
    bf16_t* C; int ldc;
    __device__ __forceinline__ void operator()(const f32x4 (&acc)[2][2][4][2], const Unit& u, int wr, int wc, int fr, int fq) const {
        const int row0 = u.pm * BM + wr * 64 + fr, col0 = u.pn * BM + wc * 32 + 8 * fq;
#pragma unroll
        for (int ai = 0; ai < 2; ++ai)
#pragma unroll
            for (int m = 0; m < 4; ++m) { bf16_t* rowp = C + (size_t)(row0 + ai * HALF + m * 16) * ldc + col0;
#pragma unroll
                for (int bj = 0; bj < 2; ++bj) { const f32x4 v0 = acc[ai][bj][m][0], v1 = acc[ai][bj][m][1];
                    u32x4 w; w.x = cvt_pk_bf16(v0[0], v0[1]); w.y = cvt_pk_bf16(v0[2], v0[3]); w.z = cvt_pk_bf16(v1[0], v1[1]); w.w = cvt_pk_bf16(v1[2], v1[3]);
                    *(u32x4*)(rowp + bj * HALF) = w; } }
    }
};
struct EpiF32 {
    static constexpr bool PERM = false, AFTER_DRAIN = false;
    float* C; int ldc;
    __device__ __forceinline__ void operator()(const f32x4 (&acc)[2][2][4][2], const Unit& u, int wr, int wc, int fr, int fq) const {
        const int row0 = u.pm * BM + wr * 64 + fr, col0 = u.pn * BM + wc * 32 + 4 * fq;
#pragma unroll
        for (int ai = 0; ai < 2; ++ai)
#pragma unroll
            for (int m = 0; m < 4; ++m) { float* rowp = C + (size_t)(row0 + ai * HALF + m * 16) * ldc + col0;
#pragma unroll
                for (int bj = 0; bj < 2; ++bj)
#pragma unroll
                    for (int n = 0; n < 2; ++n) *(f32x4*)(rowp + bj * HALF + n * 16) = acc[ai][bj][m][n]; }
    }
};

template <class Epi, class Sched, bool ALIGN_EPI = false, bool SP2 = false>
__device__ __forceinline__ void gemm_phase(PG8_LAS unsigned char* lds, const Gemm g, const Sched& S, const Epi& E) {
    int tid_ = threadIdx.x; asm volatile("" : "+v"(tid_));
    const int tid = tid_, wid = __builtin_amdgcn_readfirstlane(tid >> 6), lane = tid & 63, wr = wid >> 2, wc = wid & 3, fr = lane & 15, fq = lane >> 4;
    const int K = g.K, nt = K / BK;
    unsigned voffA[2], voffB[2];
#pragma unroll
    for (int i = 0; i < 2; ++i) { int R, C; stage_rc(tid * 16 + i * 8192, R, C); const int Rb = Epi::PERM ? ((R & ~31) + perm32(R & 31)) : R;
        voffA[i] = (unsigned)(R * K + C) * 2u; voffB[i] = (unsigned)(Rb * K + C) * 2u; }
    const size_t kstep = (size_t)(BK * 2);
    const size_t hstep = (size_t)HALF * K * 2;
    const size_t tstep = 2 * hstep;
    const unsigned ldsw = (unsigned)wid * 1024u;
    const int aoff = lds_byte(wr * 64 + fr, fq * 8), boff = lds_byte(wc * 32 + fr, fq * 8);
#define PG8_SA(b, h) (((b) * 2 + (h)) * HTB)
#define PG8_SB(b, h) ((4 + (b) * 2 + (h)) * HTB)
#define PG8_STAGE(bufoff, gbase, voff) do { _Pragma("unroll") for (int _i = 0; _i < 2; ++_i) \
        __builtin_amdgcn_global_load_lds((const unsigned*)((const char*)(gbase) + (voff)[_i]), (PG8_LAS unsigned*)(lds + (bufoff) + ldsw + _i * 8192), 16, 0, 0); } while (0)
#define PG8_LDA(dst, b, h) do { _Pragma("unroll") for (int m = 0; m < 4; ++m) _Pragma("unroll") for (int k = 0; k < 2; ++k) dst[m][k] = *(const PG8_LAS bf16x8*)(lds + PG8_SA(b, h) + aoff + m * 2048 + k * 1024); } while (0)
#define PG8_LDB(dst, b, h) do { _Pragma("unroll") for (int n = 0; n < 2; ++n) _Pragma("unroll") for (int k = 0; k < 2; ++k) dst[n][k] = *(const PG8_LAS bf16x8*)(lds + PG8_SB(b, h) + boff + n * 2048 + k * 1024); } while (0)
#define PG8_MMA(ai, bj, At, Bt) do { __builtin_amdgcn_s_setprio(1); _Pragma("unroll") for (int m = 0; m < 4; ++m) _Pragma("unroll") for (int n = 0; n < 2; ++n) _Pragma("unroll") for (int k = 0; k < 2; ++k) \
        acc[ai][bj][m][n] = __builtin_amdgcn_mfma_f32_16x16x32_bf16(Bt[n][k], At[m][k], acc[ai][bj][m][n], 0, 0, 0); __builtin_amdgcn_s_setprio(0); } while (0)
#define PG8_WAIT_V(n) asm volatile("s_waitcnt vmcnt(" #n ")" ::: "memory")
#define PG8_WAIT_L(n) asm volatile("s_waitcnt lgkmcnt(" #n ")" ::: "memory")
#define PG8_BAR __builtin_amdgcn_s_barrier()
#define PG8_SCHED __builtin_amdgcn_sched_barrier(0)
    Unit cur, nxt; int ui = 0;
    if (!S.next(0, cur)) return;
    f32x4 acc[2][2][4][2];
#pragma unroll
    for (int a = 0; a < 2; ++a)
#pragma unroll
        for (int b = 0; b < 2; ++b)
#pragma unroll
            for (int m = 0; m < 4; ++m)
#pragma unroll
                for (int n = 0; n < 2; ++n) acc[a][b][m][n] = (f32x4){0.f, 0.f, 0.f, 0.f};
    bf16x8 At[4][2], B0[2][2], B1[2][2];
    const char* cA = (const char*)g.A + (size_t)cur.pm * tstep; const char* cB = (const char*)g.Bt + (size_t)cur.pn * tstep;
    S.a_ready(cur);
    if constexpr (SP2) {
        PG8_STAGE(PG8_SB(0, 0), cB, voffB); PG8_STAGE(PG8_SB(0, 1), cB + hstep, voffB); PG8_STAGE(PG8_SA(0, 0), cA, voffA); PG8_STAGE(PG8_SA(0, 1), cA + hstep, voffA);
        if (wr == 1) PG8_BAR;
        PG8_WAIT_V(2); PG8_BAR;
        PG8_STAGE(PG8_SB(1, 0), cB + kstep, voffB); PG8_STAGE(PG8_SA(1, 0), cA + kstep, voffA); PG8_STAGE(PG8_SB(1, 1), cB + hstep + kstep, voffB);
        PG8_WAIT_V(6); PG8_BAR;
    } else {
        PG8_STAGE(PG8_SB(0, 0), cB, voffB); PG8_STAGE(PG8_SA(0, 0), cA, voffA); PG8_STAGE(PG8_SB(0, 1), cB + hstep, voffB); PG8_STAGE(PG8_SA(0, 1), cA + hstep, voffA);
        if (wr == 1) PG8_BAR;
        PG8_WAIT_V(4); PG8_BAR;
        PG8_STAGE(PG8_SB(1, 0), cB + kstep, voffB); PG8_STAGE(PG8_SA(1, 0), cA + kstep, voffA); PG8_STAGE(PG8_SB(1, 1), cB + hstep + kstep, voffB);
        PG8_WAIT_V(6); PG8_BAR;
    }
    for (;;) {
        const bool has_next = S.next(ui + 1, nxt);
        const char* nA = has_next ? (const char*)g.A + (size_t)nxt.pm * tstep : cA; const char* nB = has_next ? (const char*)g.Bt + (size_t)nxt.pn * tstep : cB;
        for (int t = 0; t < nt; t += 2) {
            const bool last = (t == nt - 2);
            const char* a1 = cA + (size_t)(t + 1) * kstep;
            const char* a2 = last ? nA : cA + (size_t)(t + 2) * kstep; const char* b2 = last ? nB : cB + (size_t)(t + 2) * kstep;
            const char* a3 = a2 + kstep; const char* b3 = b2 + kstep;
            if (last && has_next) S.a_ready(nxt);
            if constexpr (SP2) {
            PG8_LDB(B0, 0, 0); PG8_LDB(B1, 0, 1); PG8_SCHED; PG8_LDA(At, 0, 0); PG8_STAGE(PG8_SA(1, 1), a1 + hstep, voffA);
            PG8_WAIT_V(8); PG8_WAIT_L(0); PG8_BAR; PG8_MMA(0, 0, At, B0); PG8_MMA(0, 1, At, B1); PG8_BAR; PG8_SCHED;
            PG8_LDA(At, 0, 1); PG8_STAGE(PG8_SB(0, 0), b2, voffB); PG8_STAGE(PG8_SB(0, 1), b2 + hstep, voffB); PG8_STAGE(PG8_SA(0, 0), a2, voffA);
            PG8_WAIT_V(8); PG8_WAIT_L(0); PG8_BAR; PG8_MMA(1, 0, At, B0); PG8_MMA(1, 1, At, B1); PG8_BAR; PG8_SCHED;
            PG8_LDB(B0, 1, 0); PG8_LDB(B1, 1, 1); PG8_SCHED; PG8_LDA(At, 1, 0); PG8_STAGE(PG8_SA(0, 1), a2 + hstep, voffA);
            PG8_WAIT_V(8); PG8_WAIT_L(0); PG8_BAR; PG8_MMA(0, 0, At, B0); PG8_MMA(0, 1, At, B1); PG8_BAR; PG8_SCHED;
            PG8_LDA(At, 1, 1); PG8_STAGE(PG8_SB(1, 0), b3, voffB); PG8_STAGE(PG8_SB(1, 1), b3 + hstep, voffB); PG8_STAGE(PG8_SA(1, 0), a3, voffA);
            PG8_WAIT_V(8); PG8_WAIT_L(0); PG8_BAR; PG8_MMA(1, 0, At, B0); PG8_MMA(1, 1, At, B1); PG8_BAR; PG8_SCHED;
            } else {
            PG8_LDB(B0, 0, 0); PG8_SCHED; PG8_LDA(At, 0, 0); PG8_STAGE(PG8_SA(1, 1), a1 + hstep, voffA);
            PG8_WAIT_L(8); PG8_BAR; PG8_WAIT_L(0); PG8_MMA(0, 0, At, B0); PG8_BAR; PG8_SCHED;
            PG8_LDB(B1, 0, 1); PG8_STAGE(PG8_SB(0, 0), b2, voffB);
            PG8_BAR; PG8_WAIT_L(0); PG8_MMA(0, 1, At, B1); PG8_BAR;
            PG8_LDA(At, 0, 1); PG8_STAGE(PG8_SA(0, 0), a2, voffA);
            PG8_BAR; PG8_WAIT_L(0); PG8_MMA(1, 0, At, B0); PG8_BAR; PG8_SCHED;
            PG8_STAGE(PG8_SB(0, 1), b2 + hstep, voffB);
            PG8_WAIT_V(6); PG8_BAR; PG8_MMA(1, 1, At, B1); PG8_BAR;
            PG8_LDB(B0, 1, 0); PG8_SCHED; PG8_LDA(At, 1, 0); PG8_STAGE(PG8_SA(0, 1), a2 + hstep, voffA);
            PG8_WAIT_L(8); PG8_BAR; PG8_WAIT_L(0); PG8_MMA(0, 0, At, B0); PG8_BAR; PG8_SCHED;
            PG8_LDB(B1, 1, 1); PG8_STAGE(PG8_SB(1, 0), b3, voffB);
            PG8_BAR; PG8_WAIT_L(0); PG8_MMA(0, 1, At, B1); PG8_BAR;
            PG8_LDA(At, 1, 1); PG8_STAGE(PG8_SA(1, 0), a3, voffA);
            PG8_BAR; PG8_WAIT_L(0); PG8_MMA(1, 0, At, B0); PG8_BAR; PG8_SCHED;
            PG8_STAGE(PG8_SB(1, 1), b3 + hstep, voffB);
            PG8_WAIT_V(6); PG8_BAR; PG8_MMA(1, 1, At, B1); PG8_BAR;
            }
        }
        if constexpr (ALIGN_EPI) { if (wr == 0) PG8_BAR; }
        if constexpr (!Epi::AFTER_DRAIN) { E(acc, cur, wr, wc, fr, fq); S.done(cur); }
        if (!has_next) break;
#pragma unroll
        for (int a = 0; a < 2; ++a)
#pragma unroll
            for (int b = 0; b < 2; ++b)
#pragma unroll
                for (int m = 0; m < 4; ++m)
#pragma unroll
                    for (int n = 0; n < 2; ++n) acc[a][b][m][n] = (f32x4){0.f, 0.f, 0.f, 0.f};
        cur = nxt; cA = nA; cB = nB; ++ui;
        if constexpr (ALIGN_EPI) { if (wr == 1) PG8_BAR; }
    }
    PG8_WAIT_V(0);
    if constexpr (!ALIGN_EPI) { if (wr == 0) PG8_BAR; }
    PG8_BAR;
    if constexpr (Epi::AFTER_DRAIN) { E.fused(acc, cur, wr, wc, fr, fq, lds, wid, lane); S.done(cur); }
#undef PG8_SA
#undef PG8_SB
#undef PG8_STAGE
#undef PG8_LDA
#undef PG8_LDB
#undef PG8_MMA
#undef PG8_WAIT_V
#undef PG8_WAIT_L
#undef PG8_BAR
#undef PG8_SCHED
}
}

#include <hip/hip_bf16.h>
#include <cmath>
namespace attn_body {
using bf16=__hip_bfloat16;
using bf16x8=__attribute__((ext_vector_type(8)))short;
using s16x4=__attribute__((ext_vector_type(4)))short;
using f32x16=__attribute__((ext_vector_type(16)))float;
using u32x4=__attribute__((ext_vector_type(4)))unsigned;
constexpr int BATCH=8,NHEAD=8,SEQ=4096,D=64,DM=3840,OPITCH=1024;
constexpr int NW=8,QBLK=32,QB=QBLK*NW,KVBLK=64,NQB=SEQ/QB;
constexpr int ATTN_PITCH=DM, ATTN_UNIT_ROWS=QB;
__device__ __forceinline__ int crow(int r,int hi){return (r&3)+8*(r>>2)+4*hi;}
#define SBAR() __builtin_amdgcn_sched_barrier(0)
__device__ __forceinline__ void cmask(f32x16&p0,f32x16&p1,int jb,int qrel,int hi){
  const float NEG=-INFINITY; int kb=64*jb+4*hi;
  #pragma unroll
  for(int r=0;r<16;++r){int kv=kb+(r&3)+8*(r>>2); if(kv>qrel)p0[r]=NEG; if(kv+32>qrel)p1[r]=NEG;}
}

constexpr int NSLOT=3, SLOTB=8192;
constexpr int LDS_K=0, LDS_V=NSLOT*SLOTB, LDS_WS=2*NSLOT*SLOTB, LDS_OST=LDS_WS+NW*64*4, LDS_CB=LDS_OST+NW*4096, LDS_BYTES=LDS_CB+SEQ*4+1024;
constexpr float C2=0.125f*1.4426950408889634f;
__device__ __forceinline__ void glds16(const void*gsrc,unsigned lds_dst){unsigned keep;
  asm volatile("s_mov_b32 %0, m0\n\ts_mov_b32 m0, %2\n\ts_nop 0\n\tglobal_load_lds_dwordx4 %1, off\n\ts_mov_b32 m0, %0":"=&s"(keep):"v"(gsrc),"s"(lds_dst):"memory");}
__device__ __forceinline__ float max3f(float a,float b,float c){float r;asm("v_max3_f32 %0, %1, %2, %3":"=v"(r):"v"(a),"v"(b),"v"(c));return r;}
__device__ __forceinline__ float max2f(float a,float b){float r;asm("v_max_f32_e32 %0, %1, %2":"=v"(r):"v"(a),"v"(b));return r;}
__device__ __forceinline__ float fadd_s(float a,float b){float r;asm("v_add_f32_e32 %0, %1, %2":"=v"(r):"v"(a),"v"(b));return r;}
__device__ __forceinline__ float fsub_s(float a,float b){float r;asm("v_sub_f32_e32 %0, %1, %2":"=v"(r):"v"(a),"v"(b));return r;}
typedef float f32x4v __attribute__((ext_vector_type(4))); typedef float f32x2_t __attribute__((ext_vector_type(2))); typedef __bf16 bf16x2_t __attribute__((ext_vector_type(2)));
__device__ __forceinline__ unsigned cvtpk_s(float lo,float hi){f32x2_t v={lo,hi};bf16x2_t b=__builtin_convertvector(v,bf16x2_t);return __builtin_bit_cast(unsigned,b);}
#define WAIT_BAR(N) asm volatile("s_waitcnt vmcnt(" #N ") lgkmcnt(0)\n\ts_barrier":::"memory")

__device__ __forceinline__ void qkt(f32x16&p0,f32x16&p1,const char*Kslot,const bf16x8*qr,int r32,int hi){
  const char*kb=Kslot+hi*1024+r32*16;
  #pragma unroll
  for(int d0=0;d0<4;++d0){
    const bf16x8 b0=*reinterpret_cast<const bf16x8*>(kb+d0*2048);
    const bf16x8 b1=*reinterpret_cast<const bf16x8*>(kb+d0*2048+512);
    p0=__builtin_amdgcn_mfma_f32_32x32x16_bf16(b0,qr[d0],p0,0,0,0);p1=__builtin_amdgcn_mfma_f32_32x32x16_bf16(b1,qr[d0],p1,0,0,0);}
}
typedef __attribute__((address_space(3))) const char* lds_cptr;
typedef short v4i16_t __attribute__((ext_vector_type(4)));
__device__ __forceinline__ void kload8(bf16x8*kf,lds_cptr kp){
  kf[0]=*(const __attribute__((address_space(3))) bf16x8*)(kp);      kf[1]=*(const __attribute__((address_space(3))) bf16x8*)(kp+512);
  kf[2]=*(const __attribute__((address_space(3))) bf16x8*)(kp+2048); kf[3]=*(const __attribute__((address_space(3))) bf16x8*)(kp+2560);
  kf[4]=*(const __attribute__((address_space(3))) bf16x8*)(kp+4096); kf[5]=*(const __attribute__((address_space(3))) bf16x8*)(kp+4608);
  kf[6]=*(const __attribute__((address_space(3))) bf16x8*)(kp+6144); kf[7]=*(const __attribute__((address_space(3))) bf16x8*)(kp+6656);
}
__device__ __forceinline__ void kload2(bf16x8*kf,lds_cptr kp,int j){ kf[2*j]=*(const __attribute__((address_space(3))) bf16x8*)(kp+j*2048); kf[2*j+1]=*(const __attribute__((address_space(3))) bf16x8*)(kp+j*2048+512); }
__device__ __forceinline__ s16x4 vtr(lds_cptr p){ return __builtin_bit_cast(s16x4,__builtin_amdgcn_ds_read_tr16_b64_v4i16((__attribute__((address_space(3))) v4i16_t*)p)); }
__device__ __forceinline__ float rowmax(const f32x16&p0,const f32x16&p1){
  float a=max3f(p0[0],p0[1],p1[0]),b=max3f(p0[2],p0[3],p1[1]);a=max3f(a,p1[2],p1[3]);
  #pragma unroll
  for(int r=4;r<16;r+=4){a=max3f(a,p0[r],p0[r+1]);b=max3f(b,p0[r+2],p0[r+3]);a=max3f(a,p1[r],p1[r+1]);b=max3f(b,p1[r+2],p1[r+3]);}
  const float m=max2f(a,b);
  auto rr=__builtin_amdgcn_permlane32_swap(__float_as_uint(m),__float_as_uint(m),false,false);
  return max2f(__uint_as_float(rr[0]),__uint_as_float(rr[1]));
}
__device__ __forceinline__ void pv(f32x16*o,int vb,bf16x8 pa0,bf16x8 pa1,bf16x8 pa2,bf16x8 pa3){
  #pragma unroll
  for(int d0=0;d0<2;++d0){s16x4 lo[4],hi[4];
    #pragma unroll
    for(int ks=0;ks<4;++ks){
      asm volatile("ds_read_b64_tr_b16 %0,%1 offset:%c2":"=&v"(lo[ks]):"v"(vb),"i"(d0*4096+ks*1024):"memory");
      asm volatile("ds_read_b64_tr_b16 %0,%1 offset:%c2":"=&v"(hi[ks]):"v"(vb),"i"(d0*4096+ks*1024+512):"memory");}
    asm volatile("s_waitcnt lgkmcnt(0)":::"memory");SBAR();
    #define PK(k) (bf16x8){lo[k][0],lo[k][1],lo[k][2],lo[k][3],hi[k][0],hi[k][1],hi[k][2],hi[k][3]}
    o[d0]=__builtin_amdgcn_mfma_f32_32x32x16_bf16(pa0,PK(0),o[d0],0,0,0);
    o[d0]=__builtin_amdgcn_mfma_f32_32x32x16_bf16(pa1,PK(1),o[d0],0,0,0);
    o[d0]=__builtin_amdgcn_mfma_f32_32x32x16_bf16(pa2,PK(2),o[d0],0,0,0);
    o[d0]=__builtin_amdgcn_mfma_f32_32x32x16_bf16(pa3,PK(3),o[d0],0,0,0);
    #undef PK
  }
}

#ifndef ATTN_STORE16
#define ATTN_STORE16(p,v) (*(u32x4*)(p)=(v))
#endif
template<int THRL> __device__ __forceinline__ void attn_unit(int b,int h,int qb,const bf16*Q,const bf16*__restrict__ K,const bf16*__restrict__ V,const bf16*Gt,const float*CBg,const int*TSg,bf16*O,char*shm){
  int tid_=threadIdx.x; asm volatile("":"+v"(tid_)); const int tid=tid_,lane=tid&63,r32=lane&31,hi=lane>>5; const int wid=__builtin_amdgcn_readfirstlane(tid>>6);
  const long rowbase=(long)b*SEQ; const int q0=qb*QB;
  const bf16*Qw=Q+(rowbase+q0+wid*QBLK)*DM+h*D;
  const int ts=__builtin_amdgcn_readfirstlane(TSg[(b*NHEAD+h)*NQB+qb]);
  const bf16*Kh=K+(rowbase+(long)ts*KVBLK)*DM+h*D,*Vh=V+(rowbase+(long)ts*KVBLK)*DM+h*D;
  const unsigned lds0=(unsigned)(uintptr_t)shm;
  float*wsf=(float*)(shm+LDS_WS)+wid*64;
  const bf16*ksrc=Kh+(long)lane*DM+wid*8;
  const bf16*vsrc=Vh+(long)(16*(wid&3)+(lane>>2))*DM+(wid>>2)*32+(lane&3)*8;
  const unsigned kdst=lds0+LDS_K+wid*1024, vdst=lds0+LDS_V+wid*1024;
  #define DMA_K(t,slot) glds16(ksrc+(long)(t)*KVBLK*DM,(unsigned)__builtin_amdgcn_readfirstlane(kdst+(slot)))
  #define DMA_V(t,slot) glds16(vsrc+(long)(t)*KVBLK*DM,(unsigned)__builtin_amdgcn_readfirstlane(vdst+(slot)))
  const int vb0=(int)(lds0+LDS_V)+((lane>>4)&1)*32+(lane&3)*8+(4*hi+((lane&15)>>2))*64;
  const char*Kbase=shm+LDS_K; bf16x8 kf[8];
  const lds_cptr shm3=(lds_cptr)shm; const lds_cptr kp0=shm3+LDS_K+hi*1024+r32*16; const lds_cptr vp0=shm3+LDS_V+((lane>>4)&1)*32+(lane&3)*8+(4*hi+((lane&15)>>2))*64;
  const int NT=(q0+QB)/KVBLK-ts;
  { const float*cbsrc=CBg+((long)b*NHEAD+h)*SEQ; float*cbl=(float*)(shm+LDS_CB);
    #pragma unroll
    for(int i=0;i<2;++i){ const int e=(i*512+tid)*4; if(e<q0+QB){ const f32x4v v=*reinterpret_cast<const f32x4v*>(cbsrc+e); *reinterpret_cast<f32x4v*>(cbl+e)=v; } } }
  DMA_K(0,0);DMA_V(0,0);DMA_K(1,SLOTB);
  bf16x8 qr[4];
  #pragma unroll
  for(int d0=0;d0<4;++d0)qr[d0]=*reinterpret_cast<const bf16x8*>(&Qw[(long)r32*DM+d0*16+hi*8]);
  float mhat=0.f,l_reg=0.f;f32x16 o[2];o[0]=f32x16{};o[1]=f32x16{};
  const int qrel=wid*QBLK+r32;
  #define CMASK(P0,P1,t) do{int jb_=(t)-(NT-4); if(jb_>=0)cmask(P0,P1,jb_,qrel,hi);}while(0)
  bool resc=false; f32x16 pA0,pA1,pB0,pB1;
  #define START(P0,P1) do{ const float rm=rowmax(P0,P1); resc=false; \
    { const float dl=__builtin_fmaxf(rm,-16.f); mhat=fadd_s(mhat,dl); mh2=cbq+mhat; \
      _Pragma("unroll") for(int r=0;r<16;++r){P0[r]=fsub_s(P0[r],dl);P1[r]=fsub_s(P1[r],dl);} } \
    _Pragma("unroll") for(int r=0;r<16;++r)P0[r]=__builtin_amdgcn_exp2f(P0[r]); }while(0)
  #define RESC() do{ if(resc){ asm volatile("s_waitcnt lgkmcnt(0)":::"memory"); \
      _Pragma("unroll") for(int d_=0;d_<2;++d_) _Pragma("unroll") for(int r=0;r<16;++r)o[d_][r]*=wsf[crow(r,hi)]; } }while(0)
  int sl_prev=0,sl_cur=0,sl_next=SLOTB;
  #define ROT() do{sl_prev=sl_cur;sl_cur=sl_next;sl_next=(sl_next==(NSLOT-1)*SLOTB)?0:sl_next+SLOTB;}while(0)
  DMA_K(2,2*SLOTB);
  WAIT_BAR(3);
  const lds_cptr cbp=(lds_cptr)shm+LDS_CB+hi*16+ts*256;
  const float cbq=*(const __attribute__((address_space(3))) float*)((lds_cptr)shm+LDS_CB+4*(q0+wid*QBLK+r32));
  float mh2=cbq;
  #define CBINIT(P0,P1,t) do{ _Pragma("unroll") for(int g_=0;g_<4;++g_){ \
      const f32x4v c0_=*(const __attribute__((address_space(3))) f32x4v*)(cbp+(t)*256+g_*32), c1_=*(const __attribute__((address_space(3))) f32x4v*)(cbp+(t)*256+g_*32+128); \
      _Pragma("unroll") for(int i_=0;i_<4;++i_){P0[4*g_+i_]=c0_[i_]-mh2;P1[4*g_+i_]=c1_[i_]-mh2;} } }while(0)
  CBINIT(pA0,pA1,0);
  qkt(pA0,pA1,Kbase,qr,r32,hi);asm volatile("s_nop 15\n\ts_nop 7":"+v"(pA0),"+v"(pA1));CMASK(pA0,pA1,0);
  START(pA0,pA1);
  _Pragma("unroll") for(int r=0;r<16;++r)pA1[r]=__builtin_amdgcn_exp2f(pA1[r]);
  CBINIT(pB0,pB1,1);
  WAIT_BAR(0);
  DMA_K(3,0);DMA_V(1,SLOTB);
  ROT();
  kload8(kf,kp0+sl_cur);
  WAIT_BAR(2);
  s16x4 vlo[8],vhi[8]; u32x4 pw0,pw1,pw2,pw3;
  #define PKW(P,B) cvtpk_s(P[B],P[B+1])
  #define PAF(k) __builtin_bit_cast(bf16x8,pw##k)
  #define VFR(i) (bf16x8){vlo[i][0],vlo[i][1],vlo[i][2],vlo[i][3],vhi[i][0],vhi[i][1],vhi[i][2],vhi[i][3]}
  #define PIN(x) asm volatile("":"+v"(x))
  #define MX3(a,b,c) __builtin_fmaxf(__builtin_fmaxf((a),(b)),(c))
  #define GAPA(MF,A0,A1,A2,A3,W0,W1,PW) do{ MF; sacc+=A0; sacc+=A1; sacc+=A2; sacc+=A3; PIN(sacc); W0; W1; PIN(PW); SBAR(); }while(0)
  #define EX(v) __builtin_amdgcn_exp2f(v)
  #define GAPB(MF,X,B,PN,CBO) do{ MF; X[B]=EX(X[B]); X[B+1]=EX(X[B+1]); X[B+2]=EX(X[B+2]); X[B+3]=EX(X[B+3]); PIN(X); \
    { const f32x4v c_=*(const __attribute__((address_space(3))) f32x4v*)(cbn_+(CBO)); PN[B]=c_[0]-mh2; PN[B+1]=c_[1]-mh2; PN[B+2]=c_[2]-mh2; PN[B+3]=c_[3]-mh2; PIN(PN); } SBAR(); }while(0)
  #define VRD(i) do{ vlo[i]=vtr(vp_+(((i)>>2)*4096+((i)&3)*1024)); vhi[i]=vtr(vp_+(((i)>>2)*4096+((i)&3)*1024+512)); }while(0)
  #define KRD(G,j) do{ if(G){ kload2(kf,kp0+sl_next,j); SBAR(); } }while(0)
  #define STEP(C0,C1,P0,P1,t,GK,GV,GL) do{ SBAR(); \
    const lds_cptr vp_=vp0+sl_prev; \
    VRD(0); SBAR(); float sacc=(P0[0]+P0[1]); \
    GAPA(C0=__builtin_amdgcn_mfma_f32_32x32x16_bf16(kf[0],qr[0],C0,0,0,0), P0[2],P0[3],P0[4],P0[5],     pw0[0]=PKW(P0,0), pw0[1]=PKW(P0,2), pw0); \
    VRD(4); SBAR(); GAPA(C1=__builtin_amdgcn_mfma_f32_32x32x16_bf16(kf[1],qr[0],C1,0,0,0), P0[6],P0[7],P0[8],P0[9],     pw0[2]=PKW(P0,4), pw0[3]=PKW(P0,6), pw0); \
    VRD(1); SBAR(); GAPA(C0=__builtin_amdgcn_mfma_f32_32x32x16_bf16(kf[2],qr[1],C0,0,0,0),   P0[10],P0[11],P0[12],P0[13], pw1[0]=PKW(P0,8), pw1[1]=PKW(P0,10), pw1); \
    VRD(5); SBAR(); GAPA(C1=__builtin_amdgcn_mfma_f32_32x32x16_bf16(kf[3],qr[1],C1,0,0,0),   P0[14],P0[15],P1[0],P1[1],   pw1[2]=PKW(P0,12),pw1[3]=PKW(P0,14), pw1); \
    VRD(2); SBAR(); GAPA(C0=__builtin_amdgcn_mfma_f32_32x32x16_bf16(kf[4],qr[2],C0,0,0,0),   P1[2],P1[3],P1[4],P1[5],     pw2[0]=PKW(P1,0), pw2[1]=PKW(P1,2), pw2); \
    VRD(6); SBAR(); GAPA(C1=__builtin_amdgcn_mfma_f32_32x32x16_bf16(kf[5],qr[2],C1,0,0,0),   P1[6],P1[7],P1[8],P1[9],     pw2[2]=PKW(P1,4), pw2[3]=PKW(P1,6), pw2); \
    VRD(3); SBAR(); GAPA(C0=__builtin_amdgcn_mfma_f32_32x32x16_bf16(kf[6],qr[3],C0,0,0,0),   P1[10],P1[11],P1[12],P1[13], pw3[0]=PKW(P1,8), pw3[1]=PKW(P1,10), pw3); \
    VRD(7); SBAR(); GAPA(C1=__builtin_amdgcn_mfma_f32_32x32x16_bf16(kf[7],qr[3],C1,0,0,0),   P1[14],P1[15],0.f,0.f,       pw3[2]=PKW(P1,12),pw3[3]=PKW(P1,14), pw3); \
    l_reg+=sacc; \
    if(GK){DMA_K((t)+3,sl_cur);} if(GV){DMA_V((t)+1,sl_next);} \
    CMASK(C0,C1,t); \
    { float a=MX3(C0[0],C0[1],C1[0]),b=MX3(C0[2],C0[3],C1[1]); a=MX3(a,C1[2],C1[3]); \
      _Pragma("unroll") for(int r=4;r<16;r+=4){a=MX3(a,C0[r],C0[r+1]);b=MX3(b,C0[r+2],C0[r+3]);a=MX3(a,C1[r],C1[r+1]);b=MX3(b,C1[r+2],C1[r+3]);} \
      float rm=__builtin_fmaxf(a,b); { auto rr=__builtin_amdgcn_permlane32_swap(__float_as_uint(rm),__float_as_uint(rm),false,false); rm=__builtin_fmaxf(__uint_as_float(rr[0]),__uint_as_float(rr[1])); } \
      resc=false; \
      if(__builtin_expect(__any(rm>(float)THRL),0)){ const float dl=__builtin_fmaxf(rm,0.f); mhat+=dl; \
        _Pragma("unroll") for(int r=0;r<16;++r){C0[r]-=dl;C1[r]-=dl;} \
        mh2=cbq+mhat; \
        const float f=__builtin_amdgcn_exp2f(-dl); l_reg*=f; if(hi==0)wsf[r32]=f; resc=true; } } \
    SBAR(); \
    const lds_cptr cbn_=cbp+((t)+1)*256;                      \
    GAPB(o[0]=__builtin_amdgcn_mfma_f32_32x32x16_bf16(PAF(0),VFR(0),o[0],0,0,0), C0,0, P0,0); \
    GAPB(o[1]=__builtin_amdgcn_mfma_f32_32x32x16_bf16(PAF(0),VFR(4),o[1],0,0,0), C0,4, P0,32); \
    KRD(GL,0); GAPB(o[0]=__builtin_amdgcn_mfma_f32_32x32x16_bf16(PAF(1),VFR(1),o[0],0,0,0), C0,8, P0,64); \
    KRD(GL,1); GAPB(o[1]=__builtin_amdgcn_mfma_f32_32x32x16_bf16(PAF(1),VFR(5),o[1],0,0,0), C0,12, P0,96); \
    KRD(GL,2); GAPB(o[0]=__builtin_amdgcn_mfma_f32_32x32x16_bf16(PAF(2),VFR(2),o[0],0,0,0), C1,0, P1,128); \
    KRD(GL,3); GAPB(o[1]=__builtin_amdgcn_mfma_f32_32x32x16_bf16(PAF(2),VFR(6),o[1],0,0,0), C1,4, P1,160); \
    GAPB(o[0]=__builtin_amdgcn_mfma_f32_32x32x16_bf16(PAF(3),VFR(3),o[0],0,0,0), C1,8, P1,192); \
    GAPB(o[1]=__builtin_amdgcn_mfma_f32_32x32x16_bf16(PAF(3),VFR(7),o[1],0,0,0), C1,12, P1,224); \
    }while(0)
  int t=1;
  #undef CMASK
  #define CMASK(P0,P1,t) do{}while(0)
  for(;t+5<NT;t+=2){
    STEP(pB0,pB1,pA0,pA1,t,true,true,true);     WAIT_BAR(2); RESC(); ROT();
    STEP(pA0,pA1,pB0,pB1,t+1,true,true,true);   WAIT_BAR(2); RESC(); ROT();
  }
  #undef CMASK
  #define CMASK(P0,P1,t) do{int jb_=(t)-(NT-4); if(jb_>=0)cmask(P0,P1,jb_,qrel,hi);}while(0)
  #define ENDW(tt) do{ if((tt)+3<NT){WAIT_BAR(2);} else if((tt)+2<NT){WAIT_BAR(1);} else {WAIT_BAR(0);} }while(0)
  for(;t+1<NT;t+=2){
    STEP(pB0,pB1,pA0,pA1,t,(t+3<NT),(t+1<NT),(t+1<NT));       ENDW(t);   RESC(); ROT();
    STEP(pA0,pA1,pB0,pB1,t+1,(t+4<NT),(t+2<NT),(t+2<NT));     ENDW(t+1); RESC(); ROT();
  }
  STEP(pB0,pB1,pA0,pA1,NT-1,false,false,false); RESC();
  { float sacc=pB0[0]+pB0[1]; _Pragma("unroll") for(int r=2;r<16;++r)sacc+=pB0[r]; _Pragma("unroll") for(int r=0;r<16;++r)sacc+=pB1[r]; l_reg+=sacc;
    pw0=(u32x4){PKW(pB0,0),PKW(pB0,2),PKW(pB0,4),PKW(pB0,6)};pw1=(u32x4){PKW(pB0,8),PKW(pB0,10),PKW(pB0,12),PKW(pB0,14)};pw2=(u32x4){PKW(pB1,0),PKW(pB1,2),PKW(pB1,4),PKW(pB1,6)};pw3=(u32x4){PKW(pB1,8),PKW(pB1,10),PKW(pB1,12),PKW(pB1,14)};
    SBAR(); pv(o,vb0+sl_cur,PAF(0),PAF(1),PAF(2),PAF(3)); }
  #undef PKW
  #undef PAF
  #undef VFR
  #undef PIN
  #undef MX3
  #undef GAPA
  #undef GAPB
  #undef EX
  #undef VRD
  #undef KRD
  #undef STEP
  #undef ENDW
  {auto rr=__builtin_amdgcn_permlane32_swap(__float_as_uint(l_reg),__float_as_uint(l_reg),false,false);l_reg=__uint_as_float(rr[0])+__uint_as_float(rr[1]);}
  if(hi==0)wsf[32+r32]=l_reg;asm volatile("s_waitcnt lgkmcnt(0)":::"memory");
  float rli[16];
  #pragma unroll
  for(int r=0;r<16;++r)rli[r]=__builtin_amdgcn_rcpf(wsf[32+crow(r,hi)]);
  bf16*Ow=O+(rowbase+q0+wid*QBLK)*OPITCH+h*D; const bf16*Gw=Gt+(rowbase+q0+wid*QBLK)*DM+h*D;
  { bf16*stg=(bf16*)(shm+LDS_OST)+wid*2048;
    #pragma unroll
    for(int r=0;r<16;++r){const int orow=crow(r,hi);
      #pragma unroll
      for(int d0=0;d0<2;++d0)stg[orow*64+d0*32+r32]=__float2bfloat16(o[d0][r]*rli[r]);}
    asm volatile("s_waitcnt lgkmcnt(0)":::"memory");
    #pragma unroll
    for(int i=0;i<4;++i){const int row=i*8+(lane>>3),ch=lane&7; const u32x4 v=*(const u32x4*)(stg+row*64+ch*8); const u32x4 gq=*(const u32x4*)(Gw+(long)row*DM+ch*8); u32x4 w_;
      #pragma unroll
      for(int k=0;k<4;++k){ const float g0=__builtin_bit_cast(float,gq[k]<<16), g1=__builtin_bit_cast(float,gq[k]&0xffff0000u), x0=__builtin_bit_cast(float,v[k]<<16), x1=__builtin_bit_cast(float,v[k]&0xffff0000u);
        w_[k]=cvtpk_s(x0*g0*__builtin_amdgcn_rcpf(1.f+__builtin_amdgcn_exp2f(-1.4426950408889634f*g0)), x1*g1*__builtin_amdgcn_rcpf(1.f+__builtin_amdgcn_exp2f(-1.4426950408889634f*g1))); }
      ATTN_STORE16(Ow+(long)row*OPITCH+ch*8,w_);} }
  asm volatile("s_waitcnt lgkmcnt(0)\n\ts_barrier":::"memory");
  #undef CBINIT
  #undef DMA_K
  #undef DMA_V
  #undef CMASK
  #undef START
  #undef RESC
  #undef ROT
}
constexpr int ATTN_LDS_BYTES=LDS_BYTES;
struct AttnTensors { const bf16* Q; const bf16* K; const bf16* V; const bf16* G; const float* CB; const int* TS; bf16* O; };
struct AttnUnit { int bh; int qb; };
struct QueueOrder {
  unsigned* ctr; volatile __attribute__((address_space(3))) unsigned* slot;
  __device__ __forceinline__ bool next(int,AttnUnit&u)const{
    if(threadIdx.x==0){ *slot=__hip_atomic_fetch_add(ctr,1u,__ATOMIC_RELAXED,__HIP_MEMORY_SCOPE_AGENT); }
    __syncthreads(); const unsigned t=*slot; __syncthreads();
    if(t>=(unsigned)(BATCH*NHEAD*NQB))return false; u.qb=NQB-1-(int)(t/(BATCH*NHEAD)); u.bh=(int)(t%(BATCH*NHEAD)); return true; }
  __device__ __forceinline__ void a_ready(const AttnUnit&)const{}
  __device__ __forceinline__ void done(const AttnUnit&)const{}
};
template<class Sched,int THRL=8> __device__ __forceinline__ void attn_phase(char*lds,const AttnTensors&T,const Sched&S){
  AttnUnit u;
  for(int i=0;S.next(i,u);++i){ S.a_ready(u); attn_unit<THRL>(u.bh/NHEAD,u.bh%NHEAD,u.qb,T.Q,T.K,T.V,T.G,T.CB,T.TS,T.O,lds); S.done(u); }
}
#undef SBAR
#undef WAIT_BAR
}

__device__ __forceinline__ int src_col(int n) {
    if (n < 1024) { const int cp = n & 255; return (n & ~255) + 64 * ((cp >> 5) & 3) + 32 * (cp >> 7) + (cp & 31); }
    if (n < 1536) return n;
    if (n < UP) return n - UR + SR;
    if (n < UG) return -1;
    if (n < UF) return n - UG + SG;
    if (n < UF + 8) return n - UF + SF;
    return -2;
}
__device__ __forceinline__ void phase_weights(const Params& p, unsigned char* lds) {
    float (*tile)[65] = (float (*)[65])lds;
    const int tid = otid();
    constexpr int T_IN = (NU / 64) * (DM / 64), T_OUT = (DM / 64) * (DM / 64), PER_L = T_IN + T_OUT;
    for (int it = blockIdx.x; it < NL * PER_L; it += gridDim.x) {
        const int l = it / PER_L; int r = it % PER_L;
        if (r < T_IN) {
            const int nt = r / (DM / 64), kt = r % (DM / 64), n0 = nt * 64, k0 = kt * 64;
            const float* W = p.w_in + (size_t)l * DM * D_IN;
            for (int e = tid; e < 64 * 64; e += NTHREADS) {
                const int kk = e >> 6, nn = e & 63, n = n0 + nn, sc = src_col(n);
                float v = 0.f;
                if (sc >= 0) v = W[(size_t)(k0 + kk) * D_IN + sc];
                else if (sc == -1) {
                    const int g = (n - UP) >> 6, d = (n - UP) & 63;
                    const float* pw = p.pool_w + ((size_t)l * 4 + g) * 64 * 64;
                    const float* wr = W + (size_t)(k0 + kk) * D_IN + SP + g * 64;
                    float s = 0.f;
                    for (int cc = 0; cc < 64; ++cc) s += wr[cc] * pw[cc * 64 + d];
                    v = s;
                }
                tile[kk][nn] = v;
            }
            __syncthreads();
            bf16_t* WT = (bf16_t*)(p.ws + WS_WT) + (size_t)l * NU * DM;
            for (int e = tid; e < 64 * 32; e += NTHREADS) {
                const int nn = e >> 5, kp = (e & 31) * 2;
                *(unsigned*)(WT + (size_t)(n0 + nn) * DM + k0 + kp) = pk2(tile[kp][nn], tile[kp + 1][nn]);
            }
            __syncthreads();
        } else {
            r -= T_IN;
            const int nt = r / (DM / 64), kt = r % (DM / 64), n0 = nt * 64, k0 = kt * 64;
            const float* W = p.w_out + (size_t)l * DM * DM;
            for (int e = tid; e < 64 * 64; e += NTHREADS) { const int kk = e >> 6, nn = e & 63; tile[kk][nn] = W[(size_t)(k0 + kk) * DM + n0 + nn]; }
            __syncthreads();
            bf16_t* WOT = (bf16_t*)(p.ws + WS_WOT) + (size_t)l * DM * DM;
            for (int e = tid; e < 64 * 32; e += NTHREADS) {
                const int nn = e >> 5, kp = (e & 31) * 2;
                *(unsigned*)(WOT + (size_t)(n0 + nn) * DM + k0 + kp) = pk2(tile[kp][nn], tile[kp + 1][nn]);
            }
            __syncthreads();
        }
    }
}

__device__ __forceinline__ void phase_mod(const Params& p, unsigned char* lds) {
    float (*sc)[DM] = (float (*)[DM])lds;
    float (*red)[NB][64] = (float (*)[NB][64])(lds + 32768);
    const int tid = otid();
    if ((int)blockIdx.x >= NL * 48) return;
    for (int e = tid; e < NB * DM; e += NTHREADS) sc[e / DM][e % DM] = siluf_(p.c[e]);
    __syncthreads();
    float* mod = (float*)(p.ws + WS_MOD);
    const int kg = tid >> 6, cl = tid & 63;
    for (int it = blockIdx.x; it < NL * 48; it += gridDim.x) {
        const int l = it / 48, n = (it % 48) * 64 + cl;
        const float* W = p.ada_w + (size_t)l * DM * 3072 + n;
        float acc[NB];
#pragma unroll
        for (int b = 0; b < NB; ++b) acc[b] = 0.f;
#pragma unroll 8
        for (int k = kg * 128; k < kg * 128 + 128; ++k) {
            const float w = W[(size_t)k * 3072];
#pragma unroll
            for (int b = 0; b < NB; ++b) acc[b] += sc[b][k] * w;
        }
#pragma unroll
        for (int b = 0; b < NB; ++b) red[kg][b][cl] = acc[b];
        __syncthreads();
        {
            const int b = tid >> 6;
            float s = p.ada_b[l * 3072 + n];
#pragma unroll
            for (int g = 0; g < 8; ++g) s += red[g][b][cl];
            mod[((size_t)l * NB + b) * 3072 + n] = s;
        }
        __syncthreads();
    }
}

__device__ __forceinline__ void row_h_store(const f32x4 (&v)[4], float rinv, const float* npre, const float* mod_lb, bf16_t* xnrow, int lane) {
#pragma unroll
    for (int j = 0; j < 4; ++j) {
        const int c = j * 256 + lane * 4;
        const f32x4 g = *(const f32x4*)(npre + c), sh = *(const f32x4*)(mod_lb + c), scl = *(const f32x4*)(mod_lb + 1024 + c);
        f32x4 h;
#pragma unroll
        for (int i = 0; i < 4; ++i) h[i] = v[j][i] * rinv * g[i] * (1.f + scl[i]) + sh[i];
        u32x2 w; w.x = pk2(h[0], h[1]); w.y = pk2(h[2], h[3]);
        *(u32x2*)(xnrow + c) = w;
    }
}
__device__ __forceinline__ void phase_rows(const Params& p, int mode, int l) {
    const int tid = otid(), lane = tid & 63, wv = tid >> 6;
    const int gw = blockIdx.x * 8 + wv, ngw = gridDim.x * 8;
    const float* mod = (const float*)(p.ws + WS_MOD);
    bf16_t* XN = (bf16_t*)(p.ws + WS_XN);
    const bf16_t* Z = (const bf16_t*)(p.ws + WS_Z);
    for (int m = gw; m < MTOK; m += ngw) {
        const int b = m / SEQ;
        f32x4 v[4];
        if (mode == 0) {
#pragma unroll
            for (int j = 0; j < 4; ++j) v[j] = *(const f32x4*)(p.x + (size_t)m * DM + j * 256 + lane * 4);
            float s = 0.f;
#pragma unroll
            for (int j = 0; j < 4; ++j) s += v[j][0] * v[j][0] + v[j][1] * v[j][1] + v[j][2] * v[j][2] + v[j][3] * v[j][3];
            const float rinv = rsqrtf(wave_sum(s) * (1.f / DM) + 1e-6f);
            row_h_store(v, rinv, p.norm_pre, mod + ((size_t)0 * NB + b) * 3072, XN + (size_t)m * DM, lane);
        } else {
            f32x4 z[4];
#pragma unroll
            for (int j = 0; j < 4; ++j) { const u32x2 zw = *(const u32x2*)(Z + (size_t)m * DM + j * 256 + lane * 4); z[j] = (f32x4){bflo(zw.x), bfhi(zw.x), bflo(zw.y), bfhi(zw.y)}; }
            float s = 0.f;
#pragma unroll
            for (int j = 0; j < 4; ++j) s += z[j][0] * z[j][0] + z[j][1] * z[j][1] + z[j][2] * z[j][2] + z[j][3] * z[j][3];
            const float rz = rsqrtf(wave_sum(s) * (1.f / DM) + 1e-6f);
            const float* xold = (l == 0) ? p.x : p.out;
            const float* mod_lb = mod + ((size_t)l * NB + b) * 3072;
            float s2 = 0.f;
#pragma unroll
            for (int j = 0; j < 4; ++j) {
                const int c = j * 256 + lane * 4;
                const f32x4 xo = *(const f32x4*)(xold + (size_t)m * DM + c), gp = *(const f32x4*)(p.norm_post + l * DM + c), gt = *(const f32x4*)(mod_lb + 2048 + c);
#pragma unroll
                for (int i = 0; i < 4; ++i) { v[j][i] = xo[i] + gt[i] * (z[j][i] * rz * gp[i]); s2 += v[j][i] * v[j][i]; }
                *(f32x4*)(p.out + (size_t)m * DM + c) = v[j];
            }
            if (l + 1 < NL) {
                const float rinv = rsqrtf(wave_sum(s2) * (1.f / DM) + 1e-6f);
                row_h_store(v, rinv, p.norm_pre + (l + 1) * DM, mod + ((size_t)(l + 1) * NB + b) * 3072, XN + (size_t)m * DM, lane);
            }
        }
    }
}

template <int MODE>
__device__ __forceinline__ void phase_gemm_simple(unsigned char* lds, const bf16_t* A, const bf16_t* Bt, void* Cout, int M, int N, int K, const float* qg, const float* kg) {
    bf16_t (*As)[40] = (bf16_t (*)[40])lds;
    bf16_t (*Bs)[40] = (bf16_t (*)[40])(lds + 128 * 40 * 2);
    const int tid = otid(), lane = tid & 63, wv = tid >> 6;
    const int ntn = N / 64, ntm = M / 128;
    for (int it = blockIdx.x; it < ntm * ntn; it += gridDim.x) {
        const int tm = it / ntn, tn = it % ntn, m0 = tm * 128, n0 = tn * 64;
        f32x4 acc[4];
#pragma unroll
        for (int n = 0; n < 4; ++n) acc[n] = (f32x4){0.f, 0.f, 0.f, 0.f};
        for (int k0 = 0; k0 < K; k0 += 32) {
            {
                const int r = tid >> 2, ch = tid & 3;
                *(u32x4*)(&As[r][ch * 8]) = *(const u32x4*)(A + (size_t)(m0 + r) * K + k0 + ch * 8);
                if (tid < 256) *(u32x4*)(&Bs[r][ch * 8]) = *(const u32x4*)(Bt + (size_t)(n0 + r) * K + k0 + ch * 8);
            }
            __syncthreads();
            const bf16x8 a = *(const bf16x8*)(&As[wv * 16 + (lane & 15)][(lane >> 4) * 8]);
#pragma unroll
            for (int n = 0; n < 4; ++n) {
                const bf16x8 b = *(const bf16x8*)(&Bs[n * 16 + (lane & 15)][(lane >> 4) * 8]);
                acc[n] = __builtin_amdgcn_mfma_f32_16x16x32_bf16(a, b, acc[n], 0, 0, 0);
            }
            __syncthreads();
        }
        if (MODE == 0) {
            bf16_t* C = (bf16_t*)Cout;
            float scale[4] = {1.f, 1.f, 1.f, 1.f};
            float gain[4] = {1.f, 1.f, 1.f, 1.f};
            if (n0 < 1024) {
#pragma unroll
                for (int r = 0; r < 4; ++r) {
                    float s = acc[0][r] * acc[0][r] + acc[1][r] * acc[1][r] + acc[2][r] * acc[2][r] + acc[3][r] * acc[3][r];
                    s += __shfl_xor(s, 1); s += __shfl_xor(s, 2); s += __shfl_xor(s, 4); s += __shfl_xor(s, 8);
                    scale[r] = rsqrtf(s * (1.f / 64.f) + 1e-6f) * (n0 < 512 ? C2 : 1.f);
                }
#pragma unroll
                for (int n = 0; n < 4; ++n) gain[n] = (n0 < 512 ? qg : kg)[n * 16 + (lane & 15)];
            }
#pragma unroll
            for (int n = 0; n < 4; ++n)
#pragma unroll
                for (int r = 0; r < 4; ++r)
                    C[(size_t)(m0 + wv * 16 + (lane >> 4) * 4 + r) * N + n0 + n * 16 + (lane & 15)] = (bf16_t)f2bf(acc[n][r] * scale[r] * gain[n]);
        } else {
            float* C = (float*)Cout;
#pragma unroll
            for (int n = 0; n < 4; ++n)
#pragma unroll
                for (int r = 0; r < 4; ++r) C[(size_t)(m0 + wv * 16 + (lane >> 4) * 4 + r) * N + n0 + n * 16 + (lane & 15)] = acc[n][r];
        }
    }
}

__device__ __forceinline__ void phase_cum(const Params& p, int l, unsigned char* lds) {
    float (*wtot)[8] = (float (*)[8])lds;
    const int tid = otid(), lane = tid & 63, wv = tid >> 6;
    const bf16_t* U = (const bf16_t*)(p.ws + WS_U);
    float* CB = (float*)(p.ws + WS_CB);
    for (int b = blockIdx.x; b < NB; b += gridDim.x) {
        float pre[8][8];
        float run[8];
#pragma unroll
        for (int h = 0; h < 8; ++h) run[h] = 0.f;
#pragma unroll
        for (int i = 0; i < 8; ++i) {
            const u32x4 w = *(const u32x4*)(U + (size_t)(b * SEQ + tid * 8 + i) * NU + UF);
            float f[8] = {bflo(w.x), bfhi(w.x), bflo(w.y), bfhi(w.y), bflo(w.z), bfhi(w.z), bflo(w.w), bfhi(w.w)};
#pragma unroll
            for (int h = 0; h < 8; ++h) {
                const float xx = f[h] + p.f_bias[l * 8 + h];
                const float ls = fminf(xx, 0.f) - __logf(1.f + __expf(-fabsf(xx)));
                run[h] += -ls * LOG2E;
                pre[i][h] = run[h];
            }
        }
        float exc[8];
#pragma unroll
        for (int h = 0; h < 8; ++h) {
            float v = run[h];
#pragma unroll
            for (int o = 1; o < 64; o <<= 1) { const float t = __shfl_up(v, o); if (lane >= o) v += t; }
            if (lane == 63) wtot[wv][h] = v;
            exc[h] = v - run[h];
        }
        __syncthreads();
#pragma unroll
        for (int h = 0; h < 8; ++h) { float base = 0.f; for (int w2 = 0; w2 < wv; ++w2) base += wtot[w2][h]; exc[h] += base; }
#pragma unroll
        for (int h = 0; h < 8; ++h)
#pragma unroll
            for (int i = 0; i < 8; ++i) CB[((size_t)b * 8 + h) * SEQ + tid * 8 + i] = exc[h] + pre[i][h];
        float* cbe = (float*)(lds + 256);
        float* cbq0 = cbe + 512;
#pragma unroll
        for (int h = 0; h < 8; ++h) { if ((tid & 7) == 7) cbe[h * 64 + (tid >> 3)] = exc[h] + pre[7][h]; if ((tid & 31) == 0) cbq0[h * 16 + (tid >> 5)] = exc[h] + pre[0][h]; }
        __syncthreads();
        {
            float gq = fabsf(p.q_gain[l * 64 + lane]), gk = fabsf(p.k_gain[l * 64 + lane]);
#pragma unroll
            for (int o = 1; o < 64; o <<= 1) { gq = fmaxf(gq, __shfl_xor(gq, o)); gk = fmaxf(gk, __shfl_xor(gk, o)); }
            const float dskip = 2.f * 1.02f * (64.f * C2) * gq * gk + 52.f;
            int* TS = (int*)(p.ws + WS_TS);
            for (int it = wv; it < 8 * 16; it += 8) {
                const int h = it >> 4, qb = it & 15, nt = 4 * qb + 4;
                const bool pr = (lane < nt) && (cbe[h * 64 + lane] < cbq0[h * 16 + qb] - dskip);
                int ts = __popcll(__ballot(pr));
                ts &= ~1; ts = ts < nt - 4 ? ts : nt - 4;
                if (lane == 0) TS[(b * 8 + h) * 16 + qb] = ts;
            }
        }
        __syncthreads();
    }
}

typedef _Float16 h8 __attribute__((ext_vector_type(8)));
typedef _Float16 h4 __attribute__((ext_vector_type(4)));
typedef float f32x2 __attribute__((ext_vector_type(2)));
template <int CTRL> __device__ __forceinline__ float dpp_add(float x) {
    const int y = __builtin_amdgcn_update_dpp(0, __builtin_bit_cast(int, x), CTRL, 0xF, 0xF, true);
    return x + __builtin_bit_cast(float, y);
}
__device__ __forceinline__ float row16_sum(float x) {
    x = dpp_add<0xB1>(x); x = dpp_add<0x4E>(x); x = dpp_add<0x141>(x); x = dpp_add<0x140>(x); return x;
}
__device__ __forceinline__ float wave_sum_fast(float x) {
    x = row16_sum(x);
    { const unsigned xi = __builtin_bit_cast(unsigned, x); auto rr = __builtin_amdgcn_permlane16_swap(xi, xi, false, false); const unsigned r0 = rr[0], r1 = rr[1]; x = __builtin_bit_cast(float, r0) + __builtin_bit_cast(float, r1); }
    { const unsigned xi = __builtin_bit_cast(unsigned, x); auto rr = __builtin_amdgcn_permlane32_swap(xi, xi, false, false); const unsigned r0 = rr[0], r1 = rr[1]; x = __builtin_bit_cast(float, r0) + __builtin_bit_cast(float, r1); }
    return x;
}
__device__ __forceinline__ f32x4 mma_nt16(f32x4 acc, const LAS unsigned char* A, int pa, const LAS unsigned char* Bt, int pb, int K, int lane) {
    const LAS unsigned char* ap = A + (lane & 15) * pa + (lane >> 4) * 16;
    const LAS unsigned char* bp = Bt + (lane & 15) * pb + (lane >> 4) * 16;
#pragma unroll
    for (int k = 0; k < K; k += 32) {
        const bf16x8 a = *(const LAS bf16x8*)(ap + 2 * k), b = *(const LAS bf16x8*)(bp + 2 * k);
        acc = __builtin_amdgcn_mfma_f32_16x16x32_bf16(a, b, acc, 0, 0, 0);
    }
    return acc;
}
template <bool SA, bool SB>
__device__ __forceinline__ f32x4 mma_nt16s(f32x4 acc, const LAS unsigned char* A, int pa, const LAS unsigned char* Bt, int pb, int K, int lane) {
    const int r = lane & 15, q = lane >> 4;
#pragma unroll
    for (int k = 0; k < K; k += 32) {
        const int ck = (k >> 3) + q;
        const bf16x8 a = *(const LAS bf16x8*)(A + r * pa + ((SA ? (ck ^ (r & 7)) : ck) << 4)), b = *(const LAS bf16x8*)(Bt + r * pb + ((SB ? (ck ^ (r & 7)) : ck) << 4));
        acc = __builtin_amdgcn_mfma_f32_16x16x32_bf16(a, b, acc, 0, 0, 0);
    }
    return acc;
}
constexpr int CK_W2T = 0, CK_A2T = 9216, CK_XW = 18432, CK_XA = 23040, CK_SWF = 27648, CK_SAF = 35968, CK_TOT = 44288, CK_EGL = 46336;
constexpr int CK_KT = 46592, CK_RT = 51200, CK_BH = 55808, CK_KH = 60416, CK_RHS = 65024, CK_VT = 81920, CK_BBT = 87040, CK_KBT = 92160, CK_LF = 97280;
constexpr int CK_AAK = 101888, CK_AQB = 104448, CK_AQK = 107008, CK_W1T = 109568, CK_W2N = 114688, CK_OUT = 119808;
constexpr int P72 = 144, P40 = 80, PSF = 65 * 4, PRHS = 132 * 4, PLF = 36 * 4;
__device__ __forceinline__ float fsigmoid(float x) { return __builtin_amdgcn_rcpf(1.f + __expf(-x)); }
__device__ __forceinline__ float ftanh(float x) { return 1.f - 2.f * __builtin_amdgcn_rcpf(1.f + __expf(2.f * x)); }
typedef float f32x2c __attribute__((ext_vector_type(2))); typedef __bf16 bf16x2c __attribute__((ext_vector_type(2)));
__device__ __forceinline__ unsigned cvtpk(float lo, float hi) { const f32x2c v = {lo, hi}; const bf16x2c b = __builtin_convertvector(v, bf16x2c); return __builtin_bit_cast(unsigned, b); }
__device__ __forceinline__ bf16_t cvt1(float x) { return (bf16_t)(cvtpk(x, x) & 0xffffu); }
__device__ __forceinline__ void phase_rwkv_chunk(const Params& p, int l, unsigned char* lds_) {
    LAS unsigned char* lds = (LAS unsigned char*)lds_;
    const int tid = otid(), lane = tid & 63, wv = __builtin_amdgcn_readfirstlane(tid >> 6);
    const int h = (int)blockIdx.x & 3, c = h * 64 + lane;
    const bf16_t* U = (const bf16_t*)(p.ws + WS_U);
    float* BON = (float*)(p.ws + WS_BON);
    unsigned char* CHK = p.ws + WS_CHK;
    for (int e = tid; e < 2 * 64 * 64; e += NTHREADS) {
        const int which = e >> 12, k = (e >> 6) & 63, cc = e & 63;
        const float v = (which ? p.a2 : p.w2)[((size_t)l * 64 + k) * 256 + h * 64 + cc];
        *(LAS bf16_t*)(lds + (which ? CK_A2T : CK_W2T) + cc * P72 + k * 2) = cvt1(v);
    }
    const float mur = p.mu[l * 896 + c], muk = p.mu[l * 896 + 256 + c], muv = p.mu[l * 896 + 512 + c], muw = p.mu[l * 896 + 768 + lane], mua = p.mu[l * 896 + 832 + lane];
    const float w0c = p.w0[l * 256 + c], a0c = p.a0[l * 256 + c], kkc = p.k_k[l * 256 + c], kac = p.k_a[l * 256 + c], rkc = p.r_k[l * 256 + c];
    const int fr = lane & 15, fq = lane >> 4;
    unsigned short xr[5], xk[5], xv[5], xw_[5], xa_[5];
#define CK_LOAD(qq) do { const int b_ = (qq) / NCHK, ch_ = (qq) % NCHK; const bf16_t* ub = U + ((size_t)b_ * SEQ + ch_ * 32 + 4 * wv) * NU + UR; const bool first_ = (ch_ == 0 && wv == 0); \
        _Pragma("unroll") for (int u = 0; u < 5; ++u) { const bf16_t* q_ = ub + (ptrdiff_t)(u - 1 + ((u == 0 && first_) ? 1 : 0)) * NU; \
            xr[u] = q_[c]; xk[u] = q_[256 + c]; xv[u] = q_[512 + c]; xw_[u] = q_[768 + lane]; xa_[u] = q_[832 + lane]; } } while (0)
    if (((int)blockIdx.x >> 2) < NB * NCHK) CK_LOAD((int)blockIdx.x >> 2);
    for (int q = (int)blockIdx.x >> 2; q < NB * NCHK; q += (int)gridDim.x >> 2) {
        const int b = q / NCHK, ch = q % NCHK;
        int lz_ = 0; asm volatile("" : "+v"(lz_)); LAS unsigned char* L_ = lds + lz_;
        const size_t m0 = (size_t)b * SEQ + ch * 32;
        float rl[4], kl[4], vl[4];
        {
            const bool first = (ch == 0 && wv == 0);
#pragma unroll
            for (int u = 0; u < 4; ++u) {
                const float pz = (u == 0 && first) ? 0.f : 1.f;
                const float rc = bf2f(xr[u + 1]), kc = bf2f(xk[u + 1]), vc = bf2f(xv[u + 1]), wc = bf2f(xw_[u + 1]), ac = bf2f(xa_[u + 1]);
                rl[u] = rc + (bf2f(xr[u]) * pz - rc) * mur; kl[u] = kc + (bf2f(xk[u]) * pz - kc) * muk; vl[u] = vc + (bf2f(xv[u]) * pz - vc) * muv;
                const float wl = wc + (bf2f(xw_[u]) * pz - wc) * muw, al = ac + (bf2f(xa_[u]) * pz - ac) * mua;
                const int t = 4 * wv + u;
                *(LAS bf16_t*)(L_ + CK_XW + t * P72 + lane * 2) = cvt1(ftanh(wl));
                *(LAS bf16_t*)(L_ + CK_XA + t * P72 + lane * 2) = cvt1(al);
            }
            const int qn = q + ((int)gridDim.x >> 2);
            if (qn < NB * NCHK) CK_LOAD(qn);
        }
        __syncthreads();
        {
            const int mi = wv >> 2, tr = (wv >> 1) & 1;
#pragma unroll
            for (int i = 0; i < 2; ++i) {
                const int tc = 2 * (wv & 1) + i;
                f32x4 acc = {0.f, 0.f, 0.f, 0.f};
                acc = mma_nt16(acc, L_ + (mi ? CK_XA : CK_XW) + 16 * tr * P72, P72, L_ + (mi ? CK_A2T : CK_W2T) + 16 * tc * P72, P72, 64, lane);
#pragma unroll
                for (int r = 0; r < 4; ++r) *(LAS float*)(L_ + (mi ? CK_SAF : CK_SWF) + (16 * tr + 4 * fq + r) * PSF + (16 * tc + fr) * 4) = acc[r];
            }
        }
        __syncthreads();
        float lw[4], kkv[4], ktv[4], bbv[4], gl[4];
        {
            float run = 0.f;
#pragma unroll
            for (int u = 0; u < 4; ++u) {
                const int t = 4 * wv + u;
                const float sw = *(const LAS float*)(L_ + CK_SWF + t * PSF + lane * 4) + w0c, sa = *(const LAS float*)(L_ + CK_SAF + t * PSF + lane * 4) + a0c;
                lw[u] = -DECAY_SCALE * fsigmoid(sw);
                const float a = fsigmoid(sa);
                const float kx = kl[u] * kkc;
                kkv[u] = kx * __builtin_amdgcn_rsqf(fmaxf(wave_sum_fast(kx * kx), 1e-24f));
                ktv[u] = kl[u] * (1.f + (a - 1.f) * kac); bbv[u] = kkv[u] * a;
                const float bs = wave_sum_fast(rl[u] * ktv[u] * rkc);
                if (lane == 0) BON[(m0 + t) * 4 + h] = bs;
                run += lw[u]; gl[u] = run;
            }
            *(LAS float*)(L_ + CK_TOT + (wv * 64 + lane) * 4) = run;
        }
        __syncthreads();
        {
            float off = 0.f, tot = 0.f;
#pragma unroll
            for (int g = 0; g < 8; ++g) { const float x = *(const LAS float*)(L_ + CK_TOT + (g * 64 + lane) * 4); tot += x; off += (g < wv) ? x : 0.f; }
            const float etot = __expf(tot);
            if (wv == 0) *(LAS float*)(L_ + CK_EGL + lane * 4) = etot;
            float bbe[4], kte[4];
#pragma unroll
            for (int u = 0; u < 4; ++u) {
                const int t = 4 * wv + u;
                const float G = off + gl[u];
                const float e1 = __expf(G - lw[u]), e2 = __expf(G), inv = __builtin_amdgcn_rcpf(e2), el = etot * inv;
                const float ktl = kkv[u] * e1;
                *(LAS bf16_t*)(L_ + CK_KT + t * P72 + lane * 2) = cvt1(ktl);
                *(LAS float*)(L_ + CK_RHS + t * PRHS + lane * 4) = ktl;
                *(LAS bf16_t*)(L_ + CK_RT + t * P72 + lane * 2) = cvt1(rl[u] * e2);
                *(LAS bf16_t*)(L_ + CK_BH + t * P72 + lane * 2) = cvt1(bbv[u] * inv);
                *(LAS bf16_t*)(L_ + CK_KH + t * P72 + lane * 2) = cvt1(ktv[u] * inv);
                bbe[u] = bbv[u] * el; kte[u] = ktv[u] * el;
            }
            *(LAS u32x2*)(L_ + CK_VT + lane * P40 + wv * 8) = (u32x2){cvtpk(vl[0], vl[1]), cvtpk(vl[2], vl[3])};
            *(LAS u32x2*)(L_ + CK_BBT + lane * P40 + wv * 8) = (u32x2){cvtpk(bbe[0], bbe[1]), cvtpk(bbe[2], bbe[3])};
            *(LAS u32x2*)(L_ + CK_KBT + lane * P40 + wv * 8) = (u32x2){cvtpk(kte[0], kte[1]), cvtpk(kte[2], kte[3])};
        }
        __syncthreads();
        {
            const int mi = wv >> 1, tr = wv & 1;
            const LAS unsigned char* A = L_ + ((mi < 2) ? CK_KT : CK_RT) + 16 * tr * P72;
            const LAS unsigned char* Bm = L_ + ((mi & 1) ? CK_KH : CK_BH);
#pragma unroll
            for (int tc = 0; tc < 2; ++tc) {
                f32x4 acc = {0.f, 0.f, 0.f, 0.f};
                acc = mma_nt16(acc, A, P72, Bm + 16 * tc * P72, P72, 64, lane);
#pragma unroll
                for (int r = 0; r < 4; ++r) {
                    const int t = 16 * tr + 4 * fq + r, s_ = 16 * tc + fr;
                    const float x = (mi < 2 ? (s_ < t) : (s_ <= t)) ? acc[r] : 0.f;
                    if (mi == 0) *(LAS float*)(L_ + CK_LF + s_ * PLF + (((t & 3) << 3) + (t >> 2)) * 4) = x;
                    else *(LAS bf16_t*)(L_ + (mi == 1 ? CK_AAK : (mi == 2 ? CK_AQB : CK_AQK)) + t * P40 + s_ * 2) = cvt1(x);
                }
            }
        }
        __syncthreads();
        {
            const int tr = wv >> 2, ic = wv & 3;
            f32x4 acc = {0.f, 0.f, 0.f, 0.f};
            acc = mma_nt16(acc, L_ + CK_AAK + 16 * tr * P40, P40, L_ + CK_VT + 16 * ic * P40, P40, 32, lane);
#pragma unroll
            for (int r = 0; r < 4; ++r) *(LAS float*)(L_ + CK_RHS + (16 * tr + 4 * fq + r) * PRHS + (64 + 16 * ic + fr) * 4) = acc[r];
        }
        __syncthreads();
        {
            const int col = tid >> 2, pq = tid & 3;
            float acc[8];
#pragma unroll
            for (int i = 0; i < 8; ++i) acc[i] = *(const LAS float*)(L_ + CK_RHS + (4 * i + pq) * PRHS + col * 4);
            const LAS unsigned char* lp = L_ + CK_LF + pq * 32;
#pragma unroll
            for (int s_ = 0; s_ < 31; ++s_) {
                const f32x4 l0 = *(const LAS f32x4*)(lp + s_ * PLF), l1 = *(const LAS f32x4*)(lp + s_ * PLF + 16);
                const int xi_ = __builtin_bit_cast(int, acc[s_ >> 2]); int src;
                switch (s_ & 3) { case 0: src = __builtin_amdgcn_update_dpp(0, xi_, 0x00, 0xF, 0xF, true); break; case 1: src = __builtin_amdgcn_update_dpp(0, xi_, 0x55, 0xF, 0xF, true); break;
                                  case 2: src = __builtin_amdgcn_update_dpp(0, xi_, 0xAA, 0xF, 0xF, true); break; default: src = __builtin_amdgcn_update_dpp(0, xi_, 0xFF, 0xF, 0xF, true); break; }
                const float ws = __builtin_bit_cast(float, src);
#pragma unroll
                for (int i = 0; i < 4; ++i) { acc[i] -= l0[i] * ws; acc[4 + i] -= l1[i] * ws; }
                if ((s_ & 7) == 7) asm volatile("" ::: "memory");
            }
            LAS unsigned char* dst = L_ + (col < 64 ? CK_W1T : CK_W2N) + (col & 63) * P40;
#pragma unroll
            for (int i = 0; i < 8; ++i) *(LAS bf16_t*)(dst + (4 * i + pq) * 2) = cvt1(-acc[i]);
        }
        __syncthreads();
        {
            {
                const int tr = wv >> 2, cc = wv & 3;
                f32x4 acc;
#pragma unroll
                for (int r = 0; r < 4; ++r) acc[r] = bf2f(*(const LAS bf16_t*)(L_ + CK_RT + (16 * tr + 4 * fq + r) * P72 + (16 * cc + fr) * 2));
                acc = mma_nt16(acc, L_ + CK_AQB + 16 * tr * P40, P40, L_ + CK_W1T + 16 * cc * P40, P40, 32, lane);
#pragma unroll
                for (int r = 0; r < 4; ++r) { const int t_ = 16 * tr + 4 * fq + r, j_ = 16 * cc + fr; *(LAS bf16_t*)(L_ + CK_OUT + t_ * 128 + ((((j_ >> 3) ^ (t_ & 7)) << 4) | ((j_ & 7) << 1))) = cvt1(acc[r]); }
                f32x4 ac2 = {0.f, 0.f, 0.f, 0.f};
                ac2 = mma_nt16(ac2, L_ + CK_AQK + 16 * tr * P40, P40, L_ + CK_VT + 16 * cc * P40, P40, 32, lane);
                ac2 = mma_nt16(ac2, L_ + CK_AQB + 16 * tr * P40, P40, L_ + CK_W2N + 16 * cc * P40, P40, 32, lane);
                *(LAS u32x2*)(L_ + CK_OUT + 4096 + (tr * 4 + cc) * 512 + lane * 8) = (u32x2){cvtpk(ac2[0], ac2[1]), cvtpk(ac2[2], ac2[3])};
            }
#pragma unroll
            for (int i = 0; i < 2; ++i) {
                const int tl = 2 * wv + i, rr = tl >> 2, cc = tl & 3;
                f32x4 acc = {0.f, 0.f, 0.f, 0.f};
                acc = mma_nt16(acc, L_ + CK_BBT + 16 * rr * P40, P40, L_ + CK_W1T + 16 * cc * P40, P40, 32, lane);
#pragma unroll
                for (int r = 0; r < 4; ++r) { const int jp = 16 * rr + 4 * fq + r, j = 16 * cc + fr;
                    const float x = acc[r] + ((jp == j) ? *(const LAS float*)(L_ + CK_EGL + j * 4) : 0.f);
                    *(LAS bf16_t*)(L_ + CK_OUT + 8192 + jp * 128 + ((((j >> 3) ^ (jp & 7)) << 4) | ((j & 7) << 1))) = cvt1(x); }
                f32x4 ac2 = {0.f, 0.f, 0.f, 0.f};
                ac2 = mma_nt16(ac2, L_ + CK_VT + 16 * rr * P40, P40, L_ + CK_KBT + 16 * cc * P40, P40, 32, lane);
                ac2 = mma_nt16(ac2, L_ + CK_W2N + 16 * rr * P40, P40, L_ + CK_BBT + 16 * cc * P40, P40, 32, lane);
                *(LAS u32x2*)(L_ + CK_OUT + 16384 + tl * 512 + lane * 8) = (u32x2){cvtpk(ac2[0], ac2[1]), cvtpk(ac2[2], ac2[3])};
            }
        }
        __syncthreads();
        {
            unsigned char* dst = CHK + ((size_t)(b * 4 + h) * NCHK + ch) * CHK_B;
#pragma unroll
            for (int i = 0; i < 3; ++i) *(u32x4*)(dst + (i * NTHREADS + tid) * 16) = *(const LAS u32x4*)(L_ + CK_OUT + (i * NTHREADS + tid) * 16);
        }
    }
}

#undef CK_LOAD
__device__ __forceinline__ void glds16g(const void* gsrc, unsigned lds_dst) { unsigned keep;
    asm volatile("s_mov_b32 %0, m0\n\ts_mov_b32 m0, %2\n\ts_nop 0\n\tglobal_load_lds_dwordx4 %1, off\n\ts_mov_b32 m0, %0" : "=&s"(keep) : "v"(gsrc), "s"(lds_dst) : "memory"); }
constexpr int CN_NBUF = 5, CN_RING = 0, CN_SB = CN_NBUF * CHK_B;
__device__ __forceinline__ void phase_rwkv_chain(const Params& p, unsigned char* lds_, int bh) {
    LAS unsigned char* lds = (LAS unsigned char*)lds_;
    const int tid = otid(), lane = tid & 63, wv = __builtin_amdgcn_readfirstlane(tid >> 6);
    const int fr = lane & 15, fq = lane >> 4, b = bh >> 2, h = bh & 3;
    const unsigned char* rec = p.ws + WS_CHK + (size_t)bh * NCHK * CHK_B;
    float* O32 = (float*)(p.ws + WS_O32);
    const unsigned lds0 = (unsigned)(size_t)lds;
#define CN_DMA(cc) do { const unsigned char* g = rec + (size_t)(cc) * CHK_B + tid * 16; const unsigned d = (unsigned)__builtin_amdgcn_readfirstlane((int)(lds0 + CN_RING + ((cc) % CN_NBUF) * CHK_B + wv * 1024)); \
        glds16g(g, d); glds16g(g + 8192, d + 8192); glds16g(g + 16384, d + 16384); } while (0)
    for (int e = tid; e < 2 * 64 * 72 / 2; e += NTHREADS) *(LAS unsigned*)(lds + CN_SB + e * 4) = 0u;
    CN_DMA(0); CN_DMA(1); CN_DMA(2); CN_DMA(3);
    asm volatile("s_waitcnt vmcnt(0) lgkmcnt(0)\n\ts_barrier" ::: "memory");
#pragma unroll 1
    for (int cc = 0; cc < NCHK; ++cc) {
        int lz_ = 0; asm volatile("" : "+v"(lz_)); LAS unsigned char* L_ = lds + lz_;
        const LAS unsigned char* R = L_ + CN_RING + (cc % CN_NBUF) * CHK_B;
        const LAS unsigned char* Sc = L_ + CN_SB + (cc & 1) * (64 * P72);
        LAS unsigned char* Sn = L_ + CN_SB + ((cc + 1) & 1) * (64 * P72);
        {
            f32x4 acc[2];
#pragma unroll
            for (int i = 0; i < 2; ++i) { const u32x2 nm = *(const LAS u32x2*)(R + 16384 + (2 * wv + i) * 512 + lane * 8); acc[i] = (f32x4){bflo(nm.x), bfhi(nm.x), bflo(nm.y), bfhi(nm.y)}; }
#pragma unroll
            for (int i = 0; i < 2; ++i) { const int tl = 2 * wv + i, ir = tl >> 2, jc = tl & 3;
                acc[i] = mma_nt16s<false, true>(acc[i], Sc + 16 * ir * P72, P72, R + 8192 + 16 * jc * 128, 128, 64, lane); }
#pragma unroll
            for (int i = 0; i < 2; ++i) { const int tl = 2 * wv + i, ir = tl >> 2, jc = tl & 3;
#pragma unroll
                for (int r = 0; r < 4; ++r) *(LAS bf16_t*)(Sn + (16 * ir + 4 * fq + r) * P72 + (16 * jc + fr) * 2) = cvt1(acc[i][r]); }
        }
        {
            const int tr = wv >> 2, ic = wv & 3;
            const u32x2 oh = *(const LAS u32x2*)(R + 4096 + wv * 512 + lane * 8);
            f32x4 acc = {bflo(oh.x), bfhi(oh.x), bflo(oh.y), bfhi(oh.y)};
            acc = mma_nt16s<true, false>(acc, R + 16 * tr * 128, 128, Sc + 16 * ic * P72, P72, 64, lane);
            float* op = O32 + ((size_t)b * SEQ + cc * 32 + 16 * tr + 4 * fq) * 256 + h * 64 + 16 * ic + fr;
#pragma unroll
            for (int r = 0; r < 4; ++r) op[(size_t)r * 256] = acc[r];
        }
        if (cc + 4 < NCHK) CN_DMA(cc + 4);
        if (cc + 4 < NCHK) asm volatile("s_waitcnt vmcnt(9) lgkmcnt(0)\n\ts_barrier" ::: "memory");
        else asm volatile("s_waitcnt vmcnt(0) lgkmcnt(0)\n\ts_barrier" ::: "memory");
    }
#undef CN_DMA
}

__device__ __forceinline__ void phase_rwkv_fin(const Params& p, int l) {
    const int tid = otid(), lane = tid & 63, wv = tid >> 6;
    const bf16_t* U = (const bf16_t*)(p.ws + WS_U);
    const float* O32 = (const float*)(p.ws + WS_O32); const float* BON = (const float*)(p.ws + WS_BON);
    bf16_t* Y = (bf16_t*)(p.ws + WS_Y);
    const int ngw = gridDim.x * 8;
    for (int m2 = blockIdx.x * 8 + wv; m2 < MTOK / 2; m2 += ngw) {
        float o[8], vc[8], vp[8], g[8], bn[8];
#pragma unroll
        for (int k = 0; k < 8; ++k) {
            const int m = 2 * m2 + (k >> 2), h = k & 3, c = h * 64 + lane;
            const bool has_prev = (m % SEQ) != 0;
            o[k] = O32[(size_t)m * 256 + c];
            vc[k] = bf2f(U[(size_t)m * NU + UR + 512 + c]);
            vp[k] = has_prev ? bf2f(U[(size_t)(m - 1) * NU + UR + 512 + c]) : 0.f;
            g[k] = bf2f(U[(size_t)m * NU + UG + 512 + c]);
            bn[k] = BON[(size_t)m * 4 + h];
        }
#pragma unroll
        for (int k = 0; k < 8; ++k) {
            const int m = 2 * m2 + (k >> 2), h = k & 3, c = h * 64 + lane;
            const float mean = wave_sum_fast(o[k]) * (1.f / 64.f);
            const float dv = o[k] - mean;
            const float var = wave_sum_fast(dv * dv) * (1.f / 64.f);
            const float v = vc[k] + (vp[k] - vc[k]) * p.mu[l * 896 + 512 + c];
            const float on = dv * rsqrtf(var + 64e-5f) * p.ln_g[l * 256 + c] + p.ln_b[l * 256 + c] + bn[k] * v;
            Y[(size_t)m * DM + 512 + c] = (bf16_t)f2bf(on * g[k] * __builtin_amdgcn_rcpf(1.f + __expf(-g[k])));
        }
    }
}

template <int W> __device__ __forceinline__ void pool_item(const bf16_t* up, bf16_t* yp, int t0, float scl) {
    unsigned short xc[16], xp[W - 1], gg[16];
#pragma unroll
    for (int i = 0; i < 16; ++i) { xc[i] = up[(size_t)i * NU]; gg[i] = up[(size_t)i * NU + (UG + 768 - UP)]; }
#pragma unroll
    for (int d = 1; d < W; ++d) xp[d - 1] = (t0 - d >= 0) ? up[-(ptrdiff_t)d * NU] : (unsigned short)0;
    float s = 0.f;
#pragma unroll
    for (int d = 1; d < W; ++d) s += bf2f(xp[d - 1]);
#pragma unroll
    for (int i = 0; i < 16; ++i) {
        const int t = t0 + i;
        const float cur = bf2f(xc[i]);
        s += cur;
        const int cnt = (t + 1 < W) ? t + 1 : W;
        const float yv = (s * __builtin_amdgcn_rcpf((float)cnt) - cur) * scl;
        const float gv = bf2f(gg[i]);
        yp[(size_t)i * DM] = (bf16_t)f2bf(yv * gv * __builtin_amdgcn_rcpf(1.f + __expf(-gv)));
        const int k = i - W + 1;
        s -= (k >= 0) ? bf2f(xc[k >= 0 ? k : 0]) : bf2f(xp[k < 0 ? -k - 1 : 0]);
    }
}
__device__ __forceinline__ void phase_pool(const Params& p, int l) {
    const bf16_t* U = (const bf16_t*)(p.ws + WS_U);
    bf16_t* Y = (bf16_t*)(p.ws + WS_Y);
    const int tid = otid(), c = tid & 255, sub = tid >> 8, g = __builtin_amdgcn_readfirstlane(c >> 6);
    const float scl = p.pool_scale[l * 256 + c];
    for (int it = blockIdx.x * 2 + sub; it < MTOK / 16; it += gridDim.x * 2) {
        const int m0 = it * 16, t0 = m0 % SEQ;
        const bf16_t* up = U + (size_t)m0 * NU + UP + c;
        bf16_t* yp = Y + (size_t)m0 * DM + 768 + c;
        if (g == 0) pool_item<2>(up, yp, t0, scl); else if (g == 1) pool_item<4>(up, yp, t0, scl); else if (g == 2) pool_item<8>(up, yp, t0, scl); else pool_item<16>(up, yp, t0, scl);
    }
}

__global__ void __launch_bounds__(NTHREADS, 2) mega_fwd(Params p) {
    extern __shared__ __attribute__((aligned(16))) unsigned char lds[];
    volatile LAS unsigned* MISC = (volatile LAS unsigned*)((LAS unsigned char*)lds + MISC_OFF);
    if (threadIdx.x < 32) MISC[threadIdx.x] = 0u;
    __syncthreads();
    XcdBarrier bar = xcd_barrier_post((unsigned*)(p.ws + WS_CTL) + CW_BAR, MISC + 8);
#define GRID_BAR() do { XcdBarrier b_ = bar; unsigned* bp_ = (unsigned*)(p.ws + WS_CTL) + CW_BAR; asm volatile("" : "+s"(bp_)); b_.bar = bp_; xcd_barrier(b_); } while (0)
    bf16_t* XN = (bf16_t*)(p.ws + WS_XN); bf16_t* Y = (bf16_t*)(p.ws + WS_Y); bf16_t* U = (bf16_t*)(p.ws + WS_U); bf16_t* Z = (bf16_t*)(p.ws + WS_Z);

    phase_weights(p, lds);
    phase_mod(p, lds);
    GRID_BAR();
    phase_rows(p, 0, 0);
    GRID_BAR();
#pragma unroll 1
    for (int l = 0; l < NL; ++l) {
        const bf16_t* WT = (const bf16_t*)(p.ws + WS_WT) + (size_t)l * NU * DM;
        const bf16_t* WOT = (const bf16_t*)(p.ws + WS_WOT) + (size_t)l * DM * DM;
        {
            pg8::Gemm g{XN, WT, MTOK, NU, DM}; pg8::StaticOrder S; S.init(MTOK, NU, (int)gridDim.x, (int)blockIdx.x);
            pg8::EpiU E{U, p.q_gain + l * 64, p.k_gain + l * 64, NU};
            pg8::gemm_phase<pg8::EpiU, pg8::StaticOrder, true, true>((LAS unsigned char*)lds, g, S, E);
        }
        GRID_BAR();
        phase_cum(p, l, lds);
        phase_rwkv_chunk(p, l, lds);
        phase_pool(p, l);
        GRID_BAR();
        if (blockIdx.x < NB * 4) phase_rwkv_chain(p, lds, (int)blockIdx.x);
        {
            const attn_body::AttnTensors AT{(const attn_body::bf16*)(U + UQ), (const attn_body::bf16*)(U + UK), (const attn_body::bf16*)(U + UV), (const attn_body::bf16*)(U + UG),
                                            (const float*)(p.ws + WS_CB), (const int*)(p.ws + WS_TS), (attn_body::bf16*)Y};
            const attn_body::QueueOrder S{(unsigned*)(p.ws + WS_CTL) + CW_ATTQ + l * 64, MISC + 16};
            attn_body::attn_phase<attn_body::QueueOrder>((char*)lds, AT, S);
        }
        GRID_BAR();
        phase_rwkv_fin(p, l);
        GRID_BAR();
        {
            pg8::Gemm g{Y, WOT, MTOK, DM, DM}; pg8::StaticOrder S; S.init(MTOK, DM, (int)gridDim.x, (int)blockIdx.x);
            pg8::EpiB16 E{Z, DM};
            pg8::gemm_phase<pg8::EpiB16, pg8::StaticOrder, true, true>((LAS unsigned char*)lds, g, S, E);
        }
        GRID_BAR();
        phase_rows(p, 1, l);
        if (l + 1 < NL) GRID_BAR();
    }
}

extern "C" void kernel_launch(void* const* d_in, const int* in_sizes, int n_in, void* d_out, int out_size, void* d_ws, size_t ws_size, hipStream_t stream) {
    static int grid = 0;
    if (grid == 0) {
        if (n_in != 23 || ws_size < WS_END) { fprintf(stderr, "kernel_launch: unexpected n_in %d / ws_size %zu\n", n_in, ws_size); grid = -1; return; }
        int dev = 0, cus = 0, per_cu = 0;
        if (hipGetDevice(&dev) != hipSuccess || hipDeviceGetAttribute(&cus, hipDeviceAttributeMultiprocessorCount, dev) != hipSuccess) { grid = -1; return; }
        if (hipFuncSetAttribute((const void*)mega_fwd, hipFuncAttributeMaxDynamicSharedMemorySize, LDS_BYTES) != hipSuccess) { fprintf(stderr, "kernel_launch: hipFuncSetAttribute failed\n"); grid = -1; return; }
        if (hipOccupancyMaxActiveBlocksPerMultiprocessor(&per_cu, (const void*)mega_fwd, NTHREADS, LDS_BYTES) != hipSuccess || per_cu < 1) { fprintf(stderr, "kernel_launch: occupancy query failed (%d)\n", per_cu); grid = -1; return; }
        grid = cus;
        if (grid <= NB * 8) { fprintf(stderr, "kernel_launch: grid %d too small\n", grid); grid = -1; return; }
    }
    if (grid < 0) return;
    (void)hipMemsetAsync((char*)d_ws + WS_CTL, 0, CTL_ZERO_BYTES, stream);
    Params p{};
    const float** f = (const float**)&p;
    for (int i = 0; i < 23; ++i) f[i] = (const float*)d_in[i];
    p.out = (float*)d_out; p.ws = (unsigned char*)d_ws;
    void* args[] = {&p};
    hipError_t e = hipLaunchCooperativeKernel((const void*)mega_fwd, dim3(grid), dim3(NTHREADS), args, LDS_BYTES, stream);
    if (e != hipSuccess) fprintf(stderr, "cooperative launch failed: %s (grid %d)\n", hipGetErrorString(e), grid);
}
```

```cpp
#include <hip/hip_runtime.h>
#include <hip/hip_bf16.h>
#include <cstdio>
#include <cstdint>

constexpr int NB = 8, SEQ = 4096, DM = 1024, MTOK = NB * SEQ, NL = 2;
constexpr int D_IN = 3720, NU = 3840;
constexpr int UQ = 0, UK = 512, UV = 1024, UR = 1536  , UP = 2432  , UG = 2688  , UF = 3712  ;
constexpr int SQ = 0, SF = 1536, SR = 1544, SP = 2440, SG = 2696;
constexpr float C2 = 0.125f * 1.4426950408889634f;
constexpr float LOG2E = 1.4426950408889634f;
constexpr float DECAY_SCALE = 0.6065306597126334f;

typedef unsigned short bf16_t;
typedef short bf16x8 __attribute__((ext_vector_type(8)));
typedef float f32x4 __attribute__((ext_vector_type(4)));
typedef unsigned u32x4 __attribute__((ext_vector_type(4)));
typedef unsigned u32x2 __attribute__((ext_vector_type(2)));

__device__ __forceinline__ unsigned f2bf(float f) { unsigned u = __builtin_bit_cast(unsigned, f); return (u + 0x7fffu + ((u >> 16) & 1u)) >> 16; }
__device__ __forceinline__ unsigned pk2(float lo, float hi) { return f2bf(lo) | (f2bf(hi) << 16); }
__device__ __forceinline__ float bf2f(unsigned short b) { return __builtin_bit_cast(float, (unsigned)b << 16); }
__device__ __forceinline__ float bflo(unsigned w) { return __builtin_bit_cast(float, w << 16); }
__device__ __forceinline__ float bfhi(unsigned w) { return __builtin_bit_cast(float, w & 0xffff0000u); }
__device__ __forceinline__ float sigmoidf_(float x) { return 1.f / (1.f + __expf(-x)); }
__device__ __forceinline__ float siluf_(float x) { return x / (1.f + __expf(-x)); }
__device__ __forceinline__ float wave_sum(float v) {
#pragma unroll
    for (int o = 1; o < 64; o <<= 1) v += __shfl_xor(v, o);
    return v;
}

__device__ __forceinline__ int otid() { int t = threadIdx.x; asm volatile("" : "+v"(t)); return t; }

constexpr size_t MiB = 1u << 20;
constexpr size_t WS_CTL = 0;
constexpr size_t WS_MOD = 1 * MiB;
constexpr size_t WS_WT = 2 * MiB;
constexpr size_t WS_WOT = 18 * MiB;
constexpr size_t WS_TS = 512 * 1024;
constexpr size_t WS_CB = 22 * MiB;
constexpr size_t WS_XN = 24 * MiB;
constexpr size_t WS_O32 = 24 * MiB;
constexpr size_t WS_BON = 23 * MiB;
constexpr size_t WS_PA = 56 * MiB;
constexpr size_t WS_Y = 88 * MiB;
constexpr size_t WS_U = 152 * MiB;
constexpr size_t WS_Z = 152 * MiB;
constexpr size_t WS_CHK = 392 * MiB;
constexpr int CHK_B = 24576;
constexpr int NCHK = SEQ / 32;
constexpr size_t WS_END = 488 * MiB;
constexpr size_t CTL_ZERO_BYTES = 65536;
constexpr int CW_ATTQ = 8192;
constexpr int CW_BAR = 1024;

struct Params {
    const float *x, *c, *ada_w, *ada_b, *norm_pre, *norm_post, *w_in, *q_gain, *k_gain, *f_bias, *mu, *w0, *w2, *a0, *a2, *k_k, *k_a, *r_k, *ln_g, *ln_b,
        *pool_w, *pool_scale, *w_out;
    float* out;
    unsigned char* ws;
};


#define LAS __attribute__((address_space(3)))
constexpr int NTHREADS = 512;
constexpr int LDS_BYTES = 147456;
constexpr int MISC_OFF = LDS_BYTES - 128;

#define XB_TMO      128
#define XB_XCNT(j)  (256  + 64 * (j))
#define XB_XSUB(j)  (1280 + 64 * (j))
#define XB_XGEN(j)  (2304 + 64 * (j))
#define XB_TOP      3328
#define XB_TOPGEN   3392
#define XCD_BAR_WORDS 3456
#define XB_SPIN_CAP (1u << 18)
__device__ __forceinline__ unsigned xb_ld(unsigned* p)              { return __hip_atomic_load(p, __ATOMIC_RELAXED, __HIP_MEMORY_SCOPE_AGENT); }
__device__ __forceinline__ unsigned xb_add(unsigned* p, unsigned v) { return __hip_atomic_fetch_add(p, v, __ATOMIC_RELAXED, __HIP_MEMORY_SCOPE_AGENT); }
__device__ __forceinline__ unsigned xb_xcc_id() { return (unsigned)__builtin_amdgcn_s_getreg((3 << 11) | 20) & 0xFu; }
#define XB_SPIN(cond, bar) do { unsigned _sp = 0; while (cond) { __builtin_amdgcn_s_sleep(1); \
    if ((++_sp & 255u) == 0u) { if (xb_ld(&(bar)[XB_TMO])) break; if (_sp > XB_SPIN_CAP) { atomicAdd(&(bar)[XB_TMO], 1u); break; } } } } while (0)
struct XcdBarrier { unsigned* bar; unsigned x; volatile LAS unsigned* st; };
__device__ __forceinline__ XcdBarrier xcd_barrier_post(unsigned* bar, volatile LAS unsigned* st) {
    XcdBarrier b; b.bar = bar; b.x = xb_xcc_id(); b.st = st;
    if (threadIdx.x == 0) (void)xb_add(&bar[XB_XCNT(b.x)], 1u);
    return b;
}
__device__ __forceinline__ void xcd_barrier_complete(unsigned* bar, unsigned x, unsigned& nloc, unsigned& nx) {
    const unsigned G = gridDim.x * gridDim.y * gridDim.z;
    unsigned sum, cnt, mine, sp = 0u;
    for (;;) {
        sum = 0u; cnt = 0u; mine = 0u;
#pragma unroll
        for (unsigned j = 0; j < 16; ++j) { const unsigned c = xb_ld(&bar[XB_XCNT(j)]); sum += c; cnt += (c > 0u) ? 1u : 0u; mine = (j == x) ? c : mine; }
        if (sum == G) break;
        __builtin_amdgcn_s_sleep(1);
        if ((++sp & 255u) == 0u) { if (xb_ld(&bar[XB_TMO])) break; if (sp > XB_SPIN_CAP) { atomicAdd(&bar[XB_TMO], 1u); break; } }
    }
    nloc = mine > 0u ? mine : 1u; nx = cnt > 0u ? cnt : 1u;
}
__device__ __forceinline__ void xcd_barrier(const XcdBarrier& b) {
    asm volatile("s_waitcnt vmcnt(0)" ::: "memory");
    __syncthreads();
    if (threadIdx.x == 0) {
        unsigned* bar = b.bar;
        __builtin_amdgcn_s_waitcnt(0);
        unsigned nloc = b.st[0], nx = b.st[1];
        if (nloc == 0u) { xcd_barrier_complete(bar, b.x, nloc, nx); b.st[0] = nloc; b.st[1] = nx; }
        const unsigned old = xb_add(&bar[XB_XSUB(b.x)], 1u);
        const unsigned gen = old / nloc;
        if (old + 1u == (gen + 1u) * nloc) {
            __builtin_amdgcn_fence(__ATOMIC_RELEASE, "agent");
            asm volatile("s_waitcnt vmcnt(0)" ::: "memory");
            const unsigned og = xb_add(&bar[XB_TOP], 1u);
            const unsigned tg = og / nx;
            if (og + 1u == (tg + 1u) * nx) xb_add(&bar[XB_TOPGEN], 1u);
            else XB_SPIN(xb_ld(&bar[XB_TOPGEN]) == tg, bar);
            __builtin_amdgcn_fence(__ATOMIC_ACQUIRE, "agent");
            xb_add(&bar[XB_XGEN(b.x)], 1u);
            asm volatile("s_waitcnt vmcnt(0)" ::: "memory");
        } else {
            XB_SPIN(xb_ld(&bar[XB_XGEN(b.x)]) == gen, bar);
            __builtin_amdgcn_fence(__ATOMIC_ACQUIRE, "agent");
            asm volatile("s_waitcnt vmcnt(0)" ::: "memory");
        }
    }
    __syncthreads();
}


namespace pg8 {
#define PG8_LAS __attribute__((address_space(3)))
typedef unsigned short bf16_t;
typedef short bf16x8 __attribute__((ext_vector_type(8)));
typedef float f32x4 __attribute__((ext_vector_type(4)));
typedef unsigned u32x4 __attribute__((ext_vector_type(4)));
constexpr int BM = 256, BK = 64, HALF = 128, HTB = HALF * BK * 2  , STAGE_BYTES = 8 * HTB, NXCD = 8, WGM = 8;

__host__ __device__ __forceinline__ int lds_byte(int r, int c) { const int st = (r >> 4) * 2 + (c >> 5), rr = r & 15, cc = c & 31, ob = rr * 64 + cc * 2; return st * 1024 + (ob ^ (((ob >> 9) & 1) << 5)); }
__host__ __device__ __forceinline__ void stage_rc(int b, int& R, int& C) { const int st = b / 1024, sb = b % 1024, swz = sb ^ (((sb >> 9) & 1) << 5); R = (st >> 1) * 16 + swz / 64; C = (st & 1) * 32 + (swz % 64) / 2; }
__host__ __device__ __forceinline__ int perm32(int rho) { const int n = rho >> 4, i = rho & 15; return 8 * (i >> 2) + 4 * n + (i & 3); }

struct Unit { int pm, pn; };
struct Gemm { const bf16_t* A; const bf16_t* Bt; int M, N, K; };

struct StaticOrder {
    int nM, nN, nwg, G, c;
    __host__ __device__ void init(int M, int N, int G_, int c_) { nM = M / BM; nN = N / BM; nwg = nM * nN; G = G_; c = c_; }
    __host__ __device__ bool next(int i, Unit& u) const {
        const long L = (long)i * G + c; if (L >= nwg) return false;
        int wgid = (int)L; { const int q = nwg / NXCD, r = nwg % NXCD, xcd = wgid % NXCD, off = wgid / NXCD; wgid = (xcd < r ? xcd * (q + 1) : r * (q + 1) + (xcd - r) * q) + off; }
        const int nig = WGM * nN, gid = wgid / nig, fm = gid * WGM, gsz = (nM - fm) < WGM ? (nM - fm) : WGM;
        u.pm = fm + ((wgid % nig) % gsz); u.pn = (wgid % nig) / gsz; return true;
    }
    __device__ __forceinline__ void a_ready(const Unit&) const {}
    __device__ __forceinline__ void done(const Unit&) const {}
};

__device__ __forceinline__ unsigned cvt_pk_bf16(float lo, float hi) { unsigned r; asm volatile("v_cvt_pk_bf16_f32 %0, %1, %2" : "=v"(r) : "v"(lo), "v"(hi)); return r; }

struct EpiU {
    static constexpr bool PERM = true, AFTER_DRAIN = false;
    bf16_t* U; const float* qg; const float* kg; int ldc;
    __device__ __forceinline__ void operator()(const f32x4 (&acc)[2][2][4][2], const Unit& u, int wr, int wc, int fr, int fq) const {
        const int row0 = u.pm * BM + wr * 64 + fr;
        if (u.pn < 4) {
            const float* gp = (u.pn < 2 ? qg : kg) + 8 * fq; const float mult = u.pn < 2 ? (0.125f * 1.4426950408889634f) : 1.f;
            f32x4 gv[2][2];
#pragma unroll
            for (int bj = 0; bj < 2; ++bj)
#pragma unroll
                for (int n = 0; n < 2; ++n) gv[bj][n] = *(const f32x4*)(gp + 32 * bj + 4 * n);
            const int col0 = u.pn * BM + 64 * wc + 8 * fq;
#pragma unroll
            for (int ai = 0; ai < 2; ++ai)
#pragma unroll
                for (int m = 0; m < 4; ++m) {
                    float s = 0.f;
#pragma unroll
                    for (int bj = 0; bj < 2; ++bj)
#pragma unroll
                        for (int n = 0; n < 2; ++n) { const f32x4 x = acc[ai][bj][m][n]; s += (x[0] * x[0] + x[1] * x[1]) + (x[2] * x[2] + x[3] * x[3]); }
                    s += __shfl_xor(s, 16); s += __shfl_xor(s, 32);
                    const float sc = rsqrtf(s * (1.f / 64.f) + 1e-6f) * mult;
                    bf16_t* rowp = U + (size_t)(row0 + ai * HALF + m * 16) * ldc + col0;
#pragma unroll
                    for (int bj = 0; bj < 2; ++bj) { const f32x4 v0 = acc[ai][bj][m][0] * sc * gv[bj][0], v1 = acc[ai][bj][m][1] * sc * gv[bj][1];
                        u32x4 w; w.x = cvt_pk_bf16(v0[0], v0[1]); w.y = cvt_pk_bf16(v0[2], v0[3]); w.z = cvt_pk_bf16(v1[0], v1[1]); w.w = cvt_pk_bf16(v1[2], v1[3]);
                        *(u32x4*)(rowp + bj * 32) = w; }
                }
        } else {
            const int col0 = u.pn * BM + wc * 32 + 8 * fq;
#pragma unroll
            for (int ai = 0; ai < 2; ++ai)
#pragma unroll
                for (int m = 0; m < 4; ++m) { bf16_t* rowp = U + (size_t)(row0 + ai * HALF + m * 16) * ldc + col0;
#pragma unroll
                    for (int bj = 0; bj < 2; ++bj) { const f32x4 v0 = acc[ai][bj][m][0], v1 = acc[ai][bj][m][1];
                        u32x4 w; w.x = cvt_pk_bf16(v0[0], v0[1]); w.y = cvt_pk_bf16(v0[2], v0[3]); w.z = cvt_pk_bf16(v1[0], v1[1]); w.w = cvt_pk_bf16(v1[2], v1[3]);
                        *(u32x4*)(rowp + bj * HALF) = w; } }
        }
    }
};
struct EpiB16 {
    static constexpr bool PERM = true, AFTER_DRAIN = false;
    bf16_t* C; int ldc;
    __device__ __forceinline__ void operator()(const f32x4 (&acc)[2][2][4][2], const Unit& u, int wr, int wc, int fr, int fq) const {
        const int row0 = u.pm * BM + wr * 64 + fr, col0 = u.pn * BM + wc * 32 + 8 * fq;
#pragma unroll
        for (int ai = 0; ai < 2; ++ai)
#pragma unroll
            for (int m = 0; m < 4; ++m) { bf16_t* rowp = C + (size_t)(row0 + ai * HALF + m * 16) * ldc + col0;
#pragma unroll
                for (int bj = 0; bj < 2; ++bj) { const f32x4 v0 = acc[ai][bj][m][0], v1 = acc[ai][bj][m][1];
                    u32x4 w; w.x = cvt_pk_bf16(v0[0], v0[1]); w.y = cvt_pk_bf16(v0[2], v0[3]); w.z = cvt_pk_bf16(v1[0], v1[1]); w.w = cvt_pk_bf16(v1[2], v1[3]);
                    *(u32x4*)(rowp + bj * HALF) = w; } }
    }
};

template <class Epi, class Sched, bool ALIGN_EPI = false, bool SP2 = false>
__device__ __forceinline__ void gemm_phase(PG8_LAS unsigned char* lds, const Gemm g, const Sched& S, const Epi& E) {
    int tid_ = threadIdx.x; asm volatile("" : "+v"(tid_));
    const int tid = tid_, wid = __builtin_amdgcn_readfirstlane(tid >> 6), lane = tid & 63, wr = wid >> 2, wc = wid & 3, fr = lane & 15, fq = lane >> 4;
    const int K = g.K, nt = K / BK;
    unsigned voffA[2], voffB[2];
#pragma unroll
    for (int i = 0; i < 2; ++i) { int R, C; stage_rc(tid * 16 + i * 8192, R, C); const int Rb = Epi::PERM ? ((R & ~31) + perm32(R & 31)) : R;
        voffA[i] = (unsigned)(R * K + C) * 2u; voffB[i] = (unsigned)(Rb * K + C) * 2u; }
    const size_t kstep = (size_t)(BK * 2);
    const size_t hstep = (size_t)HALF * K * 2;
    const size_t tstep = 2 * hstep;
    const unsigned ldsw = (unsigned)wid * 1024u;
    const int aoff = lds_byte(wr * 64 + fr, fq * 8), boff = lds_byte(wc * 32 + fr, fq * 8);
#define PG8_SA(b, h) (((b) * 2 + (h)) * HTB)
#define PG8_SB(b, h) ((4 + (b) * 2 + (h)) * HTB)
#define PG8_STAGE(bufoff, gbase, voff) do { _Pragma("unroll") for (int _i = 0; _i < 2; ++_i) \
        __builtin_amdgcn_global_load_lds((const unsigned*)((const char*)(gbase) + (voff)[_i]), (PG8_LAS unsigned*)(lds + (bufoff) + ldsw + _i * 8192), 16, 0, 0); } while (0)
#define PG8_LDA(dst, b, h) do { _Pragma("unroll") for (int m = 0; m < 4; ++m) _Pragma("unroll") for (int k = 0; k < 2; ++k) dst[m][k] = *(const PG8_LAS bf16x8*)(lds + PG8_SA(b, h) + aoff + m * 2048 + k * 1024); } while (0)
#define PG8_LDB(dst, b, h) do { _Pragma("unroll") for (int n = 0; n < 2; ++n) _Pragma("unroll") for (int k = 0; k < 2; ++k) dst[n][k] = *(const PG8_LAS bf16x8*)(lds + PG8_SB(b, h) + boff + n * 2048 + k * 1024); } while (0)
#define PG8_MMA(ai, bj, At, Bt) do { __builtin_amdgcn_s_setprio(1); _Pragma("unroll") for (int m = 0; m < 4; ++m) _Pragma("unroll") for (int n = 0; n < 2; ++n) _Pragma("unroll") for (int k = 0; k < 2; ++k) \
        acc[ai][bj][m][n] = __builtin_amdgcn_mfma_f32_16x16x32_bf16(Bt[n][k], At[m][k], acc[ai][bj][m][n], 0, 0, 0); __builtin_amdgcn_s_setprio(0); } while (0)
#define PG8_WAIT_V(n) asm volatile("s_waitcnt vmcnt(" #n ")" ::: "memory")
#define PG8_WAIT_L(n) asm volatile("s_waitcnt lgkmcnt(" #n ")" ::: "memory")
#define PG8_BAR __builtin_amdgcn_s_barrier()
#define PG8_SCHED __builtin_amdgcn_sched_barrier(0)
    Unit cur, nxt; int ui = 0;
    if (!S.next(0, cur)) return;
    f32x4 acc[2][2][4][2];
#pragma unroll
    for (int a = 0; a < 2; ++a)
#pragma unroll
        for (int b = 0; b < 2; ++b)
#pragma unroll
            for (int m = 0; m < 4; ++m)
#pragma unroll
                for (int n = 0; n < 2; ++n) acc[a][b][m][n] = (f32x4){0.f, 0.f, 0.f, 0.f};
    bf16x8 At[4][2], B0[2][2], B1[2][2];
    const char* cA = (const char*)g.A + (size_t)cur.pm * tstep; const char* cB = (const char*)g.Bt + (size_t)cur.pn * tstep;
    S.a_ready(cur);
    if constexpr (SP2) {
        PG8_STAGE(PG8_SB(0, 0), cB, voffB); PG8_STAGE(PG8_SB(0, 1), cB + hstep, voffB); PG8_STAGE(PG8_SA(0, 0), cA, voffA); PG8_STAGE(PG8_SA(0, 1), cA + hstep, voffA);
        if (wr == 1) PG8_BAR;
        PG8_WAIT_V(2); PG8_BAR;
        PG8_STAGE(PG8_SB(1, 0), cB + kstep, voffB); PG8_STAGE(PG8_SA(1, 0), cA + kstep, voffA); PG8_STAGE(PG8_SB(1, 1), cB + hstep + kstep, voffB);
        PG8_WAIT_V(6); PG8_BAR;
    } else {
        PG8_STAGE(PG8_SB(0, 0), cB, voffB); PG8_STAGE(PG8_SA(0, 0), cA, voffA); PG8_STAGE(PG8_SB(0, 1), cB + hstep, voffB); PG8_STAGE(PG8_SA(0, 1), cA + hstep, voffA);
        if (wr == 1) PG8_BAR;
        PG8_WAIT_V(4); PG8_BAR;
        PG8_STAGE(PG8_SB(1, 0), cB + kstep, voffB); PG8_STAGE(PG8_SA(1, 0), cA + kstep, voffA); PG8_STAGE(PG8_SB(1, 1), cB + hstep + kstep, voffB);
        PG8_WAIT_V(6); PG8_BAR;
    }
    for (;;) {
        const bool has_next = S.next(ui + 1, nxt);
        const char* nA = has_next ? (const char*)g.A + (size_t)nxt.pm * tstep : cA; const char* nB = has_next ? (const char*)g.Bt + (size_t)nxt.pn * tstep : cB;
        for (int t = 0; t < nt; t += 2) {
            const bool last = (t == nt - 2);
            const char* a1 = cA + (size_t)(t + 1) * kstep;
            const char* a2 = last ? nA : cA + (size_t)(t + 2) * kstep; const char* b2 = last ? nB : cB + (size_t)(t + 2) * kstep;
            const char* a3 = a2 + kstep; const char* b3 = b2 + kstep;
            if (last && has_next) S.a_ready(nxt);
            if constexpr (SP2) {
            PG8_LDB(B0, 0, 0); PG8_LDB(B1, 0, 1); PG8_SCHED; PG8_LDA(At, 0, 0); PG8_STAGE(PG8_SA(1, 1), a1 + hstep, voffA);
            PG8_WAIT_V(8); PG8_WAIT_L(0); PG8_BAR; PG8_MMA(0, 0, At, B0); PG8_MMA(0, 1, At, B1); PG8_BAR; PG8_SCHED;
            PG8_LDA(At, 0, 1); PG8_STAGE(PG8_SB(0, 0), b2, voffB); PG8_STAGE(PG8_SB(0, 1), b2 + hstep, voffB); PG8_STAGE(PG8_SA(0, 0), a2, voffA);
            PG8_WAIT_V(8); PG8_WAIT_L(0); PG8_BAR; PG8_MMA(1, 0, At, B0); PG8_MMA(1, 1, At, B1); PG8_BAR; PG8_SCHED;
            PG8_LDB(B0, 1, 0); PG8_LDB(B1, 1, 1); PG8_SCHED; PG8_LDA(At, 1, 0); PG8_STAGE(PG8_SA(0, 1), a2 + hstep, voffA);
            PG8_WAIT_V(8); PG8_WAIT_L(0); PG8_BAR; PG8_MMA(0, 0, At, B0); PG8_MMA(0, 1, At, B1); PG8_BAR; PG8_SCHED;
            PG8_LDA(At, 1, 1); PG8_STAGE(PG8_SB(1, 0), b3, voffB); PG8_STAGE(PG8_SB(1, 1), b3 + hstep, voffB); PG8_STAGE(PG8_SA(1, 0), a3, voffA);
            PG8_WAIT_V(8); PG8_WAIT_L(0); PG8_BAR; PG8_MMA(1, 0, At, B0); PG8_MMA(1, 1, At, B1); PG8_BAR; PG8_SCHED;
            } else {
            PG8_LDB(B0, 0, 0); PG8_SCHED; PG8_LDA(At, 0, 0); PG8_STAGE(PG8_SA(1, 1), a1 + hstep, voffA);
            PG8_WAIT_L(8); PG8_BAR; PG8_WAIT_L(0); PG8_MMA(0, 0, At, B0); PG8_BAR; PG8_SCHED;
            PG8_LDB(B1, 0, 1); PG8_STAGE(PG8_SB(0, 0), b2, voffB);
            PG8_BAR; PG8_WAIT_L(0); PG8_MMA(0, 1, At, B1); PG8_BAR;
            PG8_LDA(At, 0, 1); PG8_STAGE(PG8_SA(0, 0), a2, voffA);
            PG8_BAR; PG8_WAIT_L(0); PG8_MMA(1, 0, At, B0); PG8_BAR; PG8_SCHED;
            PG8_STAGE(PG8_SB(0, 1), b2 + hstep, voffB);
            PG8_WAIT_V(6); PG8_BAR; PG8_MMA(1, 1, At, B1); PG8_BAR;
            PG8_LDB(B0, 1, 0); PG8_SCHED; PG8_LDA(At, 1, 0); PG8_STAGE(PG8_SA(0, 1), a2 + hstep, voffA);
            PG8_WAIT_L(8); PG8_BAR; PG8_WAIT_L(0); PG8_MMA(0, 0, At, B0); PG8_BAR; PG8_SCHED;
            PG8_LDB(B1, 1, 1); PG8_STAGE(PG8_SB(1, 0), b3, voffB);
            PG8_BAR; PG8_WAIT_L(0); PG8_MMA(0, 1, At, B1); PG8_BAR;
            PG8_LDA(At, 1, 1); PG8_STAGE(PG8_SA(1, 0), a3, voffA);
            PG8_BAR; PG8_WAIT_L(0); PG8_MMA(1, 0, At, B0); PG8_BAR; PG8_SCHED;
            PG8_STAGE(PG8_SB(1, 1), b3 + hstep, voffB);
            PG8_WAIT_V(6); PG8_BAR; PG8_MMA(1, 1, At, B1); PG8_BAR;
            }
        }
        if constexpr (ALIGN_EPI) { if (wr == 0) PG8_BAR; }
        if constexpr (!Epi::AFTER_DRAIN) { E(acc, cur, wr, wc, fr, fq); S.done(cur); }
        if (!has_next) break;
#pragma unroll
        for (int a = 0; a < 2; ++a)
#pragma unroll
            for (int b = 0; b < 2; ++b)
#pragma unroll
                for (int m = 0; m < 4; ++m)
#pragma unroll
                    for (int n = 0; n < 2; ++n) acc[a][b][m][n] = (f32x4){0.f, 0.f, 0.f, 0.f};
        cur = nxt; cA = nA; cB = nB; ++ui;
        if constexpr (ALIGN_EPI) { if (wr == 1) PG8_BAR; }
    }
    PG8_WAIT_V(0);
    if constexpr (!ALIGN_EPI) { if (wr == 0) PG8_BAR; }
    PG8_BAR;
    if constexpr (Epi::AFTER_DRAIN) { E.fused(acc, cur, wr, wc, fr, fq, lds, wid, lane); S.done(cur); }
#undef PG8_SA
#undef PG8_SB
#undef PG8_STAGE
#undef PG8_LDA
#undef PG8_LDB
#undef PG8_MMA
#undef PG8_WAIT_V
#undef PG8_WAIT_L
#undef PG8_BAR
#undef PG8_SCHED
}
}

#include <hip/hip_bf16.h>
#include <cmath>
namespace attn_body {
using bf16=__hip_bfloat16;
using bf16x8=__attribute__((ext_vector_type(8)))short;
using s16x4=__attribute__((ext_vector_type(4)))short;
using f32x16=__attribute__((ext_vector_type(16)))float;
using u32x4=__attribute__((ext_vector_type(4)))unsigned;
constexpr int BATCH=8,NHEAD=8,SEQ=4096,D=64,DM=3840,OPITCH=1024;
constexpr int NW=8,QBLK=32,QB=QBLK*NW,KVBLK=64,NQB=SEQ/QB;
constexpr int ATTN_PITCH=DM, ATTN_UNIT_ROWS=QB;
__device__ __forceinline__ int crow(int r,int hi){return (r&3)+8*(r>>2)+4*hi;}
#define SBAR() __builtin_amdgcn_sched_barrier(0)
__device__ __forceinline__ void cmask(f32x16&p0,f32x16&p1,int jb,int qrel,int hi){
  const float NEG=-INFINITY; int kb=64*jb+4*hi;
  #pragma unroll
  for(int r=0;r<16;++r){int kv=kb+(r&3)+8*(r>>2); if(kv>qrel)p0[r]=NEG; if(kv+32>qrel)p1[r]=NEG;}
}

constexpr int NSLOT=3, SLOTB=8192;
constexpr int LDS_K=0, LDS_V=NSLOT*SLOTB, LDS_WS=2*NSLOT*SLOTB, LDS_OST=LDS_WS+NW*64*4, LDS_CB=LDS_OST+NW*4096, LDS_BYTES=LDS_CB+SEQ*4+1024;
constexpr float C2=0.125f*1.4426950408889634f;
__device__ __forceinline__ void glds16(const void*gsrc,unsigned lds_dst){unsigned keep;
  asm volatile("s_mov_b32 %0, m0\n\ts_mov_b32 m0, %2\n\ts_nop 0\n\tglobal_load_lds_dwordx4 %1, off\n\ts_mov_b32 m0, %0":"=&s"(keep):"v"(gsrc),"s"(lds_dst):"memory");}
__device__ __forceinline__ float max3f(float a,float b,float c){float r;asm("v_max3_f32 %0, %1, %2, %3":"=v"(r):"v"(a),"v"(b),"v"(c));return r;}
__device__ __forceinline__ float max2f(float a,float b){float r;asm("v_max_f32_e32 %0, %1, %2":"=v"(r):"v"(a),"v"(b));return r;}
__device__ __forceinline__ float fadd_s(float a,float b){float r;asm("v_add_f32_e32 %0, %1, %2":"=v"(r):"v"(a),"v"(b));return r;}
__device__ __forceinline__ float fsub_s(float a,float b){float r;asm("v_sub_f32_e32 %0, %1, %2":"=v"(r):"v"(a),"v"(b));return r;}
typedef float f32x4v __attribute__((ext_vector_type(4))); typedef float f32x2_t __attribute__((ext_vector_type(2))); typedef __bf16 bf16x2_t __attribute__((ext_vector_type(2)));
__device__ __forceinline__ unsigned cvtpk_s(float lo,float hi){f32x2_t v={lo,hi};bf16x2_t b=__builtin_convertvector(v,bf16x2_t);return __builtin_bit_cast(unsigned,b);}
#define WAIT_BAR(N) asm volatile("s_waitcnt vmcnt(" #N ") lgkmcnt(0)\n\ts_barrier":::"memory")

__device__ __forceinline__ void qkt(f32x16&p0,f32x16&p1,const char*Kslot,const bf16x8*qr,int r32,int hi){
  const char*kb=Kslot+hi*1024+r32*16;
  #pragma unroll
  for(int d0=0;d0<4;++d0){
    const bf16x8 b0=*reinterpret_cast<const bf16x8*>(kb+d0*2048);
    const bf16x8 b1=*reinterpret_cast<const bf16x8*>(kb+d0*2048+512);
    p0=__builtin_amdgcn_mfma_f32_32x32x16_bf16(b0,qr[d0],p0,0,0,0);p1=__builtin_amdgcn_mfma_f32_32x32x16_bf16(b1,qr[d0],p1,0,0,0);}
}
typedef __attribute__((address_space(3))) const char* lds_cptr;
typedef short v4i16_t __attribute__((ext_vector_type(4)));
__device__ __forceinline__ void kload8(bf16x8*kf,lds_cptr kp){
  kf[0]=*(const __attribute__((address_space(3))) bf16x8*)(kp);      kf[1]=*(const __attribute__((address_space(3))) bf16x8*)(kp+512);
  kf[2]=*(const __attribute__((address_space(3))) bf16x8*)(kp+2048); kf[3]=*(const __attribute__((address_space(3))) bf16x8*)(kp+2560);
  kf[4]=*(const __attribute__((address_space(3))) bf16x8*)(kp+4096); kf[5]=*(const __attribute__((address_space(3))) bf16x8*)(kp+4608);
  kf[6]=*(const __attribute__((address_space(3))) bf16x8*)(kp+6144); kf[7]=*(const __attribute__((address_space(3))) bf16x8*)(kp+6656);
}
__device__ __forceinline__ void kload2(bf16x8*kf,lds_cptr kp,int j){ kf[2*j]=*(const __attribute__((address_space(3))) bf16x8*)(kp+j*2048); kf[2*j+1]=*(const __attribute__((address_space(3))) bf16x8*)(kp+j*2048+512); }
__device__ __forceinline__ s16x4 vtr(lds_cptr p){ return __builtin_bit_cast(s16x4,__builtin_amdgcn_ds_read_tr16_b64_v4i16((__attribute__((address_space(3))) v4i16_t*)p)); }
__device__ __forceinline__ float rowmax(const f32x16&p0,const f32x16&p1){
  float a=max3f(p0[0],p0[1],p1[0]),b=max3f(p0[2],p0[3],p1[1]);a=max3f(a,p1[2],p1[3]);
  #pragma unroll
  for(int r=4;r<16;r+=4){a=max3f(a,p0[r],p0[r+1]);b=max3f(b,p0[r+2],p0[r+3]);a=max3f(a,p1[r],p1[r+1]);b=max3f(b,p1[r+2],p1[r+3]);}
  const float m=max2f(a,b);
  auto rr=__builtin_amdgcn_permlane32_swap(__float_as_uint(m),__float_as_uint(m),false,false);
  return max2f(__uint_as_float(rr[0]),__uint_as_float(rr[1]));
}
__device__ __forceinline__ void pv(f32x16*o,int vb,bf16x8 pa0,bf16x8 pa1,bf16x8 pa2,bf16x8 pa3){
  #pragma unroll
  for(int d0=0;d0<2;++d0){s16x4 lo[4],hi[4];
    #pragma unroll
    for(int ks=0;ks<4;++ks){
      asm volatile("ds_read_b64_tr_b16 %0,%1 offset:%c2":"=&v"(lo[ks]):"v"(vb),"i"(d0*4096+ks*1024):"memory");
      asm volatile("ds_read_b64_tr_b16 %0,%1 offset:%c2":"=&v"(hi[ks]):"v"(vb),"i"(d0*4096+ks*1024+512):"memory");}
    asm volatile("s_waitcnt lgkmcnt(0)":::"memory");SBAR();
    #define PK(k) (bf16x8){lo[k][0],lo[k][1],lo[k][2],lo[k][3],hi[k][0],hi[k][1],hi[k][2],hi[k][3]}
    o[d0]=__builtin_amdgcn_mfma_f32_32x32x16_bf16(pa0,PK(0),o[d0],0,0,0);
    o[d0]=__builtin_amdgcn_mfma_f32_32x32x16_bf16(pa1,PK(1),o[d0],0,0,0);
    o[d0]=__builtin_amdgcn_mfma_f32_32x32x16_bf16(pa2,PK(2),o[d0],0,0,0);
    o[d0]=__builtin_amdgcn_mfma_f32_32x32x16_bf16(pa3,PK(3),o[d0],0,0,0);
    #undef PK
  }
}

#ifndef ATTN_STORE16
#define ATTN_STORE16(p,v) (*(u32x4*)(p)=(v))
#endif
template<int THRL> __device__ __forceinline__ void attn_unit(int b,int h,int qb,const bf16*Q,const bf16*__restrict__ K,const bf16*__restrict__ V,const bf16*Gt,const float*CBg,const int*TSg,bf16*O,char*shm){
  int tid_=threadIdx.x; asm volatile("":"+v"(tid_)); const int tid=tid_,lane=tid&63,r32=lane&31,hi=lane>>5; const int wid=__builtin_amdgcn_readfirstlane(tid>>6);
  const long rowbase=(long)b*SEQ; const int q0=qb*QB;
  const bf16*Qw=Q+(rowbase+q0+wid*QBLK)*DM+h*D;
  const int ts=__builtin_amdgcn_readfirstlane(TSg[(b*NHEAD+h)*NQB+qb]);
  const bf16*Kh=K+(rowbase+(long)ts*KVBLK)*DM+h*D,*Vh=V+(rowbase+(long)ts*KVBLK)*DM+h*D;
  const unsigned lds0=(unsigned)(uintptr_t)shm;
  float*wsf=(float*)(shm+LDS_WS)+wid*64;
  const bf16*ksrc=Kh+(long)lane*DM+wid*8;
  const bf16*vsrc=Vh+(long)(16*(wid&3)+(lane>>2))*DM+(wid>>2)*32+(lane&3)*8;
  const unsigned kdst=lds0+LDS_K+wid*1024, vdst=lds0+LDS_V+wid*1024;
  #define DMA_K(t,slot) glds16(ksrc+(long)(t)*KVBLK*DM,(unsigned)__builtin_amdgcn_readfirstlane(kdst+(slot)))
  #define DMA_V(t,slot) glds16(vsrc+(long)(t)*KVBLK*DM,(unsigned)__builtin_amdgcn_readfirstlane(vdst+(slot)))
  const int vb0=(int)(lds0+LDS_V)+((lane>>4)&1)*32+(lane&3)*8+(4*hi+((lane&15)>>2))*64;
  const char*Kbase=shm+LDS_K; bf16x8 kf[8];
  const lds_cptr shm3=(lds_cptr)shm; const lds_cptr kp0=shm3+LDS_K+hi*1024+r32*16; const lds_cptr vp0=shm3+LDS_V+((lane>>4)&1)*32+(lane&3)*8+(4*hi+((lane&15)>>2))*64;
  const int NT=(q0+QB)/KVBLK-ts;
  { const float*cbsrc=CBg+((long)b*NHEAD+h)*SEQ; float*cbl=(float*)(shm+LDS_CB);
    #pragma unroll
    for(int i=0;i<2;++i){ const int e=(i*512+tid)*4; if(e<q0+QB){ const f32x4v v=*reinterpret_cast<const f32x4v*>(cbsrc+e); *reinterpret_cast<f32x4v*>(cbl+e)=v; } } }
  DMA_K(0,0);DMA_V(0,0);DMA_K(1,SLOTB);
  bf16x8 qr[4];
  #pragma unroll
  for(int d0=0;d0<4;++d0)qr[d0]=*reinterpret_cast<const bf16x8*>(&Qw[(long)r32*DM+d0*16+hi*8]);
  float mhat=0.f,l_reg=0.f;f32x16 o[2];o[0]=f32x16{};o[1]=f32x16{};
  const int qrel=wid*QBLK+r32;
  #define CMASK(P0,P1,t) do{int jb_=(t)-(NT-4); if(jb_>=0)cmask(P0,P1,jb_,qrel,hi);}while(0)
  bool resc=false; f32x16 pA0,pA1,pB0,pB1;
  #define START(P0,P1) do{ const float rm=rowmax(P0,P1); resc=false; \
    { const float dl=__builtin_fmaxf(rm,-16.f); mhat=fadd_s(mhat,dl); mh2=cbq+mhat; \
      _Pragma("unroll") for(int r=0;r<16;++r){P0[r]=fsub_s(P0[r],dl);P1[r]=fsub_s(P1[r],dl);} } \
    _Pragma("unroll") for(int r=0;r<16;++r)P0[r]=__builtin_amdgcn_exp2f(P0[r]); }while(0)
  #define RESC() do{ if(resc){ asm volatile("s_waitcnt lgkmcnt(0)":::"memory"); \
      _Pragma("unroll") for(int d_=0;d_<2;++d_) _Pragma("unroll") for(int r=0;r<16;++r)o[d_][r]*=wsf[crow(r,hi)]; } }while(0)
  int sl_prev=0,sl_cur=0,sl_next=SLOTB;
  #define ROT() do{sl_prev=sl_cur;sl_cur=sl_next;sl_next=(sl_next==(NSLOT-1)*SLOTB)?0:sl_next+SLOTB;}while(0)
  DMA_K(2,2*SLOTB);
  WAIT_BAR(3);
  const lds_cptr cbp=(lds_cptr)shm+LDS_CB+hi*16+ts*256;
  const float cbq=*(const __attribute__((address_space(3))) float*)((lds_cptr)shm+LDS_CB+4*(q0+wid*QBLK+r32));
  float mh2=cbq;
  #define CBINIT(P0,P1,t) do{ _Pragma("unroll") for(int g_=0;g_<4;++g_){ \
      const f32x4v c0_=*(const __attribute__((address_space(3))) f32x4v*)(cbp+(t)*256+g_*32), c1_=*(const __attribute__((address_space(3))) f32x4v*)(cbp+(t)*256+g_*32+128); \
      _Pragma("unroll") for(int i_=0;i_<4;++i_){P0[4*g_+i_]=c0_[i_]-mh2;P1[4*g_+i_]=c1_[i_]-mh2;} } }while(0)
  CBINIT(pA0,pA1,0);
  qkt(pA0,pA1,Kbase,qr,r32,hi);asm volatile("s_nop 15\n\ts_nop 7":"+v"(pA0),"+v"(pA1));CMASK(pA0,pA1,0);
  START(pA0,pA1);
  _Pragma("unroll") for(int r=0;r<16;++r)pA1[r]=__builtin_amdgcn_exp2f(pA1[r]);
  CBINIT(pB0,pB1,1);
  WAIT_BAR(0);
  DMA_K(3,0);DMA_V(1,SLOTB);
  ROT();
  kload8(kf,kp0+sl_cur);
  WAIT_BAR(2);
  s16x4 vlo[8],vhi[8]; u32x4 pw0,pw1,pw2,pw3;
  #define PKW(P,B) cvtpk_s(P[B],P[B+1])
  #define PAF(k) __builtin_bit_cast(bf16x8,pw##k)
  #define VFR(i) (bf16x8){vlo[i][0],vlo[i][1],vlo[i][2],vlo[i][3],vhi[i][0],vhi[i][1],vhi[i][2],vhi[i][3]}
  #define PIN(x) asm volatile("":"+v"(x))
  #define MX3(a,b,c) __builtin_fmaxf(__builtin_fmaxf((a),(b)),(c))
  #define GAPA(MF,A0,A1,A2,A3,W0,W1,PW) do{ MF; sacc+=A0; sacc+=A1; sacc+=A2; sacc+=A3; PIN(sacc); W0; W1; PIN(PW); SBAR(); }while(0)
  #define EX(v) __builtin_amdgcn_exp2f(v)
  #define GAPB(MF,X,B,PN,CBO) do{ MF; X[B]=EX(X[B]); X[B+1]=EX(X[B+1]); X[B+2]=EX(X[B+2]); X[B+3]=EX(X[B+3]); PIN(X); \
    { const f32x4v c_=*(const __attribute__((address_space(3))) f32x4v*)(cbn_+(CBO)); PN[B]=c_[0]-mh2; PN[B+1]=c_[1]-mh2; PN[B+2]=c_[2]-mh2; PN[B+3]=c_[3]-mh2; PIN(PN); } SBAR(); }while(0)
  #define VRD(i) do{ vlo[i]=vtr(vp_+(((i)>>2)*4096+((i)&3)*1024)); vhi[i]=vtr(vp_+(((i)>>2)*4096+((i)&3)*1024+512)); }while(0)
  #define KRD(G,j) do{ if(G){ kload2(kf,kp0+sl_next,j); SBAR(); } }while(0)
  #define STEP(C0,C1,P0,P1,t,GK,GV,GL) do{ SBAR(); \
    const lds_cptr vp_=vp0+sl_prev; \
    VRD(0); SBAR(); float sacc=(P0[0]+P0[1]); \
    GAPA(C0=__builtin_amdgcn_mfma_f32_32x32x16_bf16(kf[0],qr[0],C0,0,0,0), P0[2],P0[3],P0[4],P0[5],     pw0[0]=PKW(P0,0), pw0[1]=PKW(P0,2), pw0); \
    VRD(4); SBAR(); GAPA(C1=__builtin_amdgcn_mfma_f32_32x32x16_bf16(kf[1],qr[0],C1,0,0,0), P0[6],P0[7],P0[8],P0[9],     pw0[2]=PKW(P0,4), pw0[3]=PKW(P0,6), pw0); \
    VRD(1); SBAR(); GAPA(C0=__builtin_amdgcn_mfma_f32_32x32x16_bf16(kf[2],qr[1],C0,0,0,0),   P0[10],P0[11],P0[12],P0[13], pw1[0]=PKW(P0,8), pw1[1]=PKW(P0,10), pw1); \
    VRD(5); SBAR(); GAPA(C1=__builtin_amdgcn_mfma_f32_32x32x16_bf16(kf[3],qr[1],C1,0,0,0),   P0[14],P0[15],P1[0],P1[1],   pw1[2]=PKW(P0,12),pw1[3]=PKW(P0,14), pw1); \
    VRD(2); SBAR(); GAPA(C0=__builtin_amdgcn_mfma_f32_32x32x16_bf16(kf[4],qr[2],C0,0,0,0),   P1[2],P1[3],P1[4],P1[5],     pw2[0]=PKW(P1,0), pw2[1]=PKW(P1,2), pw2); \
    VRD(6); SBAR(); GAPA(C1=__builtin_amdgcn_mfma_f32_32x32x16_bf16(kf[5],qr[2],C1,0,0,0),   P1[6],P1[7],P1[8],P1[9],     pw2[2]=PKW(P1,4), pw2[3]=PKW(P1,6), pw2); \
    VRD(3); SBAR(); GAPA(C0=__builtin_amdgcn_mfma_f32_32x32x16_bf16(kf[6],qr[3],C0,0,0,0),   P1[10],P1[11],P1[12],P1[13], pw3[0]=PKW(P1,8), pw3[1]=PKW(P1,10), pw3); \
    VRD(7); SBAR(); GAPA(C1=__builtin_amdgcn_mfma_f32_32x32x16_bf16(kf[7],qr[3],C1,0,0,0),   P1[14],P1[15],0.f,0.f,       pw3[2]=PKW(P1,12),pw3[3]=PKW(P1,14), pw3); \
    l_reg+=sacc; \
    if(GK){DMA_K((t)+3,sl_cur);} if(GV){DMA_V((t)+1,sl_next);} \
    CMASK(C0,C1,t); \
    { float a=MX3(C0[0],C0[1],C1[0]),b=MX3(C0[2],C0[3],C1[1]); a=MX3(a,C1[2],C1[3]); \
      _Pragma("unroll") for(int r=4;r<16;r+=4){a=MX3(a,C0[r],C0[r+1]);b=MX3(b,C0[r+2],C0[r+3]);a=MX3(a,C1[r],C1[r+1]);b=MX3(b,C1[r+2],C1[r+3]);} \
      float rm=__builtin_fmaxf(a,b); { auto rr=__builtin_amdgcn_permlane32_swap(__float_as_uint(rm),__float_as_uint(rm),false,false); rm=__builtin_fmaxf(__uint_as_float(rr[0]),__uint_as_float(rr[1])); } \
      resc=false; \
      if(__builtin_expect(__any(rm>(float)THRL),0)){ const float dl=__builtin_fmaxf(rm,0.f); mhat+=dl; \
        _Pragma("unroll") for(int r=0;r<16;++r){C0[r]-=dl;C1[r]-=dl;} \
        mh2=cbq+mhat; \
        const float f=__builtin_amdgcn_exp2f(-dl); l_reg*=f; if(hi==0)wsf[r32]=f; resc=true; } } \
    SBAR(); \
    const lds_cptr cbn_=cbp+((t)+1)*256;                      \
    GAPB(o[0]=__builtin_amdgcn_mfma_f32_32x32x16_bf16(PAF(0),VFR(0),o[0],0,0,0), C0,0, P0,0); \
    GAPB(o[1]=__builtin_amdgcn_mfma_f32_32x32x16_bf16(PAF(0),VFR(4),o[1],0,0,0), C0,4, P0,32); \
    KRD(GL,0); GAPB(o[0]=__builtin_amdgcn_mfma_f32_32x32x16_bf16(PAF(1),VFR(1),o[0],0,0,0), C0,8, P0,64); \
    KRD(GL,1); GAPB(o[1]=__builtin_amdgcn_mfma_f32_32x32x16_bf16(PAF(1),VFR(5),o[1],0,0,0), C0,12, P0,96); \
    KRD(GL,2); GAPB(o[0]=__builtin_amdgcn_mfma_f32_32x32x16_bf16(PAF(2),VFR(2),o[0],0,0,0), C1,0, P1,128); \
    KRD(GL,3); GAPB(o[1]=__builtin_amdgcn_mfma_f32_32x32x16_bf16(PAF(2),VFR(6),o[1],0,0,0), C1,4, P1,160); \
    GAPB(o[0]=__builtin_amdgcn_mfma_f32_32x32x16_bf16(PAF(3),VFR(3),o[0],0,0,0), C1,8, P1,192); \
    GAPB(o[1]=__builtin_amdgcn_mfma_f32_32x32x16_bf16(PAF(3),VFR(7),o[1],0,0,0), C1,12, P1,224); \
    }while(0)
  int t=1;
  #undef CMASK
  #define CMASK(P0,P1,t) do{}while(0)
  for(;t+5<NT;t+=2){
    STEP(pB0,pB1,pA0,pA1,t,true,true,true);     WAIT_BAR(2); RESC(); ROT();
    STEP(pA0,pA1,pB0,pB1,t+1,true,true,true);   WAIT_BAR(2); RESC(); ROT();
  }
  #undef CMASK
  #define CMASK(P0,P1,t) do{int jb_=(t)-(NT-4); if(jb_>=0)cmask(P0,P1,jb_,qrel,hi);}while(0)
  #define ENDW(tt) do{ if((tt)+3<NT){WAIT_BAR(2);} else if((tt)+2<NT){WAIT_BAR(1);} else {WAIT_BAR(0);} }while(0)
  for(;t+1<NT;t+=2){
    STEP(pB0,pB1,pA0,pA1,t,(t+3<NT),(t+1<NT),(t+1<NT));       ENDW(t);   RESC(); ROT();
    STEP(pA0,pA1,pB0,pB1,t+1,(t+4<NT),(t+2<NT),(t+2<NT));     ENDW(t+1); RESC(); ROT();
  }
  STEP(pB0,pB1,pA0,pA1,NT-1,false,false,false); RESC();
  { float sacc=pB0[0]+pB0[1]; _Pragma("unroll") for(int r=2;r<16;++r)sacc+=pB0[r]; _Pragma("unroll") for(int r=0;r<16;++r)sacc+=pB1[r]; l_reg+=sacc;
    pw0=(u32x4){PKW(pB0,0),PKW(pB0,2),PKW(pB0,4),PKW(pB0,6)};pw1=(u32x4){PKW(pB0,8),PKW(pB0,10),PKW(pB0,12),PKW(pB0,14)};pw2=(u32x4){PKW(pB1,0),PKW(pB1,2),PKW(pB1,4),PKW(pB1,6)};pw3=(u32x4){PKW(pB1,8),PKW(pB1,10),PKW(pB1,12),PKW(pB1,14)};
    SBAR(); pv(o,vb0+sl_cur,PAF(0),PAF(1),PAF(2),PAF(3)); }
  #undef PKW
  #undef PAF
  #undef VFR
  #undef PIN
  #undef MX3
  #undef GAPA
  #undef GAPB
  #undef EX
  #undef VRD
  #undef KRD
  #undef STEP
  #undef ENDW
  {auto rr=__builtin_amdgcn_permlane32_swap(__float_as_uint(l_reg),__float_as_uint(l_reg),false,false);l_reg=__uint_as_float(rr[0])+__uint_as_float(rr[1]);}
  if(hi==0)wsf[32+r32]=l_reg;asm volatile("s_waitcnt lgkmcnt(0)":::"memory");
  float rli[16];
  #pragma unroll
  for(int r=0;r<16;++r)rli[r]=__builtin_amdgcn_rcpf(wsf[32+crow(r,hi)]);
  bf16*Ow=O+(rowbase+q0+wid*QBLK)*OPITCH+h*D; const bf16*Gw=Gt+(rowbase+q0+wid*QBLK)*DM+h*D;
  { bf16*stg=(bf16*)(shm+LDS_OST)+wid*2048;
    #pragma unroll
    for(int r=0;r<16;++r){const int orow=crow(r,hi);
      #pragma unroll
      for(int d0=0;d0<2;++d0)stg[orow*64+d0*32+r32]=__float2bfloat16(o[d0][r]*rli[r]);}
    asm volatile("s_waitcnt lgkmcnt(0)":::"memory");
    #pragma unroll
    for(int i=0;i<4;++i){const int row=i*8+(lane>>3),ch=lane&7; const u32x4 v=*(const u32x4*)(stg+row*64+ch*8); const u32x4 gq=*(const u32x4*)(Gw+(long)row*DM+ch*8); u32x4 w_;
      #pragma unroll
      for(int k=0;k<4;++k){ const float g0=__builtin_bit_cast(float,gq[k]<<16), g1=__builtin_bit_cast(float,gq[k]&0xffff0000u), x0=__builtin_bit_cast(float,v[k]<<16), x1=__builtin_bit_cast(float,v[k]&0xffff0000u);
        w_[k]=cvtpk_s(x0*g0*__builtin_amdgcn_rcpf(1.f+__builtin_amdgcn_exp2f(-1.4426950408889634f*g0)), x1*g1*__builtin_amdgcn_rcpf(1.f+__builtin_amdgcn_exp2f(-1.4426950408889634f*g1))); }
      ATTN_STORE16(Ow+(long)row*OPITCH+ch*8,w_);} }
  asm volatile("s_waitcnt lgkmcnt(0)\n\ts_barrier":::"memory");
  #undef CBINIT
  #undef DMA_K
  #undef DMA_V
  #undef CMASK
  #undef START
  #undef RESC
  #undef ROT
}
constexpr int ATTN_LDS_BYTES=LDS_BYTES;
struct AttnTensors { const bf16* Q; const bf16* K; const bf16* V; const bf16* G; const float* CB; const int* TS; bf16* O; };
struct AttnUnit { int bh; int qb; };
struct QueueOrder {
  unsigned* ctr; volatile __attribute__((address_space(3))) unsigned* slot;
  __device__ __forceinline__ bool next(int,AttnUnit&u)const{
    if(threadIdx.x==0){ *slot=__hip_atomic_fetch_add(ctr,1u,__ATOMIC_RELAXED,__HIP_MEMORY_SCOPE_AGENT); }
    __syncthreads(); const unsigned t=*slot; __syncthreads();
    if(t>=(unsigned)(BATCH*NHEAD*NQB))return false; u.qb=NQB-1-(int)(t/(BATCH*NHEAD)); u.bh=(int)(t%(BATCH*NHEAD)); return true; }
  __device__ __forceinline__ void a_ready(const AttnUnit&)const{}
  __device__ __forceinline__ void done(const AttnUnit&)const{}
};
template<class Sched,int THRL=8> __device__ __forceinline__ void attn_phase(char*lds,const AttnTensors&T,const Sched&S){
  AttnUnit u;
  for(int i=0;S.next(i,u);++i){ S.a_ready(u); attn_unit<THRL>(u.bh/NHEAD,u.bh%NHEAD,u.qb,T.Q,T.K,T.V,T.G,T.CB,T.TS,T.O,lds); S.done(u); }
}
#undef SBAR
#undef WAIT_BAR
}

__device__ __forceinline__ int src_col(int n) {
    if (n < 1024) { const int cp = n & 255; return (n & ~255) + 64 * ((cp >> 5) & 3) + 32 * (cp >> 7) + (cp & 31); }
    if (n < 1536) return n;
    if (n < UP) return n - UR + SR;
    if (n < UG) return -1;
    if (n < UF) return n - UG + SG;
    if (n < UF + 8) return n - UF + SF;
    return -2;
}
__device__ __forceinline__ void phase_weights(const Params& p, unsigned char* lds) {
    float (*tile)[65] = (float (*)[65])lds;
    const int tid = otid();
    constexpr int T_IN = (NU / 64) * (DM / 64), T_OUT = (DM / 64) * (DM / 64), PER_L = T_IN + T_OUT;
    for (int it = blockIdx.x; it < NL * PER_L; it += gridDim.x) {
        const int l = it / PER_L; int r = it % PER_L;
        if (r < T_IN) {
            const int nt = r / (DM / 64), kt = r % (DM / 64), n0 = nt * 64, k0 = kt * 64;
            const float* W = p.w_in + (size_t)l * DM * D_IN;
            for (int e = tid; e < 64 * 64; e += NTHREADS) {
                const int kk = e >> 6, nn = e & 63, n = n0 + nn, sc = src_col(n);
                float v = 0.f;
                if (sc >= 0) v = W[(size_t)(k0 + kk) * D_IN + sc];
                else if (sc == -1) {
                    const int g = (n - UP) >> 6, d = (n - UP) & 63;
                    const float* pw = p.pool_w + ((size_t)l * 4 + g) * 64 * 64;
                    const float* wr = W + (size_t)(k0 + kk) * D_IN + SP + g * 64;
                    float s = 0.f;
                    for (int cc = 0; cc < 64; ++cc) s += wr[cc] * pw[cc * 64 + d];
                    v = s;
                }
                tile[kk][nn] = v;
            }
            __syncthreads();
            bf16_t* WT = (bf16_t*)(p.ws + WS_WT) + (size_t)l * NU * DM;
            for (int e = tid; e < 64 * 32; e += NTHREADS) {
                const int nn = e >> 5, kp = (e & 31) * 2;
                *(unsigned*)(WT + (size_t)(n0 + nn) * DM + k0 + kp) = pk2(tile[kp][nn], tile[kp + 1][nn]);
            }
            __syncthreads();
        } else {
            r -= T_IN;
            const int nt = r / (DM / 64), kt = r % (DM / 64), n0 = nt * 64, k0 = kt * 64;
            const float* W = p.w_out + (size_t)l * DM * DM;
            for (int e = tid; e < 64 * 64; e += NTHREADS) { const int kk = e >> 6, nn = e & 63; tile[kk][nn] = W[(size_t)(k0 + kk) * DM + n0 + nn]; }
            __syncthreads();
            bf16_t* WOT = (bf16_t*)(p.ws + WS_WOT) + (size_t)l * DM * DM;
            for (int e = tid; e < 64 * 32; e += NTHREADS) {
                const int nn = e >> 5, kp = (e & 31) * 2;
                *(unsigned*)(WOT + (size_t)(n0 + nn) * DM + k0 + kp) = pk2(tile[kp][nn], tile[kp + 1][nn]);
            }
            __syncthreads();
        }
    }
}

__device__ __forceinline__ void phase_mod(const Params& p, unsigned char* lds) {
    float (*sc)[DM] = (float (*)[DM])lds;
    float (*red)[NB][64] = (float (*)[NB][64])(lds + 32768);
    const int tid = otid();
    if ((int)blockIdx.x >= NL * 48) return;
    for (int e = tid; e < NB * DM; e += NTHREADS) sc[e / DM][e % DM] = siluf_(p.c[e]);
    __syncthreads();
    float* mod = (float*)(p.ws + WS_MOD);
    const int kg = tid >> 6, cl = tid & 63;
    for (int it = blockIdx.x; it < NL * 48; it += gridDim.x) {
        const int l = it / 48, n = (it % 48) * 64 + cl;
        const float* W = p.ada_w + (size_t)l * DM * 3072 + n;
        float acc[NB];
#pragma unroll
        for (int b = 0; b < NB; ++b) acc[b] = 0.f;
#pragma unroll 8
        for (int k = kg * 128; k < kg * 128 + 128; ++k) {
            const float w = W[(size_t)k * 3072];
#pragma unroll
            for (int b = 0; b < NB; ++b) acc[b] += sc[b][k] * w;
        }
#pragma unroll
        for (int b = 0; b < NB; ++b) red[kg][b][cl] = acc[b];
        __syncthreads();
        {
            const int b = tid >> 6;
            float s = p.ada_b[l * 3072 + n];
#pragma unroll
            for (int g = 0; g < 8; ++g) s += red[g][b][cl];
            mod[((size_t)l * NB + b) * 3072 + n] = s;
        }
        __syncthreads();
    }
}

__device__ __forceinline__ void row_h_store(const f32x4 (&v)[4], float rinv, const float* npre, const float* mod_lb, bf16_t* xnrow, int lane) {
#pragma unroll
    for (int j = 0; j < 4; ++j) {
        const int c = j * 256 + lane * 4;
        const f32x4 g = *(const f32x4*)(npre + c), sh = *(const f32x4*)(mod_lb + c), scl = *(const f32x4*)(mod_lb + 1024 + c);
        f32x4 h;
#pragma unroll
        for (int i = 0; i < 4; ++i) h[i] = v[j][i] * rinv * g[i] * (1.f + scl[i]) + sh[i];
        u32x2 w; w.x = pk2(h[0], h[1]); w.y = pk2(h[2], h[3]);
        *(u32x2*)(xnrow + c) = w;
    }
}
__device__ __forceinline__ void phase_rows(const Params& p, int mode, int l) {
    const int tid = otid(), lane = tid & 63, wv = tid >> 6;
    const int gw = blockIdx.x * 8 + wv, ngw = gridDim.x * 8;
    const float* mod = (const float*)(p.ws + WS_MOD);
    bf16_t* XN = (bf16_t*)(p.ws + WS_XN);
    const bf16_t* Z = (const bf16_t*)(p.ws + WS_Z);
    for (int m = gw; m < MTOK; m += ngw) {
        const int b = m / SEQ;
        f32x4 v[4];
        if (mode == 0) {
#pragma unroll
            for (int j = 0; j < 4; ++j) v[j] = *(const f32x4*)(p.x + (size_t)m * DM + j * 256 + lane * 4);
            float s = 0.f;
#pragma unroll
            for (int j = 0; j < 4; ++j) s += v[j][0] * v[j][0] + v[j][1] * v[j][1] + v[j][2] * v[j][2] + v[j][3] * v[j][3];
            const float rinv = rsqrtf(wave_sum(s) * (1.f / DM) + 1e-6f);
            row_h_store(v, rinv, p.norm_pre, mod + ((size_t)0 * NB + b) * 3072, XN + (size_t)m * DM, lane);
        } else {
            f32x4 z[4];
#pragma unroll
            for (int j = 0; j < 4; ++j) { const u32x2 zw = *(const u32x2*)(Z + (size_t)m * DM + j * 256 + lane * 4); z[j] = (f32x4){bflo(zw.x), bfhi(zw.x), bflo(zw.y), bfhi(zw.y)}; }
            float s = 0.f;
#pragma unroll
            for (int j = 0; j < 4; ++j) s += z[j][0] * z[j][0] + z[j][1] * z[j][1] + z[j][2] * z[j][2] + z[j][3] * z[j][3];
            const float rz = rsqrtf(wave_sum(s) * (1.f / DM) + 1e-6f);
            const float* xold = (l == 0) ? p.x : p.out;
            const float* mod_lb = mod + ((size_t)l * NB + b) * 3072;
            float s2 = 0.f;
#pragma unroll
            for (int j = 0; j < 4; ++j) {
                const int c = j * 256 + lane * 4;
                const f32x4 xo = *(const f32x4*)(xold + (size_t)m * DM + c), gp = *(const f32x4*)(p.norm_post + l * DM + c), gt = *(const f32x4*)(mod_lb + 2048 + c);
#pragma unroll
                for (int i = 0; i < 4; ++i) { v[j][i] = xo[i] + gt[i] * (z[j][i] * rz * gp[i]); s2 += v[j][i] * v[j][i]; }
                *(f32x4*)(p.out + (size_t)m * DM + c) = v[j];
            }
            if (l + 1 < NL) {
                const float rinv = rsqrtf(wave_sum(s2) * (1.f / DM) + 1e-6f);
                row_h_store(v, rinv, p.norm_pre + (l + 1) * DM, mod + ((size_t)(l + 1) * NB + b) * 3072, XN + (size_t)m * DM, lane);
            }
        }
    }
}

__device__ __forceinline__ void phase_cum(const Params& p, int l, unsigned char* lds) {
    float (*wtot)[8] = (float (*)[8])lds;
    const int tid = otid(), lane = tid & 63, wv = tid >> 6;
    const bf16_t* U = (const bf16_t*)(p.ws + WS_U);
    float* CB = (float*)(p.ws + WS_CB);
    for (int b = blockIdx.x; b < NB; b += gridDim.x) {
        float pre[8][8];
        float run[8];
#pragma unroll
        for (int h = 0; h < 8; ++h) run[h] = 0.f;
#pragma unroll
        for (int i = 0; i < 8; ++i) {
            const u32x4 w = *(const u32x4*)(U + (size_t)(b * SEQ + tid * 8 + i) * NU + UF);
            float f[8] = {bflo(w.x), bfhi(w.x), bflo(w.y), bfhi(w.y), bflo(w.z), bfhi(w.z), bflo(w.w), bfhi(w.w)};
#pragma unroll
            for (int h = 0; h < 8; ++h) {
                const float xx = f[h] + p.f_bias[l * 8 + h];
                const float ls = fminf(xx, 0.f) - __logf(1.f + __expf(-fabsf(xx)));
                run[h] += -ls * LOG2E;
                pre[i][h] = run[h];
            }
        }
        float exc[8];
#pragma unroll
        for (int h = 0; h < 8; ++h) {
            float v = run[h];
#pragma unroll
            for (int o = 1; o < 64; o <<= 1) { const float t = __shfl_up(v, o); if (lane >= o) v += t; }
            if (lane == 63) wtot[wv][h] = v;
            exc[h] = v - run[h];
        }
        __syncthreads();
#pragma unroll
        for (int h = 0; h < 8; ++h) { float base = 0.f; for (int w2 = 0; w2 < wv; ++w2) base += wtot[w2][h]; exc[h] += base; }
#pragma unroll
        for (int h = 0; h < 8; ++h)
#pragma unroll
            for (int i = 0; i < 8; ++i) CB[((size_t)b * 8 + h) * SEQ + tid * 8 + i] = exc[h] + pre[i][h];
        float* cbe = (float*)(lds + 256);
        float* cbq0 = cbe + 512;
#pragma unroll
        for (int h = 0; h < 8; ++h) { if ((tid & 7) == 7) cbe[h * 64 + (tid >> 3)] = exc[h] + pre[7][h]; if ((tid & 31) == 0) cbq0[h * 16 + (tid >> 5)] = exc[h] + pre[0][h]; }
        __syncthreads();
        {
            float gq = fabsf(p.q_gain[l * 64 + lane]), gk = fabsf(p.k_gain[l * 64 + lane]);
#pragma unroll
            for (int o = 1; o < 64; o <<= 1) { gq = fmaxf(gq, __shfl_xor(gq, o)); gk = fmaxf(gk, __shfl_xor(gk, o)); }
            const float dskip = 2.f * 1.02f * (64.f * C2) * gq * gk + 52.f;
            int* TS = (int*)(p.ws + WS_TS);
            for (int it = wv; it < 8 * 16; it += 8) {
                const int h = it >> 4, qb = it & 15, nt = 4 * qb + 4;
                const bool pr = (lane < nt) && (cbe[h * 64 + lane] < cbq0[h * 16 + qb] - dskip);
                int ts = __popcll(__ballot(pr));
                ts &= ~1; ts = ts < nt - 4 ? ts : nt - 4;
                if (lane == 0) TS[(b * 8 + h) * 16 + qb] = ts;
            }
        }
        __syncthreads();
    }
}

typedef _Float16 h8 __attribute__((ext_vector_type(8)));
typedef _Float16 h4 __attribute__((ext_vector_type(4)));
typedef float f32x2 __attribute__((ext_vector_type(2)));
template <int CTRL> __device__ __forceinline__ float dpp_add(float x) {
    const int y = __builtin_amdgcn_update_dpp(0, __builtin_bit_cast(int, x), CTRL, 0xF, 0xF, true);
    return x + __builtin_bit_cast(float, y);
}
__device__ __forceinline__ float row16_sum(float x) {
    x = dpp_add<0xB1>(x); x = dpp_add<0x4E>(x); x = dpp_add<0x141>(x); x = dpp_add<0x140>(x); return x;
}
__device__ __forceinline__ float wave_sum_fast(float x) {
    x = row16_sum(x);
    { const unsigned xi = __builtin_bit_cast(unsigned, x); auto rr = __builtin_amdgcn_permlane16_swap(xi, xi, false, false); const unsigned r0 = rr[0], r1 = rr[1]; x = __builtin_bit_cast(float, r0) + __builtin_bit_cast(float, r1); }
    { const unsigned xi = __builtin_bit_cast(unsigned, x); auto rr = __builtin_amdgcn_permlane32_swap(xi, xi, false, false); const unsigned r0 = rr[0], r1 = rr[1]; x = __builtin_bit_cast(float, r0) + __builtin_bit_cast(float, r1); }
    return x;
}
__device__ __forceinline__ f32x4 mma_nt16(f32x4 acc, const LAS unsigned char* A, int pa, const LAS unsigned char* Bt, int pb, int K, int lane) {
    const LAS unsigned char* ap = A + (lane & 15) * pa + (lane >> 4) * 16;
    const LAS unsigned char* bp = Bt + (lane & 15) * pb + (lane >> 4) * 16;
#pragma unroll
    for (int k = 0; k < K; k += 32) {
        const bf16x8 a = *(const LAS bf16x8*)(ap + 2 * k), b = *(const LAS bf16x8*)(bp + 2 * k);
        acc = __builtin_amdgcn_mfma_f32_16x16x32_bf16(a, b, acc, 0, 0, 0);
    }
    return acc;
}
template <bool SA, bool SB>
__device__ __forceinline__ f32x4 mma_nt16s(f32x4 acc, const LAS unsigned char* A, int pa, const LAS unsigned char* Bt, int pb, int K, int lane) {
    const int r = lane & 15, q = lane >> 4;
#pragma unroll
    for (int k = 0; k < K; k += 32) {
        const int ck = (k >> 3) + q;
        const bf16x8 a = *(const LAS bf16x8*)(A + r * pa + ((SA ? (ck ^ (r & 7)) : ck) << 4)), b = *(const LAS bf16x8*)(Bt + r * pb + ((SB ? (ck ^ (r & 7)) : ck) << 4));
        acc = __builtin_amdgcn_mfma_f32_16x16x32_bf16(a, b, acc, 0, 0, 0);
    }
    return acc;
}
constexpr int CK_W2T = 0, CK_A2T = 9216, CK_XW = 18432, CK_XA = 23040, CK_SWF = 27648, CK_SAF = 35968, CK_TOT = 44288, CK_EGL = 46336;
constexpr int CK_KT = 46592, CK_RT = 51200, CK_BH = 55808, CK_KH = 60416, CK_RHS = 65024, CK_VT = 81920, CK_BBT = 87040, CK_KBT = 92160, CK_LF = 97280;
constexpr int CK_AAK = 101888, CK_AQB = 104448, CK_AQK = 107008, CK_W1T = 109568, CK_W2N = 114688, CK_OUT = 119808;
constexpr int P72 = 144, P40 = 80, PSF = 65 * 4, PRHS = 132 * 4, PLF = 36 * 4;
__device__ __forceinline__ float fsigmoid(float x) { return __builtin_amdgcn_rcpf(1.f + __expf(-x)); }
__device__ __forceinline__ float ftanh(float x) { return 1.f - 2.f * __builtin_amdgcn_rcpf(1.f + __expf(2.f * x)); }
typedef float f32x2c __attribute__((ext_vector_type(2))); typedef __bf16 bf16x2c __attribute__((ext_vector_type(2)));
__device__ __forceinline__ unsigned cvtpk(float lo, float hi) { const f32x2c v = {lo, hi}; const bf16x2c b = __builtin_convertvector(v, bf16x2c); return __builtin_bit_cast(unsigned, b); }
__device__ __forceinline__ bf16_t cvt1(float x) { return (bf16_t)(cvtpk(x, x) & 0xffffu); }
__device__ __forceinline__ void phase_rwkv_chunk(const Params& p, int l, unsigned char* lds_) {
    LAS unsigned char* lds = (LAS unsigned char*)lds_;
    const int tid = otid(), lane = tid & 63, wv = __builtin_amdgcn_readfirstlane(tid >> 6);
    const int h = (int)blockIdx.x & 3, c = h * 64 + lane;
    const bf16_t* U = (const bf16_t*)(p.ws + WS_U);
    float* BON = (float*)(p.ws + WS_BON);
    unsigned char* CHK = p.ws + WS_CHK;
    for (int e = tid; e < 2 * 64 * 64; e += NTHREADS) {
        const int which = e >> 12, k = (e >> 6) & 63, cc = e & 63;
        const float v = (which ? p.a2 : p.w2)[((size_t)l * 64 + k) * 256 + h * 64 + cc];
        *(LAS bf16_t*)(lds + (which ? CK_A2T : CK_W2T) + cc * P72 + k * 2) = cvt1(v);
    }
    const float mur = p.mu[l * 896 + c], muk = p.mu[l * 896 + 256 + c], muv = p.mu[l * 896 + 512 + c], muw = p.mu[l * 896 + 768 + lane], mua = p.mu[l * 896 + 832 + lane];
    const float w0c = p.w0[l * 256 + c], a0c = p.a0[l * 256 + c], kkc = p.k_k[l * 256 + c], kac = p.k_a[l * 256 + c], rkc = p.r_k[l * 256 + c];
    const int fr = lane & 15, fq = lane >> 4;
    unsigned short xr[5], xk[5], xv[5], xw_[5], xa_[5];
#define CK_LOAD(qq) do { const int b_ = (qq) / NCHK, ch_ = (qq) % NCHK; const bf16_t* ub = U + ((size_t)b_ * SEQ + ch_ * 32 + 4 * wv) * NU + UR; const bool first_ = (ch_ == 0 && wv == 0); \
        _Pragma("unroll") for (int u = 0; u < 5; ++u) { const bf16_t* q_ = ub + (ptrdiff_t)(u - 1 + ((u == 0 && first_) ? 1 : 0)) * NU; \
            xr[u] = q_[c]; xk[u] = q_[256 + c]; xv[u] = q_[512 + c]; xw_[u] = q_[768 + lane]; xa_[u] = q_[832 + lane]; } } while (0)
    if (((int)blockIdx.x >> 2) < NB * NCHK) CK_LOAD((int)blockIdx.x >> 2);
    for (int q = (int)blockIdx.x >> 2; q < NB * NCHK; q += (int)gridDim.x >> 2) {
        const int b = q / NCHK, ch = q % NCHK;
        int lz_ = 0; asm volatile("" : "+v"(lz_)); LAS unsigned char* L_ = lds + lz_;
        const size_t m0 = (size_t)b * SEQ + ch * 32;
        float rl[4], kl[4], vl[4];
        {
            const bool first = (ch == 0 && wv == 0);
#pragma unroll
            for (int u = 0; u < 4; ++u) {
                const float pz = (u == 0 && first) ? 0.f : 1.f;
                const float rc = bf2f(xr[u + 1]), kc = bf2f(xk[u + 1]), vc = bf2f(xv[u + 1]), wc = bf2f(xw_[u + 1]), ac = bf2f(xa_[u + 1]);
                rl[u] = rc + (bf2f(xr[u]) * pz - rc) * mur; kl[u] = kc + (bf2f(xk[u]) * pz - kc) * muk; vl[u] = vc + (bf2f(xv[u]) * pz - vc) * muv;
                const float wl = wc + (bf2f(xw_[u]) * pz - wc) * muw, al = ac + (bf2f(xa_[u]) * pz - ac) * mua;
                const int t = 4 * wv + u;
                *(LAS bf16_t*)(L_ + CK_XW + t * P72 + lane * 2) = cvt1(ftanh(wl));
                *(LAS bf16_t*)(L_ + CK_XA + t * P72 + lane * 2) = cvt1(al);
            }
            const int qn = q + ((int)gridDim.x >> 2);
            if (qn < NB * NCHK) CK_LOAD(qn);
        }
        __syncthreads();
        {
            const int mi = wv >> 2, tr = (wv >> 1) & 1;
#pragma unroll
            for (int i = 0; i < 2; ++i) {
                const int tc = 2 * (wv & 1) + i;
                f32x4 acc = {0.f, 0.f, 0.f, 0.f};
                acc = mma_nt16(acc, L_ + (mi ? CK_XA : CK_XW) + 16 * tr * P72, P72, L_ + (mi ? CK_A2T : CK_W2T) + 16 * tc * P72, P72, 64, lane);
#pragma unroll
                for (int r = 0; r < 4; ++r) *(LAS float*)(L_ + (mi ? CK_SAF : CK_SWF) + (16 * tr + 4 * fq + r) * PSF + (16 * tc + fr) * 4) = acc[r];
            }
        }
        __syncthreads();
        float lw[4], kkv[4], ktv[4], bbv[4], gl[4];
        {
            float run = 0.f;
#pragma unroll
            for (int u = 0; u < 4; ++u) {
                const int t = 4 * wv + u;
                const float sw = *(const LAS float*)(L_ + CK_SWF + t * PSF + lane * 4) + w0c, sa = *(const LAS float*)(L_ + CK_SAF + t * PSF + lane * 4) + a0c;
                lw[u] = -DECAY_SCALE * fsigmoid(sw);
                const float a = fsigmoid(sa);
                const float kx = kl[u] * kkc;
                kkv[u] = kx * __builtin_amdgcn_rsqf(fmaxf(wave_sum_fast(kx * kx), 1e-24f));
                ktv[u] = kl[u] * (1.f + (a - 1.f) * kac); bbv[u] = kkv[u] * a;
                const float bs = wave_sum_fast(rl[u] * ktv[u] * rkc);
                if (lane == 0) BON[(m0 + t) * 4 + h] = bs;
                run += lw[u]; gl[u] = run;
            }
            *(LAS float*)(L_ + CK_TOT + (wv * 64 + lane) * 4) = run;
        }
        __syncthreads();
        {
            float off = 0.f, tot = 0.f;
#pragma unroll
            for (int g = 0; g < 8; ++g) { const float x = *(const LAS float*)(L_ + CK_TOT + (g * 64 + lane) * 4); tot += x; off += (g < wv) ? x : 0.f; }
            const float etot = __expf(tot);
            if (wv == 0) *(LAS float*)(L_ + CK_EGL + lane * 4) = etot;
            float bbe[4], kte[4];
#pragma unroll
            for (int u = 0; u < 4; ++u) {
                const int t = 4 * wv + u;
                const float G = off + gl[u];
                const float e1 = __expf(G - lw[u]), e2 = __expf(G), inv = __builtin_amdgcn_rcpf(e2), el = etot * inv;
                const float ktl = kkv[u] * e1;
                *(LAS bf16_t*)(L_ + CK_KT + t * P72 + lane * 2) = cvt1(ktl);
                *(LAS float*)(L_ + CK_RHS + t * PRHS + lane * 4) = ktl;
                *(LAS bf16_t*)(L_ + CK_RT + t * P72 + lane * 2) = cvt1(rl[u] * e2);
                *(LAS bf16_t*)(L_ + CK_BH + t * P72 + lane * 2) = cvt1(bbv[u] * inv);
                *(LAS bf16_t*)(L_ + CK_KH + t * P72 + lane * 2) = cvt1(ktv[u] * inv);
                bbe[u] = bbv[u] * el; kte[u] = ktv[u] * el;
            }
            *(LAS u32x2*)(L_ + CK_VT + lane * P40 + wv * 8) = (u32x2){cvtpk(vl[0], vl[1]), cvtpk(vl[2], vl[3])};
            *(LAS u32x2*)(L_ + CK_BBT + lane * P40 + wv * 8) = (u32x2){cvtpk(bbe[0], bbe[1]), cvtpk(bbe[2], bbe[3])};
            *(LAS u32x2*)(L_ + CK_KBT + lane * P40 + wv * 8) = (u32x2){cvtpk(kte[0], kte[1]), cvtpk(kte[2], kte[3])};
        }
        __syncthreads();
        {
            const int mi = wv >> 1, tr = wv & 1;
            const LAS unsigned char* A = L_ + ((mi < 2) ? CK_KT : CK_RT) + 16 * tr * P72;
            const LAS unsigned char* Bm = L_ + ((mi & 1) ? CK_KH : CK_BH);
#pragma unroll
            for (int tc = 0; tc < 2; ++tc) {
                f32x4 acc = {0.f, 0.f, 0.f, 0.f};
                acc = mma_nt16(acc, A, P72, Bm + 16 * tc * P72, P72, 64, lane);
#pragma unroll
                for (int r = 0; r < 4; ++r) {
                    const int t = 16 * tr + 4 * fq + r, s_ = 16 * tc + fr;
                    const float x = (mi < 2 ? (s_ < t) : (s_ <= t)) ? acc[r] : 0.f;
                    if (mi == 0) *(LAS float*)(L_ + CK_LF + s_ * PLF + (((t & 3) << 3) + (t >> 2)) * 4) = x;
                    else *(LAS bf16_t*)(L_ + (mi == 1 ? CK_AAK : (mi == 2 ? CK_AQB : CK_AQK)) + t * P40 + s_ * 2) = cvt1(x);
                }
            }
        }
        __syncthreads();
        {
            const int tr = wv >> 2, ic = wv & 3;
            f32x4 acc = {0.f, 0.f, 0.f, 0.f};
            acc = mma_nt16(acc, L_ + CK_AAK + 16 * tr * P40, P40, L_ + CK_VT + 16 * ic * P40, P40, 32, lane);
#pragma unroll
            for (int r = 0; r < 4; ++r) *(LAS float*)(L_ + CK_RHS + (16 * tr + 4 * fq + r) * PRHS + (64 + 16 * ic + fr) * 4) = acc[r];
        }
        __syncthreads();
        {
            const int col = tid >> 2, pq = tid & 3;
            float acc[8];
#pragma unroll
            for (int i = 0; i < 8; ++i) acc[i] = *(const LAS float*)(L_ + CK_RHS + (4 * i + pq) * PRHS + col * 4);
            const LAS unsigned char* lp = L_ + CK_LF + pq * 32;
#pragma unroll
            for (int s_ = 0; s_ < 31; ++s_) {
                const f32x4 l0 = *(const LAS f32x4*)(lp + s_ * PLF), l1 = *(const LAS f32x4*)(lp + s_ * PLF + 16);
                const int xi_ = __builtin_bit_cast(int, acc[s_ >> 2]); int src;
                switch (s_ & 3) { case 0: src = __builtin_amdgcn_update_dpp(0, xi_, 0x00, 0xF, 0xF, true); break; case 1: src = __builtin_amdgcn_update_dpp(0, xi_, 0x55, 0xF, 0xF, true); break;
                                  case 2: src = __builtin_amdgcn_update_dpp(0, xi_, 0xAA, 0xF, 0xF, true); break; default: src = __builtin_amdgcn_update_dpp(0, xi_, 0xFF, 0xF, 0xF, true); break; }
                const float ws = __builtin_bit_cast(float, src);
#pragma unroll
                for (int i = 0; i < 4; ++i) { acc[i] -= l0[i] * ws; acc[4 + i] -= l1[i] * ws; }
                if ((s_ & 7) == 7) asm volatile("" ::: "memory");
            }
            LAS unsigned char* dst = L_ + (col < 64 ? CK_W1T : CK_W2N) + (col & 63) * P40;
#pragma unroll
            for (int i = 0; i < 8; ++i) *(LAS bf16_t*)(dst + (4 * i + pq) * 2) = cvt1(-acc[i]);
        }
        __syncthreads();
        {
            {
                const int tr = wv >> 2, cc = wv & 3;
                f32x4 acc;
#pragma unroll
                for (int r = 0; r < 4; ++r) acc[r] = bf2f(*(const LAS bf16_t*)(L_ + CK_RT + (16 * tr + 4 * fq + r) * P72 + (16 * cc + fr) * 2));
                acc = mma_nt16(acc, L_ + CK_AQB + 16 * tr * P40, P40, L_ + CK_W1T + 16 * cc * P40, P40, 32, lane);
#pragma unroll
                for (int r = 0; r < 4; ++r) { const int t_ = 16 * tr + 4 * fq + r, j_ = 16 * cc + fr; *(LAS bf16_t*)(L_ + CK_OUT + t_ * 128 + ((((j_ >> 3) ^ (t_ & 7)) << 4) | ((j_ & 7) << 1))) = cvt1(acc[r]); }
                f32x4 ac2 = {0.f, 0.f, 0.f, 0.f};
                ac2 = mma_nt16(ac2, L_ + CK_AQK + 16 * tr * P40, P40, L_ + CK_VT + 16 * cc * P40, P40, 32, lane);
                ac2 = mma_nt16(ac2, L_ + CK_AQB + 16 * tr * P40, P40, L_ + CK_W2N + 16 * cc * P40, P40, 32, lane);
                *(LAS u32x2*)(L_ + CK_OUT + 4096 + (tr * 4 + cc) * 512 + lane * 8) = (u32x2){cvtpk(ac2[0], ac2[1]), cvtpk(ac2[2], ac2[3])};
            }
#pragma unroll
            for (int i = 0; i < 2; ++i) {
                const int tl = 2 * wv + i, rr = tl >> 2, cc = tl & 3;
                f32x4 acc = {0.f, 0.f, 0.f, 0.f};
                acc = mma_nt16(acc, L_ + CK_BBT + 16 * rr * P40, P40, L_ + CK_W1T + 16 * cc * P40, P40, 32, lane);
#pragma unroll
                for (int r = 0; r < 4; ++r) { const int jp = 16 * rr + 4 * fq + r, j = 16 * cc + fr;
                    const float x = acc[r] + ((jp == j) ? *(const LAS float*)(L_ + CK_EGL + j * 4) : 0.f);
                    *(LAS bf16_t*)(L_ + CK_OUT + 8192 + jp * 128 + ((((j >> 3) ^ (jp & 7)) << 4) | ((j & 7) << 1))) = cvt1(x); }
                f32x4 ac2 = {0.f, 0.f, 0.f, 0.f};
                ac2 = mma_nt16(ac2, L_ + CK_VT + 16 * rr * P40, P40, L_ + CK_KBT + 16 * cc * P40, P40, 32, lane);
                ac2 = mma_nt16(ac2, L_ + CK_W2N + 16 * rr * P40, P40, L_ + CK_BBT + 16 * cc * P40, P40, 32, lane);
                *(LAS u32x2*)(L_ + CK_OUT + 16384 + tl * 512 + lane * 8) = (u32x2){cvtpk(ac2[0], ac2[1]), cvtpk(ac2[2], ac2[3])};
            }
        }
        __syncthreads();
        {
            unsigned char* dst = CHK + ((size_t)(b * 4 + h) * NCHK + ch) * CHK_B;
#pragma unroll
            for (int i = 0; i < 3; ++i) *(u32x4*)(dst + (i * NTHREADS + tid) * 16) = *(const LAS u32x4*)(L_ + CK_OUT + (i * NTHREADS + tid) * 16);
        }
    }
}

#undef CK_LOAD
__device__ __forceinline__ void glds16g(const void* gsrc, unsigned lds_dst) { unsigned keep;
    asm volatile("s_mov_b32 %0, m0\n\ts_mov_b32 m0, %2\n\ts_nop 0\n\tglobal_load_lds_dwordx4 %1, off\n\ts_mov_b32 m0, %0" : "=&s"(keep) : "v"(gsrc), "s"(lds_dst) : "memory"); }
constexpr int CN_NBUF = 5, CN_RING = 0, CN_SB = CN_NBUF * CHK_B;
__device__ __forceinline__ void phase_rwkv_chain(const Params& p, unsigned char* lds_, int bh) {
    LAS unsigned char* lds = (LAS unsigned char*)lds_;
    const int tid = otid(), lane = tid & 63, wv = __builtin_amdgcn_readfirstlane(tid >> 6);
    const int fr = lane & 15, fq = lane >> 4, b = bh >> 2, h = bh & 3;
    const unsigned char* rec = p.ws + WS_CHK + (size_t)bh * NCHK * CHK_B;
    float* O32 = (float*)(p.ws + WS_O32);
    const unsigned lds0 = (unsigned)(size_t)lds;
#define CN_DMA(cc) do { if (wv < 4) { const unsigned char* g = rec + (size_t)(cc) * CHK_B + (tid & 255) * 16; const unsigned d = (unsigned)__builtin_amdgcn_readfirstlane((int)(lds0 + CN_RING + ((cc) % CN_NBUF) * CHK_B + wv * 1024)); \
        glds16g(g, d); glds16g(g + 4096, d + 4096); glds16g(g + 8192, d + 8192); glds16g(g + 12288, d + 12288); glds16g(g + 16384, d + 16384); glds16g(g + 20480, d + 20480); } } while (0)
    for (int e = tid; e < 2 * 64 * 72 / 2; e += NTHREADS) *(LAS unsigned*)(lds + CN_SB + e * 4) = 0u;
    CN_DMA(0); CN_DMA(1); CN_DMA(2); CN_DMA(3);
    asm volatile("s_waitcnt vmcnt(0) lgkmcnt(0)\n\ts_barrier" ::: "memory");
#pragma unroll 1
    for (int cc = 0; cc < NCHK; ++cc) {
        int lz_ = 0; asm volatile("" : "+v"(lz_)); LAS unsigned char* L_ = lds + lz_;
        const LAS unsigned char* R = L_ + CN_RING + (cc % CN_NBUF) * CHK_B;
        const LAS unsigned char* Sc = L_ + CN_SB + (cc & 1) * (64 * P72);
        LAS unsigned char* Sn = L_ + CN_SB + ((cc + 1) & 1) * (64 * P72);
        if (wv < 4) {
            const int ir = wv;
            f32x4 acc[4];
#pragma unroll
            for (int jc = 0; jc < 4; ++jc) { const u32x2 nm = *(const LAS u32x2*)(R + 16384 + (4 * ir + jc) * 512 + lane * 8); acc[jc] = (f32x4){bflo(nm.x), bfhi(nm.x), bflo(nm.y), bfhi(nm.y)}; }
            const LAS unsigned char* ap = Sc + (16 * ir + fr) * P72 + fq * 16;
            const bf16x8 a0 = *(const LAS bf16x8*)(ap), a1 = *(const LAS bf16x8*)(ap + 64);
#pragma unroll
            for (int jc = 0; jc < 4; ++jc) {
                const LAS unsigned char* bp = R + 8192 + (16 * jc + fr) * 128;
                const bf16x8 b0 = *(const LAS bf16x8*)(bp + ((fq ^ (fr & 7)) << 4)), b1 = *(const LAS bf16x8*)(bp + (((fq + 4) ^ (fr & 7)) << 4));
                acc[jc] = __builtin_amdgcn_mfma_f32_16x16x32_bf16(a0, b0, acc[jc], 0, 0, 0);
                acc[jc] = __builtin_amdgcn_mfma_f32_16x16x32_bf16(a1, b1, acc[jc], 0, 0, 0);
            }
#pragma unroll
            for (int jc = 0; jc < 4; ++jc)
#pragma unroll
                for (int r = 0; r < 4; ++r) *(LAS bf16_t*)(Sn + (16 * ir + 4 * fq + r) * P72 + (16 * jc + fr) * 2) = cvt1(acc[jc][r]);
            if (cc + 4 < NCHK) CN_DMA(cc + 4);
            if (cc + 4 < NCHK) asm volatile("s_waitcnt vmcnt(18) lgkmcnt(0)\n\ts_barrier" ::: "memory");
            else asm volatile("s_waitcnt vmcnt(0) lgkmcnt(0)\n\ts_barrier" ::: "memory");
        } else {
#pragma unroll
            for (int k = 0; k < 2; ++k) {
                const int o = 2 * (wv - 4) + k, tr = o >> 2, ic = o & 3;
                const u32x2 oh = *(const LAS u32x2*)(R + 4096 + o * 512 + lane * 8);
                f32x4 acc = {bflo(oh.x), bfhi(oh.x), bflo(oh.y), bfhi(oh.y)};
                acc = mma_nt16s<true, false>(acc, R + 16 * tr * 128, 128, Sc + 16 * ic * P72, P72, 64, lane);
                float* op = O32 + ((size_t)b * SEQ + cc * 32 + 16 * tr + 4 * fq) * 256 + h * 64 + 16 * ic + fr;
#pragma unroll
                for (int r = 0; r < 4; ++r) op[(size_t)r * 256] = acc[r];
            }
            asm volatile("s_waitcnt lgkmcnt(0)\n\ts_barrier" ::: "memory");
        }
    }
#undef CN_DMA
}

__device__ __forceinline__ void phase_rwkv_fin(const Params& p, int l) {
    const int tid = otid(), lane = tid & 63, wv = tid >> 6;
    const bf16_t* U = (const bf16_t*)(p.ws + WS_U);
    const float* O32 = (const float*)(p.ws + WS_O32); const float* BON = (const float*)(p.ws + WS_BON);
    bf16_t* Y = (bf16_t*)(p.ws + WS_Y);
    const int ngw = gridDim.x * 8;
    for (int m2 = blockIdx.x * 8 + wv; m2 < MTOK / 2; m2 += ngw) {
        float o[8], vc[8], vp[8], g[8], bn[8];
#pragma unroll
        for (int k = 0; k < 8; ++k) {
            const int m = 2 * m2 + (k >> 2), h = k & 3, c = h * 64 + lane;
            const bool has_prev = (m % SEQ) != 0;
            o[k] = O32[(size_t)m * 256 + c];
            vc[k] = bf2f(U[(size_t)m * NU + UR + 512 + c]);
            vp[k] = has_prev ? bf2f(U[(size_t)(m - 1) * NU + UR + 512 + c]) : 0.f;
            g[k] = bf2f(U[(size_t)m * NU + UG + 512 + c]);
            bn[k] = BON[(size_t)m * 4 + h];
        }
#pragma unroll
        for (int k = 0; k < 8; ++k) {
            const int m = 2 * m2 + (k >> 2), h = k & 3, c = h * 64 + lane;
            const float mean = wave_sum_fast(o[k]) * (1.f / 64.f);
            const float dv = o[k] - mean;
            const float var = wave_sum_fast(dv * dv) * (1.f / 64.f);
            const float v = vc[k] + (vp[k] - vc[k]) * p.mu[l * 896 + 512 + c];
            const float on = dv * rsqrtf(var + 64e-5f) * p.ln_g[l * 256 + c] + p.ln_b[l * 256 + c] + bn[k] * v;
            Y[(size_t)m * DM + 512 + c] = (bf16_t)f2bf(on * g[k] * __builtin_amdgcn_rcpf(1.f + __expf(-g[k])));
        }
    }
}

template <int W> __device__ __forceinline__ void pool_item(const bf16_t* up, bf16_t* yp, int t0, float scl) {
    unsigned short xc[16], xp[W - 1], gg[16];
#pragma unroll
    for (int i = 0; i < 16; ++i) { xc[i] = up[(size_t)i * NU]; gg[i] = up[(size_t)i * NU + (UG + 768 - UP)]; }
#pragma unroll
    for (int d = 1; d < W; ++d) xp[d - 1] = (t0 - d >= 0) ? up[-(ptrdiff_t)d * NU] : (unsigned short)0;
    float s = 0.f;
#pragma unroll
    for (int d = 1; d < W; ++d) s += bf2f(xp[d - 1]);
#pragma unroll
    for (int i = 0; i < 16; ++i) {
        const int t = t0 + i;
        const float cur = bf2f(xc[i]);
        s += cur;
        const int cnt = (t + 1 < W) ? t + 1 : W;
        const float yv = (s * __builtin_amdgcn_rcpf((float)cnt) - cur) * scl;
        const float gv = bf2f(gg[i]);
        yp[(size_t)i * DM] = (bf16_t)f2bf(yv * gv * __builtin_amdgcn_rcpf(1.f + __expf(-gv)));
        const int k = i - W + 1;
        s -= (k >= 0) ? bf2f(xc[k >= 0 ? k : 0]) : bf2f(xp[k < 0 ? -k - 1 : 0]);
    }
}
__device__ __forceinline__ void phase_pool(const Params& p, int l) {
    const bf16_t* U = (const bf16_t*)(p.ws + WS_U);
    bf16_t* Y = (bf16_t*)(p.ws + WS_Y);
    const int tid = otid(), c = tid & 255, sub = tid >> 8, g = __builtin_amdgcn_readfirstlane(c >> 6);
    const float scl = p.pool_scale[l * 256 + c];
    for (int it = blockIdx.x * 2 + sub; it < MTOK / 16; it += gridDim.x * 2) {
        const int m0 = it * 16, t0 = m0 % SEQ;
        const bf16_t* up = U + (size_t)m0 * NU + UP + c;
        bf16_t* yp = Y + (size_t)m0 * DM + 768 + c;
        if (g == 0) pool_item<2>(up, yp, t0, scl); else if (g == 1) pool_item<4>(up, yp, t0, scl); else if (g == 2) pool_item<8>(up, yp, t0, scl); else pool_item<16>(up, yp, t0, scl);
    }
}

__global__ void __launch_bounds__(NTHREADS, 2) mega_fwd(Params p) {
    extern __shared__ __attribute__((aligned(16))) unsigned char lds[];
    volatile LAS unsigned* MISC = (volatile LAS unsigned*)((LAS unsigned char*)lds + MISC_OFF);
    if (threadIdx.x < 32) MISC[threadIdx.x] = 0u;
    __syncthreads();
    XcdBarrier bar = xcd_barrier_post((unsigned*)(p.ws + WS_CTL) + CW_BAR, MISC + 8);
#define GRID_BAR() do { XcdBarrier b_ = bar; unsigned* bp_ = (unsigned*)(p.ws + WS_CTL) + CW_BAR; asm volatile("" : "+s"(bp_)); b_.bar = bp_; xcd_barrier(b_); } while (0)
    bf16_t* XN = (bf16_t*)(p.ws + WS_XN); bf16_t* Y = (bf16_t*)(p.ws + WS_Y); bf16_t* U = (bf16_t*)(p.ws + WS_U); bf16_t* Z = (bf16_t*)(p.ws + WS_Z);

    phase_weights(p, lds);
    phase_mod(p, lds);
    GRID_BAR();
    phase_rows(p, 0, 0);
    GRID_BAR();
#pragma unroll 1
    for (int l = 0; l < NL; ++l) {
        const bf16_t* WT = (const bf16_t*)(p.ws + WS_WT) + (size_t)l * NU * DM;
        const bf16_t* WOT = (const bf16_t*)(p.ws + WS_WOT) + (size_t)l * DM * DM;
        {
            pg8::Gemm g{XN, WT, MTOK, NU, DM}; pg8::StaticOrder S; S.init(MTOK, NU, (int)gridDim.x, (int)blockIdx.x);
            pg8::EpiU E{U, p.q_gain + l * 64, p.k_gain + l * 64, NU};
            pg8::gemm_phase<pg8::EpiU, pg8::StaticOrder, true, true>((LAS unsigned char*)lds, g, S, E);
        }
        GRID_BAR();
        phase_cum(p, l, lds);
        phase_rwkv_chunk(p, l, lds);
        phase_pool(p, l);
        GRID_BAR();
        if (blockIdx.x < NB * 4) phase_rwkv_chain(p, lds, (int)blockIdx.x);
        {
            const attn_body::AttnTensors AT{(const attn_body::bf16*)(U + UQ), (const attn_body::bf16*)(U + UK), (const attn_body::bf16*)(U + UV), (const attn_body::bf16*)(U + UG),
                                            (const float*)(p.ws + WS_CB), (const int*)(p.ws + WS_TS), (attn_body::bf16*)Y};
            const attn_body::QueueOrder S{(unsigned*)(p.ws + WS_CTL) + CW_ATTQ + l * 64, MISC + 16};
            attn_body::attn_phase<attn_body::QueueOrder>((char*)lds, AT, S);
        }
        GRID_BAR();
        phase_rwkv_fin(p, l);
        GRID_BAR();
        {
            pg8::Gemm g{Y, WOT, MTOK, DM, DM}; pg8::StaticOrder S; S.init(MTOK, DM, (int)gridDim.x, (int)blockIdx.x);
            pg8::EpiB16 E{Z, DM};
            pg8::gemm_phase<pg8::EpiB16, pg8::StaticOrder, true, true>((LAS unsigned char*)lds, g, S, E);
        }
        GRID_BAR();
        phase_rows(p, 1, l);
        if (l + 1 < NL) GRID_BAR();
    }
}

extern "C" void kernel_launch(void* const* d_in, const int* in_sizes, int n_in, void* d_out, int out_size, void* d_ws, size_t ws_size, hipStream_t stream) {
    static int grid = 0;
    if (grid == 0) {
        if (n_in != 23 || ws_size < WS_END) { fprintf(stderr, "kernel_launch: unexpected n_in %d / ws_size %zu\n", n_in, ws_size); grid = -1; return; }
        int dev = 0, cus = 0, per_cu = 0;
        if (hipGetDevice(&dev) != hipSuccess || hipDeviceGetAttribute(&cus, hipDeviceAttributeMultiprocessorCount, dev) != hipSuccess) { grid = -1; return; }
        if (hipFuncSetAttribute((const void*)mega_fwd, hipFuncAttributeMaxDynamicSharedMemorySize, LDS_BYTES) != hipSuccess) { fprintf(stderr, "kernel_launch: hipFuncSetAttribute failed\n"); grid = -1; return; }
        if (hipOccupancyMaxActiveBlocksPerMultiprocessor(&per_cu, (const void*)mega_fwd, NTHREADS, LDS_BYTES) != hipSuccess || per_cu < 1) { fprintf(stderr, "kernel_launch: occupancy query failed (%d)\n", per_cu); grid = -1; return; }
        grid = cus;
        if (grid <= NB * 8) { fprintf(stderr, "kernel_launch: grid %d too small\n", grid); grid = -1; return; }
    }
    if (grid < 0) return;
    (void)hipMemsetAsync((char*)d_ws + WS_CTL, 0, CTL_ZERO_BYTES, stream);
    Params p{};
    const float** f = (const float**)&p;
    for (int i = 0; i < 23; ++i) f[i] = (const float*)d_in[i];
    p.out = (float*)d_out; p.ws = (unsigned char*)d_ws;
    void* args[] = {&p};
    hipError_t e = hipLaunchCooperativeKernel((const void*)mega_fwd, dim3(grid), dim3(NTHREADS), args, LDS_BYTES, stream);
    if (e != hipSuccess) fprintf(stderr, "cooperative launch failed: %s (grid %d)\n", hipGetErrorString(e), grid);
}
```
